# Optimizing an MI355X kernel written in HIP

```python
import jax, jax.numpy as jnp
from jax import lax
import numpy as np

D_MODEL = 1024
BATCH = 2
SEQ = 8192
DEPTH = 1

CHUNK = 64
Q_BLOCK = 128
RWKV_WIDTH = D_MODEL // 2
RWKV_HEAD = 64
RWKV_HEADS = RWKV_WIDTH // RWKV_HEAD
DECAY_LORA = 64
AAA_LORA = 64
GATE_LORA = 128
DIFF_WIDTH = D_MODEL - RWKV_WIDTH
DIFF_HEAD = 64
DIFF_HEADS = DIFF_WIDTH // (2 * DIFF_HEAD)
MEM_LEN = 256
XATTN_HEADS = 4
XATTN_HEAD = D_MODEL // XATTN_HEADS
N_EXPERTS = 32
TOP_K = 4
D_FF = D_MODEL
SWIGLU_LIMIT = 7.0
SWIGLU_ALPHA = 1.702
MOE_BLOCK = 256
NORM_EPS = 1e-5
GN_EPS = 64e-5
RWKV_COL_SIZES = (RWKV_WIDTH, RWKV_WIDTH, RWKV_WIDTH, DECAY_LORA, AAA_LORA, GATE_LORA)
SHIFT_COLS = sum(RWKV_COL_SIZES)
IN_COLS = SHIFT_COLS + 3 * DIFF_WIDTH

kernel_name = "hybrid_rwkv7_diffattn_moe_block"


def rms_norm(x, g):
    xf = x.astype(jnp.float32)
    y = xf * lax.rsqrt(jnp.mean(xf * xf, axis=-1, keepdims=True) + NORM_EPS)
    return (y * g.astype(jnp.float32)).astype(x.dtype)


def token_shift(p):
    return jnp.pad(p, ((0, 0), (1, 0), (0, 0)))[:, :-1]


def split_cols(p, sizes):
    idx = np.cumsum(sizes)[:-1].tolist()
    return jnp.split(p, idx, axis=-1)


def rwkv7_group(p, mu, w0, w2, a0, a2, g2, k_k, k_a, r_k, lnx_g, lnx_b):
    B, T, _ = p.shape
    H, N = RWKV_HEADS, RWKV_HEAD
    p = p + (token_shift(p) - p) * mu
    r, k, v, wd, ad, gd = split_cols(p, RWKV_COL_SIZES)
    w = -jax.nn.softplus(-(w0 + jnp.tanh(wd) @ w2)) - 0.5
    decay = jnp.exp(-jnp.exp(w.astype(jnp.float32)))
    a = jax.nn.sigmoid(a0 + ad @ a2)
    g = jax.nn.sigmoid(gd) @ g2
    kk = (k * k_k).reshape(B, T, H, N).astype(jnp.float32)
    kk = kk / jnp.maximum(jnp.sqrt(jnp.sum(kk * kk, axis=-1, keepdims=True)), 1e-12)
    k = k * (1.0 + (a - 1.0) * k_a)
    hs = lambda t: jnp.moveaxis(t.reshape(B, T, H, N).astype(jnp.float32), 1, 0)
    rh, kh, vh, ah = hs(r), hs(k), hs(v), hs(a)
    xs = (rh, hs(decay), kh, vh, jnp.moveaxis(kk, 1, 0), ah)

    def step(S, inp):
        rt, wt, kt, vt, kkt, at = inp
        sa = jnp.einsum('bhvk,bhk->bhv', S, -kkt)
        S = S * wt[:, :, None, :] + sa[..., None] * (kkt * at)[:, :, None, :] + vt[..., None] * kt[:, :, None, :]
        return S, jnp.einsum('bhvk,bhk->bhv', S, rt)

    S0 = jnp.zeros((B, H, N, N), jnp.float32)
    _, y = lax.scan(step, S0, xs)
    mean = jnp.mean(y, axis=-1, keepdims=True)
    var = jnp.mean(jnp.square(y - mean), axis=-1, keepdims=True)
    yn = ((y - mean) * lax.rsqrt(var + GN_EPS)).reshape(T, B, H * N)
    yn = yn * lnx_g.astype(jnp.float32) + lnx_b.astype(jnp.float32)
    yn = jnp.moveaxis(yn, 0, 1).reshape(B, T, H, N)
    bonus = jnp.sum(jnp.moveaxis(rh * kh, 0, 1) * r_k.astype(jnp.float32), axis=-1, keepdims=True) * jnp.moveaxis(vh, 0, 1)
    out = (yn + bonus).reshape(B, T, H * N).astype(p.dtype) * g
    return out


def diff_attn_group(q, k, v, lam_q1, lam_k1, lam_q2, lam_k2, subln_g, lambda_init):
    B, T, _ = q.shape
    H, d = DIFF_HEADS, DIFF_HEAD
    NB = T // Q_BLOCK
    qh = jnp.transpose(q.reshape(B, T, H, 2, d), (0, 2, 3, 1, 4))
    kh = jnp.transpose(k.reshape(B, T, H, 2, d), (0, 2, 3, 1, 4))
    vh = jnp.transpose(v.reshape(B, T, H, 2 * d), (0, 2, 1, 3))
    lam = (jnp.exp(jnp.sum(lam_q1.astype(jnp.float32) * lam_k1.astype(jnp.float32)))
           - jnp.exp(jnp.sum(lam_q2.astype(jnp.float32) * lam_k2.astype(jnp.float32))) + lambda_init)
    scale = d ** -0.5
    qb = jnp.moveaxis(qh.reshape(B, H, 2, NB, Q_BLOCK, d), 3, 0)
    k_chunk = jnp.arange(T) // CHUNK

    def block(args):
        qi, bi = args
        s = jnp.einsum('bhcqd,bhckd->bhcqk', qi, kh).astype(jnp.float32) * scale
        q_chunk = (bi * Q_BLOCK + jnp.arange(Q_BLOCK)) // CHUNK
        allowed = k_chunk[None, :] <= q_chunk[:, None]
        s = jnp.where(allowed, s, -1e30)
        pr = jax.nn.softmax(s, axis=-1)
        attn = pr[:, :, 0] - lam * pr[:, :, 1]
        return jnp.einsum('bhqk,bhkd->bhqd', attn.astype(vh.dtype), vh)

    o = lax.map(block, (qb, jnp.arange(NB)))
    o = jnp.moveaxis(o, 0, 2).reshape(B, H, T, 2 * d)
    o = rms_norm(o, subln_g) * (1.0 - lambda_init)
    return jnp.transpose(o, (0, 2, 1, 3)).reshape(B, T, H * 2 * d)


def cross_attn(hn, memn, wq, wkv, wo):
    B, T, _ = hn.shape
    q = (hn @ wq).reshape(B, T, XATTN_HEADS, XATTN_HEAD)
    kv = memn @ wkv
    km, vm = jnp.split(kv, 2, axis=-1)
    km = km.reshape(B, MEM_LEN, XATTN_HEADS, XATTN_HEAD)
    vm = vm.reshape(B, MEM_LEN, XATTN_HEADS, XATTN_HEAD)
    s = jnp.einsum('bqhd,bkhd->bhqk', q, km).astype(jnp.float32) * (XATTN_HEAD ** -0.5)
    pr = jax.nn.softmax(s, axis=-1).astype(vm.dtype)
    o = jnp.einsum('bhqk,bkhd->bqhd', pr, vm).reshape(B, T, D_MODEL)
    return o @ wo


def moe(xn, router_w, router_b, w1, b1, w2, b2):
    B, T, D = xn.shape
    N = B * T
    xf = xn.reshape(N, D)
    logits = (xf @ router_w + router_b).astype(jnp.float32)
    top_v, top_i = lax.top_k(logits, TOP_K)
    gates = jax.nn.softmax(top_v, axis=-1).astype(xn.dtype)
    M = N * TOP_K
    flat_e = top_i.reshape(M).astype(jnp.int32)
    flat_tok = jnp.repeat(jnp.arange(N, dtype=jnp.int32), TOP_K)
    flat_g = gates.reshape(M)
    order = jnp.argsort(flat_e, stable=True)
    sorted_e = flat_e[order]
    counts = jnp.bincount(flat_e, length=N_EXPERTS).astype(jnp.int32)
    offsets = jnp.cumsum(counts) - counts
    padded_counts = ((counts + MOE_BLOCK - 1) // MOE_BLOCK) * MOE_BLOCK
    padded_end = jnp.cumsum(padded_counts)
    padded_off = padded_end - padded_counts
    dest = padded_off[sorted_e] + (jnp.arange(M, dtype=jnp.int32) - offsets[sorted_e])
    P = M + N_EXPERTS * MOE_BLOCK
    NBLK = P // MOE_BLOCK
    row_tok = jnp.full((P,), N, jnp.int32).at[dest].set(flat_tok[order])
    row_g = jnp.zeros((P,), xn.dtype).at[dest].set(flat_g[order])
    block_start = jnp.arange(NBLK, dtype=jnp.int32) * MOE_BLOCK
    block_e = jnp.minimum(jnp.sum(block_start[:, None] >= padded_end[None, :], axis=1), N_EXPERTS - 1)
    x_pad = jnp.concatenate([xf, jnp.zeros((1, D), xf.dtype)], axis=0)
    xin = x_pad[row_tok].reshape(NBLK, MOE_BLOCK, D)

    def expert_block(args):
        xb, e = args
        h = xb @ w1[e] + b1[e]
        gate, lin = jnp.split(h, 2, axis=-1)
        gate = jnp.minimum(gate, SWIGLU_LIMIT)
        lin = jnp.clip(lin, -SWIGLU_LIMIT, SWIGLU_LIMIT)
        act = gate * jax.nn.sigmoid(SWIGLU_ALPHA * gate) * (lin + 1.0)
        return act @ w2[e] + b2[e]

    yb = lax.map(expert_block, (xin, block_e)).reshape(P, D) * row_g[:, None]
    y = jax.ops.segment_sum(yb, row_tok, num_segments=N + 1)[:N]
    return y.reshape(B, T, D)


def setup_inputs(seed: int = 0) -> dict:
    key = jax.random.key(seed)
    ks = iter(jax.random.split(key, 40))
    L, D, E, F = DEPTH, D_MODEL, N_EXPERTS, D_FF
    nrm = lambda shape, s: jax.random.normal(next(ks), shape, jnp.float32) * s
    ratio = jnp.linspace(0.0, 1.0, RWKV_WIDTH, dtype=jnp.float32)
    return {
        "x": nrm((BATCH, SEQ, D), 1.0),
        "mem": nrm((BATCH, MEM_LEN, D), 1.0),
        "norm1_g": 1.0 + nrm((L, D), 0.02),
        "w_in": nrm((L, D, IN_COLS), D ** -0.5),
        "mu_shift": jax.random.uniform(next(ks), (L, SHIFT_COLS), jnp.float32),
        "w0": (-6.5 + 5.0 * ratio ** 0.9)[None, :] + nrm((L, RWKV_WIDTH), 0.1),
        "w2": nrm((L, DECAY_LORA, RWKV_WIDTH), 0.1 * DECAY_LORA ** -0.5),
        "a0": nrm((L, RWKV_WIDTH), 0.1),
        "a2": nrm((L, AAA_LORA, RWKV_WIDTH), AAA_LORA ** -0.5),
        "g2": nrm((L, GATE_LORA, RWKV_WIDTH), GATE_LORA ** -0.5),
        "k_k": 0.85 + nrm((L, RWKV_WIDTH), 0.02),
        "k_a": 1.0 + nrm((L, RWKV_WIDTH), 0.02),
        "r_k": nrm((L, RWKV_HEADS, RWKV_HEAD), 0.1),
        "lnx_g": 1.0 + nrm((L, RWKV_WIDTH), 0.02),
        "lnx_b": nrm((L, RWKV_WIDTH), 0.02),
        "lam_q1": nrm((L, DIFF_HEAD), 0.1),
        "lam_k1": nrm((L, DIFF_HEAD), 0.1),
        "lam_q2": nrm((L, DIFF_HEAD), 0.1),
        "lam_k2": nrm((L, DIFF_HEAD), 0.1),
        "subln_g": 1.0 + nrm((L, 2 * DIFF_HEAD), 0.02),
        "w_out": nrm((L, D, D), D ** -0.5),
        "norm2_g": 1.0 + nrm((L, D), 0.02),
        "mem_norm_g": 1.0 + nrm((L, D), 0.02),
        "wq_x": nrm((L, D, D), D ** -0.5),
        "wkv_x": nrm((L, D, 2 * D), D ** -0.5),
        "wo_x": nrm((L, D, D), D ** -0.5),
        "norm3_g": 1.0 + nrm((L, D), 0.02),
        "router_w": nrm((L, D, E), D ** -0.5),
        "router_b": nrm((L, E), 0.01),
        "moe_w1": nrm((L, E, D, 2 * F), D ** -0.5),
        "moe_b1": nrm((L, E, 2 * F), 0.01),
        "moe_w2": nrm((L, E, F, D), F ** -0.5),
        "moe_b2": nrm((L, E, D), 0.01),
        "final_g": 1.0 + nrm((D,), 0.02),
    }


def reference(x, mem, norm1_g, w_in, mu_shift, w0, w2, a0, a2, g2, k_k, k_a, r_k, lnx_g, lnx_b,
              lam_q1, lam_k1, lam_q2, lam_k2, subln_g, w_out, norm2_g, mem_norm_g, wq_x, wkv_x, wo_x,
              norm3_g, router_w, router_b, moe_w1, moe_b1, moe_w2, moe_b2, final_g):
    h = x
    for i in range(DEPTH):
        lambda_init = 0.8 - 0.6 * float(np.exp(-0.3 * i))
        xn = rms_norm(h, norm1_g[i])
        proj = xn @ w_in[i]
        p_rwkv = proj[..., :SHIFT_COLS]
        q_d, k_d, v_d = split_cols(proj[..., SHIFT_COLS:], (DIFF_WIDTH, DIFF_WIDTH, DIFF_WIDTH))
        y_rwkv = rwkv7_group(p_rwkv, mu_shift[i], w0[i], w2[i], a0[i], a2[i], g2[i],
                             k_k[i], k_a[i], r_k[i], lnx_g[i], lnx_b[i])
        y_diff = diff_attn_group(q_d, k_d, v_d, lam_q1[i], lam_k1[i], lam_q2[i], lam_k2[i],
                                 subln_g[i], lambda_init)
        h = h + jnp.concatenate([y_rwkv, y_diff], axis=-1) @ w_out[i]
        h = h + cross_attn(rms_norm(h, norm2_g[i]), rms_norm(mem, mem_norm_g[i]), wq_x[i], wkv_x[i], wo_x[i])
        h = h + moe(rms_norm(h, norm3_g[i]), router_w[i], router_b[i], moe_w1[i], moe_b1[i], moe_w2[i], moe_b2[i])
    return rms_norm(h, final_g)
```

```cpp
#include <hip/hip_runtime.h>
#include <cstdio>
#include <cstdint>

#define GAS __attribute__((address_space(1)))
#define LAS __attribute__((address_space(3)))
typedef unsigned short bf16;
typedef short bf16x8 __attribute__((ext_vector_type(8)));
typedef short bf16x4 __attribute__((ext_vector_type(4)));
typedef float f32x4 __attribute__((ext_vector_type(4)));
typedef float f32x2 __attribute__((ext_vector_type(2)));
typedef unsigned u32x4 __attribute__((ext_vector_type(4)));
typedef unsigned u32x2 __attribute__((ext_vector_type(2)));
typedef GAS unsigned gu32;
#define RLX_AGENT __ATOMIC_RELAXED, __HIP_MEMORY_SCOPE_AGENT
#define LDS_WAIT() asm volatile("s_waitcnt lgkmcnt(0)" ::: "memory")
#define VM_WAIT() asm volatile("s_waitcnt vmcnt(0)" ::: "memory")

typedef __bf16 bf16x2_t __attribute__((ext_vector_type(2)));
__device__ __forceinline__ unsigned cvt_pk_bf16(float lo, float hi) { const f32x2 v = {lo, hi}; const bf16x2_t b = __builtin_convertvector(v, bf16x2_t); return __builtin_bit_cast(unsigned, b); }
__device__ __forceinline__ unsigned f2bf(float f) { unsigned u = __builtin_bit_cast(unsigned, f); return (u + 0x7fffu + ((u >> 16) & 1u)) >> 16; }
__device__ __forceinline__ unsigned pk2(float lo, float hi) { return f2bf(lo) | (f2bf(hi) << 16); }
__device__ __forceinline__ float bf2f(bf16 b) { return __builtin_bit_cast(float, (unsigned)b << 16); }
__device__ __forceinline__ float bflo(unsigned u) { return __builtin_bit_cast(float, u << 16); }
__device__ __forceinline__ float bfhi(unsigned u) { return __builtin_bit_cast(float, u & 0xffff0000u); }
__device__ __forceinline__ float fexp2(float x) { return __builtin_amdgcn_exp2f(x); }
__device__ __forceinline__ float fexp(float x) { return __builtin_amdgcn_exp2f(x * 1.4426950408889634f); }
__device__ __forceinline__ float frcp(float x) { return __builtin_amdgcn_rcpf(x); }
__device__ __forceinline__ float sigmoidf_(float x) { return frcp(1.0f + fexp(-x)); }

namespace pg8 {
constexpr int BM = 256, BK = 64, HALF = 128, HTB = HALF * BK * 2  , STAGE_BYTES = 8 * HTB, NXCD = 8, WGM = 8;
__host__ __device__ __forceinline__ int lds_byte(int r, int c) { const int st = (r >> 4) * 2 + (c >> 5), rr = r & 15, cc = c & 31, ob = rr * 64 + cc * 2; return st * 1024 + (ob ^ (((ob >> 9) & 1) << 5)); }
__host__ __device__ __forceinline__ void stage_rc(int b, int& R, int& C) { const int st = b / 1024, sb = b % 1024, swz = sb ^ (((sb >> 9) & 1) << 5); R = (st >> 1) * 16 + swz / 64; C = (st & 1) * 32 + (swz % 64) / 2; }
__host__ __device__ __forceinline__ int perm32(int rho) { const int n = rho >> 4, i = rho & 15; return 8 * (i >> 2) + 4 * n + (i & 3); }

struct Unit { int pm, pn, e, nvalid, lbase, orow; };
struct Gemm { const bf16* A; const bf16* Bt; int K; size_t bstride; const int* rowlist; };

struct StaticOrder {
    int nM, nN, nwg, G, c;
    __device__ void init(int M, int N, int G_, int c_, int rot) { nM = M / BM; nN = N / BM; nwg = nM * nN; G = G_; c = (c_ + rot) % G_; }
    __device__ bool next(int i, Unit& u) const {
        const long L = (long)i * G + c; if (L >= nwg) return false;
        int wgid = (int)L; { const int q = nwg / NXCD, r = nwg % NXCD, xcd = wgid % NXCD, off = wgid / NXCD; wgid = (xcd < r ? xcd * (q + 1) : r * (q + 1) + (xcd - r) * q) + off; }
        const int nig = WGM * nN, gid = wgid / nig, fm = gid * WGM, gsz = (nM - fm) < WGM ? (nM - fm) : WGM;
        u.pm = fm + ((wgid % nig) % gsz); u.pn = (wgid % nig) / gsz; u.e = 0; u.nvalid = 256; u.lbase = 0; u.orow = u.pm * BM; return true;
    }
};

template <class Epi, class Sched, bool ALIGN_EPI, bool GATHER>
__device__ __forceinline__ void gemm_phase(LAS unsigned char* lds, LAS int* lstage  , const Gemm g, const Sched& S, const Epi& E) {
    int tid = threadIdx.x; asm volatile("" : "+v"(tid));
    const int wid = __builtin_amdgcn_readfirstlane(tid >> 6), lane = tid & 63, wr = wid >> 2, wc = wid & 3, fr = lane & 15, fq = lane >> 4;
    const int K = g.K, nt = K / BK;
    unsigned voffB[2], vA[2][2];
#pragma unroll
    for (int i = 0; i < 2; ++i) { int R, C; stage_rc(tid * 16 + i * 8192, R, C); const int Rb = Epi::PERM ? ((R & ~31) + perm32(R & 31)) : R;
        voffB[i] = (unsigned)(Rb * K + C) * 2u;
#pragma unroll
        for (int h = 0; h < 2; ++h) vA[h][i] = (unsigned)((h * HALF + R) * K + C) * 2u; }
    const size_t kstep = (size_t)(BK * 2);
    const size_t hstep = (size_t)HALF * K * 2;
    const size_t tstep = 2 * hstep;
    const unsigned ldsw = (unsigned)wid * 1024u;
    const int aoff = lds_byte(wr * 64 + fr, fq * 8), boff = lds_byte(wc * 32 + fr, fq * 8);
#define PG8_SA(b, h) (((b) * 2 + (h)) * HTB)
#define PG8_SB(b, h) ((4 + (b) * 2 + (h)) * HTB)
#define PG8_STAGE(bufoff, gbase, voff) do { _Pragma("unroll") for (int _i = 0; _i < 2; ++_i) \
        __builtin_amdgcn_global_load_lds((const unsigned*)((const char*)(gbase) + (voff)[_i]), (LAS unsigned*)(lds + (bufoff) + ldsw + _i * 8192), 16, 0, 0); } while (0)
#define PG8_LDA(dst, b, h) do { _Pragma("unroll") for (int m = 0; m < 4; ++m) _Pragma("unroll") for (int k = 0; k < 2; ++k) dst[m][k] = *(const LAS bf16x8*)(lds + PG8_SA(b, h) + aoff + m * 2048 + k * 1024); } while (0)
#define PG8_LDB(dst, b, h) do { _Pragma("unroll") for (int n = 0; n < 2; ++n) _Pragma("unroll") for (int k = 0; k < 2; ++k) dst[n][k] = *(const LAS bf16x8*)(lds + PG8_SB(b, h) + boff + n * 2048 + k * 1024); } while (0)
#define PG8_MMA(ai, bj, At, Bt) do { __builtin_amdgcn_s_setprio(1); _Pragma("unroll") for (int m = 0; m < 4; ++m) _Pragma("unroll") for (int n = 0; n < 2; ++n) _Pragma("unroll") for (int k = 0; k < 2; ++k) \
        acc[ai][bj][m][n] = __builtin_amdgcn_mfma_f32_16x16x32_bf16(Bt[n][k], At[m][k], acc[ai][bj][m][n], 0, 0, 0); __builtin_amdgcn_s_setprio(0); } while (0)
#define PG8_WAIT_V(n) asm volatile("s_waitcnt vmcnt(" #n ")" ::: "memory")
#define PG8_WAIT_L(n) asm volatile("s_waitcnt lgkmcnt(" #n ")" ::: "memory")
#define PG8_BAR __builtin_amdgcn_s_barrier()
#define PG8_SCHED __builtin_amdgcn_sched_barrier(0)
    Unit cur, nxt; int ui = 0;
    if (!S.next(0, cur)) return;
    f32x4 acc[2][2][4][2];
#pragma unroll
    for (int a = 0; a < 2; ++a)
#pragma unroll
        for (int b = 0; b < 2; ++b)
#pragma unroll
            for (int m = 0; m < 4; ++m)
#pragma unroll
                for (int n = 0; n < 2; ++n) acc[a][b][m][n] = (f32x4){0.f, 0.f, 0.f, 0.f};
    bf16x8 At[4][2], B0[2][2], B1[2][2];
    const char* cA = (const char*)g.A + (GATHER ? (size_t)0 : (size_t)cur.pm * tstep);
    const char* cB = (const char*)g.Bt + ((size_t)cur.e * g.bstride) * 2 + (size_t)cur.pn * tstep;
    if constexpr (GATHER) {
        if (wid == 0) { unsigned lo16 = threadIdx.x; asm volatile("" : "+v"(lo16)); lo16 = (lo16 & 63u) * 16u; __builtin_amdgcn_global_load_lds((const unsigned*)((const char*)(g.rowlist + cur.lbase) + lo16), (LAS unsigned*)lstage, 16, 0, 0); }
        PG8_WAIT_V(0); __builtin_amdgcn_s_barrier();
#pragma unroll
        for (int h = 0; h < 2; ++h)
#pragma unroll
            for (int i = 0; i < 2; ++i) { int R, C; stage_rc(tid * 16 + i * 8192, R, C); const int rr = h * HALF + R; const int ent = lstage[rr]; const int src = rr < cur.nvalid ? ((ent >> 2) & 16383) : 0; vA[h][i] = (unsigned)(src * K + C) * 2u; }
        PG8_WAIT_L(0); __builtin_amdgcn_s_barrier();
    }
    PG8_STAGE(PG8_SB(0, 0), cB, voffB); PG8_STAGE(PG8_SB(0, 1), cB + hstep, voffB); PG8_STAGE(PG8_SA(0, 0), cA, vA[0]); PG8_STAGE(PG8_SA(0, 1), cA, vA[1]);
    if (wr == 1) PG8_BAR;
    PG8_WAIT_V(2); PG8_BAR;
    PG8_STAGE(PG8_SB(1, 0), cB + kstep, voffB); PG8_STAGE(PG8_SA(1, 0), cA + kstep, vA[0]); PG8_STAGE(PG8_SB(1, 1), cB + hstep + kstep, voffB);
    PG8_WAIT_V(6); PG8_BAR;
    for (;;) {
        const bool has_next = S.next(ui + 1, nxt);
        const char* nA = has_next ? (const char*)g.A + (GATHER ? (size_t)0 : (size_t)nxt.pm * tstep) : cA;
        const char* nB = has_next ? (const char*)g.Bt + ((size_t)nxt.e * g.bstride) * 2 + (size_t)nxt.pn * tstep : cB;
        for (int t = 0; t < nt; t += 2) {
            const bool last = (t == nt - 2);
            if constexpr (GATHER) {
                if (t == 0 && has_next && wid == 0) { unsigned lo16 = threadIdx.x; asm volatile("" : "+v"(lo16)); lo16 = (lo16 & 63u) * 16u;
                    __builtin_amdgcn_global_load_lds((const unsigned*)((const char*)(g.rowlist + nxt.lbase) + lo16), (LAS unsigned*)(lstage + 256 * ((ui + 1) & 1)), 16, 0, 0); }
            }
            const char* a1 = cA + (size_t)(t + 1) * kstep;
            const char* a2 = last ? nA : cA + (size_t)(t + 2) * kstep; const char* b2 = last ? nB : cB + (size_t)(t + 2) * kstep;
            const char* a3 = a2 + kstep; const char* b3 = b2 + kstep;
            PG8_LDB(B0, 0, 0); PG8_LDB(B1, 0, 1); PG8_SCHED; PG8_LDA(At, 0, 0); PG8_STAGE(PG8_SA(1, 1), a1, vA[1]);
            if constexpr (GATHER) { if (last && has_next) {
                int tl = tid; asm volatile("" : "+v"(tl));
#pragma unroll
                for (int h = 0; h < 2; ++h)
#pragma unroll
                    for (int i = 0; i < 2; ++i) { int R, C; stage_rc(tl * 16 + i * 8192, R, C); const int rr = h * HALF + R; const int ent = lstage[256 * ((ui + 1) & 1) + rr]; const int src = rr < nxt.nvalid ? ((ent >> 2) & 16383) : 0; vA[h][i] = (unsigned)(src * K + C) * 2u; } } }
            PG8_WAIT_V(8); PG8_WAIT_L(0); PG8_BAR; PG8_MMA(0, 0, At, B0); PG8_MMA(0, 1, At, B1); PG8_BAR; PG8_SCHED;
            PG8_LDA(At, 0, 1); PG8_STAGE(PG8_SB(0, 0), b2, voffB); PG8_STAGE(PG8_SB(0, 1), b2 + hstep, voffB); PG8_STAGE(PG8_SA(0, 0), a2, vA[0]);
            PG8_WAIT_V(8); PG8_WAIT_L(0); PG8_BAR; PG8_MMA(1, 0, At, B0); PG8_MMA(1, 1, At, B1); PG8_BAR; PG8_SCHED;
            PG8_LDB(B0, 1, 0); PG8_LDB(B1, 1, 1); PG8_SCHED; PG8_LDA(At, 1, 0); PG8_STAGE(PG8_SA(0, 1), a2, vA[1]);
            PG8_WAIT_V(8); PG8_WAIT_L(0); PG8_BAR; PG8_MMA(0, 0, At, B0); PG8_MMA(0, 1, At, B1); PG8_BAR; PG8_SCHED;
            PG8_LDA(At, 1, 1); PG8_STAGE(PG8_SB(1, 0), b3, voffB); PG8_STAGE(PG8_SB(1, 1), b3 + hstep, voffB); PG8_STAGE(PG8_SA(1, 0), a3, vA[0]);
            PG8_WAIT_V(8); PG8_WAIT_L(0); PG8_BAR; PG8_MMA(1, 0, At, B0); PG8_MMA(1, 1, At, B1); PG8_BAR; PG8_SCHED;
        }
        if constexpr (ALIGN_EPI) { if (wr == 0) PG8_BAR; }
        E(acc, cur, wr, wc, fr, fq);
        if (!has_next) break;
#pragma unroll
        for (int a = 0; a < 2; ++a)
#pragma unroll
            for (int b = 0; b < 2; ++b)
#pragma unroll
                for (int m = 0; m < 4; ++m)
#pragma unroll
                    for (int n = 0; n < 2; ++n) acc[a][b][m][n] = (f32x4){0.f, 0.f, 0.f, 0.f};
        cur = nxt; cA = nA; cB = nB; ++ui;
        if constexpr (ALIGN_EPI) { if (wr == 1) PG8_BAR; }
    }
    PG8_WAIT_V(0);
    if constexpr (!ALIGN_EPI) { if (wr == 0) PG8_BAR; }
    PG8_BAR;
#undef PG8_SA
#undef PG8_SB
#undef PG8_STAGE
#undef PG8_LDA
#undef PG8_LDB
#undef PG8_MMA
#undef PG8_WAIT_V
#undef PG8_WAIT_L
#undef PG8_BAR
#undef PG8_SCHED
}
}
constexpr int NWAVES = 8, NTHR = 512;
constexpr int BATCH = 2, T = 8192, D = 1024, M = BATCH * T;
constexpr int CH = 64, NCHUNK = T / CH;
constexpr int RW = 512, RH = 8, RN = 64;
constexpr int DH = 4, DD = 64, DV = 128;
constexpr int SHIFT_COLS = 1792, PCOLS = 2816, IN_COLS = 3328;
constexpr int C_R = 0, C_K = 512, C_V = 1024, C_WD = 1536, C_AD = 1600, C_GD = 1664, C_QD = 1792, C_KD = 2304, C_VD = 2816;
constexpr int MEM = 256, XH = 4, XD = 256;
constexpr int NE = 32, TOPK = 4, FF = 1024, CAP = M;
constexpr int MAXRT = (M * TOPK) / 256 + NE;
constexpr float NORM_EPS = 1e-5f, GN_EPS = 64e-5f, LOG2E = 1.4426950408889634f;
constexpr float LAMBDA_INIT = 0.8f - 0.6f;

constexpr size_t MiB = 1u << 20;
constexpr size_t WS_CTL = 0, CTL_ZERO_BYTES = 1 * MiB;
constexpr size_t WS_SS1 = 250 * MiB + 512 * 1024, WS_SS3 = 251 * MiB;
constexpr size_t WS_WINT = 1 * MiB, WS_WOUTT = 8 * MiB, WS_WQT = 10 * MiB, WS_WKVT = 12 * MiB, WS_WOT = 16 * MiB;
constexpr size_t WS_W2LT = 18 * MiB, WS_A2LT = WS_W2LT + 64 * 1024, WS_G2LT = WS_W2LT + 128 * 1024, WS_RWT = WS_W2LT + 256 * 1024;
constexpr size_t WS_W1T = 20 * MiB, WS_W2T = 148 * MiB;
constexpr size_t WS_LGATE = 212 * MiB, WS_LRINV = 214 * MiB;
constexpr size_t WS_XN = 212 * MiB, WS_MEMN = 244 * MiB, WS_KMEM = 245 * MiB, WS_VTMEM = 246 * MiB;
constexpr size_t WS_LISTS = 247 * MiB, WS_GATES = 249 * MiB, WS_GC = 249 * MiB + 512 * 1024, WS_BS = 250 * MiB;
constexpr size_t WS_PROJ = 252 * MiB, WS_VT = 340 * MiB, WS_QT = 356 * MiB, WS_PT = 372 * MiB, WS_S0 = 388 * MiB, WS_GATE = 404 * MiB, WS_YLOC = 420 * MiB, WS_NN = 452 * MiB;
constexpr size_t WS_CAT = 484 * MiB, WS_H1 = 516 * MiB, WS_H1B = 580 * MiB, WS_QX = 612 * MiB, WS_XO = 644 * MiB, WS_H2 = 676 * MiB, WS_H2B = 740 * MiB;
constexpr size_t WS_ACT = 252 * MiB;
constexpr size_t WS_YBUF = 404 * MiB, WS_END = 772 * MiB;
static_assert(WS_ACT + (size_t)MAXRT * 256 * FF * 2 <= WS_GATE, "ACT overlay");
static_assert(WS_PROJ + (size_t)M * PCOLS * 2 <= WS_VT, "PROJ");
constexpr int CW_TMO = 0, CW_BAR = 4096, CW_CNT = 8192;
static_assert((CW_BAR + 3456) <= CW_CNT && (CW_CNT + 64 * NE) * 4 <= (int)CTL_ZERO_BYTES, "CTL map");

constexpr int RING_BYTES = 131072;
constexpr int X_OFF = RING_BYTES;
constexpr int MISC_OFF = 163840 - 1024;
constexpr int LDS_BYTES = 163840;

__device__ __forceinline__ float row_ss(const float* ssp, int row) {
    const f32x4 a = *(const f32x4*)(ssp + (size_t)row * 16), b = *(const f32x4*)(ssp + (size_t)row * 16 + 4), c = *(const f32x4*)(ssp + (size_t)row * 16 + 8), d = *(const f32x4*)(ssp + (size_t)row * 16 + 12);
    return (((a[0] + a[1]) + (a[2] + a[3])) + ((b[0] + b[1]) + (b[2] + b[3]))) + (((c[0] + c[1]) + (c[2] + c[3])) + ((d[0] + d[1]) + (d[2] + d[3])));
}
namespace pg8 {
struct EpiBf16 {
    static constexpr bool PERM = true;
    bf16* O; int ldc;
    __device__ __forceinline__ void operator()(const f32x4 (&acc)[2][2][4][2], const Unit& u, int wr, int wc, int fr, int fq) const {
        { unsigned tl = threadIdx.x; asm volatile("" : "+v"(tl)); fr = (int)(tl & 15u); fq = (int)((tl >> 4) & 3u); }
        const int col0 = u.pn * BM + wc * 32 + 8 * fq;
#pragma unroll
        for (int ai = 0; ai < 2; ++ai)
#pragma unroll
            for (int m = 0; m < 4; ++m) { bf16* rowp = O + (size_t)(u.orow + ai * HALF + wr * 64 + m * 16 + fr) * ldc + col0;
#pragma unroll
                for (int bj = 0; bj < 2; ++bj) { const f32x4 v0 = acc[ai][bj][m][0], v1 = acc[ai][bj][m][1];
                    u32x4 w; w.x = cvt_pk_bf16(v0[0], v0[1]); w.y = cvt_pk_bf16(v0[2], v0[3]); w.z = cvt_pk_bf16(v1[0], v1[1]); w.w = cvt_pk_bf16(v1[2], v1[3]);
                    *(u32x4*)(rowp + bj * HALF) = w; } }
    }
};
struct EpiRowScaleBf16 {
    static constexpr bool PERM = true;
    bf16* O; int ldc; const float* ss; float scale;
    __device__ __forceinline__ void operator()(const f32x4 (&acc)[2][2][4][2], const Unit& u, int wr, int wc, int fr, int fq) const {
        { unsigned tl = threadIdx.x; asm volatile("" : "+v"(tl)); fr = (int)(tl & 15u); fq = (int)((tl >> 4) & 3u); }
        const int col0 = u.pn * BM + wc * 32 + 8 * fq;
#pragma unroll
        for (int ai = 0; ai < 2; ++ai)
#pragma unroll
            for (int m = 0; m < 4; ++m) { const int row = u.orow + ai * HALF + wr * 64 + m * 16 + fr; bf16* rowp = O + (size_t)row * ldc + col0;
                const float s = scale * __builtin_amdgcn_rsqf(row_ss(ss, row) * (1.0f / D) + NORM_EPS);
#pragma unroll
                for (int bj = 0; bj < 2; ++bj) { const f32x4 v0 = acc[ai][bj][m][0] * s, v1 = acc[ai][bj][m][1] * s;
                    u32x4 w; w.x = cvt_pk_bf16(v0[0], v0[1]); w.y = cvt_pk_bf16(v0[2], v0[3]); w.z = cvt_pk_bf16(v1[0], v1[1]); w.w = cvt_pk_bf16(v1[2], v1[3]);
                    *(u32x4*)(rowp + bj * HALF) = w; } }
    }
};
struct EpiResid {
    static constexpr bool PERM = true;
    const float* base; float* H; bf16* Hb; float* ss;
    __device__ __forceinline__ void operator()(const f32x4 (&acc)[2][2][4][2], const Unit& u, int wr, int wc, int fr, int fq) const {
        { unsigned tl = threadIdx.x; asm volatile("" : "+v"(tl)); fr = (int)(tl & 15u); fq = (int)((tl >> 4) & 3u); }
        const int col0 = u.pn * BM + wc * 32 + 8 * fq;
#pragma unroll
        for (int ai = 0; ai < 2; ++ai)
#pragma unroll
            for (int m = 0; m < 4; ++m) { const int row = u.orow + ai * HALF + wr * 64 + m * 16 + fr; const size_t off = (size_t)row * D + col0; float q = 0.f;
#pragma unroll
                for (int bj = 0; bj < 2; ++bj) {
                    const f32x4 b0 = *(const f32x4*)(base + off + bj * HALF), b1 = *(const f32x4*)(base + off + bj * HALF + 4);
                    const f32x4 v0 = acc[ai][bj][m][0] + b0, v1 = acc[ai][bj][m][1] + b1;
                    *(f32x4*)(H + off + bj * HALF) = v0; *(f32x4*)(H + off + bj * HALF + 4) = v1;
                    u32x4 w; w.x = cvt_pk_bf16(v0[0], v0[1]); w.y = cvt_pk_bf16(v0[2], v0[3]); w.z = cvt_pk_bf16(v1[0], v1[1]); w.w = cvt_pk_bf16(v1[2], v1[3]);
                    *(u32x4*)(Hb + off + bj * HALF) = w;
                    q += (v0[0] * v0[0] + v0[1] * v0[1]) + (v0[2] * v0[2] + v0[3] * v0[3]) + (v1[0] * v1[0] + v1[1] * v1[1]) + (v1[2] * v1[2] + v1[3] * v1[3]); }
                q += __shfl_xor(q, 16); q += __shfl_xor(q, 32);
                if (fq == 0) ss[(size_t)row * 16 + u.pn * 4 + wc] = q; }
    }
};
struct EpiResid2 {
    static constexpr bool PERM = true;
    const float* basef; const bf16* baseb; float* H; bf16* Hb; float* ss;
    __device__ __forceinline__ void operator()(const f32x4 (&acc)[2][2][4][2], const Unit& u, int wr, int wc, int fr, int fq) const {
        { unsigned tl = threadIdx.x; asm volatile("" : "+v"(tl)); fr = (int)(tl & 15u); fq = (int)((tl >> 4) & 3u); }
        const int col0 = u.pn * BM + wc * 32 + 8 * fq;
#pragma unroll
        for (int ai = 0; ai < 2; ++ai)
#pragma unroll
            for (int m = 0; m < 4; ++m) { const int row = u.orow + ai * HALF + wr * 64 + m * 16 + fr; const size_t off = (size_t)row * D + col0; float q = 0.f;
#pragma unroll
                for (int bj = 0; bj < 2; ++bj) {
                    f32x4 b0, b1;
                    if (basef) { b0 = *(const f32x4*)(basef + off + bj * HALF); b1 = *(const f32x4*)(basef + off + bj * HALF + 4); }
                    else { const u32x4 bb = *(const u32x4*)(baseb + off + bj * HALF); b0 = (f32x4){bflo(bb.x), bfhi(bb.x), bflo(bb.y), bfhi(bb.y)}; b1 = (f32x4){bflo(bb.z), bfhi(bb.z), bflo(bb.w), bfhi(bb.w)}; }
                    const f32x4 v0 = acc[ai][bj][m][0] + b0, v1 = acc[ai][bj][m][1] + b1;
                    if (H) { *(f32x4*)(H + off + bj * HALF) = v0; *(f32x4*)(H + off + bj * HALF + 4) = v1; }
                    u32x4 w; w.x = cvt_pk_bf16(v0[0], v0[1]); w.y = cvt_pk_bf16(v0[2], v0[3]); w.z = cvt_pk_bf16(v1[0], v1[1]); w.w = cvt_pk_bf16(v1[2], v1[3]);
                    *(u32x4*)(Hb + off + bj * HALF) = w;
                    q += (v0[0] * v0[0] + v0[1] * v0[1]) + (v0[2] * v0[2] + v0[3] * v0[3]) + (v1[0] * v1[0] + v1[1] * v1[1]) + (v1[2] * v1[2] + v1[3] * v1[3]); }
                q += __shfl_xor(q, 16); q += __shfl_xor(q, 32);
                if (fq == 0) ss[(size_t)row * 16 + u.pn * 4 + wc] = q; }
    }
};
struct EpiSwiglu {
    static constexpr bool PERM = true;
    bf16* ACT; const float* b1; const float* lrinv; const int* list;
    __device__ __forceinline__ void operator()(const f32x4 (&acc)[2][2][4][2], const Unit& u, int wr, int wc, int fr, int fq) const {
        { unsigned tl = threadIdx.x; asm volatile("" : "+v"(tl)); fr = (int)(tl & 15u); fq = (int)((tl >> 4) & 3u); }
        const int j0 = u.pn * HALF + wc * 32 + 8 * fq; const float* bg = b1 + (size_t)u.e * (2 * FF) + j0; const float* bl = bg + FF;
        const f32x4 g0 = *(const f32x4*)bg, g1 = *(const f32x4*)(bg + 4), l0 = *(const f32x4*)bl, l1 = *(const f32x4*)(bl + 4);
#pragma unroll
        for (int ai = 0; ai < 2; ++ai)
#pragma unroll
            for (int m = 0; m < 4; ++m) { const int rr = ai * HALF + wr * 64 + m * 16 + fr;
                if (rr < u.nvalid) {
                    const float s = lrinv[u.lbase + rr];
                    float o[8];
#pragma unroll
                    for (int n = 0; n < 2; ++n)
#pragma unroll
                        for (int j = 0; j < 4; ++j) { float gt = acc[ai][0][m][n][j] * s + (n ? g1[j] : g0[j]), ln = acc[ai][1][m][n][j] * s + (n ? l1[j] : l0[j]);
                            gt = fminf(gt, 7.0f); ln = fminf(fmaxf(ln, -7.0f), 7.0f);
                            o[n * 4 + j] = gt * frcp(1.0f + fexp(-1.702f * gt)) * (ln + 1.0f); }
                    u32x4 w; w.x = cvt_pk_bf16(o[0], o[1]); w.y = cvt_pk_bf16(o[2], o[3]); w.z = cvt_pk_bf16(o[4], o[5]); w.w = cvt_pk_bf16(o[6], o[7]);
                    *(u32x4*)(ACT + (size_t)(u.orow + rr) * FF + j0) = w; } }
    }
};
struct EpiMoe2 {
    static constexpr bool PERM = true;
    bf16* Y; const float* b2; const float* gates; const int* list;
    __device__ __forceinline__ void operator()(const f32x4 (&acc)[2][2][4][2], const Unit& u, int wr, int wc, int fr, int fq) const {
        { unsigned tl = threadIdx.x; asm volatile("" : "+v"(tl)); fr = (int)(tl & 15u); fq = (int)((tl >> 4) & 3u); }
        const int col0 = u.pn * BM + wc * 32 + 8 * fq; const float* bb = b2 + (size_t)u.e * D + col0;
        f32x4 bv[2][2];
#pragma unroll
        for (int bj = 0; bj < 2; ++bj) { bv[bj][0] = *(const f32x4*)(bb + bj * HALF); bv[bj][1] = *(const f32x4*)(bb + bj * HALF + 4); }
#pragma unroll
        for (int ai = 0; ai < 2; ++ai)
#pragma unroll
            for (int m = 0; m < 4; ++m) { const int rr = ai * HALF + wr * 64 + m * 16 + fr;
                if (rr < u.nvalid) {
                    const int ent = list[u.lbase + rr] & 65535; const float gw = gates[u.lbase + rr]; bf16* rowp = Y + (size_t)ent * D + col0;
#pragma unroll
                    for (int bj = 0; bj < 2; ++bj) { const f32x4 v0 = (acc[ai][bj][m][0] + bv[bj][0]) * gw, v1 = (acc[ai][bj][m][1] + bv[bj][1]) * gw;
                        u32x4 w; w.x = cvt_pk_bf16(v0[0], v0[1]); w.y = cvt_pk_bf16(v0[2], v0[3]); w.z = cvt_pk_bf16(v1[0], v1[1]); w.w = cvt_pk_bf16(v1[2], v1[3]);
                        *(u32x4*)(rowp + bj * HALF) = w; } } }
    }
};
struct MoeOrder {
    const LAS int* tb; const LAS int* cn; const LAS int* rte; int ncol, G, c, ntile;
    __device__ bool next(int i, Unit& u) const {
        const int L = i * G + c, rt = L / ncol, pn = L % ncol; if (rt >= ntile) return false;
        const int e = __builtin_amdgcn_readfirstlane(rte[rt]);
        const int tile = rt - __builtin_amdgcn_readfirstlane(tb[e]), left = __builtin_amdgcn_readfirstlane(cn[e]) - tile * 256;
        u.pm = rt; u.pn = pn; u.e = e; u.nvalid = left < 256 ? left : 256; u.lbase = e * CAP + tile * 256; u.orow = rt * 256; return true;
    }
};
}
#define XB_TMO      128
#define XB_XCNT(j)  (256  + 64 * (j))
#define XB_XSUB(j)  (1280 + 64 * (j))
#define XB_XGEN(j)  (2304 + 64 * (j))
#define XB_TOP      3328
#define XB_TOPGEN   3392
#define XCD_BAR_WORDS 3456
#define XB_SPIN_CAP (1u << 18)

__device__ __forceinline__ unsigned xb_ld(unsigned* p)              { return __hip_atomic_load(p, __ATOMIC_RELAXED, __HIP_MEMORY_SCOPE_AGENT); }
__device__ __forceinline__ unsigned xb_add(unsigned* p, unsigned v) { return __hip_atomic_fetch_add(p, v, __ATOMIC_RELAXED, __HIP_MEMORY_SCOPE_AGENT); }
__device__ __forceinline__ unsigned xb_xcc_id() { return (unsigned)__builtin_amdgcn_s_getreg((3 << 11) | 20) & 0xFu; }
#define XB_SPIN(cond, bar) do { unsigned _sp = 0; while (cond) { __builtin_amdgcn_s_sleep(1); \
    if ((++_sp & 255u) == 0u) { if (xb_ld(&(bar)[XB_TMO])) break; if (_sp > XB_SPIN_CAP) { atomicAdd(&(bar)[XB_TMO], 1u); break; } } } } while (0)

struct XcdBarrier {
    unsigned* bar; unsigned x;
    volatile LAS unsigned* st;
};

__device__ __forceinline__ XcdBarrier xcd_barrier_post(unsigned* bar, volatile LAS unsigned* st) {
    XcdBarrier b; b.bar = bar; b.x = xb_xcc_id(); b.st = st;
    if (threadIdx.x == 0) (void)xb_add(&bar[XB_XCNT(b.x)], 1u);
    return b;
}
__device__ __forceinline__ void xcd_barrier_complete(unsigned* bar, unsigned x, unsigned& nloc, unsigned& nx) {
    const unsigned G = gridDim.x * gridDim.y * gridDim.z;
    unsigned sum, cnt, mine, sp = 0u;
    for (;;) {
        sum = 0u; cnt = 0u; mine = 0u;
#pragma unroll
        for (unsigned j = 0; j < 16; ++j) { const unsigned c = xb_ld(&bar[XB_XCNT(j)]); sum += c; cnt += (c > 0u) ? 1u : 0u; mine = (j == x) ? c : mine; }
        if (sum == G) break;
        __builtin_amdgcn_s_sleep(1);
        if ((++sp & 255u) == 0u) { if (xb_ld(&bar[XB_TMO])) break; if (sp > XB_SPIN_CAP) { atomicAdd(&bar[XB_TMO], 1u); break; } }
    }
    nloc = mine > 0u ? mine : 1u; nx = cnt > 0u ? cnt : 1u;
}

__device__ __forceinline__ void xcd_barrier(const XcdBarrier& b) {
    asm volatile("s_waitcnt vmcnt(0)" ::: "memory");
    __syncthreads();
    if (threadIdx.x == 0) {
        unsigned* bar = b.bar;
        __builtin_amdgcn_s_waitcnt(0);
        unsigned nloc = b.st[0], nx = b.st[1];
        if (nloc == 0u) { xcd_barrier_complete(bar, b.x, nloc, nx); b.st[0] = nloc; b.st[1] = nx; }
        const unsigned old = xb_add(&bar[XB_XSUB(b.x)], 1u);
        const unsigned gen = old / nloc;
        if (old + 1u == (gen + 1u) * nloc) {
            __builtin_amdgcn_fence(__ATOMIC_RELEASE, "agent");
            asm volatile("s_waitcnt vmcnt(0)" ::: "memory");
            const unsigned og = xb_add(&bar[XB_TOP], 1u);
            const unsigned tg = og / nx;
            if (og + 1u == (tg + 1u) * nx) xb_add(&bar[XB_TOPGEN], 1u);
            else XB_SPIN(xb_ld(&bar[XB_TOPGEN]) == tg, bar);
            __builtin_amdgcn_fence(__ATOMIC_ACQUIRE, "agent");
            xb_add(&bar[XB_XGEN(b.x)], 1u);
            asm volatile("s_waitcnt vmcnt(0)" ::: "memory");
        } else {
            XB_SPIN(xb_ld(&bar[XB_XGEN(b.x)]) == gen, bar);
            __builtin_amdgcn_fence(__ATOMIC_ACQUIRE, "agent");
            asm volatile("s_waitcnt vmcnt(0)" ::: "memory");
        }
    }
    __syncthreads();
}
#ifdef DBG_SEL
#define DBGCNT(F, k, cond) do { if (cond) atomicAdd((unsigned*)((F).ctl + 12288 + (k)), 1u); } while (0)
#else
#define DBGCNT(F, k, cond) do { } while (0)
#endif
struct Frame {
    LAS unsigned char* lds;
    volatile LAS unsigned* MISC;
    gu32* ctl;
    unsigned char* ws;
    int tid, lane, wave, G, bid;
    const float* in[34];
    float* out;
};
__device__ __forceinline__ float wave_sum(float v) {
#pragma unroll
    for (int o = 1; o < 64; o <<= 1) v += __shfl_xor(v, o);
    return v;
}
__device__ __forceinline__ float wave_max(float v) {
#pragma unroll
    for (int o = 1; o < 64; o <<= 1) v = fmaxf(v, __shfl_xor(v, o));
    return v;
}
__device__ __forceinline__ void p0_transpose_item(const float* W, int N, const float* gk, bf16* WT, int Kd, int k0, int n0, int drow, LAS float* scr, int lane) {
    float v[32];
#pragma unroll
    for (int i = 0; i < 32; ++i) { const int kk = 2 * i + (lane >> 5); v[i] = W[(size_t)(k0 + kk) * N + n0 + (lane & 31)]; }
    if (gk) {
#pragma unroll
        for (int i = 0; i < 32; ++i) { const int kk = 2 * i + (lane >> 5); v[i] *= gk[k0 + kk]; }
    }
#pragma unroll
    for (int i = 0; i < 32; ++i) { const int kk = 2 * i + (lane >> 5); scr[kk * 33 + (lane & 31)] = v[i]; }
    LDS_WAIT(); asm volatile("" ::: "memory");
    const int c = lane & 7;
#pragma unroll
    for (int j = 0; j < 4; ++j) { const int n = (lane >> 3) + 8 * j; const LAS float* s = scr + (8 * c) * 33 + n;
        u32x4 o; o.x = pk2(s[0 * 33], s[1 * 33]); o.y = pk2(s[2 * 33], s[3 * 33]); o.z = pk2(s[4 * 33], s[5 * 33]); o.w = pk2(s[6 * 33], s[7 * 33]);
        *(GAS u32x4*)(WT + (size_t)(drow + n) * Kd + k0 + 8 * c) = o; }
    LDS_WAIT(); asm volatile("" ::: "memory");
}
__device__ __forceinline__ void rms_row_to_bf16(const float* xrow, const float* g, bf16* orow, int lane) {
    const GAS f32x4* xr = (const GAS f32x4*)xrow + lane; const GAS f32x4* gr = (const GAS f32x4*)g + lane;
    f32x4 v[4]; float s = 0.f;
#pragma unroll
    for (int j = 0; j < 4; ++j) { v[j] = xr[64 * j]; s += (v[j].x * v[j].x + v[j].y * v[j].y) + (v[j].z * v[j].z + v[j].w * v[j].w); }
    const float rstd = 1.f / sqrtf(wave_sum(s) * (1.f / D) + NORM_EPS);
    GAS unsigned long long* o8 = (GAS unsigned long long*)orow + lane;
#pragma unroll
    for (int j = 0; j < 4; ++j) { const f32x4 gg = gr[64 * j];
        o8[64 * j] = (unsigned long long)pk2(v[j].x * rstd * gg.x, v[j].y * rstd * gg.y) | ((unsigned long long)pk2(v[j].z * rstd * gg.z, v[j].w * rstd * gg.w) << 32); }
}
enum { I_X = 0, I_MEM, I_N1G, I_WIN, I_MU, I_W0, I_W2, I_A0, I_A2, I_G2, I_KK, I_KA, I_RK, I_LNG, I_LNB, I_LQ1, I_LK1, I_LQ2, I_LK2, I_SUBG, I_WOUT, I_N2G, I_MNG, I_WQ, I_WKV, I_WO, I_N3G,
       I_RW, I_RB, I_W1, I_B1, I_W2E, I_B2, I_FG };

__device__ __forceinline__ void p0_prologue(Frame& F) {
    LAS float* scr = (LAS float*)(F.lds + F.wave * 16384);
    const int gw = F.bid * NWAVES + F.wave, NGW = F.G * NWAVES;
    constexpr int I_IN = 16 * (IN_COLS / 32), I_SQ = 16 * 32, I_KV = 16 * 64, I_L64 = 1 * 16, I_L128 = 2 * 16, I_E1 = 16 * 64, I_E2 = 16 * 32;
    constexpr int NITEMS = I_IN + 3 * I_SQ + I_KV + 2 * I_L64 + I_L128;
    for (int it = gw; it < NITEMS; it += NGW) {
        int r = it;
        if (r < I_IN) { const int nb = IN_COLS / 32; p0_transpose_item(F.in[I_WIN], IN_COLS, nullptr, (bf16*)(F.ws + WS_WINT), D, 64 * (r / nb), 32 * (r % nb), 32 * (r % nb), scr, F.lane); continue; } r -= I_IN;
        if (r < I_SQ) { p0_transpose_item(F.in[I_WOUT], D, nullptr, (bf16*)(F.ws + WS_WOUTT), D, 64 * (r / 32), 32 * (r % 32), 32 * (r % 32), scr, F.lane); continue; } r -= I_SQ;
        if (r < I_SQ) { p0_transpose_item(F.in[I_WQ], D, F.in[I_N2G], (bf16*)(F.ws + WS_WQT), D, 64 * (r / 32), 32 * (r % 32), 32 * (r % 32), scr, F.lane); continue; } r -= I_SQ;
        if (r < I_SQ) { p0_transpose_item(F.in[I_WO], D, nullptr, (bf16*)(F.ws + WS_WOT), D, 64 * (r / 32), 32 * (r % 32), 32 * (r % 32), scr, F.lane); continue; } r -= I_SQ;
        if (r < I_KV) { p0_transpose_item(F.in[I_WKV], 2 * D, nullptr, (bf16*)(F.ws + WS_WKVT), D, 64 * (r / 64), 32 * (r % 64), 32 * (r % 64), scr, F.lane); continue; } r -= I_KV;
        if (r < I_L64) { p0_transpose_item(F.in[I_W2], RW, nullptr, (bf16*)(F.ws + WS_W2LT), 64, 0, 32 * r, 32 * r, scr, F.lane); continue; } r -= I_L64;
        if (r < I_L64) { p0_transpose_item(F.in[I_A2], RW, nullptr, (bf16*)(F.ws + WS_A2LT), 64, 0, 32 * r, 32 * r, scr, F.lane); continue; } r -= I_L64;
        p0_transpose_item(F.in[I_G2], RW, nullptr, (bf16*)(F.ws + WS_G2LT), 128, 64 * (r / 16), 32 * (r % 16), 32 * (r % 16), scr, F.lane);
    }
    for (int m = gw; m < M; m += NGW) rms_row_to_bf16(F.in[I_X] + (size_t)m * D, F.in[I_N1G], (bf16*)(F.ws + WS_XN) + (size_t)m * D, F.lane);
    for (int m = gw; m < BATCH * MEM; m += NGW) rms_row_to_bf16(F.in[I_MEM] + (size_t)m * D, F.in[I_MNG], (bf16*)(F.ws + WS_MEMN) + (size_t)m * D, F.lane);
    { float* rwt = (float*)(F.ws + WS_RWT); const int gt = F.bid * NTHR + F.tid;
      for (int i = gt; i < NE * D; i += F.G * NTHR) { const int e = i / D, k = i % D; rwt[i] = F.in[I_RW][k * NE + e] * F.in[I_N3G][k]; } }
}

__device__ __forceinline__ void p0_experts(Frame& F, int wg0) {
    LAS float* scr = (LAS float*)(F.lds + F.wave * 16384);
    constexpr int I_E1 = 16 * 64, I_E2 = 16 * 32;
    const int gw = (F.bid - wg0) * NWAVES + F.wave, NGW = (F.G - wg0) * NWAVES;
    for (int it = gw; it < NE * (I_E1 + I_E2); it += NGW) {
        const int e = it / (I_E1 + I_E2); int r = it - e * (I_E1 + I_E2);
        if (r < I_E1) {
            const int n0 = 32 * (r % 64), k0 = 64 * (r / 64); const int nn = n0 < FF ? n0 : n0 - FF; const int drow = 256 * (nn / 128) + (n0 < FF ? 0 : 128) + (nn % 128);
            p0_transpose_item(F.in[I_W1] + (size_t)e * D * 2 * FF, 2 * FF, F.in[I_N3G], (bf16*)(F.ws + WS_W1T) + (size_t)e * 2 * FF * D, D, k0, n0, drow, scr, F.lane);
        } else { r -= I_E1;
            p0_transpose_item(F.in[I_W2E] + (size_t)e * FF * D, D, nullptr, (bf16*)(F.ws + WS_W2T) + (size_t)e * D * FF, FF, 64 * (r / 32), 32 * (r % 32), 32 * (r % 32), scr, F.lane);
        }
    }
}
template <int NMAP, int DQK, int DVV, int NBUF, int PF>
struct AttnBody {
    static constexpr int KROW = DQK * 2, VROW = 128, KCH = DQK / 8;
    static constexpr int KT_BYTES = NMAP * 64 * KROW, VT_BYTES = DVV * VROW, BUF_BYTES = KT_BYTES + VT_BYTES;
    static constexpr int NPK = KT_BYTES / (16 * NTHR), NPV = VT_BYTES / (16 * NTHR), NDMA = NPK + NPV;
    static constexpr int NKS = DQK / 32, NDT = DVV / 16, KB = NKS < 4 ? NKS : 4;
    static_assert(NBUF * BUF_BYTES <= RING_BYTES + 24576, "attention ring exceeds LDS");
    static_assert(NDMA * (NBUF - 1) <= 48 && NBUF >= 2, "vmcnt range; a ring needs two slots");

    __device__ __forceinline__ void dma_tile(LAS unsigned char* slot, const bf16* Kp, int ldk, const bf16* VTp, int ldvt, int key0, int tid, int wave) const {
        asm volatile("" : "+v"(tid));
#pragma unroll
        for (int i = 0; i < NPK; ++i) { const int p = tid + NTHR * i, row = p / KCH, sl = p % KCH, ch = sl ^ ksw(row), mp = row >> 6, key = row & 63;
            __builtin_amdgcn_global_load_lds((const unsigned*)(Kp + (unsigned)((key0 + key) * ldk + mp * DQK + ch * 8)), (LAS unsigned*)(slot + (i * NTHR + wave * 64) * 16), 16, 0, 0); }
#pragma unroll
        for (int i = 0; i < NPV; ++i) { const int p = tid + NTHR * i, dv = p >> 3, sl = p & 7, ch = sl ^ vsw(dv);
            __builtin_amdgcn_global_load_lds((const unsigned*)(VTp + (unsigned)(dv * ldvt + key0 + ch * 8)), (LAS unsigned*)(slot + KT_BYTES + (i * NTHR + wave * 64) * 16), 16, 0, 0); }
    }
    __device__ __forceinline__ static int ksw(int row) { return KCH == 8 ? ((row & 3) | (((row >> 3) & 1) << 2)) : (((row & 1) * 3) | (((row >> 1) & 1) << 2) | (((row >> 3) & 1) << 3)); }
    __device__ __forceinline__ static int vsw(int dv) { return dv & 7; }
    __device__ __forceinline__ static int vt_off(int dv, int ch) { return KT_BYTES + dv * VROW + ((ch ^ vsw(dv)) << 4); }
    __device__ __forceinline__ static int k_off(int row, int ch) { return row * KROW + ((ch ^ ksw(row)) << 4); }
    __device__ __forceinline__ static int sigma(int t4, int m) { return 32 * (t4 >> 1) + 8 * (m >> 2) + 4 * (t4 & 1) + (m & 3); }
    static constexpr int NKB = NKS < 4 ? NKS : 4;
    struct Offs { int kb[NKB]; int vb[2]; };
    __device__ __forceinline__ static Offs make_offs(int lq, int g) { Offs o; const int r0 = 8 * (lq >> 2) + (lq & 3);
#pragma unroll
        for (int j = 0; j < NKB; ++j) o.kb[j] = k_off(r0, 4 * j + g);
        o.vb[0] = vt_off(lq, g); o.vb[1] = vt_off(lq, 4 + g); return o; }

    __device__ __forceinline__ void pv_tile(const LAS unsigned char* buf, bf16x8 (&vf)[PF], const bf16x8 (&pf)[NMAP][2], f32x4 (&o)[NMAP][NDT], const Offs& of) {
#pragma unroll
        for (int f0 = 0; f0 < 2 * NDT; f0 += PF) {
            bf16x8 vn[PF];
            if (f0 + PF < 2 * NDT) {
#pragma unroll
                for (int f = 0; f < PF; ++f) { const int dt = (f0 + PF + f) >> 1, mb = (f0 + PF + f) & 1; vn[f] = *(const LAS bf16x8*)(buf + of.vb[mb] + dt * 16 * VROW); }
            }
#pragma unroll
            for (int f = 0; f < PF; ++f) { const int dt = (f0 + f) >> 1, mb = (f0 + f) & 1;
#pragma unroll
                for (int c = 0; c < NMAP; ++c) o[c][dt] = __builtin_amdgcn_mfma_f32_16x16x32_bf16(vf[f], pf[c][mb], o[c][dt], 0, 0, 0); }
            if (f0 + PF < 2 * NDT) {
#pragma unroll
                for (int f = 0; f < PF; ++f) vf[f] = vn[f];
            }
        }
    }
    __device__ __forceinline__ void vf_first(const LAS unsigned char* buf, bf16x8 (&vf)[PF], const Offs& of) {
#pragma unroll
        for (int f = 0; f < PF; ++f) { const int dt = f >> 1, mb = f & 1; vf[f] = *(const LAS bf16x8*)(buf + of.vb[mb] + dt * 16 * VROW); }
    }
    __device__ __forceinline__ void s_tile(const LAS unsigned char* buf, const bf16x8 (&qf)[NMAP][NKS], float (&mrun)[NMAP], f32x4 (&ol)[NMAP], f32x4 (&o)[NMAP][NDT], bf16x8 (&pf)[NMAP][2], const Offs& of, bool first) {
        constexpr float THR = 8.0f;
        f32x4 s[NMAP][4];
#pragma unroll
        for (int c = 0; c < NMAP; ++c) { const float mi = first ? 0.f : -mrun[c];
#pragma unroll
            for (int t4 = 0; t4 < 4; ++t4) { s[c][t4] = (f32x4){mi, mi, mi, mi};
#pragma unroll
                for (int k0 = 0; k0 < NKS; k0 += KB) { bf16x8 kf[KB];
#pragma unroll
                    for (int ks = 0; ks < KB; ++ks) kf[ks] = *(const LAS bf16x8*)(buf + of.kb[(k0 + ks) & (NKB - 1)] + ((c * 64 + 32 * (t4 >> 1) + 4 * (t4 & 1)) * KROW + ((k0 + ks) / NKB) * NKB * 64));
#pragma unroll
                    for (int ks = 0; ks < KB; ++ks) s[c][t4] = __builtin_amdgcn_mfma_f32_16x16x32_bf16(kf[ks], qf[c][k0 + ks], s[c][t4], 0, 0, 0); } } }
#pragma unroll
        for (int c = 0; c < NMAP; ++c) {
            float mx = __builtin_fmaxf(__builtin_fmaxf(s[c][0][0], s[c][0][1]), s[c][0][2]);
#pragma unroll
            for (int t4 = 0; t4 < 4; ++t4) { if (t4 > 0) mx = __builtin_fmaxf(__builtin_fmaxf(mx, s[c][t4][0]), s[c][t4][1]); mx = __builtin_fmaxf(__builtin_fmaxf(mx, s[c][t4][2]), s[c][t4][3]); }
            { const auto r1 = __builtin_amdgcn_permlane16_swap(__float_as_uint(mx), __float_as_uint(mx), false, false); mx = fmaxf(__uint_as_float(r1[0]), __uint_as_float(r1[1]));
              const auto r2 = __builtin_amdgcn_permlane32_swap(__float_as_uint(mx), __float_as_uint(mx), false, false); mx = fmaxf(__uint_as_float(r2[0]), __uint_as_float(r2[1])); }
            if (first) {
                mrun[c] = mx;
#pragma unroll
                for (int t4 = 0; t4 < 4; ++t4) s[c][t4] = s[c][t4] - mx;
            } else if (__any(mx > THR)) {
                const float d = mx > THR ? mx : 0.f, alpha = fexp2(-d); mrun[c] += d; ol[c] = ol[c] * alpha;
#pragma unroll
                for (int dt = 0; dt < NDT; ++dt) o[c][dt] = o[c][dt] * alpha;
#pragma unroll
                for (int t4 = 0; t4 < 4; ++t4) s[c][t4] = s[c][t4] - d;
            }
#pragma unroll
            for (int t4 = 0; t4 < 4; ++t4)
#pragma unroll
                for (int i = 0; i < 4; ++i) s[c][t4][i] = fexp2(s[c][t4][i]);
#pragma unroll
            for (int mb = 0; mb < 2; ++mb) { u32x4 w; w.x = cvt_pk_bf16(s[c][2 * mb][0], s[c][2 * mb][1]); w.y = cvt_pk_bf16(s[c][2 * mb][2], s[c][2 * mb][3]);
                w.z = cvt_pk_bf16(s[c][2 * mb + 1][0], s[c][2 * mb + 1][1]); w.w = cvt_pk_bf16(s[c][2 * mb + 1][2], s[c][2 * mb + 1][3]); pf[c][mb] = __builtin_bit_cast(bf16x8, w); }
            const bf16x8 ones = (bf16x8){0x3F80, 0x3F80, 0x3F80, 0x3F80, 0x3F80, 0x3F80, 0x3F80, 0x3F80};
            ol[c] = __builtin_amdgcn_mfma_f32_16x16x32_bf16(ones, pf[c][0], ol[c], 0, 0, 0); ol[c] = __builtin_amdgcn_mfma_f32_16x16x32_bf16(ones, pf[c][1], ol[c], 0, 0, 0);
        }
    }

    __device__ __forceinline__ void run(LAS unsigned char* lds, const bf16* Qp, int ldq, float qscale, const bf16* Kp, int ldk, const bf16* VTp, int ldvt, int nkt, int nkt_w, bool late,
                                        f32x4 (&o)[NMAP][NDT], float (&lsum)[NMAP], int tid, int lane) {
        const int g = lane >> 4, lq = lane & 15;
        bf16x8 qf[NMAP][NKS];
#pragma unroll
        for (int c = 0; c < NMAP; ++c)
#pragma unroll
            for (int ks = 0; ks < NKS; ++ks) { const u32x4 raw = *(const GAS u32x4*)(Qp + (size_t)lq * ldq + c * DQK + ks * 32 + g * 8);
                u32x4 w = raw;
                if (qscale != 1.0f) { w.x = cvt_pk_bf16(bflo(raw.x) * qscale, bfhi(raw.x) * qscale); w.y = cvt_pk_bf16(bflo(raw.y) * qscale, bfhi(raw.y) * qscale);
                                      w.z = cvt_pk_bf16(bflo(raw.z) * qscale, bfhi(raw.z) * qscale); w.w = cvt_pk_bf16(bflo(raw.w) * qscale, bfhi(raw.w) * qscale); }
                qf[c][ks] = __builtin_bit_cast(bf16x8, w); }
        float mrun[NMAP]; f32x4 ol[NMAP];
#pragma unroll
        for (int c = 0; c < NMAP; ++c) { mrun[c] = -INFINITY; ol[c] = (f32x4){0.f, 0.f, 0.f, 0.f};
#pragma unroll
            for (int dt = 0; dt < NDT; ++dt) o[c][dt] = (f32x4){0.f, 0.f, 0.f, 0.f}; }
        bf16x8 pfp[NMAP][2];
#pragma unroll
        for (int c = 0; c < NMAP; ++c) { pfp[c][0] = (bf16x8){0, 0, 0, 0, 0, 0, 0, 0}; pfp[c][1] = pfp[c][0]; }

        const int wave = __builtin_amdgcn_readfirstlane(tid >> 6);
        const Offs of = make_offs(lq, g);
#pragma unroll
        for (int j = 0; j < NBUF - 1; ++j) if (j < nkt) dma_tile(lds + j * BUF_BYTES, Kp, ldk, VTp, ldvt, j * 64, tid, wave);
        int bi = 0;
        for (int kt = 0; kt < nkt; ++kt) {
            LAS unsigned char* buf = lds + bi * BUF_BYTES;
            { const int ahead = (nkt - 1 - kt) < (NBUF - 2) ? (nkt - 1 - kt) : (NBUF - 2);
              if (ahead >= 1 && NBUF > 2) asm volatile("s_waitcnt vmcnt(%0)" :: "n"(NDMA) : "memory"); else asm volatile("s_waitcnt vmcnt(0)" ::: "memory"); }
            __builtin_amdgcn_s_barrier(); asm volatile("" ::: "memory");
            if (kt < nkt_w) { bf16x8 vf[PF]; s_tile(buf, qf, mrun, ol, o, pfp, of, kt == 0); vf_first(buf, vf, of);
                { const int kn = kt + NBUF - 1; if (kn < nkt) { const int bn = (bi == 0) ? NBUF - 1 : bi - 1; dma_tile(lds + bn * BUF_BYTES, Kp, ldk, VTp, ldvt, kn * 64, tid, wave); } }
                pv_tile(buf, vf, pfp, o, of); }
            else { const int kn = kt + NBUF - 1; if (kn < nkt) { const int bn = (bi == 0) ? NBUF - 1 : bi - 1; dma_tile(lds + bn * BUF_BYTES, Kp, ldk, VTp, ldvt, kn * 64, tid, wave); } }
            bi = (bi + 1 == NBUF) ? 0 : bi + 1;
        }
        asm volatile("s_waitcnt lgkmcnt(0)" ::: "memory"); __builtin_amdgcn_s_barrier(); asm volatile("" ::: "memory");
#pragma unroll
        for (int c = 0; c < NMAP; ++c) lsum[c] = ol[c][0];
    }
};
typedef float f32x16 __attribute__((ext_vector_type(16)));
struct DiffBody32 {
    static constexpr int KT_BYTES = 2 * 64 * 128, VT_BYTES = 128 * 128, BUF_BYTES = KT_BYTES + VT_BYTES, NBUF = 3, NDMA = 4;
    __device__ __forceinline__ static int swz(int row) { return (row >> 1) & 7; }
    __device__ __forceinline__ static int sigma(int rho) { return 16 * (rho >> 4) + 8 * ((rho >> 2) & 1) + 4 * ((rho >> 3) & 1) + (rho & 3); }
    __device__ __forceinline__ void dma_tile(LAS unsigned char* slot, const bf16* Kp, int ldk, const bf16* VTp, int ldvt, int key0, int tid, int wave) const {
        asm volatile("" : "+v"(tid));
#pragma unroll
        for (int i = 0; i < 2; ++i) { const int p = tid + NTHR * i, row = p >> 3, sl = p & 7, ch = sl ^ swz(row), mp = row >> 6, key = row & 63;
            __builtin_amdgcn_global_load_lds((const unsigned*)(Kp + (unsigned)((key0 + key) * ldk + mp * 64 + ch * 8)), (LAS unsigned*)(slot + (i * NTHR + wave * 64) * 16), 16, 0, 0); }
#pragma unroll
        for (int i = 0; i < 2; ++i) { const int p = tid + NTHR * i, dv = p >> 3, sl = p & 7, ch = sl ^ swz(dv);
            __builtin_amdgcn_global_load_lds((const unsigned*)(VTp + (unsigned)(dv * ldvt + key0 + ch * 8)), (LAS unsigned*)(slot + KT_BYTES + (i * NTHR + wave * 64) * 16), 16, 0, 0); }
    }
    __device__ __forceinline__ void run(LAS unsigned char* lds, const bf16* Qp  , int ldq, float qscale, const bf16* Kp, int ldk, const bf16* VTp, int ldvt,
                                        int nkt, int nkt_w, int c, f32x16 (&o)[4], float& lsum, int tid, int lane) {
        const int r = lane & 31, h = lane >> 5, wave = __builtin_amdgcn_readfirstlane(tid >> 6);
        bf16x8 qf[4];
#pragma unroll
        for (int ks = 0; ks < 4; ++ks) { const u32x4 raw = *(const GAS u32x4*)(Qp + (size_t)r * ldq + ks * 16 + h * 8); u32x4 w;
            w.x = cvt_pk_bf16(bflo(raw.x) * qscale, bfhi(raw.x) * qscale); w.y = cvt_pk_bf16(bflo(raw.y) * qscale, bfhi(raw.y) * qscale);
            w.z = cvt_pk_bf16(bflo(raw.z) * qscale, bfhi(raw.z) * qscale); w.w = cvt_pk_bf16(bflo(raw.w) * qscale, bfhi(raw.w) * qscale); qf[ks] = __builtin_bit_cast(bf16x8, w); }
        int kof[4], vof[4];
        { const int kr = sigma(r);
#pragma unroll
          for (int ks = 0; ks < 4; ++ks) kof[ks] = kr * 128 + (((2 * ks + h) ^ swz(kr)) << 4);
#pragma unroll
          for (int f = 0; f < 4; ++f) vof[f] = KT_BYTES + r * 128 + (((2 * f + h) ^ swz(r)) << 4); }
        float mrun = -INFINITY, ls = 0.f;
#pragma unroll
        for (int db = 0; db < 4; ++db)
#pragma unroll
            for (int i = 0; i < 16; ++i) o[db][i] = 0.f;
#pragma unroll
        for (int j = 0; j < NBUF - 1; ++j) if (j < nkt) dma_tile(lds + j * BUF_BYTES, Kp, ldk, VTp, ldvt, j * 64, tid, wave);
        int bi = 0;
        for (int kt = 0; kt < nkt; ++kt) {
            const LAS unsigned char* buf = lds + bi * BUF_BYTES;
            { const int ahead = (nkt - 1 - kt) < 1 ? (nkt - 1 - kt) : 1;
              if (ahead >= 1) asm volatile("s_waitcnt vmcnt(%0)" :: "n"(NDMA) : "memory"); else asm volatile("s_waitcnt vmcnt(0)" ::: "memory"); }
            __builtin_amdgcn_s_barrier(); asm volatile("" ::: "memory");
            const int kn = kt + NBUF - 1; const int bn = (bi == 0) ? NBUF - 1 : bi - 1;
            if (kt < nkt_w) {
                constexpr float THR = 8.0f; const bool first = (kt == 0);
                f32x16 s[2];
                { const float mi = first ? 0.f : -mrun;
#pragma unroll
                  for (int kb = 0; kb < 2; ++kb) {
#pragma unroll
                      for (int i = 0; i < 16; ++i) s[kb][i] = mi;
                      bf16x8 kf[4];
#pragma unroll
                      for (int ks = 0; ks < 4; ++ks) kf[ks] = *(const LAS bf16x8*)(buf + kof[ks] + (c * 64 + 32 * kb) * 128);
#pragma unroll
                      for (int ks = 0; ks < 4; ++ks) s[kb] = __builtin_amdgcn_mfma_f32_32x32x16_bf16(kf[ks], qf[ks], s[kb], 0, 0, 0); } }
                float mx = __builtin_fmaxf(__builtin_fmaxf(s[0][0], s[0][1]), s[0][2]);
#pragma unroll
                for (int kb = 0; kb < 2; ++kb)
#pragma unroll
                    for (int i = (kb == 0 ? 3 : 0); i + 1 < 16; i += 2) mx = __builtin_fmaxf(__builtin_fmaxf(mx, s[kb][i]), s[kb][i + 1]);
                mx = fmaxf(mx, s[0][15]); mx = fmaxf(mx, s[1][15] > s[1][14] ? s[1][15] : s[1][14]);
                { const auto r2 = __builtin_amdgcn_permlane32_swap(__float_as_uint(mx), __float_as_uint(mx), false, false); mx = fmaxf(__uint_as_float(r2[0]), __uint_as_float(r2[1])); }
                if (first) { mrun = mx; s[0] = s[0] - mx; s[1] = s[1] - mx; }
                else if (__any(mx > THR)) { const float d = mx > THR ? mx : 0.f, alpha = fexp2(-d); mrun += d; ls *= alpha;
#pragma unroll
                    for (int db = 0; db < 4; ++db) o[db] = o[db] * alpha;
                    s[0] = s[0] - d; s[1] = s[1] - d; }
                float ps = 0.f;
#pragma unroll
                for (int kb = 0; kb < 2; ++kb)
#pragma unroll
                    for (int i = 0; i < 16; ++i) { s[kb][i] = fexp2(s[kb][i]); ps += s[kb][i]; }
                ls += ps;
                bf16x8 pf[4];
#pragma unroll
                for (int f = 0; f < 4; ++f) { const int kb = f >> 1, s8 = 8 * (f & 1); u32x4 w;
                    w.x = cvt_pk_bf16(s[kb][s8 + 0], s[kb][s8 + 1]); w.y = cvt_pk_bf16(s[kb][s8 + 2], s[kb][s8 + 3]); w.z = cvt_pk_bf16(s[kb][s8 + 4], s[kb][s8 + 5]); w.w = cvt_pk_bf16(s[kb][s8 + 6], s[kb][s8 + 7]);
                    pf[f] = __builtin_bit_cast(bf16x8, w); }
                bf16x8 vf[4][4];
#pragma unroll
                for (int f = 0; f < 4; ++f) vf[0][f] = *(const LAS bf16x8*)(buf + vof[f]);
                if (kn < nkt) dma_tile(lds + bn * BUF_BYTES, Kp, ldk, VTp, ldvt, kn * 64, tid, wave);
#pragma unroll
                for (int db = 0; db < 4; ++db) {
                    if (db + 1 < 4) {
#pragma unroll
                        for (int f = 0; f < 4; ++f) vf[db + 1][f] = *(const LAS bf16x8*)(buf + vof[f] + (db + 1) * 32 * 128);
                    }
#pragma unroll
                    for (int f = 0; f < 4; ++f) o[db] = __builtin_amdgcn_mfma_f32_32x32x16_bf16(vf[db][f], pf[f], o[db], 0, 0, 0); }
            } else if (kn < nkt) dma_tile(lds + bn * BUF_BYTES, Kp, ldk, VTp, ldvt, kn * 64, tid, wave);
            bi = (bi + 1 == NBUF) ? 0 : bi + 1;
        }
        asm volatile("s_waitcnt lgkmcnt(0)" ::: "memory"); __builtin_amdgcn_s_barrier(); asm volatile("" ::: "memory");
        { const auto r2 = __builtin_amdgcn_permlane32_swap(__float_as_uint(ls), __float_as_uint(ls), false, false); lsum = __uint_as_float(r2[0]) + __uint_as_float(r2[1]); }
    }
};
constexpr int ATTN_MAXU = 2;
__constant__ unsigned short attn_tab[256][ATTN_MAXU] = {
{34,17},
{98,81},
{162,145},
{226,209},
{290,273},
{354,337},
{418,401},
{482,465},
{33,19},
{97,83},
{161,147},
{225,211},
{289,275},
{353,339},
{417,403},
{481,467},
{31,20},
{95,84},
{159,148},
{223,212},
{287,276},
{351,340},
{415,404},
{479,468},
{50,1},
{114,65},
{178,129},
{242,193},
{306,257},
{370,321},
{434,385},
{498,449},
{52,0},
{116,64},
{180,128},
{244,192},
{308,256},
{372,320},
{436,384},
{500,448},
{36,15},
{100,79},
{164,143},
{228,207},
{292,271},
{356,335},
{420,399},
{484,463},
{49,2},
{113,66},
{177,130},
{241,194},
{305,258},
{369,322},
{433,386},
{497,450},
{47,5},
{111,69},
{175,133},
{239,197},
{303,261},
{367,325},
{431,389},
{495,453},
{39,28},
{103,92},
{167,156},
{231,220},
{295,284},
{359,348},
{423,412},
{487,476},
{57,10},
{121,74},
{185,138},
{249,202},
{313,266},
{377,330},
{441,394},
{505,458},
{45,22},
{109,86},
{173,150},
{237,214},
{301,278},
{365,342},
{429,406},
{493,470},
{40,27},
{104,91},
{168,155},
{232,219},
{296,283},
{360,347},
{424,411},
{488,475},
{54,13},
{118,77},
{182,141},
{246,205},
{310,269},
{374,333},
{438,397},
{502,461},
{44,23},
{108,87},
{172,151},
{236,215},
{300,279},
{364,343},
{428,407},
{492,471},
{35,32},
{99,96},
{163,160},
{227,224},
{291,288},
{355,352},
{419,416},
{483,480},
{58,9},
{122,73},
{186,137},
{250,201},
{314,265},
{378,329},
{442,393},
{506,457},
{37,30},
{101,94},
{165,158},
{229,222},
{293,286},
{357,350},
{421,414},
{485,478},
{59,8},
{123,72},
{187,136},
{251,200},
{315,264},
{379,328},
{443,392},
{507,456},
{55,12},
{119,76},
{183,140},
{247,204},
{311,268},
{375,332},
{439,396},
{503,460},
{53,14},
{117,78},
{181,142},
{245,206},
{309,270},
{373,334},
{437,398},
{501,462},
{43,24},
{107,88},
{171,152},
{235,216},
{299,280},
{363,344},
{427,408},
{491,472},
{61,6},
{125,70},
{189,134},
{253,198},
{317,262},
{381,326},
{445,390},
{509,454},
{38,29},
{102,93},
{166,157},
{230,221},
{294,285},
{358,349},
{422,413},
{486,477},
{60,7},
{124,71},
{188,135},
{252,199},
{316,263},
{380,327},
{444,391},
{508,455},
{62,4},
{126,68},
{190,132},
{254,196},
{318,260},
{382,324},
{446,388},
{510,452},
{56,11},
{120,75},
{184,139},
{248,203},
{312,267},
{376,331},
{440,395},
{504,459},
{48,18},
{112,82},
{176,146},
{240,210},
{304,274},
{368,338},
{432,402},
{496,466},
{41,26},
{105,90},
{169,154},
{233,218},
{297,282},
{361,346},
{425,410},
{489,474},
{42,25},
{106,89},
{170,153},
{234,217},
{298,281},
{362,345},
{426,409},
{490,473},
{51,16},
{115,80},
{179,144},
{243,208},
{307,272},
{371,336},
{435,400},
{499,464},
{63,3},
{127,67},
{191,131},
{255,195},
{319,259},
{383,323},
{447,387},
{511,451},
{46,21},
{110,85},
{174,149},
{238,213},
{302,277},
{366,341},
{430,405},
{494,469}};
namespace rk {
constexpr int MS = 144;
constexpr int MB = 64 * MS;
constexpr int O_AB = 0 * MB, O_BB = 1 * MB, O_KB = 2 * MB, O_RB = 3 * MB, O_ABT = 4 * MB, O_VTT = 5 * MB, O_BTT = 6 * MB, O_KTT = 7 * MB, O_AAK = 8 * MB, O_ARB = 9 * MB, O_ARK = 10 * MB;
constexpr int O_TM = O_KB, O_GT = O_AB, O_WTT = O_BB, O_UTT = O_AAK;
constexpr int FS = 66;
constexpr int O_LF = 11 * MB, O_TF = 0;
constexpr int O_LA = O_LF + 64 * FS * 4;
static_assert(O_LA + MB <= RING_BYTES && 64 * FS * 4 <= 2 * MB, "rwkv LDS map");
constexpr int O_LW = X_OFF, O_LG = X_OFF + MB, LGS = 272, O_NRM = O_LG + 64 * LGS, O_BSP = O_NRM + 512, O_C63 = O_BSP + 512;
static_assert(O_C63 + 1024 <= MISC_OFF, "rwkv LDS extras");

template <int NKS>
__device__ __forceinline__ f32x4 mm_tile(const LAS unsigned char* A, int astr, int tr, const LAS unsigned char* B, int bstr, int tc, f32x4 acc, int lq, int g) {
#pragma unroll
    for (int ks = 0; ks < NKS; ++ks) {
        const bf16x8 a = *(const LAS bf16x8*)(A + (16 * tr + lq) * astr + (32 * ks + 8 * g) * 2);
        const bf16x8 b = *(const LAS bf16x8*)(B + (16 * tc + lq) * bstr + (32 * ks + 8 * g) * 2);
        acc = __builtin_amdgcn_mfma_f32_16x16x32_bf16(a, b, acc, 0, 0, 0); }
    return acc;
}
template <int NKS>
__device__ __forceinline__ f32x4 mm_tile_gb(const LAS unsigned char* A, int astr, int tr, const bf16* Bg, int ldb, f32x4 acc, int lq, int g) {
#pragma unroll
    for (int ks = 0; ks < NKS; ++ks) {
        const bf16x8 a = *(const LAS bf16x8*)(A + (16 * tr + lq) * astr + (32 * ks + 8 * g) * 2);
        const bf16x8 b = *(const GAS bf16x8*)(Bg + (size_t)lq * ldb + 32 * ks + 8 * g);
        acc = __builtin_amdgcn_mfma_f32_16x16x32_bf16(a, b, acc, 0, 0, 0); }
    return acc;
}
__device__ __forceinline__ void st_nat(LAS unsigned char* Mx, int t0, int col, const f32x4& v) {
#pragma unroll
    for (int i = 0; i < 4; ++i) *(LAS bf16*)(Mx + (t0 + i) * MS + col * 2) = (bf16)f2bf(v[i]);
}
__device__ __forceinline__ void st_tr(LAS unsigned char* Mx, int t0, int col, const f32x4& v) {
    u32x2 w; w.x = cvt_pk_bf16(v[0], v[1]); w.y = cvt_pk_bf16(v[2], v[3]); *(LAS u32x2*)(Mx + col * MS + t0 * 2) = w;
}

__device__ __forceinline__ void tri_inverse(const LAS float* L, LAS float* Tm, int lane) {
    const int g = lane >> 4, lq = lane & 15;
    {
        float x[16];
#pragma unroll
        for (int r = 0; r < 16; ++r) { float a = (r == lq) ? 1.f : 0.f;
#pragma unroll
            for (int s = 0; s < r; ++s) a += L[(16 * g + r) * FS + 16 * g + s] * x[s];
            x[r] = a; }
#pragma unroll
        for (int r = 0; r < 16; ++r) Tm[(16 * g + r) * FS + 16 * g + lq] = x[r];
    }
#pragma unroll
    for (int d = 1; d < 4; ++d)
#pragma unroll
        for (int i = d; i < 4; ++i) { const int j = i - d;
            f32x4 X = (f32x4){0.f, 0.f, 0.f, 0.f};
#pragma unroll
            for (int m = j; m < i; ++m)
#pragma unroll
                for (int kq = 0; kq < 4; ++kq) X = __builtin_amdgcn_mfma_f32_16x16x4f32(L[(16 * i + lq) * FS + 16 * m + 4 * kq + g], Tm[(16 * m + 4 * kq + g) * FS + 16 * j + lq], X, 0, 0, 0);
            f32x4 R = (f32x4){0.f, 0.f, 0.f, 0.f};
#pragma unroll
            for (int kk = 0; kk < 4; ++kk) R = __builtin_amdgcn_mfma_f32_16x16x4f32(Tm[(16 * i + lq) * FS + 16 * i + 4 * g + kk], X[kk], R, 0, 0, 0);
#pragma unroll
            for (int q = 0; q < 4; ++q) Tm[(16 * i + 4 * g + q) * FS + 16 * j + lq] = R[q];
        }
}

__device__ __forceinline__ void tri_inverse_simple(const LAS float* L, LAS float* Tm, int lane) {
#pragma unroll 1
    for (int t = 0; t < 64; ++t) { float a = (t == lane) ? 1.f : 0.f;
#pragma unroll 1
        for (int s = 0; s < t; ++s) a += L[t * FS + s] * Tm[s * FS + lane];
        Tm[t * FS + lane] = a; }
}
__device__ __forceinline__ float mixf(unsigned short cur, unsigned short prev, float mu) { const float c = bf2f(cur), p = bf2f(prev); return c + (p - c) * mu; }

__device__ __forceinline__ void phase_a(Frame& F, int b, int c) {
    LAS unsigned char* lds = F.lds;
    const int tid = F.tid, lane = F.lane, w = F.wave, g = lane >> 4, lq = lane & 15;
    const bf16* PROJ = (const bf16*)(F.ws + WS_PROJ);
    const int n0 = b * T + c * CH;
    const bool first = (c == 0);
    const float* mu = F.in[I_MU]; bf16* GATEp = (bf16*)(F.ws + WS_GATE);
    {
        const int t = tid >> 3, c0 = (tid & 7) * 32; const unsigned oc = (unsigned)(n0 + t) * PCOLS + C_WD + c0; const bool hasp = !(first && t == 0); const unsigned op = hasp ? oc - PCOLS : oc; const float* mup = mu + C_WD + c0;
#pragma unroll
        for (int q = 0; q < 4; ++q) {
            const u32x4 cu = *(const GAS u32x4*)(PROJ + (oc + q * 8)); u32x4 pv = *(const GAS u32x4*)(PROJ + (op + q * 8)); if (!hasp) pv = (u32x4){0u, 0u, 0u, 0u};
            const f32x4 m0 = *(const GAS f32x4*)(mup + q * 8), m1 = *(const GAS f32x4*)(mup + q * 8 + 4);
            float o[8];
#pragma unroll
            for (int k = 0; k < 4; ++k) { const unsigned cw = cu[k], pw = pv[k];
                const float x0 = bflo(cw) + (bflo(pw) - bflo(cw)) * (k < 2 ? m0[2 * k] : m1[2 * k - 4]), x1 = bfhi(cw) + (bfhi(pw) - bfhi(cw)) * (k < 2 ? m0[2 * k + 1] : m1[2 * k - 3]);
                if (c0 < 64) { o[2 * k] = 1.f - 2.f * frcp(fexp(2.f * x0) + 1.f); o[2 * k + 1] = 1.f - 2.f * frcp(fexp(2.f * x1) + 1.f); }
                else if (c0 < 128) { o[2 * k] = x0; o[2 * k + 1] = x1; }
                else { o[2 * k] = sigmoidf_(x0); o[2 * k + 1] = sigmoidf_(x1); } }
            u32x4 wv; wv.x = cvt_pk_bf16(o[0], o[1]); wv.y = cvt_pk_bf16(o[2], o[3]); wv.z = cvt_pk_bf16(o[4], o[5]); wv.w = cvt_pk_bf16(o[6], o[7]);
            LAS unsigned char* dst = (c0 < 64) ? lds + O_LW + t * MS + (c0 + q * 8) * 2 : (c0 < 128) ? lds + O_LA + t * MS + (c0 - 64 + q * 8) * 2 : lds + O_LG + t * LGS + (c0 - 128 + q * 8) * 2;
            *(LAS u32x4*)dst = wv; }
    }
    __syncthreads();
    const int tr = w >> 1, tcb = 2 * (w & 1);
    LAS float* EF = (LAS float*)(lds + O_LF);
    LAS float* NRM = (LAS float*)(lds + O_NRM); LAS float* BSP = (LAS float*)(lds + O_BSP); LAS float* TT = (LAS float*)(lds + O_C63);
#pragma unroll 1
    for (int h = 0; h < RH; ++h) {
        const int item = (b * RH + h) * NCHUNK + c;
        float ev[2][4], av[2][4], rv[2][4], kv[2][4], vv[2][4], kkr[2][4];
        float nrm_p[4] = {0.f, 0.f, 0.f, 0.f};
#pragma unroll
        for (int x = 0; x < 2; ++x) { const int tc = tcb + x, hj = h * RN + 16 * tc + lq;
            f32x4 wl = (f32x4){0.f, 0.f, 0.f, 0.f}, al = wl, gl = wl;
            wl = mm_tile_gb<2>(lds + O_LW, MS, tr, (const bf16*)(F.ws + WS_W2LT) + (size_t)(h * RN + 16 * tc) * 64, 64, wl, lq, g);
            al = mm_tile_gb<2>(lds + O_LA, MS, tr, (const bf16*)(F.ws + WS_A2LT) + (size_t)(h * RN + 16 * tc) * 64, 64, al, lq, g);
            gl = mm_tile_gb<4>(lds + O_LG, LGS, tr, (const bf16*)(F.ws + WS_G2LT) + (size_t)(h * RN + 16 * tc) * 128, 128, gl, lq, g);
            const float w0 = F.in[I_W0][hj], a0 = F.in[I_A0][hj], kkw = F.in[I_KK][hj];
            const float mur = mu[C_R + hj], muk = mu[C_K + hj], muv = mu[C_V + hj];
#pragma unroll
            for (int i = 0; i < 4; ++i) { const int t = 16 * tr + 4 * g + i; const bool hasp = !(first && t == 0); const unsigned oc = (unsigned)(n0 + t) * PCOLS + hj, op = hasp ? oc - PCOLS : oc;
                const float xw = -(w0 + wl[i]); const float sp = xw > 20.f ? xw : __logf(1.f + fexp(xw)); ev[x][i] = fexp(-sp - 0.5f);
                av[x][i] = sigmoidf_(a0 + al[i]);
                GATEp[(unsigned)(n0 + t) * RW + hj] = (bf16)f2bf(gl[i]);
                const unsigned short rc = PROJ[oc + C_R], kc = PROJ[oc + C_K], vc = PROJ[oc + C_V]; unsigned short rp = PROJ[op + C_R], kp = PROJ[op + C_K], vp = PROJ[op + C_V];
                if (!hasp) { rp = 0; kp = 0; vp = 0; }
                rv[x][i] = mixf(rc, rp, mur); kv[x][i] = mixf(kc, kp, muk); vv[x][i] = mixf(vc, vp, muv);
                kkr[x][i] = kv[x][i] * kkw; nrm_p[i] += kkr[x][i] * kkr[x][i]; }
        }
#pragma unroll
        for (int i = 0; i < 4; ++i) { float q = nrm_p[i]; q += __shfl_xor(q, 1); q += __shfl_xor(q, 2); q += __shfl_xor(q, 4); q += __shfl_xor(q, 8); if (lq == 0) NRM[(16 * tr + 4 * g + i) * 2 + (w & 1)] = q; }
        float cs[2][4];
#pragma unroll
        for (int x = 0; x < 2; ++x) { cs[x][0] = ev[x][0]; cs[x][1] = cs[x][0] + ev[x][1]; cs[x][2] = cs[x][1] + ev[x][2]; cs[x][3] = cs[x][2] + ev[x][3];
            float a = cs[x][3]; const float b1 = __shfl(a, lane - 16); a += (g >= 1) ? b1 : 0.f; const float b2 = __shfl(a, lane - 32); a += (g >= 2) ? b2 : 0.f;
            const float ex = a - cs[x][3];
#pragma unroll
            for (int i = 0; i < 4; ++i) cs[x][i] += ex;
            if (g == 3) TT[tr * 64 + 16 * (tcb + x) + lq] = a; }
        __syncthreads();
        float bs_p[4] = {0.f, 0.f, 0.f, 0.f};
#pragma unroll
        for (int x = 0; x < 2; ++x) { const int tc = tcb + x, j = 16 * tc + lq, hj = h * RN + j; const float ka = F.in[I_KA][hj], rk = F.in[I_RK][hj];
            const float t0v = TT[j], t1v = TT[64 + j], t2v = TT[128 + j], t3v = TT[192 + j]; const float c63 = (t0v + t1v) + (t2v + t3v);
            const float cbase = (tr > 0 ? t0v : 0.f) + (tr > 1 ? t1v : 0.f) + (tr > 2 ? t2v : 0.f);
            if (tr == 3 && g == 3) ((float*)(F.ws + WS_GC))[(size_t)item * 64 + j] = fexp(-c63);
            f32x4 ab, bb, kb, rb, bt, kt, vx;
#pragma unroll
            for (int i = 0; i < 4; ++i) { const int t = 16 * tr + 4 * g + i; const float cin = cs[x][i] + cbase, cex = cin - ev[x][i];
                const float nr = NRM[t * 2] + NRM[t * 2 + 1]; const float kk = kkr[x][i] / fmaxf(sqrtf(nr), 1e-12f);
                DBGCNT(F, 2, !(nr > 1e-6f && nr < 1e6f)); DBGCNT(F, 3, !(fabsf(kk) <= 1.001f)); DBGCNT(F, 6, !(ev[x][i] > 0.f && ev[x][i] < 0.62f && av[x][i] > 0.f && av[x][i] < 1.f)); DBGCNT(F, 8, !(fabsf(rv[x][i]) < 100.f && fabsf(kv[x][i]) < 100.f && fabsf(vv[x][i]) < 100.f)); DBGCNT(F, 9, !(cin >= 0.f && cin < 40.f && c63 >= cin));
                const float a = av[x][i], k2 = kv[x][i] * (1.f + (a - 1.f) * ka);
                const float gin = fexp(-cin), ginv = fexp(cin), gex = fexp(-cex), grel = fexp(cin - c63);
                ab[i] = -kk * gex; bb[i] = kk * a * ginv; kb[i] = k2 * ginv; rb[i] = rv[x][i] * gin; bt[i] = kk * a * grel; kt[i] = k2 * grel; vx[i] = vv[x][i];
                bs_p[i] += rv[x][i] * k2 * rk; }
            const int t0 = 16 * tr + 4 * g;
            st_nat(lds + O_AB, t0, j, ab); st_nat(lds + O_BB, t0, j, bb); st_nat(lds + O_KB, t0, j, kb); st_nat(lds + O_RB, t0, j, rb);
            st_tr(lds + O_ABT, t0, j, ab); st_tr(lds + O_VTT, t0, j, vx); st_tr(lds + O_BTT, t0, j, bt); st_tr(lds + O_KTT, t0, j, kt);
        }
#pragma unroll
        for (int i = 0; i < 4; ++i) { float q = bs_p[i]; q += __shfl_xor(q, 1); q += __shfl_xor(q, 2); q += __shfl_xor(q, 4); q += __shfl_xor(q, 8); if (lq == 0) BSP[(16 * tr + 4 * g + i) * 2 + (w & 1)] = q; }
        __syncthreads();
        if (tid < 64) ((float*)(F.ws + WS_BS))[(size_t)(n0 + tid) * RH + h] = BSP[tid * 2] + BSP[tid * 2 + 1];
#pragma unroll
        for (int x = 0; x < 2; ++x) { const int tc = tcb + x; f32x4 l = (f32x4){0.f, 0.f, 0.f, 0.f}, ak = l, rbm = l, rkm = l;
            if (tc <= tr) {
                l = mm_tile<2>(lds + O_AB, MS, tr, lds + O_BB, MS, tc, l, lq, g); ak = mm_tile<2>(lds + O_AB, MS, tr, lds + O_KB, MS, tc, ak, lq, g);
                rbm = mm_tile<2>(lds + O_RB, MS, tr, lds + O_BB, MS, tc, rbm, lq, g); rkm = mm_tile<2>(lds + O_RB, MS, tr, lds + O_KB, MS, tc, rkm, lq, g);
                const int s = 16 * tc + lq;
#pragma unroll
                for (int i = 0; i < 4; ++i) { const int t = 16 * tr + 4 * g + i; if (s >= t) { l[i] = 0.f; ak[i] = 0.f; } if (s > t) { rbm[i] = 0.f; rkm[i] = 0.f; } }
            }
            const int t0 = 16 * tr + 4 * g, s = 16 * tc + lq;
#pragma unroll
            for (int i = 0; i < 4; ++i) { EF[(t0 + i) * FS + s] = l[i]; DBGCNT(F, 7, !(fabsf(l[i]) <= 1.01f)); DBGCNT(F, 10, !(fabsf(ak[i]) < 300.f && fabsf(rbm[i]) < 300.f && fabsf(rkm[i]) < 300.f)); }
            st_nat(lds + O_AAK, t0, s, ak); st_nat(lds + O_ARB, t0, s, rbm); st_nat(lds + O_ARK, t0, s, rkm);
        }
        __syncthreads();
#ifdef DBG_SIMPLE_TRI
        if (w == 0) tri_inverse_simple(EF, (LAS float*)(lds + O_TF), lane);
#else
        if (w == 0) tri_inverse(EF, (LAS float*)(lds + O_TF), lane);
#endif
        __syncthreads();
        { const int t = tid >> 3, s0 = (tid & 7) * 8; const LAS float* tp = (const LAS float*)(lds + O_TF) + t * FS + s0; float o[8];
#pragma unroll
          for (int k = 0; k < 8; ++k) { o[k] = ((s0 >> 4) > (t >> 4)) ? 0.f : tp[k]; DBGCNT(F, 4, !(fabsf(o[k]) < 50.f)); }
          u32x4 wv; wv.x = cvt_pk_bf16(o[0], o[1]); wv.y = cvt_pk_bf16(o[2], o[3]); wv.z = cvt_pk_bf16(o[4], o[5]); wv.w = cvt_pk_bf16(o[6], o[7]);
          __syncthreads();
          *(LAS u32x4*)(lds + O_TM + t * MS + s0 * 2) = wv; }
        __syncthreads();
#pragma unroll
        for (int x = 0; x < 2; ++x) { const int tc = tcb + x; f32x4 gg = (f32x4){0.f, 0.f, 0.f, 0.f}, wt = gg;
            gg = mm_tile<2>(lds + O_AAK, MS, tr, lds + O_VTT, MS, tc, gg, lq, g); wt = mm_tile<2>(lds + O_TM, MS, tr, lds + O_ABT, MS, tc, wt, lq, g);
#pragma unroll
            for (int i = 0; i < 4; ++i) { DBGCNT(F, 12, !(fabsf(gg[i]) < 1e3f)); DBGCNT(F, 13, !(fabsf(wt[i]) < 1e2f)); }
            st_tr(lds + O_GT, 16 * tr + 4 * g, 16 * tc + lq, gg); st_tr(lds + O_WTT, 16 * tr + 4 * g, 16 * tc + lq, wt); }
        __syncthreads();
#pragma unroll
        for (int x = 0; x < 2; ++x) { const int tc = tcb + x; f32x4 ut = (f32x4){0.f, 0.f, 0.f, 0.f};
            ut = mm_tile<2>(lds + O_TM, MS, tr, lds + O_GT, MS, tc, ut, lq, g);
#pragma unroll
            for (int i = 0; i < 4; ++i) DBGCNT(F, 14, !(fabsf(ut[i]) < 1e3f));
            st_tr(lds + O_UTT, 16 * tr + 4 * g, 16 * tc + lq, ut); }
        __syncthreads();
#pragma unroll
        for (int x = 0; x < 2; ++x) { const int tc = tcb + x, t0 = 16 * tr + 4 * g, cj = 16 * tc + lq;
            f32x4 qt = (f32x4){0.f, 0.f, 0.f, 0.f}, yl = qt, pp = qt, nn = qt;
            qt = mm_tile<2>(lds + O_ARB, MS, tr, lds + O_WTT, MS, tc, qt, lq, g);
            yl = mm_tile<2>(lds + O_ARB, MS, tr, lds + O_UTT, MS, tc, yl, lq, g);
#ifdef DBG_SEL
            { f32x4 y2 = (f32x4){0.f, 0.f, 0.f, 0.f}; y2 = mm_tile<2>(lds + O_ARK, MS, tr, lds + O_VTT, MS, tc, y2, lq, g);
#pragma unroll
              for (int i = 0; i < 4; ++i) { DBGCNT(F, 15, !(fabsf(yl[i]) < 1e4f)); DBGCNT(F, 16, !(fabsf(y2[i]) < 1e4f)); }
#pragma unroll
              for (int ks = 0; ks < 2; ++ks) { const bf16x8 a1 = *(const LAS bf16x8*)(lds + O_ARB + (16 * tr + lq) * MS + (32 * ks + 8 * g) * 2), a2 = *(const LAS bf16x8*)(lds + O_ARK + (16 * tr + lq) * MS + (32 * ks + 8 * g) * 2);
                  const bf16x8 b1 = *(const LAS bf16x8*)(lds + O_UTT + (16 * tc + lq) * MS + (32 * ks + 8 * g) * 2), b2 = *(const LAS bf16x8*)(lds + O_VTT + (16 * tc + lq) * MS + (32 * ks + 8 * g) * 2);
#pragma unroll
                  for (int j = 0; j < 8; ++j) { DBGCNT(F, 17, !(fabsf(bf2f((bf16)a1[j])) < 300.f)); DBGCNT(F, 18, !(fabsf(bf2f((bf16)a2[j])) < 300.f)); DBGCNT(F, 19, !(fabsf(bf2f((bf16)b1[j])) < 1e3f)); DBGCNT(F, 20, !(fabsf(bf2f((bf16)b2[j])) < 100.f)); } } }
#endif
            yl = mm_tile<2>(lds + O_ARK, MS, tr, lds + O_VTT, MS, tc, yl, lq, g);
            pp = mm_tile<2>(lds + O_WTT, MS, tr, lds + O_BTT, MS, tc, pp, lq, g);
            nn = mm_tile<2>(lds + O_UTT, MS, tr, lds + O_BTT, MS, tc, nn, lq, g); nn = mm_tile<2>(lds + O_VTT, MS, tr, lds + O_KTT, MS, tc, nn, lq, g);
            bf16* QT = (bf16*)(F.ws + WS_QT) + (size_t)item * 4096; float* YL = (float*)(F.ws + WS_YLOC) + (size_t)item * 4096;
            bf16* PT = (bf16*)(F.ws + WS_PT) + (size_t)item * 4096; float* NNp = (float*)(F.ws + WS_NN) + (size_t)item * 4096;
#pragma unroll
            for (int i = 0; i < 4; ++i) { const float rbv = bf2f(*(const LAS bf16*)(lds + O_RB + (t0 + i) * MS + cj * 2));
                DBGCNT(F, 5, !(fabsf(yl[i]) < 1e4f)); DBGCNT(F, 11, !(fabsf(nn[i]) < 1e4f && fabsf(pp[i]) < 1e2f && fabsf(qt[i]) < 1e4f));
                QT[(unsigned)((t0 + i) * 64 + cj)] = (bf16)f2bf(qt[i] + rbv); YL[(unsigned)((t0 + i) * 64 + cj)] = yl[i]; NNp[(unsigned)((t0 + i) * 64 + cj)] = nn[i]; }
            u32x2 pw; pw.x = cvt_pk_bf16(pp[0], pp[1]); pw.y = cvt_pk_bf16(pp[2], pp[3]); *(GAS u32x2*)(PT + (unsigned)(cj * 64 + t0)) = pw;
        }
        __syncthreads();
    }
}

constexpr int SC_PT = 0, SC_NN = 8192, SC_GC = 12288, SC_DUM = 12544, SC_SLOT = 12800, SC_DEPTH = 8;
static_assert(SC_DEPTH * SC_SLOT <= RING_BYTES, "scan ring");
__device__ __forceinline__ void scan_issue(LAS unsigned char* ring, const unsigned char* ws, int bh, int vg, int c, int w, int lane) {
    const size_t item = (size_t)bh * NCHUNK + c; LAS unsigned char* slot = ring + (c & (SC_DEPTH - 1)) * SC_SLOT;
#pragma unroll
    for (int k = 0; k < 2; ++k) { const int id = 2 * (w - 1) + k;
        if (id < 8) { const int p = 64 * id + lane, r = p >> 3, sl = p & 7, ch = sl ^ (r & 7);
            __builtin_amdgcn_global_load_lds((const unsigned*)((const bf16*)(ws + WS_PT) + item * 4096 + r * 64 + ch * 8), (LAS unsigned*)(slot + SC_PT + 1024 * id), 16, 0, 0); }
        else if (id < 12) { const int q = id - 8, p = 64 * q + lane, r = p >> 4, sl = p & 15, ch = sl ^ (r & 15);
            __builtin_amdgcn_global_load_lds((const unsigned*)((const float*)(ws + WS_NN) + item * 4096 + (16 * vg + r) * 64 + ch * 4), (LAS unsigned*)(slot + SC_NN + 1024 * q), 16, 0, 0); }
        else { __builtin_amdgcn_global_load_lds((const unsigned*)((const float*)(ws + WS_GC) + item * 64 + lane), (LAS unsigned*)(slot + (id == 12 ? SC_GC : SC_DUM)), 4, 0, 0); }
    }
}
__device__ __forceinline__ void phase_scan(Frame& F, int bh, int vg) {
    const int lane = F.lane, w = F.wave, g = lane >> 4, lq = lane & 15;
    LAS unsigned char* ring = F.lds;
    f32x4 S[4];
#pragma unroll
    for (int kt = 0; kt < 4; ++kt) S[kt] = (f32x4){0.f, 0.f, 0.f, 0.f};
    const int v = 16 * vg + lq;
    if (w >= 1) {
#pragma unroll 1
        for (int c = 0; c < SC_DEPTH - 1; ++c) scan_issue(ring, F.ws, bh, vg, c, w, lane);
    }
#pragma unroll 1
    for (int c = 0; c < NCHUNK; ++c) {
        if (c <= NCHUNK - SC_DEPTH + 1) asm volatile("s_waitcnt vmcnt(12)" ::: "memory"); else asm volatile("s_waitcnt vmcnt(0)" ::: "memory");
        __builtin_amdgcn_s_barrier(); asm volatile("" ::: "memory");
        if (w >= 1 && c + SC_DEPTH - 1 < NCHUNK) scan_issue(ring, F.ws, bh, vg, c + SC_DEPTH - 1, w, lane);
        if (w == 0) {
            const LAS unsigned char* slot = ring + (c & (SC_DEPTH - 1)) * SC_SLOT; const size_t item = (size_t)bh * NCHUNK + c;
            bf16* S0 = (bf16*)(F.ws + WS_S0) + item * 4096;
            bf16x8 sf[2];
#pragma unroll
            for (int kt = 0; kt < 4; ++kt) { u32x2 wv; wv.x = cvt_pk_bf16(S[kt][0], S[kt][1]); wv.y = cvt_pk_bf16(S[kt][2], S[kt][3]); *(GAS u32x2*)(S0 + (size_t)v * 64 + 16 * kt + 4 * g) = wv; }
#pragma unroll
            for (int mb = 0; mb < 2; ++mb) { u32x4 wv; wv.x = cvt_pk_bf16(S[2 * mb][0], S[2 * mb][1]); wv.y = cvt_pk_bf16(S[2 * mb][2], S[2 * mb][3]);
                wv.z = cvt_pk_bf16(S[2 * mb + 1][0], S[2 * mb + 1][1]); wv.w = cvt_pk_bf16(S[2 * mb + 1][2], S[2 * mb + 1][3]); sf[mb] = __builtin_bit_cast(bf16x8, wv); }
#pragma unroll
            for (int kt = 0; kt < 4; ++kt) { const int k2 = 16 * kt + lq;
                const f32x4 nv = *(const LAS f32x4*)(slot + SC_NN + lq * 256 + (((4 * kt + g) ^ lq) << 4));
                const f32x4 gc = *(const LAS f32x4*)(slot + SC_GC + (16 * kt + 4 * g) * 4);
                f32x4 a = S[kt] * gc + nv;
#pragma unroll
                for (int mb = 0; mb < 2; ++mb) {
                    const u32x2 lo = *(const LAS u32x2*)(slot + SC_PT + k2 * 128 + (((4 * mb + (g >> 1)) ^ (k2 & 7)) << 4) + 8 * (g & 1));
                    const u32x2 hi = *(const LAS u32x2*)(slot + SC_PT + k2 * 128 + (((4 * mb + 2 + (g >> 1)) ^ (k2 & 7)) << 4) + 8 * (g & 1));
                    const bf16x8 pf = __builtin_bit_cast(bf16x8, (u32x4){lo.x, lo.y, hi.x, hi.y});
                    a = __builtin_amdgcn_mfma_f32_16x16x32_bf16(pf, sf[mb], a, 0, 0, 0); }
                S[kt] = a; }
        }
    }
    asm volatile("s_waitcnt vmcnt(0) lgkmcnt(0)" ::: "memory"); __builtin_amdgcn_s_barrier(); asm volatile("" ::: "memory");
}

__device__ __forceinline__ void phase_c(Frame& F, int b, int c, int h) {
    const int lane = F.lane, g = lane >> 4, lq = lane & 15;
    const size_t item = (size_t)(b * RH + h) * NCHUNK + c; const int n0 = b * T + c * CH;
    const bf16* QT = (const bf16*)(F.ws + WS_QT) + item * 4096; const bf16* S0 = (const bf16*)(F.ws + WS_S0) + item * 4096; const float* YL = (const float*)(F.ws + WS_YLOC) + item * 4096;
    const bf16* PROJ = (const bf16*)(F.ws + WS_PROJ); const bf16* GATEp = (const bf16*)(F.ws + WS_GATE); bf16* CAT = (bf16*)(F.ws + WS_CAT);
    bf16x8 sa[4][2]; f32x4 lng[4], lnb[4], muv[4];
#pragma unroll
    for (int vt = 0; vt < 4; ++vt) {
#pragma unroll
        for (int ks = 0; ks < 2; ++ks) sa[vt][ks] = *(const GAS bf16x8*)(S0 + (size_t)(16 * vt + lq) * 64 + 32 * ks + 8 * g);
        const int hv = h * RN + 16 * vt + 4 * g; lng[vt] = *(const GAS f32x4*)(F.in[I_LNG] + hv); lnb[vt] = *(const GAS f32x4*)(F.in[I_LNB] + hv); muv[vt] = *(const GAS f32x4*)(F.in[I_MU] + C_V + hv); }
#pragma unroll 1
    for (int tt = 0; tt < 4; ++tt) { const int t = 16 * tt + lq, n = n0 + t;
        bf16x8 qb[2];
#pragma unroll
        for (int ks = 0; ks < 2; ++ks) qb[ks] = *(const GAS bf16x8*)(QT + (size_t)t * 64 + 32 * ks + 8 * g);
        f32x4 y[4];
#pragma unroll
        for (int vt = 0; vt < 4; ++vt) { y[vt] = *(const GAS f32x4*)(YL + (size_t)t * 64 + 16 * vt + 4 * g);
#ifndef DBG_NO_STATE
#pragma unroll
            for (int ks = 0; ks < 2; ++ks) y[vt] = __builtin_amdgcn_mfma_f32_16x16x32_bf16(sa[vt][ks], qb[ks], y[vt], 0, 0, 0);
#endif
        }
        float s = 0.f;
#pragma unroll
        for (int vt = 0; vt < 4; ++vt) s += (y[vt][0] + y[vt][1]) + (y[vt][2] + y[vt][3]);
        s += __shfl_xor(s, 16); s += __shfl_xor(s, 32);
        const float mean = s * (1.f / 64.f); float q = 0.f;
#pragma unroll
        for (int vt = 0; vt < 4; ++vt)
#pragma unroll
            for (int i = 0; i < 4; ++i) { const float dlt = y[vt][i] - mean; q += dlt * dlt; }
        q += __shfl_xor(q, 16); q += __shfl_xor(q, 32);
        const float rstd = __builtin_amdgcn_rsqf(q * (1.f / 64.f) + GN_EPS);
        const float bsv = ((const float*)(F.ws + WS_BS))[(size_t)n * RH + h];
        const bool hasp = !(c == 0 && t == 0); const bf16* rowc = PROJ + (size_t)n * PCOLS + C_V + h * RN; const bf16* rowp = hasp ? rowc - PCOLS : rowc;
#pragma unroll
        for (int vt = 0; vt < 4; ++vt) { const int v0 = 16 * vt + 4 * g;
            const u32x2 vc = *(const GAS u32x2*)(rowc + v0); u32x2 vp = *(const GAS u32x2*)(rowp + v0); if (!hasp) { vp.x = 0u; vp.y = 0u; }
            const u32x2 gt = *(const GAS u32x2*)(GATEp + (size_t)n * RW + h * RN + v0);
            const float c0 = bflo(vc.x), c1 = bfhi(vc.x), c2 = bflo(vc.y), c3 = bfhi(vc.y);
            const float m0 = c0 + (bflo(vp.x) - c0) * muv[vt][0], m1 = c1 + (bfhi(vp.x) - c1) * muv[vt][1], m2 = c2 + (bflo(vp.y) - c2) * muv[vt][2], m3 = c3 + (bfhi(vp.y) - c3) * muv[vt][3];
            float o0 = ((y[vt][0] - mean) * rstd * lng[vt][0] + lnb[vt][0] + bsv * m0) * bflo(gt.x), o1 = ((y[vt][1] - mean) * rstd * lng[vt][1] + lnb[vt][1] + bsv * m1) * bfhi(gt.x);
            float o2 = ((y[vt][2] - mean) * rstd * lng[vt][2] + lnb[vt][2] + bsv * m2) * bflo(gt.y), o3 = ((y[vt][3] - mean) * rstd * lng[vt][3] + lnb[vt][3] + bsv * m3) * bfhi(gt.y);
#ifdef DBG_ZERO_RWKV
            o0 = o1 = o2 = o3 = 0.f;
#endif
            u32x2 wv; wv.x = cvt_pk_bf16(o0, o1); wv.y = cvt_pk_bf16(o2, o3); *(GAS u32x2*)(CAT + (size_t)n * D + h * RN + v0) = wv; }
    }
}
}
__device__ __forceinline__ void diff_attn_phase(Frame& F) {
    const int lane = F.lane, w = F.wave, r = lane & 31, h = lane >> 5, rg = w >> 1, c = w & 1;
    float lam;
    { const float a = F.in[I_LQ1][lane] * F.in[I_LK1][lane], b2 = F.in[I_LQ2][lane] * F.in[I_LK2][lane]; lam = fexp(wave_sum(a)) - fexp(wave_sum(b2)) + LAMBDA_INIT; }
    const bf16* PROJ = (const bf16*)(F.ws + WS_PROJ); const bf16* VT = (const bf16*)(F.ws + WS_VT); bf16* CAT = (bf16*)(F.ws + WS_CAT);
    LAS float* xch = (LAS float*)F.lds;
    const bool tab = (F.G == 256);
    for (int p = F.bid; p < 256; p += F.G) {
#pragma unroll 1
        for (int s = 0; s < 2; ++s) { int bh, qb;
            if (tab) { const int u = attn_tab[F.bid][s]; if (u == 0xFFFF) break; bh = u >> 6; qb = u & 63; }
            else { bh = p >> 5; const int j = p & 31; qb = s ? 63 - j : j; }
            const int b = bh >> 2, hd = bh & 3; const int row0 = b * T + 128 * qb + 32 * rg;
            DiffBody32 body; f32x16 o[4]; float ls;
            const int nkt = 2 * qb + 2, nkt_w = (rg < 2) ? nkt - 1 : nkt;
            body.run(F.lds, PROJ + (size_t)row0 * PCOLS + C_QD + hd * 128 + c * 64, PCOLS, 0.125f * LOG2E, PROJ + (size_t)(b * T) * PCOLS + C_KD + hd * 128, PCOLS,
                     VT + (size_t)(hd * DV) * M + b * T, M, nkt, nkt_w, c, o, ls, F.tid, lane);
            if (c == 1) { const float sc = lam / ls;
#pragma unroll
                for (int db = 0; db < 4; ++db)
#pragma unroll
                    for (int i = 0; i < 16; ++i) xch[(rg * 64 + db * 16 + i) * 64 + lane] = o[db][i] * sc; }
            asm volatile("s_waitcnt lgkmcnt(0)" ::: "memory"); __builtin_amdgcn_s_barrier(); asm volatile("" ::: "memory");
            if (c == 0) { const float i0 = 1.f / ls; float q = 0.f;
#pragma unroll
                for (int db = 0; db < 4; ++db)
#pragma unroll
                    for (int i = 0; i < 16; ++i) { const float v = o[db][i] * i0 - xch[(rg * 64 + db * 16 + i) * 64 + lane]; o[db][i] = v; q += v * v; }
                { const auto r2 = __builtin_amdgcn_permlane32_swap(__float_as_uint(q), __float_as_uint(q), false, false); q = __uint_as_float(r2[0]) + __uint_as_float(r2[1]); }
                const float rstd = __builtin_amdgcn_rsqf(q * (1.f / DV) + NORM_EPS) * (1.f - LAMBDA_INIT);
                bf16* orow = CAT + (size_t)(row0 + r) * D + RW + hd * DV;
#pragma unroll
                for (int db = 0; db < 4; ++db)
#pragma unroll
                    for (int t = 0; t < 4; ++t) { const int dv = 32 * db + 8 * t + 4 * h; const f32x4 sg = *(const GAS f32x4*)(F.in[I_SUBG] + dv);
                        u32x2 wv; wv.x = cvt_pk_bf16(o[db][4 * t] * rstd * sg[0], o[db][4 * t + 1] * rstd * sg[1]); wv.y = cvt_pk_bf16(o[db][4 * t + 2] * rstd * sg[2], o[db][4 * t + 3] * rstd * sg[3]);
#ifdef DBG_ZERO_DIFF
                        wv.x = 0u; wv.y = 0u;
#endif
                        *(GAS u32x2*)(orow + dv) = wv; } }
            asm volatile("s_waitcnt lgkmcnt(0)" ::: "memory"); __builtin_amdgcn_s_barrier(); asm volatile("" ::: "memory");
        }
    }
}
__device__ __forceinline__ void cross_attn_phase(Frame& F) {
    typedef AttnBody<1, XD, XD, 2, 8> Body;
    const int lane = F.lane, w = F.wave, g = lane >> 4, lq = lane & 15;
    const bf16* QX = (const bf16*)(F.ws + WS_QX); const bf16* KM = (const bf16*)(F.ws + WS_KMEM); const bf16* VTM = (const bf16*)(F.ws + WS_VTMEM); bf16* XO = (bf16*)(F.ws + WS_XO);
#pragma unroll 1
    for (int u = F.bid; u < 512; u += F.G) { const int bh = u >> 6, rb = u & 63, b = bh >> 2, h = bh & 3; const int row0 = b * T + 128 * rb + 16 * w;
        Body body; f32x4 o[1][16]; float ls[1];
        body.run(F.lds, QX + (size_t)row0 * D + h * XD, D, 1.0f, KM + (size_t)(b * MEM) * D + h * XD, D, VTM + (size_t)(h * XD) * (BATCH * MEM) + b * MEM, BATCH * MEM, 4, 4, false, o, ls, F.tid, lane);
        const float inv = 1.f / ls[0]; bf16* orow = XO + (size_t)(row0 + lq) * D + h * XD;
#pragma unroll
        for (int dt = 0; dt < 16; ++dt) { const f32x4 y = o[0][dt] * inv; u32x2 wv; wv.x = cvt_pk_bf16(y[0], y[1]); wv.y = cvt_pk_bf16(y[2], y[3]);
#ifdef DBG_ZERO_XATTN
            wv.x = 0u; wv.y = 0u;
#endif
            *(GAS u32x2*)(orow + 16 * dt + 4 * g) = wv; }
    }
}

constexpr int RT_LCNT = X_OFF + 4096, RT_GBASE = RT_LCNT + 128, RT_ENTE = RT_GBASE + 128, RT_ENTP = RT_ENTE + 1024, RT_LGT = RT_ENTP + 1024;
__device__ __forceinline__ void router_phase(Frame& F, int cw_cnt, size_t ws_lists, size_t ws_gates) {
    const int lane = F.lane, w = F.wave, tid = F.tid;
    LAS int* lcnt = (LAS int*)(F.lds + RT_LCNT); LAS int* gbase = (LAS int*)(F.lds + RT_GBASE); LAS int* ente = (LAS int*)(F.lds + RT_ENTE); LAS int* entp = (LAS int*)(F.lds + RT_ENTP); LAS float* lgt = (LAS float*)(F.lds + RT_LGT);
    const float* H2 = (const float*)(F.ws + WS_H2); const float* RWT = (const float*)(F.ws + WS_RWT); const float* SS3 = (const float*)(F.ws + WS_SS3);
    int* lists = (int*)(F.ws + ws_lists); float* lgate = (float*)(F.ws + ws_gates); float* lrinv = lgate + (size_t)NE * CAP;
    LAS float* entg = (LAS float*)(F.lds + RT_LGT + 8448); LAS float* entr = entg + 256;
#pragma unroll 1
    for (int blk = F.bid; blk < M / 64; blk += F.G) {
        if (tid < NE) lcnt[tid] = 0;
        __syncthreads();
        const int nb = blk * 64 + w * 8;
        { const int tt = w >> 1, et = w & 1, lq = lane & 15, g = lane >> 4;
          const f32x4* ap = (const f32x4*)(H2 + (size_t)(blk * 64 + tt * 16 + lq) * D + 4 * g); const f32x4* bp = (const f32x4*)(RWT + (size_t)(et * 16 + lq) * D + 4 * g);
          f32x4 acc0 = (f32x4){0.f, 0.f, 0.f, 0.f}, acc1 = acc0;
#pragma unroll 8
          for (int j = 0; j < D / 16; j += 2) { const f32x4 a0 = ap[4 * j], b0 = bp[4 * j], a1 = ap[4 * j + 4], b1 = bp[4 * j + 4];
#pragma unroll
              for (int m = 0; m < 4; ++m) { acc0 = __builtin_amdgcn_mfma_f32_16x16x4f32(a0[m], b0[m], acc0, 0, 0, 0); acc1 = __builtin_amdgcn_mfma_f32_16x16x4f32(a1[m], b1[m], acc1, 0, 0, 0); } }
#pragma unroll
          for (int i = 0; i < 4; ++i) { const int tok = tt * 16 + 4 * g + i; lgt[tok * 33 + et * 16 + lq] = acc0[i] + acc1[i]; } }
        __syncthreads();
        if (lane < 8) { const int tl = w * 8 + lane, n = blk * 64 + tl;
            const float rinv = __builtin_amdgcn_rsqf(row_ss(SS3, n) * (1.f / D) + NORM_EPS);
            float v0 = -INFINITY, v1 = -INFINITY, v2 = -INFINITY, v3 = -INFINITY; int e0 = 0, e1 = 0, e2 = 0, e3 = 0;
#pragma unroll
            for (int e = 0; e < NE; ++e) { float x = lgt[tl * 33 + e] * rinv + F.in[I_RB][e]; if (!(x == x)) x = -3.0e38f;
                const bool c0 = x > v0, c1 = x > v1, c2 = x > v2, c3 = x > v3;
                v3 = c3 ? (c2 ? v2 : x) : v3; e3 = c3 ? (c2 ? e2 : e) : e3;
                v2 = c2 ? (c1 ? v1 : x) : v2; e2 = c2 ? (c1 ? e1 : e) : e2;
                v1 = c1 ? (c0 ? v0 : x) : v1; e1 = c1 ? (c0 ? e0 : e) : e1;
                v0 = c0 ? x : v0; e0 = c0 ? e : e0; }
            const float x1 = fexp(v1 - v0), x2 = fexp(v2 - v0), x3 = fexp(v3 - v0); const float inv = 1.f / (1.f + x1 + x2 + x3);
            const int es[4] = {e0, e1, e2, e3}; const float gs[4] = {inv, x1 * inv, x2 * inv, x3 * inv};
#pragma unroll
            for (int k = 0; k < 4; ++k) { const int li = tl * 4 + k; const int lp = __hip_atomic_fetch_add(&lcnt[es[k]], 1, __ATOMIC_RELAXED, __HIP_MEMORY_SCOPE_WORKGROUP); ente[li] = es[k]; entp[li] = lp; entg[li] = gs[k]; entr[li] = rinv; }
        }
        __syncthreads();
        if (tid < NE) gbase[tid] = (int)__hip_atomic_fetch_add((unsigned*)(F.ctl + cw_cnt + 64 * tid), (unsigned)lcnt[tid], RLX_AGENT);
#ifdef DUP_ATOM
        if (tid < NE) lgt[tid] = (float)__hip_atomic_fetch_add((unsigned*)(F.ctl + cw_cnt + 8192 + 64 * tid), (unsigned)lcnt[tid], RLX_AGENT);
#endif
        __syncthreads();
        if (tid < 256) { const int ee = ente[tid]; const size_t pos = (size_t)ee * CAP + gbase[ee] + entp[tid]; lists[pos] = blk * 256 + tid; lgate[pos] = entg[tid]; lrinv[pos] = entr[tid]; }
        __syncthreads();
    }
}
__device__ __forceinline__ void final_phase(Frame& F) {
    const int gw = F.bid * NWAVES + F.wave, NGW = F.G * NWAVES, lane = F.lane;
    const float* H2 = (const float*)(F.ws + WS_H2); const bf16* Y = (const bf16*)(F.ws + WS_YBUF);
    for (int n = gw; n < M; n += NGW) {
        f32x4 v[4]; float s = 0.f;
#pragma unroll
        for (int j = 0; j < 4; ++j) { v[j] = *((const GAS f32x4*)(H2 + (size_t)n * D) + lane + 64 * j);
#pragma unroll
            for (int k = 0; k < 4; ++k) { u32x2 y = *((const GAS u32x2*)(Y + (size_t)(n * 4 + k) * D) + lane + 64 * j);
#ifdef DBG_ZERO_MOE
                y.x = 0u; y.y = 0u;
#endif
                v[j].x += bflo(y.x); v[j].y += bfhi(y.x); v[j].z += bflo(y.y); v[j].w += bfhi(y.y); }
            s += (v[j].x * v[j].x + v[j].y * v[j].y) + (v[j].z * v[j].z + v[j].w * v[j].w); }
        float rstd = 1.f / sqrtf(wave_sum(s) * (1.f / D) + NORM_EPS);
#ifdef DBG_SEL
        { const unsigned cnt = __hip_atomic_load(F.ctl + 12288 + DBG_SEL, RLX_AGENT); rstd *= 0.9f * __log2f(1.f + (float)cnt) * (1.f / 30.f); }
#endif
#pragma unroll
        for (int j = 0; j < 4; ++j) { const f32x4 gg = *((const GAS f32x4*)F.in[I_FG] + lane + 64 * j); *((GAS f32x4*)(F.out + (size_t)n * D) + lane + 64 * j) = v[j] * rstd * gg; }
    }
}

constexpr int NPHASE = 13;
#ifndef P1_GEMM_WGS
#define P1_GEMM_WGS 144
#endif
struct Args { const float* in[34]; float* out; unsigned char* ws; int ph_lo, ph_hi; };
__global__ void __launch_bounds__(NTHR, 2) fwd_kernel(Args args) {
    extern __shared__ __attribute__((aligned(16))) unsigned char lds[];
    Frame F;
    F.lds = (LAS unsigned char*)lds; F.MISC = (volatile LAS unsigned*)(F.lds + MISC_OFF);
    F.tid = threadIdx.x; F.lane = F.tid & 63; F.wave = __builtin_amdgcn_readfirstlane(F.tid >> 6);
    F.G = gridDim.x; F.bid = blockIdx.x; F.ws = args.ws; F.ctl = (gu32*)(args.ws + WS_CTL); F.out = args.out;
#pragma unroll
    for (int i = 0; i < 34; ++i) F.in[i] = args.in[i];
    for (int u = F.tid; u < (LDS_BYTES - MISC_OFF) / 4; u += NTHR) ((LAS unsigned*)(F.lds + MISC_OFF))[u] = 0u;
    __syncthreads();
    XcdBarrier bar = xcd_barrier_post((unsigned*)(F.ctl + CW_BAR), F.MISC + 8);
    const int lo = args.ph_lo, hi = args.ph_hi;
#ifndef PHM
#define PHM 0xffff
#endif
#define IN(k) (((PHM >> (k)) & 1) && lo <= (k) && (k) < hi)
#ifdef DUP_BARRIER
#define SEAM(k) do { if (IN(k) && IN((k) + 1)) { xcd_barrier(bar); if ((k) == DUP_BARRIER || DUP_BARRIER == 99) { xcd_barrier(bar); } } } while (0)
#else
#define SEAM(k) do { if (IN(k) && IN((k) + 1)) xcd_barrier(bar); } while (0)
#endif
    LAS int* lstage = (LAS int*)(F.lds + X_OFF);
    LAS int* moe_tb = (LAS int*)(F.lds + X_OFF + 2048); LAS int* moe_cn = (LAS int*)(F.lds + X_OFF + 2048 + 256); LAS int* moe_rte = (LAS int*)(F.lds + X_OFF + 2048 + 512);

#define RETID() do { int t_ = threadIdx.x; asm volatile("" : "+v"(t_)); F.tid = t_; F.lane = t_ & 63; } while (0)
    if (IN(0)) { RETID(); p0_prologue(F);
#if defined(DUP_PHASE) && DUP_PHASE == 0
        { RETID(); p0_prologue(F);  }
#endif
    } SEAM(0);
    if (IN(1)) { RETID();
        const int NG1 = (F.G == 256) ? P1_GEMM_WGS : F.G;
        if (F.bid < NG1) {
        const bf16* XN = (const bf16*)(F.ws + WS_XN); const bf16* WinT = (const bf16*)(F.ws + WS_WINT); const bf16* MEMN = (const bf16*)(F.ws + WS_MEMN); const bf16* WkvT = (const bf16*)(F.ws + WS_WKVT);
        { pg8::Gemm g{XN, WinT, D, 0, nullptr}; pg8::StaticOrder S; S.init(M, PCOLS, NG1, F.bid, 0); pg8::EpiBf16 E{(bf16*)(F.ws + WS_PROJ), PCOLS};
          pg8::gemm_phase<pg8::EpiBf16, pg8::StaticOrder, true, false>(F.lds, lstage, g, S, E); }
        { pg8::Gemm g{WinT + (size_t)C_VD * D, XN, D, 0, nullptr}; pg8::StaticOrder S; S.init(512, M, NG1, F.bid, 0); pg8::EpiBf16 E{(bf16*)(F.ws + WS_VT), M};
          pg8::gemm_phase<pg8::EpiBf16, pg8::StaticOrder, true, false>(F.lds, lstage, g, S, E); }
        { pg8::Gemm g{MEMN, WkvT, D, 0, nullptr}; pg8::StaticOrder S; S.init(BATCH * MEM, D, NG1, F.bid, 16); pg8::EpiBf16 E{(bf16*)(F.ws + WS_KMEM), D};
          pg8::gemm_phase<pg8::EpiBf16, pg8::StaticOrder, true, false>(F.lds, lstage, g, S, E); }
        { pg8::Gemm g{WkvT + (size_t)D * D, MEMN, D, 0, nullptr}; pg8::StaticOrder S; S.init(D, BATCH * MEM, NG1, F.bid, 8); pg8::EpiBf16 E{(bf16*)(F.ws + WS_VTMEM), BATCH * MEM};
          pg8::gemm_phase<pg8::EpiBf16, pg8::StaticOrder, true, false>(F.lds, lstage, g, S, E); }

        }
        if (NG1 == F.G || F.bid >= NG1) p0_experts(F, NG1 == F.G ? 0 : NG1);
    } SEAM(1);
    if (IN(2)) { RETID(); for (int it = F.bid; it < BATCH * NCHUNK; it += F.G) rk::phase_a(F, it / NCHUNK, it % NCHUNK);
#if defined(DUP_PHASE) && DUP_PHASE == 2
        { RETID(); for (int it = F.bid; it < BATCH * NCHUNK; it += F.G) rk::phase_a(F, it / NCHUNK, it % NCHUNK);  }
#endif
    } SEAM(2);
    if (IN(3)) { RETID();
        for (int it = F.bid; it < BATCH * RH * 4; it += F.G) rk::phase_scan(F, it >> 2, it & 3);
#ifdef DUP_SCAN
        for (int it = F.bid; it < BATCH * RH * 4; it += F.G) rk::phase_scan(F, it >> 2, it & 3);
#endif
        diff_attn_phase(F);
#ifdef DUP_ATTN
        diff_attn_phase(F);
#endif

#if defined(DUP_PHASE) && DUP_PHASE == 3
        { RETID();
        for (int it = F.bid; it < BATCH * RH * 4; it += F.G) rk::phase_scan(F, it >> 2, it & 3);
        diff_attn_phase(F);
     }
#endif
    } SEAM(3);
    if (IN(4)) { RETID(); for (int it = F.bid; it < BATCH * NCHUNK; it += F.G) rk::phase_c(F, it / NCHUNK, it % NCHUNK, F.wave);
#if defined(DUP_PHASE) && DUP_PHASE == 4
        { RETID(); for (int it = F.bid; it < BATCH * NCHUNK; it += F.G) rk::phase_c(F, it / NCHUNK, it % NCHUNK, F.wave);  }
#endif
    } SEAM(4);
    if (IN(5)) { RETID(); pg8::Gemm g{(const bf16*)(F.ws + WS_CAT), (const bf16*)(F.ws + WS_WOUTT), D, 0, nullptr}; pg8::StaticOrder S; S.init(M, D, F.G, F.bid, 0);
        pg8::EpiResid2 E{F.in[I_X], nullptr, nullptr, (bf16*)(F.ws + WS_H1B), (float*)(F.ws + WS_SS1)};
        pg8::gemm_phase<pg8::EpiResid2, pg8::StaticOrder, true, false>(F.lds, lstage, g, S, E);
#if defined(DUP_PHASE) && DUP_PHASE == 5
        { RETID(); pg8::Gemm g{(const bf16*)(F.ws + WS_CAT), (const bf16*)(F.ws + WS_WOUTT), D, 0, nullptr}; pg8::StaticOrder S; S.init(M, D, F.G, F.bid, 0);
        pg8::EpiResid2 E{F.in[I_X], nullptr, nullptr, (bf16*)(F.ws + WS_H1B), (float*)(F.ws + WS_SS1)};
        pg8::gemm_phase<pg8::EpiResid2, pg8::StaticOrder, true, false>(F.lds, lstage, g, S, E);  }
#endif
    } SEAM(5);
    if (IN(6)) { RETID(); pg8::Gemm g{(const bf16*)(F.ws + WS_H1B), (const bf16*)(F.ws + WS_WQT), D, 0, nullptr}; pg8::StaticOrder S; S.init(M, D, F.G, F.bid, 0);
        pg8::EpiRowScaleBf16 E{(bf16*)(F.ws + WS_QX), D, (const float*)(F.ws + WS_SS1), 0.0625f * LOG2E};
        pg8::gemm_phase<pg8::EpiRowScaleBf16, pg8::StaticOrder, true, false>(F.lds, lstage, g, S, E);
#if defined(DUP_PHASE) && DUP_PHASE == 6
        { RETID(); pg8::Gemm g{(const bf16*)(F.ws + WS_H1B), (const bf16*)(F.ws + WS_WQT), D, 0, nullptr}; pg8::StaticOrder S; S.init(M, D, F.G, F.bid, 0);
        pg8::EpiRowScaleBf16 E{(bf16*)(F.ws + WS_QX), D, (const float*)(F.ws + WS_SS1), 0.0625f * LOG2E};
        pg8::gemm_phase<pg8::EpiRowScaleBf16, pg8::StaticOrder, true, false>(F.lds, lstage, g, S, E);  }
#endif
    } SEAM(6);
    if (IN(7)) { RETID(); cross_attn_phase(F);
#if defined(DUP_PHASE) && DUP_PHASE == 7
        { RETID(); cross_attn_phase(F);  }
#endif
    } SEAM(7);
    if (IN(8)) { RETID(); pg8::Gemm g{(const bf16*)(F.ws + WS_XO), (const bf16*)(F.ws + WS_WOT), D, 0, nullptr}; pg8::StaticOrder S; S.init(M, D, F.G, F.bid, 0);
        pg8::EpiResid2 E{nullptr, (const bf16*)(F.ws + WS_H1B), (float*)(F.ws + WS_H2), (bf16*)(F.ws + WS_H2B), (float*)(F.ws + WS_SS3)};
        pg8::gemm_phase<pg8::EpiResid2, pg8::StaticOrder, true, false>(F.lds, lstage, g, S, E);
#if defined(DUP_PHASE) && DUP_PHASE == 8
        { RETID(); pg8::Gemm g{(const bf16*)(F.ws + WS_XO), (const bf16*)(F.ws + WS_WOT), D, 0, nullptr}; pg8::StaticOrder S; S.init(M, D, F.G, F.bid, 0);
        pg8::EpiResid2 E{nullptr, (const bf16*)(F.ws + WS_H1B), (float*)(F.ws + WS_H2), (bf16*)(F.ws + WS_H2B), (float*)(F.ws + WS_SS3)};
        pg8::gemm_phase<pg8::EpiResid2, pg8::StaticOrder, true, false>(F.lds, lstage, g, S, E);  }
#endif
    } SEAM(8);
    if (IN(9)) { RETID(); router_phase(F, CW_CNT, WS_LISTS, WS_LGATE);
#if defined(DUP_PHASE) && DUP_PHASE == 9
        { RETID(); router_phase(F, CW_CNT + 4096, WS_YBUF, WS_YBUF + 4 * MiB); }
#endif
    } SEAM(9);
    if (IN(10) || IN(11)) { RETID();
        if (F.tid < NE) moe_cn[F.tid] = (int)__hip_atomic_load(F.ctl + CW_CNT + 64 * F.tid, RLX_AGENT);
        __syncthreads();
        if (F.tid == 0) { int a = 0; for (int e = 0; e < NE; ++e) { moe_tb[e] = a; a += (moe_cn[e] + 255) >> 8; } moe_tb[NE] = a; }
        __syncthreads();
        if (F.tid < MAXRT) { int e = 0; for (int k = 1; k < NE; ++k) e = (F.tid >= moe_tb[k]) ? k : e; moe_rte[F.tid] = e; }
        __syncthreads();
    }
    if (IN(10)) { RETID(); pg8::Gemm g{(const bf16*)(F.ws + WS_H2B), (const bf16*)(F.ws + WS_W1T), D, (size_t)2 * FF * D, (const int*)(F.ws + WS_LISTS)};
        pg8::MoeOrder S{moe_tb, moe_cn, moe_rte, 8, F.G, F.bid, __builtin_amdgcn_readfirstlane(moe_tb[NE])};
        pg8::EpiSwiglu E{(bf16*)(F.ws + WS_ACT), F.in[I_B1], (const float*)(F.ws + WS_LRINV), (const int*)(F.ws + WS_LISTS)};
        pg8::gemm_phase<pg8::EpiSwiglu, pg8::MoeOrder, true, true>(F.lds, lstage, g, S, E);
#if defined(DUP_PHASE) && DUP_PHASE == 10
        { RETID(); pg8::Gemm g{(const bf16*)(F.ws + WS_H2B), (const bf16*)(F.ws + WS_W1T), D, (size_t)2 * FF * D, (const int*)(F.ws + WS_LISTS)};
        pg8::MoeOrder S{moe_tb, moe_cn, moe_rte, 8, F.G, F.bid, __builtin_amdgcn_readfirstlane(moe_tb[NE])};
        pg8::EpiSwiglu E{(bf16*)(F.ws + WS_ACT), F.in[I_B1], (const float*)(F.ws + WS_LRINV), (const int*)(F.ws + WS_LISTS)};
        pg8::gemm_phase<pg8::EpiSwiglu, pg8::MoeOrder, true, true>(F.lds, lstage, g, S, E);  }
#endif
    } SEAM(10);
    if (IN(11)) { RETID(); pg8::Gemm g{(const bf16*)(F.ws + WS_ACT), (const bf16*)(F.ws + WS_W2T), FF, (size_t)D * FF, nullptr};
        pg8::MoeOrder S{moe_tb, moe_cn, moe_rte, 4, F.G, F.bid, __builtin_amdgcn_readfirstlane(moe_tb[NE])};
        pg8::EpiMoe2 E{(bf16*)(F.ws + WS_YBUF), F.in[I_B2], (const float*)(F.ws + WS_LGATE), (const int*)(F.ws + WS_LISTS)};
        pg8::gemm_phase<pg8::EpiMoe2, pg8::MoeOrder, true, false>(F.lds, lstage, g, S, E);
#if defined(DUP_PHASE) && DUP_PHASE == 112
        { RETID(); pg8::Gemm g{(const bf16*)(F.ws + WS_H2B), (const bf16*)(F.ws + WS_W2T), FF, (size_t)D * FF, (const int*)(F.ws + WS_LISTS)};
        pg8::MoeOrder S{moe_tb, moe_cn, moe_rte, 4, F.G, F.bid, __builtin_amdgcn_readfirstlane(moe_tb[NE])};
        pg8::EpiBf16 E{(bf16*)(F.ws + 532 * MiB), D};
        pg8::gemm_phase<pg8::EpiBf16, pg8::MoeOrder, true, true>(F.lds, lstage, g, S, E);  }
#endif
#if defined(DUP_PHASE) && DUP_PHASE == 11
        { RETID(); pg8::Gemm g{(const bf16*)(F.ws + WS_ACT), (const bf16*)(F.ws + WS_W2T), FF, (size_t)D * FF, nullptr};
        pg8::MoeOrder S{moe_tb, moe_cn, moe_rte, 4, F.G, F.bid, __builtin_amdgcn_readfirstlane(moe_tb[NE])};
        pg8::EpiMoe2 E{(bf16*)(F.ws + WS_YBUF), F.in[I_B2], (const float*)(F.ws + WS_LGATE), (const int*)(F.ws + WS_LISTS)};
        pg8::gemm_phase<pg8::EpiMoe2, pg8::MoeOrder, true, false>(F.lds, lstage, g, S, E);  }
#endif
    } SEAM(11);
    if (IN(12)) { RETID(); final_phase(F);
#if defined(DUP_PHASE) && DUP_PHASE == 12
        { RETID(); final_phase(F);  }
#endif
    }
#undef IN
#undef SEAM
}

#ifndef MK_SPLIT
#define MK_SPLIT 0
#endif
extern "C" void kernel_launch(void* const* d_in, const int* in_sizes, int n_in, void* d_out, int out_size, void* d_ws, size_t ws_size, hipStream_t stream) {
    static int grid = 0;
    if (grid == 0) {
        if (n_in != 34 || out_size != M * D || ws_size < WS_END) { fprintf(stderr, "kernel_launch: unexpected shapes (n_in %d out %d ws %zu)\n", n_in, out_size, ws_size); grid = -1; return; }
        int dev = 0, cus = 0, per_cu = 0;
        if (hipGetDevice(&dev) != hipSuccess || hipDeviceGetAttribute(&cus, hipDeviceAttributeMultiprocessorCount, dev) != hipSuccess) { grid = -1; return; }
        if (hipFuncSetAttribute((const void*)fwd_kernel, hipFuncAttributeMaxDynamicSharedMemorySize, LDS_BYTES) != hipSuccess) { fprintf(stderr, "kernel_launch: hipFuncSetAttribute failed\n"); grid = -1; return; }
        if (hipOccupancyMaxActiveBlocksPerMultiprocessor(&per_cu, (const void*)fwd_kernel, NTHR, LDS_BYTES) != hipSuccess || per_cu < 1) fprintf(stderr, "kernel_launch: occupancy query reports %d\n", per_cu);
        (void)hipGetLastError();
        grid = cus;
    }
    if (grid < 0) return;
    (void)hipMemsetAsync((char*)d_ws + WS_CTL, 0, CTL_ZERO_BYTES, stream);
    Args a{};
    for (int i = 0; i < 34; ++i) a.in[i] = (const float*)d_in[i];
    a.out = (float*)d_out; a.ws = (unsigned char*)d_ws;
#if MK_SPLIT
    for (int p = 0; p < NPHASE; ++p) { a.ph_lo = p; a.ph_hi = p + 1; hipLaunchKernelGGL(fwd_kernel, dim3(grid), dim3(NTHR), LDS_BYTES, stream, a); }
#else
    a.ph_lo = 0; a.ph_hi = NPHASE; hipLaunchKernelGGL(fwd_kernel, dim3(grid), dim3(NTHR), LDS_BYTES, stream, a);
#endif
}
```

```cpp
#include <hip/hip_runtime.h>
#include <cstdio>
#include <cstdint>

#define GAS __attribute__((address_space(1)))
#define LAS __attribute__((address_space(3)))
typedef unsigned short bf16;
typedef short bf16x8 __attribute__((ext_vector_type(8)));
typedef short bf16x4 __attribute__((ext_vector_type(4)));
typedef float f32x4 __attribute__((ext_vector_type(4)));
typedef float f32x2 __attribute__((ext_vector_type(2)));
typedef unsigned u32x4 __attribute__((ext_vector_type(4)));
typedef unsigned u32x2 __attribute__((ext_vector_type(2)));
typedef GAS unsigned gu32;
typedef int i32x4 __attribute__((ext_vector_type(4)));
typedef int i32x8 __attribute__((ext_vector_type(8)));
#define RLX_AGENT __ATOMIC_RELAXED, __HIP_MEMORY_SCOPE_AGENT
#define LDS_WAIT() asm volatile("s_waitcnt lgkmcnt(0)" ::: "memory")
#define VM_WAIT() asm volatile("s_waitcnt vmcnt(0)" ::: "memory")

typedef __bf16 bf16x2_t __attribute__((ext_vector_type(2)));
__device__ __forceinline__ unsigned cvt_pk_bf16(float lo, float hi) { const f32x2 v = {lo, hi}; const bf16x2_t b = __builtin_convertvector(v, bf16x2_t); return __builtin_bit_cast(unsigned, b); }
__device__ __forceinline__ unsigned f2bf(float f) { unsigned u = __builtin_bit_cast(unsigned, f); return (u + 0x7fffu + ((u >> 16) & 1u)) >> 16; }
__device__ __forceinline__ unsigned pk2(float lo, float hi) { return f2bf(lo) | (f2bf(hi) << 16); }
__device__ __forceinline__ float bf2f(bf16 b) { return __builtin_bit_cast(float, (unsigned)b << 16); }
__device__ __forceinline__ float bflo(unsigned u) { return __builtin_bit_cast(float, u << 16); }
__device__ __forceinline__ float bfhi(unsigned u) { return __builtin_bit_cast(float, u & 0xffff0000u); }
__device__ __forceinline__ float fexp2(float x) { return __builtin_amdgcn_exp2f(x); }
__device__ __forceinline__ float fexp(float x) { return __builtin_amdgcn_exp2f(x * 1.4426950408889634f); }
__device__ __forceinline__ float frcp(float x) { return __builtin_amdgcn_rcpf(x); }
__device__ __forceinline__ float sigmoidf_(float x) { return frcp(1.0f + fexp(-x)); }
__device__ __forceinline__ unsigned pk4_fp8(float a, float b, float c, float d) {
    a = __builtin_amdgcn_fmed3f(a, -448.f, 448.f); b = __builtin_amdgcn_fmed3f(b, -448.f, 448.f); c = __builtin_amdgcn_fmed3f(c, -448.f, 448.f); d = __builtin_amdgcn_fmed3f(d, -448.f, 448.f);
    int w = 0; w = __builtin_amdgcn_cvt_pk_fp8_f32(a, b, w, false); w = __builtin_amdgcn_cvt_pk_fp8_f32(c, d, w, true); return (unsigned)w; }
__device__ __forceinline__ i32x8 cat8(bf16x8 lo, bf16x8 hi) { const i32x4 a = __builtin_bit_cast(i32x4, lo), b = __builtin_bit_cast(i32x4, hi); return __builtin_shufflevector(a, b, 0, 1, 2, 3, 4, 5, 6, 7); }
constexpr float F8_SA = 16.f, F8_SW = 256.f, F8_SACT = 8.f;

namespace pg8 {
constexpr int BM = 256, BK = 64, HALF = 128, HTB = HALF * BK * 2  , STAGE_BYTES = 8 * HTB, NXCD = 8, WGM = 8;
__host__ __device__ __forceinline__ int lds_byte(int r, int c) { const int st = (r >> 4) * 2 + (c >> 5), rr = r & 15, cc = c & 31, ob = rr * 64 + cc * 2; return st * 1024 + (ob ^ (((ob >> 9) & 1) << 5)); }
__host__ __device__ __forceinline__ void stage_rc(int b, int& R, int& C) { const int st = b / 1024, sb = b % 1024, swz = sb ^ (((sb >> 9) & 1) << 5); R = (st >> 1) * 16 + swz / 64; C = (st & 1) * 32 + (swz % 64) / 2; }
__host__ __device__ __forceinline__ int perm32(int rho) { const int n = rho >> 4, i = rho & 15; return 8 * (i >> 2) + 4 * n + (i & 3); }

struct Unit { int pm, pn, e, nvalid, lbase, orow; };
struct Gemm { const bf16* A; const bf16* Bt; int K; size_t bstride; const int* rowlist; };

struct StaticOrder {
    int nM, nN, nwg, G, c;
    __device__ void init(int M, int N, int G_, int c_, int rot) { nM = M / BM; nN = N / BM; nwg = nM * nN; G = G_; c = (c_ + rot) % G_; }
    __device__ bool next(int i, Unit& u) const {
        const long L = (long)i * G + c; if (L >= nwg) return false;
        int wgid = (int)L; { const int q = nwg / NXCD, r = nwg % NXCD, xcd = wgid % NXCD, off = wgid / NXCD; wgid = (xcd < r ? xcd * (q + 1) : r * (q + 1) + (xcd - r) * q) + off; }
        const int nig = WGM * nN, gid = wgid / nig, fm = gid * WGM, gsz = (nM - fm) < WGM ? (nM - fm) : WGM;
        u.pm = fm + ((wgid % nig) % gsz); u.pn = (wgid % nig) / gsz; u.e = 0; u.nvalid = 256; u.lbase = 0; u.orow = u.pm * BM; return true;
    }
};

template <class Epi, class Sched, bool ALIGN_EPI, bool GATHER, bool F8 = false>
__device__ __forceinline__ void gemm_phase(LAS unsigned char* lds, LAS int* lstage  , const Gemm g, const Sched& S, const Epi& E) {
    int tid = threadIdx.x; asm volatile("" : "+v"(tid));
    const int wid = __builtin_amdgcn_readfirstlane(tid >> 6), lane = tid & 63, wr = wid >> 2, wc = wid & 3, fr = lane & 15, fq = lane >> 4;
    const int K = g.K, nt = K / BK;
    unsigned voffB[2], vA[2][2];
#pragma unroll
    for (int i = 0; i < 2; ++i) { int R, C; stage_rc(tid * 16 + i * 8192, R, C); const int Rb = Epi::PERM ? ((R & ~31) + perm32(R & 31)) : R;
        voffB[i] = (unsigned)(Rb * K + C) * 2u;
#pragma unroll
        for (int h = 0; h < 2; ++h) vA[h][i] = (unsigned)((h * HALF + R) * K + C) * 2u; }
    const size_t kstep = (size_t)(BK * 2);
    const size_t hstep = (size_t)HALF * K * 2;
    const size_t tstep = 2 * hstep;
    constexpr int AH1 = GATHER ? 1 : 0; const size_t AH = GATHER ? (size_t)0 : hstep;
    const unsigned ldsw = (unsigned)wid * 1024u;
    const int aoff = lds_byte(wr * 64 + fr, fq * 8), boff = lds_byte(wc * 32 + fr, fq * 8);
#define PG8_SA(b, h) (((b) * 2 + (h)) * HTB)
#define PG8_SB(b, h) ((4 + (b) * 2 + (h)) * HTB)
#define PG8_STAGE_(rs, base, bufoff, off, voff) do { _Pragma("unroll") for (int _i = 0; _i < 2; ++_i) { \
        if constexpr (F8) { unsigned keep_; asm volatile("s_mov_b32 %0, m0\n\ts_mov_b32 m0, %1\n\ts_nop 0\n\tbuffer_load_dwordx4 %2, %3, %4 offen lds\n\ts_mov_b32 m0, %0" \
            : "=&s"(keep_) : "s"(lds32 + (unsigned)(bufoff) + ldsw + (unsigned)_i * 8192u), "v"((voff)[_i]), "s"(rs), "s"((unsigned)(off)) : "memory"); } \
        else __builtin_amdgcn_global_load_lds((const unsigned*)((const char*)(base) + (off) + (voff)[_i]), (LAS unsigned*)(lds + (bufoff) + ldsw + _i * 8192), 16, 0, 0); } } while (0)
#define PG8_STA(bufoff, off, voff) PG8_STAGE_(rsA, g.A, bufoff, off, voff)
#define PG8_STB(bufoff, off, voff) PG8_STAGE_(rsB, g.Bt, bufoff, off, voff)
#define PG8_LDA(dst, b, h) do { _Pragma("unroll") for (int m = 0; m < 4; ++m) _Pragma("unroll") for (int k = 0; k < 2; ++k) dst[m][k] = *(const LAS bf16x8*)(lds + PG8_SA(b, h) + aoff + m * 2048 + k * 1024); } while (0)
#define PG8_LDB(dst, b, h) do { _Pragma("unroll") for (int n = 0; n < 2; ++n) _Pragma("unroll") for (int k = 0; k < 2; ++k) dst[n][k] = *(const LAS bf16x8*)(lds + PG8_SB(b, h) + boff + n * 2048 + k * 1024); } while (0)
#define PG8_MMA(ai, bj, At, Bt) do { __builtin_amdgcn_s_setprio(1); _Pragma("unroll") for (int m = 0; m < 4; ++m) _Pragma("unroll") for (int n = 0; n < 2; ++n) { \
        if constexpr (F8) acc[ai][bj][m][n] = __builtin_amdgcn_mfma_scale_f32_16x16x128_f8f6f4(cat8(Bt[n][0], Bt[n][1]), cat8(At[m][0], At[m][1]), acc[ai][bj][m][n], 0, 0, 0, 0x7F7F7F7F, 0, 0x7F7F7F7F); \
        else { _Pragma("unroll") for (int k = 0; k < 2; ++k) acc[ai][bj][m][n] = __builtin_amdgcn_mfma_f32_16x16x32_bf16(Bt[n][k], At[m][k], acc[ai][bj][m][n], 0, 0, 0); } } __builtin_amdgcn_s_setprio(0); } while (0)
#define PG8_WAIT_V(n) asm volatile("s_waitcnt vmcnt(" #n ")" ::: "memory")
#define PG8_WAIT_L(n) asm volatile("s_waitcnt lgkmcnt(" #n ")" ::: "memory")
#define PG8_BAR __builtin_amdgcn_s_barrier()
#define PG8_SCHED __builtin_amdgcn_sched_barrier(0)
    Unit cur, nxt; int ui = 0;
    if (!S.next(0, cur)) return;
    f32x4 acc[2][2][4][2];
#pragma unroll
    for (int a = 0; a < 2; ++a)
#pragma unroll
        for (int b = 0; b < 2; ++b)
#pragma unroll
            for (int m = 0; m < 4; ++m)
#pragma unroll
                for (int n = 0; n < 2; ++n) acc[a][b][m][n] = (f32x4){0.f, 0.f, 0.f, 0.f};
    bf16x8 At[4][2], B0[2][2], B1[2][2];
    size_t cA = GATHER ? (size_t)0 : (size_t)cur.pm * tstep;
    size_t cB = ((size_t)cur.e * g.bstride) * 2 + (size_t)cur.pn * tstep;
    const unsigned lds32 = (unsigned)(uintptr_t)lds;
    const __amdgpu_buffer_rsrc_t rsA = __builtin_amdgcn_make_buffer_rsrc((void*)g.A, 0, 0x7fffffff, 0x00020000), rsB = __builtin_amdgcn_make_buffer_rsrc((void*)g.Bt, 0, 0x7fffffff, 0x00020000);
    if constexpr (GATHER) {
        if (wid == 0) { unsigned lo16 = threadIdx.x; asm volatile("" : "+v"(lo16)); lo16 = (lo16 & 63u) * 16u; __builtin_amdgcn_global_load_lds((const unsigned*)((const char*)(g.rowlist + cur.lbase) + lo16), (LAS unsigned*)lstage, 16, 0, 0); }
        PG8_WAIT_V(0); __builtin_amdgcn_s_barrier();
#pragma unroll
        for (int h = 0; h < 2; ++h)
#pragma unroll
            for (int i = 0; i < 2; ++i) { int R, C; stage_rc(tid * 16 + i * 8192, R, C); const int rr = h * HALF + R; const int ent = lstage[rr]; const int src = rr < cur.nvalid ? ((ent >> 2) & 16383) : 0; vA[h][i] = (unsigned)(src * K + C) * 2u; }
        PG8_WAIT_L(0); __builtin_amdgcn_s_barrier();
    }
    PG8_STB(PG8_SB(0, 0), cB, voffB); PG8_STB(PG8_SB(0, 1), cB + hstep, voffB); PG8_STA(PG8_SA(0, 0), cA, vA[0]); PG8_STA(PG8_SA(0, 1), cA + AH, vA[AH1]);
    if (wr == 1) PG8_BAR;
    PG8_WAIT_V(2); PG8_BAR;
    PG8_STB(PG8_SB(1, 0), cB + kstep, voffB); PG8_STA(PG8_SA(1, 0), cA + kstep, vA[0]); PG8_STB(PG8_SB(1, 1), cB + hstep + kstep, voffB);
    PG8_WAIT_V(6); PG8_BAR;
    for (;;) {
        const bool has_next = S.next(ui + 1, nxt);
        const size_t nA = has_next ? (GATHER ? (size_t)0 : (size_t)nxt.pm * tstep) : cA;
        const size_t nB = has_next ? ((size_t)nxt.e * g.bstride) * 2 + (size_t)nxt.pn * tstep : cB;
#pragma unroll 1
        for (int t = 0; t < nt; t += 2) {
            const bool last = (t == nt - 2);
            if constexpr (GATHER) {
                if (t == 0 && has_next && wid == 0) { unsigned lo16 = threadIdx.x; asm volatile("" : "+v"(lo16)); lo16 = (lo16 & 63u) * 16u;
                    __builtin_amdgcn_global_load_lds((const unsigned*)((const char*)(g.rowlist + nxt.lbase) + lo16), (LAS unsigned*)(lstage + 256 * ((ui + 1) & 1)), 16, 0, 0); }
            }
            const size_t a1 = cA + (size_t)(t + 1) * kstep;
            const size_t a2 = last ? nA : cA + (size_t)(t + 2) * kstep; const size_t b2 = last ? nB : cB + (size_t)(t + 2) * kstep;
            const size_t a3 = a2 + kstep; const size_t b3 = b2 + kstep;
            PG8_LDB(B0, 0, 0); PG8_LDB(B1, 0, 1); PG8_SCHED; PG8_LDA(At, 0, 0); PG8_STA(PG8_SA(1, 1), a1 + AH, vA[AH1]);
            if constexpr (GATHER) { if (last && has_next) {
                int tl = tid; asm volatile("" : "+v"(tl));
#pragma unroll
                for (int h = 0; h < 2; ++h)
#pragma unroll
                    for (int i = 0; i < 2; ++i) { int R, C; stage_rc(tl * 16 + i * 8192, R, C); const int rr = h * HALF + R; const int ent = lstage[256 * ((ui + 1) & 1) + rr]; const int src = rr < nxt.nvalid ? ((ent >> 2) & 16383) : 0; vA[h][i] = (unsigned)(src * K + C) * 2u; } } }
            PG8_WAIT_V(8); PG8_WAIT_L(0); PG8_BAR; PG8_MMA(0, 0, At, B0); PG8_MMA(0, 1, At, B1); PG8_BAR; PG8_SCHED;
            PG8_LDA(At, 0, 1); PG8_STB(PG8_SB(0, 0), b2, voffB); PG8_STB(PG8_SB(0, 1), b2 + hstep, voffB); PG8_STA(PG8_SA(0, 0), a2, vA[0]);
            PG8_WAIT_V(8); PG8_WAIT_L(0); PG8_BAR; PG8_MMA(1, 0, At, B0); PG8_MMA(1, 1, At, B1); PG8_BAR; PG8_SCHED;
            PG8_LDB(B0, 1, 0); PG8_LDB(B1, 1, 1); PG8_SCHED; PG8_LDA(At, 1, 0); PG8_STA(PG8_SA(0, 1), a2 + AH, vA[AH1]);
            PG8_WAIT_V(8); PG8_WAIT_L(0); PG8_BAR; PG8_MMA(0, 0, At, B0); PG8_MMA(0, 1, At, B1); PG8_BAR; PG8_SCHED;
            PG8_LDA(At, 1, 1); PG8_STB(PG8_SB(1, 0), b3, voffB); PG8_STB(PG8_SB(1, 1), b3 + hstep, voffB); PG8_STA(PG8_SA(1, 0), a3, vA[0]);
            PG8_WAIT_V(8); PG8_WAIT_L(0); PG8_BAR; PG8_MMA(1, 0, At, B0); PG8_MMA(1, 1, At, B1); PG8_BAR; PG8_SCHED;
        }
        if constexpr (ALIGN_EPI) { if (wr == 0) PG8_BAR; }
        E(acc, cur, wr, wc, fr, fq);
        if (!has_next) break;
#pragma unroll
        for (int a = 0; a < 2; ++a)
#pragma unroll
            for (int b = 0; b < 2; ++b)
#pragma unroll
                for (int m = 0; m < 4; ++m)
#pragma unroll
                    for (int n = 0; n < 2; ++n) acc[a][b][m][n] = (f32x4){0.f, 0.f, 0.f, 0.f};
        cur = nxt; cA = nA; cB = nB; ++ui;
        if constexpr (ALIGN_EPI) { if (wr == 1) PG8_BAR; }
    }
    PG8_WAIT_V(0);
    if constexpr (!ALIGN_EPI) { if (wr == 0) PG8_BAR; }
    PG8_BAR;
#undef PG8_SA
#undef PG8_SB
#undef PG8_STAGE_
#undef PG8_STA
#undef PG8_STB
#undef PG8_LDA
#undef PG8_LDB
#undef PG8_MMA
#undef PG8_WAIT_V
#undef PG8_WAIT_L
#undef PG8_BAR
#undef PG8_SCHED
}
}
constexpr int NWAVES = 8, NTHR = 512;
constexpr int BATCH = 2, T = 8192, D = 1024, M = BATCH * T;
constexpr int CH = 64, NCHUNK = T / CH;
constexpr int RW = 512, RH = 8, RN = 64;
constexpr int DH = 4, DD = 64, DV = 128;
constexpr int SHIFT_COLS = 1792, PCOLS = 2816, IN_COLS = 3328;
constexpr int C_R = 0, C_K = 512, C_V = 1024, C_WD = 1536, C_AD = 1600, C_GD = 1664, C_QD = 1792, C_KD = 2304, C_VD = 2816;
constexpr int MEM = 256, XH = 4, XD = 256;
constexpr int NE = 32, TOPK = 4, FF = 1024, CAP = M;
constexpr int MAXRT = (M * TOPK) / 256 + NE;
constexpr float NORM_EPS = 1e-5f, GN_EPS = 64e-5f, LOG2E = 1.4426950408889634f;
constexpr float LAMBDA_INIT = 0.8f - 0.6f;

constexpr size_t MiB = 1u << 20;
constexpr size_t WS_CTL = 0, CTL_ZERO_BYTES = 1 * MiB;
constexpr size_t WS_SS1 = 250 * MiB + 512 * 1024, WS_SS3 = 251 * MiB;
constexpr size_t WS_WINT = 1 * MiB, WS_WOUTT = 8 * MiB, WS_WQT = 10 * MiB, WS_WKVT = 12 * MiB, WS_WOT = 16 * MiB;
constexpr size_t WS_W2LT = 18 * MiB, WS_A2LT = WS_W2LT + 64 * 1024, WS_G2LT = WS_W2LT + 128 * 1024, WS_RWT = WS_W2LT + 256 * 1024;
constexpr size_t WS_W1T = 20 * MiB, WS_W2T = 148 * MiB;
constexpr size_t WS_LGATE = 212 * MiB, WS_LRINV = 214 * MiB;
constexpr size_t WS_XN = 212 * MiB, WS_MEMN = 244 * MiB, WS_KMEM = 245 * MiB, WS_VTMEM = 246 * MiB;
constexpr size_t WS_LISTS = 247 * MiB, WS_GATES = 249 * MiB, WS_GC = 249 * MiB + 512 * 1024, WS_BS = 250 * MiB;
constexpr size_t WS_PROJ = 252 * MiB, WS_VT = 340 * MiB, WS_QT = 356 * MiB, WS_PT = 372 * MiB, WS_S0 = 388 * MiB, WS_GATE = 404 * MiB, WS_YLOC = 420 * MiB, WS_NN = 452 * MiB;
constexpr size_t WS_CAT = 484 * MiB, WS_H1 = 516 * MiB, WS_H1B = 580 * MiB, WS_QX = 612 * MiB, WS_XO = 644 * MiB, WS_H2 = 676 * MiB, WS_H2B = 740 * MiB;
constexpr size_t WS_ACT = 252 * MiB;
constexpr size_t WS_YBUF = 404 * MiB, WS_END = 772 * MiB;
static_assert(WS_ACT + (size_t)MAXRT * 256 * FF * 2 <= WS_GATE, "ACT overlay");
static_assert(WS_PROJ + (size_t)M * PCOLS * 2 <= WS_VT, "PROJ");
constexpr int CW_TMO = 0, CW_BAR = 4096, CW_CNT = 8192;
static_assert((CW_BAR + 3456) <= CW_CNT && (CW_CNT + 64 * NE) * 4 <= (int)CTL_ZERO_BYTES, "CTL map");

constexpr int RING_BYTES = 131072;
constexpr int X_OFF = RING_BYTES;
constexpr int MISC_OFF = 163840 - 1024;
constexpr int LDS_BYTES = 163840;

__device__ __forceinline__ float row_ss(const float* ssp, int row) {
    const f32x4 a = *(const f32x4*)(ssp + (size_t)row * 16), b = *(const f32x4*)(ssp + (size_t)row * 16 + 4), c = *(const f32x4*)(ssp + (size_t)row * 16 + 8), d = *(const f32x4*)(ssp + (size_t)row * 16 + 12);
    return (((a[0] + a[1]) + (a[2] + a[3])) + ((b[0] + b[1]) + (b[2] + b[3]))) + (((c[0] + c[1]) + (c[2] + c[3])) + ((d[0] + d[1]) + (d[2] + d[3])));
}
namespace pg8 {
struct EpiBf16 {
    static constexpr bool PERM = true;
    bf16* O; int ldc;
    __device__ __forceinline__ void operator()(const f32x4 (&acc)[2][2][4][2], const Unit& u, int wr, int wc, int fr, int fq) const {
        { unsigned tl = threadIdx.x; asm volatile("" : "+v"(tl)); fr = (int)(tl & 15u); fq = (int)((tl >> 4) & 3u); }
        const int col0 = u.pn * BM + wc * 32 + 8 * fq;
#pragma unroll
        for (int ai = 0; ai < 2; ++ai)
#pragma unroll
            for (int m = 0; m < 4; ++m) { bf16* rowp = O + (size_t)(u.orow + ai * HALF + wr * 64 + m * 16 + fr) * ldc + col0;
#pragma unroll
                for (int bj = 0; bj < 2; ++bj) { const f32x4 v0 = acc[ai][bj][m][0], v1 = acc[ai][bj][m][1];
                    u32x4 w; w.x = cvt_pk_bf16(v0[0], v0[1]); w.y = cvt_pk_bf16(v0[2], v0[3]); w.z = cvt_pk_bf16(v1[0], v1[1]); w.w = cvt_pk_bf16(v1[2], v1[3]);
                    *(u32x4*)(rowp + bj * HALF) = w; } }
    }
};
struct EpiRowScaleBf16 {
    static constexpr bool PERM = true;
    bf16* O; int ldc; const float* ss; float scale;
    __device__ __forceinline__ void operator()(const f32x4 (&acc)[2][2][4][2], const Unit& u, int wr, int wc, int fr, int fq) const {
        { unsigned tl = threadIdx.x; asm volatile("" : "+v"(tl)); fr = (int)(tl & 15u); fq = (int)((tl >> 4) & 3u); }
        const int col0 = u.pn * BM + wc * 32 + 8 * fq;
#pragma unroll
        for (int ai = 0; ai < 2; ++ai)
#pragma unroll
            for (int m = 0; m < 4; ++m) { const int row = u.orow + ai * HALF + wr * 64 + m * 16 + fr; bf16* rowp = O + (size_t)row * ldc + col0;
                const float s = scale * __builtin_amdgcn_rsqf(row_ss(ss, row) * (1.0f / D) + NORM_EPS);
#pragma unroll
                for (int bj = 0; bj < 2; ++bj) { const f32x4 v0 = acc[ai][bj][m][0] * s, v1 = acc[ai][bj][m][1] * s;
                    u32x4 w; w.x = cvt_pk_bf16(v0[0], v0[1]); w.y = cvt_pk_bf16(v0[2], v0[3]); w.z = cvt_pk_bf16(v1[0], v1[1]); w.w = cvt_pk_bf16(v1[2], v1[3]);
                    *(u32x4*)(rowp + bj * HALF) = w; } }
    }
};
struct EpiResid {
    static constexpr bool PERM = true;
    const float* base; float* H; bf16* Hb; float* ss;
    __device__ __forceinline__ void operator()(const f32x4 (&acc)[2][2][4][2], const Unit& u, int wr, int wc, int fr, int fq) const {
        { unsigned tl = threadIdx.x; asm volatile("" : "+v"(tl)); fr = (int)(tl & 15u); fq = (int)((tl >> 4) & 3u); }
        const int col0 = u.pn * BM + wc * 32 + 8 * fq;
#pragma unroll
        for (int ai = 0; ai < 2; ++ai)
#pragma unroll
            for (int m = 0; m < 4; ++m) { const int row = u.orow + ai * HALF + wr * 64 + m * 16 + fr; const size_t off = (size_t)row * D + col0; float q = 0.f;
#pragma unroll
                for (int bj = 0; bj < 2; ++bj) {
                    const f32x4 b0 = *(const f32x4*)(base + off + bj * HALF), b1 = *(const f32x4*)(base + off + bj * HALF + 4);
                    const f32x4 v0 = acc[ai][bj][m][0] + b0, v1 = acc[ai][bj][m][1] + b1;
                    *(f32x4*)(H + off + bj * HALF) = v0; *(f32x4*)(H + off + bj * HALF + 4) = v1;
                    u32x4 w; w.x = cvt_pk_bf16(v0[0], v0[1]); w.y = cvt_pk_bf16(v0[2], v0[3]); w.z = cvt_pk_bf16(v1[0], v1[1]); w.w = cvt_pk_bf16(v1[2], v1[3]);
                    *(u32x4*)(Hb + off + bj * HALF) = w;
                    q += (v0[0] * v0[0] + v0[1] * v0[1]) + (v0[2] * v0[2] + v0[3] * v0[3]) + (v1[0] * v1[0] + v1[1] * v1[1]) + (v1[2] * v1[2] + v1[3] * v1[3]); }
                q += __shfl_xor(q, 16); q += __shfl_xor(q, 32);
                if (fq == 0) ss[(size_t)row * 16 + u.pn * 4 + wc] = q; }
    }
};
template <bool HB8>
struct EpiResid2T {
    static constexpr bool PERM = true;
    const float* basef; const bf16* baseb; float* H; bf16* Hb; float* ss;
    __device__ __forceinline__ void operator()(const f32x4 (&acc)[2][2][4][2], const Unit& u, int wr, int wc, int fr, int fq) const {
        { unsigned tl = threadIdx.x; asm volatile("" : "+v"(tl)); fr = (int)(tl & 15u); fq = (int)((tl >> 4) & 3u); }
        const int col0 = u.pn * BM + wc * 32 + 8 * fq;
#pragma unroll
        for (int ai = 0; ai < 2; ++ai)
#pragma unroll
            for (int m = 0; m < 4; ++m) { const int row = u.orow + ai * HALF + wr * 64 + m * 16 + fr; const size_t off = (size_t)row * D + col0; float q = 0.f;
#pragma unroll
                for (int bj = 0; bj < 2; ++bj) {
                    f32x4 b0, b1;
                    if (basef) { b0 = *(const f32x4*)(basef + off + bj * HALF); b1 = *(const f32x4*)(basef + off + bj * HALF + 4); }
                    else { const u32x4 bb = *(const u32x4*)(baseb + off + bj * HALF); b0 = (f32x4){bflo(bb.x), bfhi(bb.x), bflo(bb.y), bfhi(bb.y)}; b1 = (f32x4){bflo(bb.z), bfhi(bb.z), bflo(bb.w), bfhi(bb.w)}; }
                    const f32x4 v0 = acc[ai][bj][m][0] + b0, v1 = acc[ai][bj][m][1] + b1;
                    if (H) { *(f32x4*)(H + off + bj * HALF) = v0; *(f32x4*)(H + off + bj * HALF + 4) = v1; }
                    if constexpr (HB8) { u32x2 w8; w8.x = pk4_fp8(v0[0] * F8_SA, v0[1] * F8_SA, v0[2] * F8_SA, v0[3] * F8_SA); w8.y = pk4_fp8(v1[0] * F8_SA, v1[1] * F8_SA, v1[2] * F8_SA, v1[3] * F8_SA);
                        *(u32x2*)((unsigned char*)Hb + off + bj * HALF) = w8; }
                    else { u32x4 w; w.x = cvt_pk_bf16(v0[0], v0[1]); w.y = cvt_pk_bf16(v0[2], v0[3]); w.z = cvt_pk_bf16(v1[0], v1[1]); w.w = cvt_pk_bf16(v1[2], v1[3]);
                        *(u32x4*)(Hb + off + bj * HALF) = w; }
                    q += (v0[0] * v0[0] + v0[1] * v0[1]) + (v0[2] * v0[2] + v0[3] * v0[3]) + (v1[0] * v1[0] + v1[1] * v1[1]) + (v1[2] * v1[2] + v1[3] * v1[3]); }
                q += __shfl_xor(q, 16); q += __shfl_xor(q, 32);
                if (fq == 0) ss[(size_t)row * 16 + u.pn * 4 + wc] = q; }
    }
};
using EpiResid2 = EpiResid2T<false>;
struct EpiSwiglu {
    static constexpr bool PERM = true;
    unsigned char* ACT; const float* b1; const float* lrinv; const int* list;
    __device__ __forceinline__ void operator()(const f32x4 (&acc)[2][2][4][2], const Unit& u, int wr, int wc, int fr, int fq) const {
        { unsigned tl = threadIdx.x; asm volatile("" : "+v"(tl)); fr = (int)(tl & 15u); fq = (int)((tl >> 4) & 3u); }
        const int j0 = u.pn * HALF + wc * 32 + 8 * fq; const float* bg = b1 + (size_t)u.e * (2 * FF) + j0; const float* bl = bg + FF;
        const f32x4 g0 = *(const f32x4*)bg, g1 = *(const f32x4*)(bg + 4), l0 = *(const f32x4*)bl, l1 = *(const f32x4*)(bl + 4);
#pragma unroll
        for (int ai = 0; ai < 2; ++ai)
#pragma unroll
            for (int m = 0; m < 4; ++m) { const int rr = ai * HALF + wr * 64 + m * 16 + fr;
                if (rr < u.nvalid) {
                    const float s = lrinv[u.lbase + rr] * (1.0f / (F8_SA * F8_SW));
                    float o[8];
#pragma unroll
                    for (int n = 0; n < 2; ++n)
#pragma unroll
                        for (int j = 0; j < 4; ++j) { float gt = acc[ai][0][m][n][j] * s + (n ? g1[j] : g0[j]), ln = acc[ai][1][m][n][j] * s + (n ? l1[j] : l0[j]);
                            gt = fminf(gt, 7.0f); ln = fminf(fmaxf(ln, -7.0f), 7.0f);
                            o[n * 4 + j] = gt * frcp(1.0f + fexp(-1.702f * gt)) * (ln * F8_SACT + F8_SACT); }
                    u32x2 w; w.x = pk4_fp8(o[0], o[1], o[2], o[3]); w.y = pk4_fp8(o[4], o[5], o[6], o[7]);
                    *(u32x2*)(ACT + (size_t)(u.orow + rr) * FF + j0) = w; } }
        asm volatile("" :: "v"(g0), "v"(g1), "v"(l0), "v"(l1));
    }
};
struct EpiMoe2 {
    static constexpr bool PERM = true;
    bf16* Y; const float* b2; const float* gates; const int* list;
    __device__ __forceinline__ void operator()(const f32x4 (&acc)[2][2][4][2], const Unit& u, int wr, int wc, int fr, int fq) const {
        { unsigned tl = threadIdx.x; asm volatile("" : "+v"(tl)); fr = (int)(tl & 15u); fq = (int)((tl >> 4) & 3u); }
        const int col0 = u.pn * BM + wc * 32 + 8 * fq; const float* bb = b2 + (size_t)u.e * D + col0;
        f32x4 bv[2][2];
#pragma unroll
        for (int bj = 0; bj < 2; ++bj) { bv[bj][0] = *(const f32x4*)(bb + bj * HALF); bv[bj][1] = *(const f32x4*)(bb + bj * HALF + 4); }
#pragma unroll
        for (int ai = 0; ai < 2; ++ai)
#pragma unroll
            for (int m = 0; m < 4; ++m) { const int rr = ai * HALF + wr * 64 + m * 16 + fr;
                if (rr < u.nvalid) {
                    const int ent = list[u.lbase + rr] & 65535; const float gw = gates[u.lbase + rr]; bf16* rowp = Y + (size_t)ent * D + col0;
#pragma unroll
                    for (int bj = 0; bj < 2; ++bj) { const f32x4 v0 = (acc[ai][bj][m][0] * (1.0f / (F8_SACT * F8_SW)) + bv[bj][0]) * gw, v1 = (acc[ai][bj][m][1] * (1.0f / (F8_SACT * F8_SW)) + bv[bj][1]) * gw;
                        u32x4 w; w.x = cvt_pk_bf16(v0[0], v0[1]); w.y = cvt_pk_bf16(v0[2], v0[3]); w.z = cvt_pk_bf16(v1[0], v1[1]); w.w = cvt_pk_bf16(v1[2], v1[3]);
                        *(u32x4*)(rowp + bj * HALF) = w; } } }
        asm volatile("" :: "v"(bv[0][0]), "v"(bv[0][1]), "v"(bv[1][0]), "v"(bv[1][1]));
    }
};
struct MoeOrder {
    const LAS int* tb; const LAS int* cn; const LAS int* rte; int ncol, G, c, ntile;
    __device__ bool next(int i, Unit& u) const {
        const int L = i * G + c, rt = L / ncol, pn = L % ncol; if (rt >= ntile) return false;
        const int e = __builtin_amdgcn_readfirstlane(rte[rt]);
        const int tile = rt - __builtin_amdgcn_readfirstlane(tb[e]), left = __builtin_amdgcn_readfirstlane(cn[e]) - tile * 256;
        u.pm = rt; u.pn = pn; u.e = e; u.nvalid = left < 256 ? left : 256; u.lbase = e * CAP + tile * 256; u.orow = rt * 256; return true;
    }
};
}
#define XB_TMO      128
#define XB_XCNT(j)  (256  + 64 * (j))
#define XB_XSUB(j)  (1280 + 64 * (j))
#define XB_XGEN(j)  (2304 + 64 * (j))
#define XB_TOP      3328
#define XB_TOPGEN   3392
#define XCD_BAR_WORDS 3456
#define XB_SPIN_CAP (1u << 18)

__device__ __forceinline__ unsigned xb_ld(unsigned* p)              { return __hip_atomic_load(p, __ATOMIC_RELAXED, __HIP_MEMORY_SCOPE_AGENT); }
__device__ __forceinline__ unsigned xb_add(unsigned* p, unsigned v) { return __hip_atomic_fetch_add(p, v, __ATOMIC_RELAXED, __HIP_MEMORY_SCOPE_AGENT); }
__device__ __forceinline__ unsigned xb_xcc_id() { return (unsigned)__builtin_amdgcn_s_getreg((3 << 11) | 20) & 0xFu; }
#define XB_SPIN(cond, bar) do { unsigned _sp = 0; while (cond) { __builtin_amdgcn_s_sleep(1); \
    if ((++_sp & 255u) == 0u) { if (xb_ld(&(bar)[XB_TMO])) break; if (_sp > XB_SPIN_CAP) { atomicAdd(&(bar)[XB_TMO], 1u); break; } } } } while (0)

struct XcdBarrier {
    unsigned* bar; unsigned x;
    volatile LAS unsigned* st;
};

__device__ __forceinline__ XcdBarrier xcd_barrier_post(unsigned* bar, volatile LAS unsigned* st) {
    XcdBarrier b; b.bar = bar; b.x = xb_xcc_id(); b.st = st;
    if (threadIdx.x == 0) (void)xb_add(&bar[XB_XCNT(b.x)], 1u);
    return b;
}
__device__ __forceinline__ void xcd_barrier_complete(unsigned* bar, unsigned x, unsigned& nloc, unsigned& nx) {
    const unsigned G = gridDim.x * gridDim.y * gridDim.z;
    unsigned sum, cnt, mine, sp = 0u;
    for (;;) {
        sum = 0u; cnt = 0u; mine = 0u;
#pragma unroll
        for (unsigned j = 0; j < 16; ++j) { const unsigned c = xb_ld(&bar[XB_XCNT(j)]); sum += c; cnt += (c > 0u) ? 1u : 0u; mine = (j == x) ? c : mine; }
        if (sum == G) break;
        __builtin_amdgcn_s_sleep(1);
        if ((++sp & 255u) == 0u) { if (xb_ld(&bar[XB_TMO])) break; if (sp > XB_SPIN_CAP) { atomicAdd(&bar[XB_TMO], 1u); break; } }
    }
    nloc = mine > 0u ? mine : 1u; nx = cnt > 0u ? cnt : 1u;
}

__device__ __forceinline__ void xcd_barrier(const XcdBarrier& b) {
    asm volatile("s_waitcnt vmcnt(0)" ::: "memory");
    __syncthreads();
    if (threadIdx.x == 0) {
        unsigned* bar = b.bar;
        __builtin_amdgcn_s_waitcnt(0);
        unsigned nloc = b.st[0], nx = b.st[1];
        if (nloc == 0u) { xcd_barrier_complete(bar, b.x, nloc, nx); b.st[0] = nloc; b.st[1] = nx; }
        const unsigned old = xb_add(&bar[XB_XSUB(b.x)], 1u);
        const unsigned gen = old / nloc;
        if (old + 1u == (gen + 1u) * nloc) {
            __builtin_amdgcn_fence(__ATOMIC_RELEASE, "agent");
            asm volatile("s_waitcnt vmcnt(0)" ::: "memory");
            const unsigned og = xb_add(&bar[XB_TOP], 1u);
            const unsigned tg = og / nx;
            if (og + 1u == (tg + 1u) * nx) xb_add(&bar[XB_TOPGEN], 1u);
            else XB_SPIN(xb_ld(&bar[XB_TOPGEN]) == tg, bar);
            __builtin_amdgcn_fence(__ATOMIC_ACQUIRE, "agent");
            xb_add(&bar[XB_XGEN(b.x)], 1u);
            asm volatile("s_waitcnt vmcnt(0)" ::: "memory");
        } else {
            XB_SPIN(xb_ld(&bar[XB_XGEN(b.x)]) == gen, bar);
            __builtin_amdgcn_fence(__ATOMIC_ACQUIRE, "agent");
            asm volatile("s_waitcnt vmcnt(0)" ::: "memory");
        }
    }
    __syncthreads();
}
#ifdef DBG_SEL
#define DBGCNT(F, k, cond) do { if (cond) atomicAdd((unsigned*)((F).ctl + 12288 + (k)), 1u); } while (0)
#else
#define DBGCNT(F, k, cond) do { } while (0)
#endif
struct Frame {
    LAS unsigned char* lds;
    volatile LAS unsigned* MISC;
    gu32* ctl;
    unsigned char* ws;
    int tid, lane, wave, G, bid;
    const float* in[34];
    float* out;
};
__device__ __forceinline__ float wave_sum(float v) {
#pragma unroll
    for (int o = 1; o < 64; o <<= 1) v += __shfl_xor(v, o);
    return v;
}
__device__ __forceinline__ float wave_max(float v) {
#pragma unroll
    for (int o = 1; o < 64; o <<= 1) v = fmaxf(v, __shfl_xor(v, o));
    return v;
}
__device__ __forceinline__ void p0_transpose_item(const float* W, int N, const float* gk, bf16* WT, int Kd, int k0, int n0, int drow, LAS float* scr, int lane) {
    float v[32];
#pragma unroll
    for (int i = 0; i < 32; ++i) { const int kk = 2 * i + (lane >> 5); v[i] = W[(size_t)(k0 + kk) * N + n0 + (lane & 31)]; }
    if (gk) {
#pragma unroll
        for (int i = 0; i < 32; ++i) { const int kk = 2 * i + (lane >> 5); v[i] *= gk[k0 + kk]; }
    }
#pragma unroll
    for (int i = 0; i < 32; ++i) { const int kk = 2 * i + (lane >> 5); scr[kk * 33 + (lane & 31)] = v[i]; }
    LDS_WAIT(); asm volatile("" ::: "memory");
    const int c = lane & 7;
#pragma unroll
    for (int j = 0; j < 4; ++j) { const int n = (lane >> 3) + 8 * j; const LAS float* s = scr + (8 * c) * 33 + n;
        u32x4 o; o.x = pk2(s[0 * 33], s[1 * 33]); o.y = pk2(s[2 * 33], s[3 * 33]); o.z = pk2(s[4 * 33], s[5 * 33]); o.w = pk2(s[6 * 33], s[7 * 33]);
        *(GAS u32x4*)(WT + (size_t)(drow + n) * Kd + k0 + 8 * c) = o; }
    LDS_WAIT(); asm volatile("" ::: "memory");
}
__device__ __forceinline__ void p0_transpose_item8(const float* W, int N, const float* gk, float scale, unsigned char* WT, int Kd, int k0, int n0, int drow, LAS float* scr, int lane) {
#pragma unroll 1
    for (int hh = 0; hh < 2; ++hh, k0 += 64) {
        float v[32];
#pragma unroll
        for (int i = 0; i < 32; ++i) { const int kk = 2 * i + (lane >> 5); v[i] = W[(size_t)(k0 + kk) * N + n0 + (lane & 31)]; }
        if (gk) {
#pragma unroll
            for (int i = 0; i < 32; ++i) { const int kk = 2 * i + (lane >> 5); v[i] *= gk[k0 + kk]; }
        }
#pragma unroll
        for (int i = 0; i < 32; ++i) { const int kk = 2 * i + (lane >> 5); scr[kk * 33 + (lane & 31)] = v[i] * scale; }
        LDS_WAIT(); asm volatile("" ::: "memory");
        const int c = lane & 7;
#pragma unroll
        for (int j = 0; j < 4; ++j) { const int n = (lane >> 3) + 8 * j; const LAS float* s = scr + (8 * c) * 33 + n;
            u32x2 o; o.x = pk4_fp8(s[0 * 33], s[1 * 33], s[2 * 33], s[3 * 33]); o.y = pk4_fp8(s[4 * 33], s[5 * 33], s[6 * 33], s[7 * 33]);
            *(GAS u32x2*)(WT + (size_t)(drow + n) * Kd + k0 + 8 * c) = o; }
        LDS_WAIT(); asm volatile("" ::: "memory");
    }
}
__device__ __forceinline__ void rms_row_to_bf16(const float* xrow, const float* g, bf16* orow, int lane) {
    const GAS f32x4* xr = (const GAS f32x4*)xrow + lane; const GAS f32x4* gr = (const GAS f32x4*)g + lane;
    f32x4 v[4]; float s = 0.f;
#pragma unroll
    for (int j = 0; j < 4; ++j) { v[j] = xr[64 * j]; s += (v[j].x * v[j].x + v[j].y * v[j].y) + (v[j].z * v[j].z + v[j].w * v[j].w); }
    const float rstd = 1.f / sqrtf(wave_sum(s) * (1.f / D) + NORM_EPS);
    GAS unsigned long long* o8 = (GAS unsigned long long*)orow + lane;
#pragma unroll
    for (int j = 0; j < 4; ++j) { const f32x4 gg = gr[64 * j];
        o8[64 * j] = (unsigned long long)pk2(v[j].x * rstd * gg.x, v[j].y * rstd * gg.y) | ((unsigned long long)pk2(v[j].z * rstd * gg.z, v[j].w * rstd * gg.w) << 32); }
}
enum { I_X = 0, I_MEM, I_N1G, I_WIN, I_MU, I_W0, I_W2, I_A0, I_A2, I_G2, I_KK, I_KA, I_RK, I_LNG, I_LNB, I_LQ1, I_LK1, I_LQ2, I_LK2, I_SUBG, I_WOUT, I_N2G, I_MNG, I_WQ, I_WKV, I_WO, I_N3G,
       I_RW, I_RB, I_W1, I_B1, I_W2E, I_B2, I_FG };

__device__ __forceinline__ void p0_prologue(Frame& F) {
    LAS float* scr = (LAS float*)(F.lds + F.wave * 16384);
    const int gw = F.bid * NWAVES + F.wave, NGW = F.G * NWAVES;
    constexpr int I_IN = 16 * (IN_COLS / 32), I_SQ = 16 * 32, I_KV = 16 * 64, I_L64 = 1 * 16, I_L128 = 2 * 16, I_E1 = 16 * 64, I_E2 = 16 * 32;
    constexpr int NITEMS = I_IN + 3 * I_SQ + I_KV + 2 * I_L64 + I_L128;
    for (int it = gw; it < NITEMS; it += NGW) {
        int r = it;
        if (r < I_IN) { const int nb = IN_COLS / 32; p0_transpose_item(F.in[I_WIN], IN_COLS, nullptr, (bf16*)(F.ws + WS_WINT), D, 64 * (r / nb), 32 * (r % nb), 32 * (r % nb), scr, F.lane); continue; } r -= I_IN;
        if (r < I_SQ) { p0_transpose_item(F.in[I_WOUT], D, nullptr, (bf16*)(F.ws + WS_WOUTT), D, 64 * (r / 32), 32 * (r % 32), 32 * (r % 32), scr, F.lane); continue; } r -= I_SQ;
        if (r < I_SQ) { p0_transpose_item(F.in[I_WQ], D, F.in[I_N2G], (bf16*)(F.ws + WS_WQT), D, 64 * (r / 32), 32 * (r % 32), 32 * (r % 32), scr, F.lane); continue; } r -= I_SQ;
        if (r < I_SQ) { p0_transpose_item(F.in[I_WO], D, nullptr, (bf16*)(F.ws + WS_WOT), D, 64 * (r / 32), 32 * (r % 32), 32 * (r % 32), scr, F.lane); continue; } r -= I_SQ;
        if (r < I_KV) { p0_transpose_item(F.in[I_WKV], 2 * D, nullptr, (bf16*)(F.ws + WS_WKVT), D, 64 * (r / 64), 32 * (r % 64), 32 * (r % 64), scr, F.lane); continue; } r -= I_KV;
        if (r < I_L64) { p0_transpose_item(F.in[I_W2], RW, nullptr, (bf16*)(F.ws + WS_W2LT), 64, 0, 32 * r, 32 * r, scr, F.lane); continue; } r -= I_L64;
        if (r < I_L64) { p0_transpose_item(F.in[I_A2], RW, nullptr, (bf16*)(F.ws + WS_A2LT), 64, 0, 32 * r, 32 * r, scr, F.lane); continue; } r -= I_L64;
        p0_transpose_item(F.in[I_G2], RW, nullptr, (bf16*)(F.ws + WS_G2LT), 128, 64 * (r / 16), 32 * (r % 16), 32 * (r % 16), scr, F.lane);
    }
    for (int m = gw; m < M; m += NGW) rms_row_to_bf16(F.in[I_X] + (size_t)m * D, F.in[I_N1G], (bf16*)(F.ws + WS_XN) + (size_t)m * D, F.lane);
    for (int m = gw; m < BATCH * MEM; m += NGW) rms_row_to_bf16(F.in[I_MEM] + (size_t)m * D, F.in[I_MNG], (bf16*)(F.ws + WS_MEMN) + (size_t)m * D, F.lane);
    { float* rwt = (float*)(F.ws + WS_RWT); const int gt = F.bid * NTHR + F.tid;
      for (int i = gt; i < NE * D; i += F.G * NTHR) { const int e = i / D, k = i % D; rwt[i] = F.in[I_RW][k * NE + e] * F.in[I_N3G][k]; } }
}

__device__ __forceinline__ void p0_experts(Frame& F, int wg0) {
    LAS float* scr = (LAS float*)(F.lds + F.wave * 16384);
    constexpr int I_E1 = 8 * 64, I_E2 = 8 * 32;
    const int gw = (F.bid - wg0) * NWAVES + F.wave, NGW = (F.G - wg0) * NWAVES;
    for (int it = gw; it < NE * (I_E1 + I_E2); it += NGW) {
        const int e = it / (I_E1 + I_E2); int r = it - e * (I_E1 + I_E2);
        if (r < I_E1) {
            const int n0 = 32 * (r % 64), k0 = 128 * (r / 64); const int nn = n0 < FF ? n0 : n0 - FF; const int drow = 256 * (nn / 128) + (n0 < FF ? 0 : 128) + (nn % 128);
            p0_transpose_item8(F.in[I_W1] + (size_t)e * D * 2 * FF, 2 * FF, F.in[I_N3G], F8_SW, F.ws + WS_W1T + (size_t)e * 2 * FF * D, D, k0, n0, drow, scr, F.lane);
        } else { r -= I_E1;
            p0_transpose_item8(F.in[I_W2E] + (size_t)e * FF * D, D, nullptr, F8_SW, F.ws + WS_W2T + (size_t)e * D * FF, FF, 128 * (r / 32), 32 * (r % 32), 32 * (r % 32), scr, F.lane);
        }
    }
}
template <int NMAP, int DQK, int DVV, int NBUF, int PF>
struct AttnBody {
    static constexpr int KROW = DQK * 2, VROW = 128, KCH = DQK / 8;
    static constexpr int KT_BYTES = NMAP * 64 * KROW, VT_BYTES = DVV * VROW, BUF_BYTES = KT_BYTES + VT_BYTES;
    static constexpr int NPK = KT_BYTES / (16 * NTHR), NPV = VT_BYTES / (16 * NTHR), NDMA = NPK + NPV;
    static constexpr int NKS = DQK / 32, NDT = DVV / 16, KB = NKS < 4 ? NKS : 4;
    static_assert(NBUF * BUF_BYTES <= RING_BYTES + 24576, "attention ring exceeds LDS");
    static_assert(NDMA * (NBUF - 1) <= 48 && NBUF >= 2, "vmcnt range; a ring needs two slots");

    __device__ __forceinline__ void dma_tile(LAS unsigned char* slot, const bf16* Kp, int ldk, const bf16* VTp, int ldvt, int key0, int tid, int wave) const {
        asm volatile("" : "+v"(tid));
#pragma unroll
        for (int i = 0; i < NPK; ++i) { const int p = tid + NTHR * i, row = p / KCH, sl = p % KCH, ch = sl ^ ksw(row), mp = row >> 6, key = row & 63;
            __builtin_amdgcn_global_load_lds((const unsigned*)(Kp + (unsigned)((key0 + key) * ldk + mp * DQK + ch * 8)), (LAS unsigned*)(slot + (i * NTHR + wave * 64) * 16), 16, 0, 0); }
#pragma unroll
        for (int i = 0; i < NPV; ++i) { const int p = tid + NTHR * i, dv = p >> 3, sl = p & 7, ch = sl ^ vsw(dv);
            __builtin_amdgcn_global_load_lds((const unsigned*)(VTp + (unsigned)(dv * ldvt + key0 + ch * 8)), (LAS unsigned*)(slot + KT_BYTES + (i * NTHR + wave * 64) * 16), 16, 0, 0); }
    }
    __device__ __forceinline__ static int ksw(int row) { return KCH == 8 ? ((row & 3) | (((row >> 3) & 1) << 2)) : (((row & 1) * 3) | (((row >> 1) & 1) << 2) | (((row >> 3) & 1) << 3)); }
    __device__ __forceinline__ static int vsw(int dv) { return dv & 7; }
    __device__ __forceinline__ static int vt_off(int dv, int ch) { return KT_BYTES + dv * VROW + ((ch ^ vsw(dv)) << 4); }
    __device__ __forceinline__ static int k_off(int row, int ch) { return row * KROW + ((ch ^ ksw(row)) << 4); }
    __device__ __forceinline__ static int sigma(int t4, int m) { return 32 * (t4 >> 1) + 8 * (m >> 2) + 4 * (t4 & 1) + (m & 3); }
    static constexpr int NKB = NKS < 4 ? NKS : 4;
    struct Offs { int kb[NKB]; int vb[2]; };
    __device__ __forceinline__ static Offs make_offs(int lq, int g) { Offs o; const int r0 = 8 * (lq >> 2) + (lq & 3);
#pragma unroll
        for (int j = 0; j < NKB; ++j) o.kb[j] = k_off(r0, 4 * j + g);
        o.vb[0] = vt_off(lq, g); o.vb[1] = vt_off(lq, 4 + g); return o; }

    __device__ __forceinline__ void pv_tile(const LAS unsigned char* buf, bf16x8 (&vf)[PF], const bf16x8 (&pf)[NMAP][2], f32x4 (&o)[NMAP][NDT], const Offs& of) {
#pragma unroll
        for (int f0 = 0; f0 < 2 * NDT; f0 += PF) {
            bf16x8 vn[PF];
            if (f0 + PF < 2 * NDT) {
#pragma unroll
                for (int f = 0; f < PF; ++f) { const int dt = (f0 + PF + f) >> 1, mb = (f0 + PF + f) & 1; vn[f] = *(const LAS bf16x8*)(buf + of.vb[mb] + dt * 16 * VROW); }
            }
#pragma unroll
            for (int f = 0; f < PF; ++f) { const int dt = (f0 + f) >> 1, mb = (f0 + f) & 1;
#pragma unroll
                for (int c = 0; c < NMAP; ++c) o[c][dt] = __builtin_amdgcn_mfma_f32_16x16x32_bf16(vf[f], pf[c][mb], o[c][dt], 0, 0, 0); }
            if (f0 + PF < 2 * NDT) {
#pragma unroll
                for (int f = 0; f < PF; ++f) vf[f] = vn[f];
            }
        }
    }
    __device__ __forceinline__ void vf_first(const LAS unsigned char* buf, bf16x8 (&vf)[PF], const Offs& of) {
#pragma unroll
        for (int f = 0; f < PF; ++f) { const int dt = f >> 1, mb = f & 1; vf[f] = *(const LAS bf16x8*)(buf + of.vb[mb] + dt * 16 * VROW); }
    }
    __device__ __forceinline__ void s_tile(const LAS unsigned char* buf, const bf16x8 (&qf)[NMAP][NKS], float (&mrun)[NMAP], f32x4 (&ol)[NMAP], f32x4 (&o)[NMAP][NDT], bf16x8 (&pf)[NMAP][2], const Offs& of, bool first) {
        constexpr float THR = 8.0f;
        f32x4 s[NMAP][4];
#pragma unroll
        for (int c = 0; c < NMAP; ++c) { const float mi = first ? 0.f : -mrun[c];
#pragma unroll
            for (int t4 = 0; t4 < 4; ++t4) { s[c][t4] = (f32x4){mi, mi, mi, mi};
#pragma unroll
                for (int k0 = 0; k0 < NKS; k0 += KB) { bf16x8 kf[KB];
#pragma unroll
                    for (int ks = 0; ks < KB; ++ks) kf[ks] = *(const LAS bf16x8*)(buf + of.kb[(k0 + ks) & (NKB - 1)] + ((c * 64 + 32 * (t4 >> 1) + 4 * (t4 & 1)) * KROW + ((k0 + ks) / NKB) * NKB * 64));
#pragma unroll
                    for (int ks = 0; ks < KB; ++ks) s[c][t4] = __builtin_amdgcn_mfma_f32_16x16x32_bf16(kf[ks], qf[c][k0 + ks], s[c][t4], 0, 0, 0); } } }
#pragma unroll
        for (int c = 0; c < NMAP; ++c) {
            float mx = __builtin_fmaxf(__builtin_fmaxf(s[c][0][0], s[c][0][1]), s[c][0][2]);
#pragma unroll
            for (int t4 = 0; t4 < 4; ++t4) { if (t4 > 0) mx = __builtin_fmaxf(__builtin_fmaxf(mx, s[c][t4][0]), s[c][t4][1]); mx = __builtin_fmaxf(__builtin_fmaxf(mx, s[c][t4][2]), s[c][t4][3]); }
            { const auto r1 = __builtin_amdgcn_permlane16_swap(__float_as_uint(mx), __float_as_uint(mx), false, false); mx = fmaxf(__uint_as_float(r1[0]), __uint_as_float(r1[1]));
              const auto r2 = __builtin_amdgcn_permlane32_swap(__float_as_uint(mx), __float_as_uint(mx), false, false); mx = fmaxf(__uint_as_float(r2[0]), __uint_as_float(r2[1])); }
            if (first) {
                mrun[c] = mx;
#pragma unroll
                for (int t4 = 0; t4 < 4; ++t4) s[c][t4] = s[c][t4] - mx;
            } else if (__any(mx > THR)) {
                const float d = mx > THR ? mx : 0.f, alpha = fexp2(-d); mrun[c] += d; ol[c] = ol[c] * alpha;
#pragma unroll
                for (int dt = 0; dt < NDT; ++dt) o[c][dt] = o[c][dt] * alpha;
#pragma unroll
                for (int t4 = 0; t4 < 4; ++t4) s[c][t4] = s[c][t4] - d;
            }
#pragma unroll
            for (int t4 = 0; t4 < 4; ++t4)
#pragma unroll
                for (int i = 0; i < 4; ++i) s[c][t4][i] = fexp2(s[c][t4][i]);
#pragma unroll
            for (int mb = 0; mb < 2; ++mb) { u32x4 w; w.x = cvt_pk_bf16(s[c][2 * mb][0], s[c][2 * mb][1]); w.y = cvt_pk_bf16(s[c][2 * mb][2], s[c][2 * mb][3]);
                w.z = cvt_pk_bf16(s[c][2 * mb + 1][0], s[c][2 * mb + 1][1]); w.w = cvt_pk_bf16(s[c][2 * mb + 1][2], s[c][2 * mb + 1][3]); pf[c][mb] = __builtin_bit_cast(bf16x8, w); }
            const bf16x8 ones = (bf16x8){0x3F80, 0x3F80, 0x3F80, 0x3F80, 0x3F80, 0x3F80, 0x3F80, 0x3F80};
            ol[c] = __builtin_amdgcn_mfma_f32_16x16x32_bf16(ones, pf[c][0], ol[c], 0, 0, 0); ol[c] = __builtin_amdgcn_mfma_f32_16x16x32_bf16(ones, pf[c][1], ol[c], 0, 0, 0);
        }
    }

    __device__ __forceinline__ void run(LAS unsigned char* lds, const bf16* Qp, int ldq, float qscale, const bf16* Kp, int ldk, const bf16* VTp, int ldvt, int nkt, int nkt_w, bool late,
                                        f32x4 (&o)[NMAP][NDT], float (&lsum)[NMAP], int tid, int lane) {
        const int g = lane >> 4, lq = lane & 15;
        bf16x8 qf[NMAP][NKS];
#pragma unroll
        for (int c = 0; c < NMAP; ++c)
#pragma unroll
            for (int ks = 0; ks < NKS; ++ks) { const u32x4 raw = *(const GAS u32x4*)(Qp + (size_t)lq * ldq + c * DQK + ks * 32 + g * 8);
                u32x4 w = raw;
                if (qscale != 1.0f) { w.x = cvt_pk_bf16(bflo(raw.x) * qscale, bfhi(raw.x) * qscale); w.y = cvt_pk_bf16(bflo(raw.y) * qscale, bfhi(raw.y) * qscale);
                                      w.z = cvt_pk_bf16(bflo(raw.z) * qscale, bfhi(raw.z) * qscale); w.w = cvt_pk_bf16(bflo(raw.w) * qscale, bfhi(raw.w) * qscale); }
                qf[c][ks] = __builtin_bit_cast(bf16x8, w); }
        float mrun[NMAP]; f32x4 ol[NMAP];
#pragma unroll
        for (int c = 0; c < NMAP; ++c) { mrun[c] = -INFINITY; ol[c] = (f32x4){0.f, 0.f, 0.f, 0.f};
#pragma unroll
            for (int dt = 0; dt < NDT; ++dt) o[c][dt] = (f32x4){0.f, 0.f, 0.f, 0.f}; }
        bf16x8 pfp[NMAP][2];
#pragma unroll
        for (int c = 0; c < NMAP; ++c) { pfp[c][0] = (bf16x8){0, 0, 0, 0, 0, 0, 0, 0}; pfp[c][1] = pfp[c][0]; }

        const int wave = __builtin_amdgcn_readfirstlane(tid >> 6);
        const Offs of = make_offs(lq, g);
#pragma unroll
        for (int j = 0; j < NBUF - 1; ++j) if (j < nkt) dma_tile(lds + j * BUF_BYTES, Kp, ldk, VTp, ldvt, j * 64, tid, wave);
        int bi = 0;
        for (int kt = 0; kt < nkt; ++kt) {
            LAS unsigned char* buf = lds + bi * BUF_BYTES;
            { const int ahead = (nkt - 1 - kt) < (NBUF - 2) ? (nkt - 1 - kt) : (NBUF - 2);
              if (ahead >= 1 && NBUF > 2) asm volatile("s_waitcnt vmcnt(%0)" :: "n"(NDMA) : "memory"); else asm volatile("s_waitcnt vmcnt(0)" ::: "memory"); }
            __builtin_amdgcn_s_barrier(); asm volatile("" ::: "memory");
            if (kt < nkt_w) { bf16x8 vf[PF]; s_tile(buf, qf, mrun, ol, o, pfp, of, kt == 0); vf_first(buf, vf, of);
                { const int kn = kt + NBUF - 1; if (kn < nkt) { const int bn = (bi == 0) ? NBUF - 1 : bi - 1; dma_tile(lds + bn * BUF_BYTES, Kp, ldk, VTp, ldvt, kn * 64, tid, wave); } }
                pv_tile(buf, vf, pfp, o, of); }
            else { const int kn = kt + NBUF - 1; if (kn < nkt) { const int bn = (bi == 0) ? NBUF - 1 : bi - 1; dma_tile(lds + bn * BUF_BYTES, Kp, ldk, VTp, ldvt, kn * 64, tid, wave); } }
            bi = (bi + 1 == NBUF) ? 0 : bi + 1;
        }
        asm volatile("s_waitcnt lgkmcnt(0)" ::: "memory"); __builtin_amdgcn_s_barrier(); asm volatile("" ::: "memory");
#pragma unroll
        for (int c = 0; c < NMAP; ++c) lsum[c] = ol[c][0];
    }
};
typedef float f32x16 __attribute__((ext_vector_type(16)));
struct DiffBody32 {
    static constexpr int KT_BYTES = 2 * 64 * 128, VT_BYTES = 128 * 128, BUF_BYTES = KT_BYTES + VT_BYTES, NBUF = 3, NDMA = 4;
    __device__ __forceinline__ static int swz(int row) { return (row >> 1) & 7; }
    __device__ __forceinline__ static int sigma(int rho) { return 16 * (rho >> 4) + 8 * ((rho >> 2) & 1) + 4 * ((rho >> 3) & 1) + (rho & 3); }
    __device__ __forceinline__ void dma_tile(LAS unsigned char* slot, const bf16* Kp, int ldk, const bf16* VTp, int ldvt, int key0, int tid, int wave) const {
        asm volatile("" : "+v"(tid));
#pragma unroll
        for (int i = 0; i < 2; ++i) { const int p = tid + NTHR * i, row = p >> 3, sl = p & 7, ch = sl ^ swz(row), mp = row >> 6, key = row & 63;
            __builtin_amdgcn_global_load_lds((const unsigned*)(Kp + (unsigned)((key0 + key) * ldk + mp * 64 + ch * 8)), (LAS unsigned*)(slot + (i * NTHR + wave * 64) * 16), 16, 0, 0); }
#pragma unroll
        for (int i = 0; i < 2; ++i) { const int p = tid + NTHR * i, dv = p >> 3, sl = p & 7, ch = sl ^ swz(dv);
            __builtin_amdgcn_global_load_lds((const unsigned*)(VTp + (unsigned)(dv * ldvt + key0 + ch * 8)), (LAS unsigned*)(slot + KT_BYTES + (i * NTHR + wave * 64) * 16), 16, 0, 0); }
    }
    __device__ __forceinline__ void run(LAS unsigned char* lds, const bf16* Qp  , int ldq, float qscale, const bf16* Kp, int ldk, const bf16* VTp, int ldvt,
                                        int nkt, int nkt_w, int c, f32x16 (&o)[4], float& lsum, int tid, int lane) {
        const int r = lane & 31, h = lane >> 5, wave = __builtin_amdgcn_readfirstlane(tid >> 6);
        bf16x8 qf[4];
#pragma unroll
        for (int ks = 0; ks < 4; ++ks) { const u32x4 raw = *(const GAS u32x4*)(Qp + (size_t)r * ldq + ks * 16 + h * 8); u32x4 w;
            w.x = cvt_pk_bf16(bflo(raw.x) * qscale, bfhi(raw.x) * qscale); w.y = cvt_pk_bf16(bflo(raw.y) * qscale, bfhi(raw.y) * qscale);
            w.z = cvt_pk_bf16(bflo(raw.z) * qscale, bfhi(raw.z) * qscale); w.w = cvt_pk_bf16(bflo(raw.w) * qscale, bfhi(raw.w) * qscale); qf[ks] = __builtin_bit_cast(bf16x8, w); }
        int kof[4], vof[4];
        { const int kr = sigma(r);
#pragma unroll
          for (int ks = 0; ks < 4; ++ks) kof[ks] = kr * 128 + (((2 * ks + h) ^ swz(kr)) << 4);
#pragma unroll
          for (int f = 0; f < 4; ++f) vof[f] = KT_BYTES + r * 128 + (((2 * f + h) ^ swz(r)) << 4); }
        float mrun = -INFINITY, ls = 0.f;
#pragma unroll
        for (int db = 0; db < 4; ++db)
#pragma unroll
            for (int i = 0; i < 16; ++i) o[db][i] = 0.f;
#pragma unroll
        for (int j = 0; j < NBUF - 1; ++j) if (j < nkt) dma_tile(lds + j * BUF_BYTES, Kp, ldk, VTp, ldvt, j * 64, tid, wave);
        int bi = 0;
        for (int kt = 0; kt < nkt; ++kt) {
            const LAS unsigned char* buf = lds + bi * BUF_BYTES;
            { const int ahead = (nkt - 1 - kt) < 1 ? (nkt - 1 - kt) : 1;
              if (ahead >= 1) asm volatile("s_waitcnt vmcnt(%0)" :: "n"(NDMA) : "memory"); else asm volatile("s_waitcnt vmcnt(0)" ::: "memory"); }
            __builtin_amdgcn_s_barrier(); asm volatile("" ::: "memory");
            const int kn = kt + NBUF - 1; const int bn = (bi == 0) ? NBUF - 1 : bi - 1;
            if (kt < nkt_w) {
                constexpr float THR = 8.0f; const bool first = (kt == 0);
                f32x16 s[2];
                { const float mi = first ? 0.f : -mrun;
#pragma unroll
                  for (int kb = 0; kb < 2; ++kb) {
#pragma unroll
                      for (int i = 0; i < 16; ++i) s[kb][i] = mi;
                      bf16x8 kf[4];
#pragma unroll
                      for (int ks = 0; ks < 4; ++ks) kf[ks] = *(const LAS bf16x8*)(buf + kof[ks] + (c * 64 + 32 * kb) * 128);
#pragma unroll
                      for (int ks = 0; ks < 4; ++ks) s[kb] = __builtin_amdgcn_mfma_f32_32x32x16_bf16(kf[ks], qf[ks], s[kb], 0, 0, 0); } }
                float mx = __builtin_fmaxf(__builtin_fmaxf(s[0][0], s[0][1]), s[0][2]);
#pragma unroll
                for (int kb = 0; kb < 2; ++kb)
#pragma unroll
                    for (int i = (kb == 0 ? 3 : 0); i + 1 < 16; i += 2) mx = __builtin_fmaxf(__builtin_fmaxf(mx, s[kb][i]), s[kb][i + 1]);
                mx = fmaxf(mx, s[0][15]); mx = fmaxf(mx, s[1][15] > s[1][14] ? s[1][15] : s[1][14]);
                { const auto r2 = __builtin_amdgcn_permlane32_swap(__float_as_uint(mx), __float_as_uint(mx), false, false); mx = fmaxf(__uint_as_float(r2[0]), __uint_as_float(r2[1])); }
                if (first) { mrun = mx; s[0] = s[0] - mx; s[1] = s[1] - mx; }
                else if (__any(mx > THR)) { const float d = mx > THR ? mx : 0.f, alpha = fexp2(-d); mrun += d; ls *= alpha;
#pragma unroll
                    for (int db = 0; db < 4; ++db) o[db] = o[db] * alpha;
                    s[0] = s[0] - d; s[1] = s[1] - d; }
                float ps = 0.f;
#pragma unroll
                for (int kb = 0; kb < 2; ++kb)
#pragma unroll
                    for (int i = 0; i < 16; ++i) { s[kb][i] = fexp2(s[kb][i]); ps += s[kb][i]; }
                ls += ps;
                bf16x8 pf[4];
#pragma unroll
                for (int f = 0; f < 4; ++f) { const int kb = f >> 1, s8 = 8 * (f & 1); u32x4 w;
                    w.x = cvt_pk_bf16(s[kb][s8 + 0], s[kb][s8 + 1]); w.y = cvt_pk_bf16(s[kb][s8 + 2], s[kb][s8 + 3]); w.z = cvt_pk_bf16(s[kb][s8 + 4], s[kb][s8 + 5]); w.w = cvt_pk_bf16(s[kb][s8 + 6], s[kb][s8 + 7]);
                    pf[f] = __builtin_bit_cast(bf16x8, w); }
                bf16x8 vf[4][4];
#pragma unroll
                for (int f = 0; f < 4; ++f) vf[0][f] = *(const LAS bf16x8*)(buf + vof[f]);
                if (kn < nkt) dma_tile(lds + bn * BUF_BYTES, Kp, ldk, VTp, ldvt, kn * 64, tid, wave);
#pragma unroll
                for (int db = 0; db < 4; ++db) {
                    if (db + 1 < 4) {
#pragma unroll
                        for (int f = 0; f < 4; ++f) vf[db + 1][f] = *(const LAS bf16x8*)(buf + vof[f] + (db + 1) * 32 * 128);
                    }
#pragma unroll
                    for (int f = 0; f < 4; ++f) o[db] = __builtin_amdgcn_mfma_f32_32x32x16_bf16(vf[db][f], pf[f], o[db], 0, 0, 0); }
            } else if (kn < nkt) dma_tile(lds + bn * BUF_BYTES, Kp, ldk, VTp, ldvt, kn * 64, tid, wave);
            bi = (bi + 1 == NBUF) ? 0 : bi + 1;
        }
        asm volatile("s_waitcnt lgkmcnt(0)" ::: "memory"); __builtin_amdgcn_s_barrier(); asm volatile("" ::: "memory");
        { const auto r2 = __builtin_amdgcn_permlane32_swap(__float_as_uint(ls), __float_as_uint(ls), false, false); lsum = __uint_as_float(r2[0]) + __uint_as_float(r2[1]); }
    }
};
constexpr int ATTN_MAXU = 2;
__constant__ unsigned short attn_tab[256][ATTN_MAXU] = {
{34,17},
{98,81},
{162,145},
{226,209},
{290,273},
{354,337},
{418,401},
{482,465},
{33,19},
{97,83},
{161,147},
{225,211},
{289,275},
{353,339},
{417,403},
{481,467},
{31,20},
{95,84},
{159,148},
{223,212},
{287,276},
{351,340},
{415,404},
{479,468},
{50,1},
{114,65},
{178,129},
{242,193},
{306,257},
{370,321},
{434,385},
{498,449},
{52,0},
{116,64},
{180,128},
{244,192},
{308,256},
{372,320},
{436,384},
{500,448},
{36,15},
{100,79},
{164,143},
{228,207},
{292,271},
{356,335},
{420,399},
{484,463},
{49,2},
{113,66},
{177,130},
{241,194},
{305,258},
{369,322},
{433,386},
{497,450},
{47,5},
{111,69},
{175,133},
{239,197},
{303,261},
{367,325},
{431,389},
{495,453},
{39,28},
{103,92},
{167,156},
{231,220},
{295,284},
{359,348},
{423,412},
{487,476},
{57,10},
{121,74},
{185,138},
{249,202},
{313,266},
{377,330},
{441,394},
{505,458},
{45,22},
{109,86},
{173,150},
{237,214},
{301,278},
{365,342},
{429,406},
{493,470},
{40,27},
{104,91},
{168,155},
{232,219},
{296,283},
{360,347},
{424,411},
{488,475},
{54,13},
{118,77},
{182,141},
{246,205},
{310,269},
{374,333},
{438,397},
{502,461},
{44,23},
{108,87},
{172,151},
{236,215},
{300,279},
{364,343},
{428,407},
{492,471},
{35,32},
{99,96},
{163,160},
{227,224},
{291,288},
{355,352},
{419,416},
{483,480},
{58,9},
{122,73},
{186,137},
{250,201},
{314,265},
{378,329},
{442,393},
{506,457},
{37,30},
{101,94},
{165,158},
{229,222},
{293,286},
{357,350},
{421,414},
{485,478},
{59,8},
{123,72},
{187,136},
{251,200},
{315,264},
{379,328},
{443,392},
{507,456},
{55,12},
{119,76},
{183,140},
{247,204},
{311,268},
{375,332},
{439,396},
{503,460},
{53,14},
{117,78},
{181,142},
{245,206},
{309,270},
{373,334},
{437,398},
{501,462},
{43,24},
{107,88},
{171,152},
{235,216},
{299,280},
{363,344},
{427,408},
{491,472},
{61,6},
{125,70},
{189,134},
{253,198},
{317,262},
{381,326},
{445,390},
{509,454},
{38,29},
{102,93},
{166,157},
{230,221},
{294,285},
{358,349},
{422,413},
{486,477},
{60,7},
{124,71},
{188,135},
{252,199},
{316,263},
{380,327},
{444,391},
{508,455},
{62,4},
{126,68},
{190,132},
{254,196},
{318,260},
{382,324},
{446,388},
{510,452},
{56,11},
{120,75},
{184,139},
{248,203},
{312,267},
{376,331},
{440,395},
{504,459},
{48,18},
{112,82},
{176,146},
{240,210},
{304,274},
{368,338},
{432,402},
{496,466},
{41,26},
{105,90},
{169,154},
{233,218},
{297,282},
{361,346},
{425,410},
{489,474},
{42,25},
{106,89},
{170,153},
{234,217},
{298,281},
{362,345},
{426,409},
{490,473},
{51,16},
{115,80},
{179,144},
{243,208},
{307,272},
{371,336},
{435,400},
{499,464},
{63,3},
{127,67},
{191,131},
{255,195},
{319,259},
{383,323},
{447,387},
{511,451},
{46,21},
{110,85},
{174,149},
{238,213},
{302,277},
{366,341},
{430,405},
{494,469}};
namespace rk {
constexpr int MS = 144;
constexpr int MB = 64 * MS;
constexpr int O_AB = 0 * MB, O_BB = 1 * MB, O_KB = 2 * MB, O_RB = 3 * MB, O_ABT = 4 * MB, O_VTT = 5 * MB, O_BTT = 6 * MB, O_KTT = 7 * MB, O_AAK = 8 * MB, O_ARB = 9 * MB, O_ARK = 10 * MB;
constexpr int O_TM = O_KB, O_GT = O_AB, O_WTT = O_BB, O_UTT = O_AAK;
constexpr int FS = 66;
constexpr int O_LF = 11 * MB, O_TF = 0;
constexpr int O_LA = O_LF + 64 * FS * 4;
static_assert(O_LA + MB <= RING_BYTES && 64 * FS * 4 <= 2 * MB, "rwkv LDS map");
constexpr int O_LW = X_OFF, O_LG = X_OFF + MB, LGS = 272, O_NRM = O_LG + 64 * LGS, O_BSP = O_NRM + 512, O_C63 = O_BSP + 512;
static_assert(O_C63 + 1024 <= MISC_OFF, "rwkv LDS extras");

template <int NKS>
__device__ __forceinline__ f32x4 mm_tile(const LAS unsigned char* A, int astr, int tr, const LAS unsigned char* B, int bstr, int tc, f32x4 acc, int lq, int g) {
#pragma unroll
    for (int ks = 0; ks < NKS; ++ks) {
        const bf16x8 a = *(const LAS bf16x8*)(A + (16 * tr + lq) * astr + (32 * ks + 8 * g) * 2);
        const bf16x8 b = *(const LAS bf16x8*)(B + (16 * tc + lq) * bstr + (32 * ks + 8 * g) * 2);
        acc = __builtin_amdgcn_mfma_f32_16x16x32_bf16(a, b, acc, 0, 0, 0); }
    return acc;
}
template <int NKS>
__device__ __forceinline__ f32x4 mm_tile_gb(const LAS unsigned char* A, int astr, int tr, const bf16* Bg, int ldb, f32x4 acc, int lq, int g) {
#pragma unroll
    for (int ks = 0; ks < NKS; ++ks) {
        const bf16x8 a = *(const LAS bf16x8*)(A + (16 * tr + lq) * astr + (32 * ks + 8 * g) * 2);
        const bf16x8 b = *(const GAS bf16x8*)(Bg + (size_t)lq * ldb + 32 * ks + 8 * g);
        acc = __builtin_amdgcn_mfma_f32_16x16x32_bf16(a, b, acc, 0, 0, 0); }
    return acc;
}
__device__ __forceinline__ void st_nat(LAS unsigned char* Mx, int t0, int col, const f32x4& v) {
#pragma unroll
    for (int i = 0; i < 4; ++i) *(LAS bf16*)(Mx + (t0 + i) * MS + col * 2) = (bf16)f2bf(v[i]);
}
__device__ __forceinline__ void st_tr(LAS unsigned char* Mx, int t0, int col, const f32x4& v) {
    u32x2 w; w.x = cvt_pk_bf16(v[0], v[1]); w.y = cvt_pk_bf16(v[2], v[3]); *(LAS u32x2*)(Mx + col * MS + t0 * 2) = w;
}

__device__ __forceinline__ void tri_inverse(const LAS float* L, LAS float* Tm, int lane) {
    const int g = lane >> 4, lq = lane & 15;
    {
        float x[16];
#pragma unroll
        for (int r = 0; r < 16; ++r) { float a = (r == lq) ? 1.f : 0.f;
#pragma unroll
            for (int s = 0; s < r; ++s) a += L[(16 * g + r) * FS + 16 * g + s] * x[s];
            x[r] = a; }
#pragma unroll
        for (int r = 0; r < 16; ++r) Tm[(16 * g + r) * FS + 16 * g + lq] = x[r];
    }
#pragma unroll
    for (int d = 1; d < 4; ++d)
#pragma unroll
        for (int i = d; i < 4; ++i) { const int j = i - d;
            f32x4 X = (f32x4){0.f, 0.f, 0.f, 0.f};
#pragma unroll
            for (int m = j; m < i; ++m)
#pragma unroll
                for (int kq = 0; kq < 4; ++kq) X = __builtin_amdgcn_mfma_f32_16x16x4f32(L[(16 * i + lq) * FS + 16 * m + 4 * kq + g], Tm[(16 * m + 4 * kq + g) * FS + 16 * j + lq], X, 0, 0, 0);
            f32x4 R = (f32x4){0.f, 0.f, 0.f, 0.f};
#pragma unroll
            for (int kk = 0; kk < 4; ++kk) R = __builtin_amdgcn_mfma_f32_16x16x4f32(Tm[(16 * i + lq) * FS + 16 * i + 4 * g + kk], X[kk], R, 0, 0, 0);
#pragma unroll
            for (int q = 0; q < 4; ++q) Tm[(16 * i + 4 * g + q) * FS + 16 * j + lq] = R[q];
        }
}

__device__ __forceinline__ void tri_inverse_simple(const LAS float* L, LAS float* Tm, int lane) {
#pragma unroll 1
    for (int t = 0; t < 64; ++t) { float a = (t == lane) ? 1.f : 0.f;
#pragma unroll 1
        for (int s = 0; s < t; ++s) a += L[t * FS + s] * Tm[s * FS + lane];
        Tm[t * FS + lane] = a; }
}
__device__ __forceinline__ float mixf(unsigned short cur, unsigned short prev, float mu) { const float c = bf2f(cur), p = bf2f(prev); return c + (p - c) * mu; }

__device__ __forceinline__ void phase_a(Frame& F, int b, int c) {
    LAS unsigned char* lds = F.lds;
    const int tid = F.tid, lane = F.lane, w = F.wave, g = lane >> 4, lq = lane & 15;
    const bf16* PROJ = (const bf16*)(F.ws + WS_PROJ);
    const int n0 = b * T + c * CH;
    const bool first = (c == 0);
    const float* mu = F.in[I_MU]; bf16* GATEp = (bf16*)(F.ws + WS_GATE);
    {
        const int t = tid >> 3, c0 = (tid & 7) * 32; const unsigned oc = (unsigned)(n0 + t) * PCOLS + C_WD + c0; const bool hasp = !(first && t == 0); const unsigned op = hasp ? oc - PCOLS : oc; const float* mup = mu + C_WD + c0;
#pragma unroll
        for (int q = 0; q < 4; ++q) {
            const u32x4 cu = *(const GAS u32x4*)(PROJ + (oc + q * 8)); u32x4 pv = *(const GAS u32x4*)(PROJ + (op + q * 8)); if (!hasp) pv = (u32x4){0u, 0u, 0u, 0u};
            const f32x4 m0 = *(const GAS f32x4*)(mup + q * 8), m1 = *(const GAS f32x4*)(mup + q * 8 + 4);
            float o[8];
#pragma unroll
            for (int k = 0; k < 4; ++k) { const unsigned cw = cu[k], pw = pv[k];
                const float x0 = bflo(cw) + (bflo(pw) - bflo(cw)) * (k < 2 ? m0[2 * k] : m1[2 * k - 4]), x1 = bfhi(cw) + (bfhi(pw) - bfhi(cw)) * (k < 2 ? m0[2 * k + 1] : m1[2 * k - 3]);
                if (c0 < 64) { o[2 * k] = 1.f - 2.f * frcp(fexp(2.f * x0) + 1.f); o[2 * k + 1] = 1.f - 2.f * frcp(fexp(2.f * x1) + 1.f); }
                else if (c0 < 128) { o[2 * k] = x0; o[2 * k + 1] = x1; }
                else { o[2 * k] = sigmoidf_(x0); o[2 * k + 1] = sigmoidf_(x1); } }
            u32x4 wv; wv.x = cvt_pk_bf16(o[0], o[1]); wv.y = cvt_pk_bf16(o[2], o[3]); wv.z = cvt_pk_bf16(o[4], o[5]); wv.w = cvt_pk_bf16(o[6], o[7]);
            LAS unsigned char* dst = (c0 < 64) ? lds + O_LW + t * MS + (c0 + q * 8) * 2 : (c0 < 128) ? lds + O_LA + t * MS + (c0 - 64 + q * 8) * 2 : lds + O_LG + t * LGS + (c0 - 128 + q * 8) * 2;
            *(LAS u32x4*)dst = wv; }
    }
    __syncthreads();
    const int tr = w >> 1, tcb = 2 * (w & 1);
    LAS float* EF = (LAS float*)(lds + O_LF);
    LAS float* NRM = (LAS float*)(lds + O_NRM); LAS float* BSP = (LAS float*)(lds + O_BSP); LAS float* TT = (LAS float*)(lds + O_C63);
#pragma unroll 1
    for (int h = 0; h < RH; ++h) {
        const int item = (b * RH + h) * NCHUNK + c;
        float ev[2][4], av[2][4], rv[2][4], kv[2][4], vv[2][4], kkr[2][4];
        float nrm_p[4] = {0.f, 0.f, 0.f, 0.f};
#pragma unroll
        for (int x = 0; x < 2; ++x) { const int tc = tcb + x, hj = h * RN + 16 * tc + lq;
            f32x4 wl = (f32x4){0.f, 0.f, 0.f, 0.f}, al = wl, gl = wl;
            wl = mm_tile_gb<2>(lds + O_LW, MS, tr, (const bf16*)(F.ws + WS_W2LT) + (size_t)(h * RN + 16 * tc) * 64, 64, wl, lq, g);
            al = mm_tile_gb<2>(lds + O_LA, MS, tr, (const bf16*)(F.ws + WS_A2LT) + (size_t)(h * RN + 16 * tc) * 64, 64, al, lq, g);
            gl = mm_tile_gb<4>(lds + O_LG, LGS, tr, (const bf16*)(F.ws + WS_G2LT) + (size_t)(h * RN + 16 * tc) * 128, 128, gl, lq, g);
            const float w0 = F.in[I_W0][hj], a0 = F.in[I_A0][hj], kkw = F.in[I_KK][hj];
            const float mur = mu[C_R + hj], muk = mu[C_K + hj], muv = mu[C_V + hj];
#pragma unroll
            for (int i = 0; i < 4; ++i) { const int t = 16 * tr + 4 * g + i; const bool hasp = !(first && t == 0); const unsigned oc = (unsigned)(n0 + t) * PCOLS + hj, op = hasp ? oc - PCOLS : oc;
                const float xw = -(w0 + wl[i]); const float sp = xw > 20.f ? xw : __logf(1.f + fexp(xw)); ev[x][i] = fexp(-sp - 0.5f);
                av[x][i] = sigmoidf_(a0 + al[i]);
                GATEp[(unsigned)(n0 + t) * RW + hj] = (bf16)f2bf(gl[i]);
                const unsigned short rc = PROJ[oc + C_R], kc = PROJ[oc + C_K], vc = PROJ[oc + C_V]; unsigned short rp = PROJ[op + C_R], kp = PROJ[op + C_K], vp = PROJ[op + C_V];
                if (!hasp) { rp = 0; kp = 0; vp = 0; }
                rv[x][i] = mixf(rc, rp, mur); kv[x][i] = mixf(kc, kp, muk); vv[x][i] = mixf(vc, vp, muv);
                kkr[x][i] = kv[x][i] * kkw; nrm_p[i] += kkr[x][i] * kkr[x][i]; }
        }
#pragma unroll
        for (int i = 0; i < 4; ++i) { float q = nrm_p[i]; q += __shfl_xor(q, 1); q += __shfl_xor(q, 2); q += __shfl_xor(q, 4); q += __shfl_xor(q, 8); if (lq == 0) NRM[(16 * tr + 4 * g + i) * 2 + (w & 1)] = q; }
        float cs[2][4];
#pragma unroll
        for (int x = 0; x < 2; ++x) { cs[x][0] = ev[x][0]; cs[x][1] = cs[x][0] + ev[x][1]; cs[x][2] = cs[x][1] + ev[x][2]; cs[x][3] = cs[x][2] + ev[x][3];
            float a = cs[x][3]; const float b1 = __shfl(a, lane - 16); a += (g >= 1) ? b1 : 0.f; const float b2 = __shfl(a, lane - 32); a += (g >= 2) ? b2 : 0.f;
            const float ex = a - cs[x][3];
#pragma unroll
            for (int i = 0; i < 4; ++i) cs[x][i] += ex;
            if (g == 3) TT[tr * 64 + 16 * (tcb + x) + lq] = a; }
        __syncthreads();
        float bs_p[4] = {0.f, 0.f, 0.f, 0.f};
#pragma unroll
        for (int x = 0; x < 2; ++x) { const int tc = tcb + x, j = 16 * tc + lq, hj = h * RN + j; const float ka = F.in[I_KA][hj], rk = F.in[I_RK][hj];
            const float t0v = TT[j], t1v = TT[64 + j], t2v = TT[128 + j], t3v = TT[192 + j]; const float c63 = (t0v + t1v) + (t2v + t3v);
            const float cbase = (tr > 0 ? t0v : 0.f) + (tr > 1 ? t1v : 0.f) + (tr > 2 ? t2v : 0.f);
            if (tr == 3 && g == 3) ((float*)(F.ws + WS_GC))[(size_t)item * 64 + j] = fexp(-c63);
            f32x4 ab, bb, kb, rb, bt, kt, vx;
#pragma unroll
            for (int i = 0; i < 4; ++i) { const int t = 16 * tr + 4 * g + i; const float cin = cs[x][i] + cbase, cex = cin - ev[x][i];
                const float nr = NRM[t * 2] + NRM[t * 2 + 1]; const float kk = kkr[x][i] / fmaxf(sqrtf(nr), 1e-12f);
                DBGCNT(F, 2, !(nr > 1e-6f && nr < 1e6f)); DBGCNT(F, 3, !(fabsf(kk) <= 1.001f)); DBGCNT(F, 6, !(ev[x][i] > 0.f && ev[x][i] < 0.62f && av[x][i] > 0.f && av[x][i] < 1.f)); DBGCNT(F, 8, !(fabsf(rv[x][i]) < 100.f && fabsf(kv[x][i]) < 100.f && fabsf(vv[x][i]) < 100.f)); DBGCNT(F, 9, !(cin >= 0.f && cin < 40.f && c63 >= cin));
                const float a = av[x][i], k2 = kv[x][i] * (1.f + (a - 1.f) * ka);
                const float gin = fexp(-cin), ginv = fexp(cin), gex = fexp(-cex), grel = fexp(cin - c63);
                ab[i] = -kk * gex; bb[i] = kk * a * ginv; kb[i] = k2 * ginv; rb[i] = rv[x][i] * gin; bt[i] = kk * a * grel; kt[i] = k2 * grel; vx[i] = vv[x][i];
                bs_p[i] += rv[x][i] * k2 * rk; }
            const int t0 = 16 * tr + 4 * g;
            st_nat(lds + O_AB, t0, j, ab); st_nat(lds + O_BB, t0, j, bb); st_nat(lds + O_KB, t0, j, kb); st_nat(lds + O_RB, t0, j, rb);
            st_tr(lds + O_ABT, t0, j, ab); st_tr(lds + O_VTT, t0, j, vx); st_tr(lds + O_BTT, t0, j, bt); st_tr(lds + O_KTT, t0, j, kt);
        }
#pragma unroll
        for (int i = 0; i < 4; ++i) { float q = bs_p[i]; q += __shfl_xor(q, 1); q += __shfl_xor(q, 2); q += __shfl_xor(q, 4); q += __shfl_xor(q, 8); if (lq == 0) BSP[(16 * tr + 4 * g + i) * 2 + (w & 1)] = q; }
        __syncthreads();
        if (tid < 64) ((float*)(F.ws + WS_BS))[(size_t)(n0 + tid) * RH + h] = BSP[tid * 2] + BSP[tid * 2 + 1];
#pragma unroll
        for (int x = 0; x < 2; ++x) { const int tc = tcb + x; f32x4 l = (f32x4){0.f, 0.f, 0.f, 0.f}, ak = l, rbm = l, rkm = l;
            if (tc <= tr) {
                l = mm_tile<2>(lds + O_AB, MS, tr, lds + O_BB, MS, tc, l, lq, g); ak = mm_tile<2>(lds + O_AB, MS, tr, lds + O_KB, MS, tc, ak, lq, g);
                rbm = mm_tile<2>(lds + O_RB, MS, tr, lds + O_BB, MS, tc, rbm, lq, g); rkm = mm_tile<2>(lds + O_RB, MS, tr, lds + O_KB, MS, tc, rkm, lq, g);
                const int s = 16 * tc + lq;
#pragma unroll
                for (int i = 0; i < 4; ++i) { const int t = 16 * tr + 4 * g + i; if (s >= t) { l[i] = 0.f; ak[i] = 0.f; } if (s > t) { rbm[i] = 0.f; rkm[i] = 0.f; } }
            }
            const int t0 = 16 * tr + 4 * g, s = 16 * tc + lq;
#pragma unroll
            for (int i = 0; i < 4; ++i) { EF[(t0 + i) * FS + s] = l[i]; DBGCNT(F, 7, !(fabsf(l[i]) <= 1.01f)); DBGCNT(F, 10, !(fabsf(ak[i]) < 300.f && fabsf(rbm[i]) < 300.f && fabsf(rkm[i]) < 300.f)); }
            st_nat(lds + O_AAK, t0, s, ak); st_nat(lds + O_ARB, t0, s, rbm); st_nat(lds + O_ARK, t0, s, rkm);
        }
        __syncthreads();
#ifdef DBG_SIMPLE_TRI
        if (w == 0) tri_inverse_simple(EF, (LAS float*)(lds + O_TF), lane);
#else
        if (w == 0) tri_inverse(EF, (LAS float*)(lds + O_TF), lane);
#endif
        __syncthreads();
        { const int t = tid >> 3, s0 = (tid & 7) * 8; const LAS float* tp = (const LAS float*)(lds + O_TF) + t * FS + s0; float o[8];
#pragma unroll
          for (int k = 0; k < 8; ++k) { o[k] = ((s0 >> 4) > (t >> 4)) ? 0.f : tp[k]; DBGCNT(F, 4, !(fabsf(o[k]) < 50.f)); }
          u32x4 wv; wv.x = cvt_pk_bf16(o[0], o[1]); wv.y = cvt_pk_bf16(o[2], o[3]); wv.z = cvt_pk_bf16(o[4], o[5]); wv.w = cvt_pk_bf16(o[6], o[7]);
          __syncthreads();
          *(LAS u32x4*)(lds + O_TM + t * MS + s0 * 2) = wv; }
        __syncthreads();
#pragma unroll
        for (int x = 0; x < 2; ++x) { const int tc = tcb + x; f32x4 gg = (f32x4){0.f, 0.f, 0.f, 0.f}, wt = gg;
            gg = mm_tile<2>(lds + O_AAK, MS, tr, lds + O_VTT, MS, tc, gg, lq, g); wt = mm_tile<2>(lds + O_TM, MS, tr, lds + O_ABT, MS, tc, wt, lq, g);
#pragma unroll
            for (int i = 0; i < 4; ++i) { DBGCNT(F, 12, !(fabsf(gg[i]) < 1e3f)); DBGCNT(F, 13, !(fabsf(wt[i]) < 1e2f)); }
            st_tr(lds + O_GT, 16 * tr + 4 * g, 16 * tc + lq, gg); st_tr(lds + O_WTT, 16 * tr + 4 * g, 16 * tc + lq, wt); }
        __syncthreads();
#pragma unroll
        for (int x = 0; x < 2; ++x) { const int tc = tcb + x; f32x4 ut = (f32x4){0.f, 0.f, 0.f, 0.f};
            ut = mm_tile<2>(lds + O_TM, MS, tr, lds + O_GT, MS, tc, ut, lq, g);
#pragma unroll
            for (int i = 0; i < 4; ++i) DBGCNT(F, 14, !(fabsf(ut[i]) < 1e3f));
            st_tr(lds + O_UTT, 16 * tr + 4 * g, 16 * tc + lq, ut); }
        __syncthreads();
#pragma unroll
        for (int x = 0; x < 2; ++x) { const int tc = tcb + x, t0 = 16 * tr + 4 * g, cj = 16 * tc + lq;
            f32x4 qt = (f32x4){0.f, 0.f, 0.f, 0.f}, yl = qt, pp = qt, nn = qt;
            qt = mm_tile<2>(lds + O_ARB, MS, tr, lds + O_WTT, MS, tc, qt, lq, g);
            yl = mm_tile<2>(lds + O_ARB, MS, tr, lds + O_UTT, MS, tc, yl, lq, g);
#ifdef DBG_SEL
            { f32x4 y2 = (f32x4){0.f, 0.f, 0.f, 0.f}; y2 = mm_tile<2>(lds + O_ARK, MS, tr, lds + O_VTT, MS, tc, y2, lq, g);
#pragma unroll
              for (int i = 0; i < 4; ++i) { DBGCNT(F, 15, !(fabsf(yl[i]) < 1e4f)); DBGCNT(F, 16, !(fabsf(y2[i]) < 1e4f)); }
#pragma unroll
              for (int ks = 0; ks < 2; ++ks) { const bf16x8 a1 = *(const LAS bf16x8*)(lds + O_ARB + (16 * tr + lq) * MS + (32 * ks + 8 * g) * 2), a2 = *(const LAS bf16x8*)(lds + O_ARK + (16 * tr + lq) * MS + (32 * ks + 8 * g) * 2);
                  const bf16x8 b1 = *(const LAS bf16x8*)(lds + O_UTT + (16 * tc + lq) * MS + (32 * ks + 8 * g) * 2), b2 = *(const LAS bf16x8*)(lds + O_VTT + (16 * tc + lq) * MS + (32 * ks + 8 * g) * 2);
#pragma unroll
                  for (int j = 0; j < 8; ++j) { DBGCNT(F, 17, !(fabsf(bf2f((bf16)a1[j])) < 300.f)); DBGCNT(F, 18, !(fabsf(bf2f((bf16)a2[j])) < 300.f)); DBGCNT(F, 19, !(fabsf(bf2f((bf16)b1[j])) < 1e3f)); DBGCNT(F, 20, !(fabsf(bf2f((bf16)b2[j])) < 100.f)); } } }
#endif
            yl = mm_tile<2>(lds + O_ARK, MS, tr, lds + O_VTT, MS, tc, yl, lq, g);
            pp = mm_tile<2>(lds + O_WTT, MS, tr, lds + O_BTT, MS, tc, pp, lq, g);
            nn = mm_tile<2>(lds + O_UTT, MS, tr, lds + O_BTT, MS, tc, nn, lq, g); nn = mm_tile<2>(lds + O_VTT, MS, tr, lds + O_KTT, MS, tc, nn, lq, g);
            bf16* QT = (bf16*)(F.ws + WS_QT) + (size_t)item * 4096; float* YL = (float*)(F.ws + WS_YLOC) + (size_t)item * 4096;
            bf16* PT = (bf16*)(F.ws + WS_PT) + (size_t)item * 4096; float* NNp = (float*)(F.ws + WS_NN) + (size_t)item * 4096;
#pragma unroll
            for (int i = 0; i < 4; ++i) { const float rbv = bf2f(*(const LAS bf16*)(lds + O_RB + (t0 + i) * MS + cj * 2));
                DBGCNT(F, 5, !(fabsf(yl[i]) < 1e4f)); DBGCNT(F, 11, !(fabsf(nn[i]) < 1e4f && fabsf(pp[i]) < 1e2f && fabsf(qt[i]) < 1e4f));
                QT[(unsigned)((t0 + i) * 64 + cj)] = (bf16)f2bf(qt[i] + rbv); YL[(unsigned)((t0 + i) * 64 + cj)] = yl[i]; NNp[(unsigned)((t0 + i) * 64 + cj)] = nn[i]; }
            u32x2 pw; pw.x = cvt_pk_bf16(pp[0], pp[1]); pw.y = cvt_pk_bf16(pp[2], pp[3]); *(GAS u32x2*)(PT + (unsigned)(cj * 64 + t0)) = pw;
        }
        __syncthreads();
    }
}

constexpr int SC_PT = 0, SC_NN = 8192, SC_GC = 12288, SC_DUM = 12544, SC_SLOT = 12800, SC_DEPTH = 8;
static_assert(SC_DEPTH * SC_SLOT <= RING_BYTES, "scan ring");
__device__ __forceinline__ void scan_issue(LAS unsigned char* ring, const unsigned char* ws, int bh, int vg, int c, int w, int lane) {
    const size_t item = (size_t)bh * NCHUNK + c; LAS unsigned char* slot = ring + (c & (SC_DEPTH - 1)) * SC_SLOT;
#pragma unroll
    for (int k = 0; k < 2; ++k) { const int id = 2 * (w - 1) + k;
        if (id < 8) { const int p = 64 * id + lane, r = p >> 3, sl = p & 7, ch = sl ^ (r & 7);
            __builtin_amdgcn_global_load_lds((const unsigned*)((const bf16*)(ws + WS_PT) + item * 4096 + r * 64 + ch * 8), (LAS unsigned*)(slot + SC_PT + 1024 * id), 16, 0, 0); }
        else if (id < 12) { const int q = id - 8, p = 64 * q + lane, r = p >> 4, sl = p & 15, ch = sl ^ (r & 15);
            __builtin_amdgcn_global_load_lds((const unsigned*)((const float*)(ws + WS_NN) + item * 4096 + (16 * vg + r) * 64 + ch * 4), (LAS unsigned*)(slot + SC_NN + 1024 * q), 16, 0, 0); }
        else { __builtin_amdgcn_global_load_lds((const unsigned*)((const float*)(ws + WS_GC) + item * 64 + lane), (LAS unsigned*)(slot + (id == 12 ? SC_GC : SC_DUM)), 4, 0, 0); }
    }
}
__device__ __forceinline__ void phase_scan(Frame& F, int bh, int vg) {
    const int lane = F.lane, w = F.wave, g = lane >> 4, lq = lane & 15;
    LAS unsigned char* ring = F.lds;
    f32x4 S[4];
#pragma unroll
    for (int kt = 0; kt < 4; ++kt) S[kt] = (f32x4){0.f, 0.f, 0.f, 0.f};
    const int v = 16 * vg + lq;
    if (w >= 1) {
#pragma unroll 1
        for (int c = 0; c < SC_DEPTH - 1; ++c) scan_issue(ring, F.ws, bh, vg, c, w, lane);
    }
#pragma unroll 1
    for (int c = 0; c < NCHUNK; ++c) {
        if (c <= NCHUNK - SC_DEPTH + 1) asm volatile("s_waitcnt vmcnt(12)" ::: "memory"); else asm volatile("s_waitcnt vmcnt(0)" ::: "memory");
        __builtin_amdgcn_s_barrier(); asm volatile("" ::: "memory");
        if (w >= 1 && c + SC_DEPTH - 1 < NCHUNK) scan_issue(ring, F.ws, bh, vg, c + SC_DEPTH - 1, w, lane);
        if (w == 0) {
            const LAS unsigned char* slot = ring + (c & (SC_DEPTH - 1)) * SC_SLOT; const size_t item = (size_t)bh * NCHUNK + c;
            bf16* S0 = (bf16*)(F.ws + WS_S0) + item * 4096;
            bf16x8 sf[2];
#pragma unroll
            for (int kt = 0; kt < 4; ++kt) { u32x2 wv; wv.x = cvt_pk_bf16(S[kt][0], S[kt][1]); wv.y = cvt_pk_bf16(S[kt][2], S[kt][3]); *(GAS u32x2*)(S0 + (size_t)v * 64 + 16 * kt + 4 * g) = wv; }
#pragma unroll
            for (int mb = 0; mb < 2; ++mb) { u32x4 wv; wv.x = cvt_pk_bf16(S[2 * mb][0], S[2 * mb][1]); wv.y = cvt_pk_bf16(S[2 * mb][2], S[2 * mb][3]);
                wv.z = cvt_pk_bf16(S[2 * mb + 1][0], S[2 * mb + 1][1]); wv.w = cvt_pk_bf16(S[2 * mb + 1][2], S[2 * mb + 1][3]); sf[mb] = __builtin_bit_cast(bf16x8, wv); }
#pragma unroll
            for (int kt = 0; kt < 4; ++kt) { const int k2 = 16 * kt + lq;
                const f32x4 nv = *(const LAS f32x4*)(slot + SC_NN + lq * 256 + (((4 * kt + g) ^ lq) << 4));
                const f32x4 gc = *(const LAS f32x4*)(slot + SC_GC + (16 * kt + 4 * g) * 4);
                f32x4 a = S[kt] * gc + nv;
#pragma unroll
                for (int mb = 0; mb < 2; ++mb) {
                    const u32x2 lo = *(const LAS u32x2*)(slot + SC_PT + k2 * 128 + (((4 * mb + (g >> 1)) ^ (k2 & 7)) << 4) + 8 * (g & 1));
                    const u32x2 hi = *(const LAS u32x2*)(slot + SC_PT + k2 * 128 + (((4 * mb + 2 + (g >> 1)) ^ (k2 & 7)) << 4) + 8 * (g & 1));
                    const bf16x8 pf = __builtin_bit_cast(bf16x8, (u32x4){lo.x, lo.y, hi.x, hi.y});
                    a = __builtin_amdgcn_mfma_f32_16x16x32_bf16(pf, sf[mb], a, 0, 0, 0); }
                S[kt] = a; }
        }
    }
    asm volatile("s_waitcnt vmcnt(0) lgkmcnt(0)" ::: "memory"); __builtin_amdgcn_s_barrier(); asm volatile("" ::: "memory");
}

__device__ __forceinline__ void phase_c(Frame& F, int b, int c, int h) {
    const int lane = F.lane, g = lane >> 4, lq = lane & 15;
    const size_t item = (size_t)(b * RH + h) * NCHUNK + c; const int n0 = b * T + c * CH;
    const bf16* QT = (const bf16*)(F.ws + WS_QT) + item * 4096; const bf16* S0 = (const bf16*)(F.ws + WS_S0) + item * 4096; const float* YL = (const float*)(F.ws + WS_YLOC) + item * 4096;
    const bf16* PROJ = (const bf16*)(F.ws + WS_PROJ); const float* mu = F.in[I_MU];
    bf16x8 sb[4][2];
#pragma unroll
    for (int tc = 0; tc < 4; ++tc)
#pragma unroll
        for (int ks = 0; ks < 2; ++ks) sb[tc][ks] = *(const GAS bf16x8*)(S0 + (size_t)(16 * tc + lq) * 64 + 32 * ks + 8 * g);
#pragma unroll 1
    for (int tr = 0; tr < 4; ++tr) {
        bf16x8 qa[2];
#pragma unroll
        for (int ks = 0; ks < 2; ++ks) qa[ks] = *(const GAS bf16x8*)(QT + (size_t)(16 * tr + lq) * 64 + 32 * ks + 8 * g);
        f32x4 y[4];
#pragma unroll
        for (int tc = 0; tc < 4; ++tc) {
#pragma unroll
            for (int i = 0; i < 4; ++i) { y[tc][i] = YL[(size_t)(16 * tr + 4 * g + i) * 64 + 16 * tc + lq]; DBGCNT(F, 0, !(fabsf(y[tc][i]) < 1e4f)); }
#ifndef DBG_NO_STATE
#pragma unroll
            for (int ks = 0; ks < 2; ++ks) y[tc] = __builtin_amdgcn_mfma_f32_16x16x32_bf16(qa[ks], sb[tc][ks], y[tc], 0, 0, 0);
#endif
            }
#pragma unroll
        for (int i = 0; i < 4; ++i) { const int t = 16 * tr + 4 * g + i, n = n0 + t;
            float s = (y[0][i] + y[1][i]) + (y[2][i] + y[3][i]); s += __shfl_xor(s, 1); s += __shfl_xor(s, 2); s += __shfl_xor(s, 4); s += __shfl_xor(s, 8);
            const float mean = s * (1.f / 64.f); float q = 0.f;
#pragma unroll
            for (int tc = 0; tc < 4; ++tc) { const float dlt = y[tc][i] - mean; q += dlt * dlt; }
            q += __shfl_xor(q, 1); q += __shfl_xor(q, 2); q += __shfl_xor(q, 4); q += __shfl_xor(q, 8);
            const float rstd = __builtin_amdgcn_rsqf(q * (1.f / 64.f) + GN_EPS);
            const float bsv = ((const float*)(F.ws + WS_BS))[(size_t)n * RH + h];
            const bool hasp = !(c == 0 && t == 0); const bf16* rowc = PROJ + (size_t)n * PCOLS; const bf16* rowp = hasp ? rowc - PCOLS : rowc;
#pragma unroll
            for (int tc = 0; tc < 4; ++tc) { const int hv = h * RN + 16 * tc + lq;
                const unsigned short vc = rowc[C_V + hv]; unsigned short vp = rowp[C_V + hv]; if (!hasp) vp = 0;
                const float vm = mixf(vc, vp, mu[C_V + hv]);
                const float yn = (y[tc][i] - mean) * rstd * F.in[I_LNG][hv] + F.in[I_LNB][hv];
                const float gt = bf2f(((const bf16*)(F.ws + WS_GATE))[(size_t)n * RW + hv]);
                float ov = (yn + bsv * vm) * gt;
#ifdef DBG_ZERO_RWKV
                ov = 0.f;
#endif
#ifdef DBG_PROBE
                ov = (DBG_PROBE == 1) ? gt : (DBG_PROBE == 2) ? bsv : (DBG_PROBE == 3) ? yn : (DBG_PROBE == 4) ? y[tc][i] : (DBG_PROBE == 5) ? 0.02f * (y[tc][i] - mean) : (DBG_PROBE == 6) ? 0.02f * y[tc][i] : vm;
#endif
#ifdef DBG_SCRUB_RWKV
                if (!(fabsf(ov) < 1e30f)) ov = 0.f;
#endif
                ((bf16*)(F.ws + WS_CAT))[(size_t)n * D + hv] = (bf16)f2bf(ov); }
        }
    }
}
}
__device__ __forceinline__ void diff_attn_phase(Frame& F) {
    const int lane = F.lane, w = F.wave, r = lane & 31, h = lane >> 5, rg = w >> 1, c = w & 1;
    float lam;
    { const float a = F.in[I_LQ1][lane] * F.in[I_LK1][lane], b2 = F.in[I_LQ2][lane] * F.in[I_LK2][lane]; lam = fexp(wave_sum(a)) - fexp(wave_sum(b2)) + LAMBDA_INIT; }
    const bf16* PROJ = (const bf16*)(F.ws + WS_PROJ); const bf16* VT = (const bf16*)(F.ws + WS_VT); bf16* CAT = (bf16*)(F.ws + WS_CAT);
    LAS float* xch = (LAS float*)F.lds;
    const bool tab = (F.G == 256);
    for (int p = F.bid; p < 256; p += F.G) {
#pragma unroll 1
        for (int s = 0; s < 2; ++s) { int bh, qb;
            if (tab) { const int u = attn_tab[F.bid][s]; if (u == 0xFFFF) break; bh = u >> 6; qb = u & 63; }
            else { bh = p >> 5; const int j = p & 31; qb = s ? 63 - j : j; }
            const int b = bh >> 2, hd = bh & 3; const int row0 = b * T + 128 * qb + 32 * rg;
            DiffBody32 body; f32x16 o[4]; float ls;
            const int nkt = 2 * qb + 2, nkt_w = (rg < 2) ? nkt - 1 : nkt;
            body.run(F.lds, PROJ + (size_t)row0 * PCOLS + C_QD + hd * 128 + c * 64, PCOLS, 0.125f * LOG2E, PROJ + (size_t)(b * T) * PCOLS + C_KD + hd * 128, PCOLS,
                     VT + (size_t)(hd * DV) * M + b * T, M, nkt, nkt_w, c, o, ls, F.tid, lane);
            if (c == 1) { const float sc = lam / ls;
#pragma unroll
                for (int db = 0; db < 4; ++db)
#pragma unroll
                    for (int i = 0; i < 16; ++i) xch[(rg * 64 + db * 16 + i) * 64 + lane] = o[db][i] * sc; }
            asm volatile("s_waitcnt lgkmcnt(0)" ::: "memory"); __builtin_amdgcn_s_barrier(); asm volatile("" ::: "memory");
            if (c == 0) { const float i0 = 1.f / ls; float q = 0.f;
#pragma unroll
                for (int db = 0; db < 4; ++db)
#pragma unroll
                    for (int i = 0; i < 16; ++i) { const float v = o[db][i] * i0 - xch[(rg * 64 + db * 16 + i) * 64 + lane]; o[db][i] = v; q += v * v; }
                { const auto r2 = __builtin_amdgcn_permlane32_swap(__float_as_uint(q), __float_as_uint(q), false, false); q = __uint_as_float(r2[0]) + __uint_as_float(r2[1]); }
                const float rstd = __builtin_amdgcn_rsqf(q * (1.f / DV) + NORM_EPS) * (1.f - LAMBDA_INIT);
                bf16* orow = CAT + (size_t)(row0 + r) * D + RW + hd * DV;
#pragma unroll
                for (int db = 0; db < 4; ++db)
#pragma unroll
                    for (int t = 0; t < 4; ++t) { const int dv = 32 * db + 8 * t + 4 * h; const f32x4 sg = *(const GAS f32x4*)(F.in[I_SUBG] + dv);
                        u32x2 wv; wv.x = cvt_pk_bf16(o[db][4 * t] * rstd * sg[0], o[db][4 * t + 1] * rstd * sg[1]); wv.y = cvt_pk_bf16(o[db][4 * t + 2] * rstd * sg[2], o[db][4 * t + 3] * rstd * sg[3]);
#ifdef DBG_ZERO_DIFF
                        wv.x = 0u; wv.y = 0u;
#endif
                        *(GAS u32x2*)(orow + dv) = wv; } }
            asm volatile("s_waitcnt lgkmcnt(0)" ::: "memory"); __builtin_amdgcn_s_barrier(); asm volatile("" ::: "memory");
        }
    }
}
__device__ __forceinline__ void cross_attn_phase(Frame& F) {
    typedef AttnBody<1, XD, XD, 2, 8> Body;
    const int lane = F.lane, w = F.wave, g = lane >> 4, lq = lane & 15;
    const bf16* QX = (const bf16*)(F.ws + WS_QX); const bf16* KM = (const bf16*)(F.ws + WS_KMEM); const bf16* VTM = (const bf16*)(F.ws + WS_VTMEM); bf16* XO = (bf16*)(F.ws + WS_XO);
#pragma unroll 1
    for (int u = F.bid; u < 512; u += F.G) { const int bh = u >> 6, rb = u & 63, b = bh >> 2, h = bh & 3; const int row0 = b * T + 128 * rb + 16 * w;
        Body body; f32x4 o[1][16]; float ls[1];
        body.run(F.lds, QX + (size_t)row0 * D + h * XD, D, 1.0f, KM + (size_t)(b * MEM) * D + h * XD, D, VTM + (size_t)(h * XD) * (BATCH * MEM) + b * MEM, BATCH * MEM, 4, 4, false, o, ls, F.tid, lane);
        const float inv = 1.f / ls[0]; bf16* orow = XO + (size_t)(row0 + lq) * D + h * XD;
#pragma unroll
        for (int dt = 0; dt < 16; ++dt) { const f32x4 y = o[0][dt] * inv; u32x2 wv; wv.x = cvt_pk_bf16(y[0], y[1]); wv.y = cvt_pk_bf16(y[2], y[3]);
#ifdef DBG_ZERO_XATTN
            wv.x = 0u; wv.y = 0u;
#endif
            *(GAS u32x2*)(orow + 16 * dt + 4 * g) = wv; }
    }
}

constexpr int RT_LCNT = X_OFF + 4096, RT_GBASE = RT_LCNT + 128, RT_ENTE = RT_GBASE + 128, RT_ENTP = RT_ENTE + 1024, RT_LGT = RT_ENTP + 1024;
__device__ __forceinline__ void router_phase(Frame& F, int cw_cnt, size_t ws_lists, size_t ws_gates) {
    const int lane = F.lane, w = F.wave, tid = F.tid;
    LAS int* lcnt = (LAS int*)(F.lds + RT_LCNT); LAS int* gbase = (LAS int*)(F.lds + RT_GBASE); LAS int* ente = (LAS int*)(F.lds + RT_ENTE); LAS int* entp = (LAS int*)(F.lds + RT_ENTP); LAS float* lgt = (LAS float*)(F.lds + RT_LGT);
    const float* H2 = (const float*)(F.ws + WS_H2); const float* RWT = (const float*)(F.ws + WS_RWT); const float* SS3 = (const float*)(F.ws + WS_SS3);
    int* lists = (int*)(F.ws + ws_lists); float* lgate = (float*)(F.ws + ws_gates); float* lrinv = lgate + (size_t)NE * CAP;
    LAS float* entg = (LAS float*)(F.lds + RT_LGT + 8448); LAS float* entr = entg + 256;
#pragma unroll 1
    for (int blk = F.bid; blk < M / 64; blk += F.G) {
        if (tid < NE) lcnt[tid] = 0;
        __syncthreads();
        const int nb = blk * 64 + w * 8;
        { const int tt = w >> 1, et = w & 1, lq = lane & 15, g = lane >> 4;
          const f32x4* ap = (const f32x4*)(H2 + (size_t)(blk * 64 + tt * 16 + lq) * D + 4 * g); const f32x4* bp = (const f32x4*)(RWT + (size_t)(et * 16 + lq) * D + 4 * g);
          f32x4 acc0 = (f32x4){0.f, 0.f, 0.f, 0.f}, acc1 = acc0;
#pragma unroll 8
          for (int j = 0; j < D / 16; j += 2) { const f32x4 a0 = ap[4 * j], b0 = bp[4 * j], a1 = ap[4 * j + 4], b1 = bp[4 * j + 4];
#pragma unroll
              for (int m = 0; m < 4; ++m) { acc0 = __builtin_amdgcn_mfma_f32_16x16x4f32(a0[m], b0[m], acc0, 0, 0, 0); acc1 = __builtin_amdgcn_mfma_f32_16x16x4f32(a1[m], b1[m], acc1, 0, 0, 0); } }
#pragma unroll
          for (int i = 0; i < 4; ++i) { const int tok = tt * 16 + 4 * g + i; lgt[tok * 33 + et * 16 + lq] = acc0[i] + acc1[i]; } }
        __syncthreads();
        if (lane < 8) { const int tl = w * 8 + lane, n = blk * 64 + tl;
            const float rinv = __builtin_amdgcn_rsqf(row_ss(SS3, n) * (1.f / D) + NORM_EPS);
            float v0 = -INFINITY, v1 = -INFINITY, v2 = -INFINITY, v3 = -INFINITY; int e0 = 0, e1 = 0, e2 = 0, e3 = 0;
#pragma unroll
            for (int e = 0; e < NE; ++e) { float x = lgt[tl * 33 + e] * rinv + F.in[I_RB][e]; if (!(x == x)) x = -3.0e38f;
                const bool c0 = x > v0, c1 = x > v1, c2 = x > v2, c3 = x > v3;
                v3 = c3 ? (c2 ? v2 : x) : v3; e3 = c3 ? (c2 ? e2 : e) : e3;
                v2 = c2 ? (c1 ? v1 : x) : v2; e2 = c2 ? (c1 ? e1 : e) : e2;
                v1 = c1 ? (c0 ? v0 : x) : v1; e1 = c1 ? (c0 ? e0 : e) : e1;
                v0 = c0 ? x : v0; e0 = c0 ? e : e0; }
            const float x1 = fexp(v1 - v0), x2 = fexp(v2 - v0), x3 = fexp(v3 - v0); const float inv = 1.f / (1.f + x1 + x2 + x3);
            const int es[4] = {e0, e1, e2, e3}; const float gs[4] = {inv, x1 * inv, x2 * inv, x3 * inv};
#pragma unroll
            for (int k = 0; k < 4; ++k) { const int li = tl * 4 + k; const int lp = __hip_atomic_fetch_add(&lcnt[es[k]], 1, __ATOMIC_RELAXED, __HIP_MEMORY_SCOPE_WORKGROUP); ente[li] = es[k]; entp[li] = lp; entg[li] = gs[k]; entr[li] = rinv; }
        }
        __syncthreads();
        if (tid < NE) gbase[tid] = (int)__hip_atomic_fetch_add((unsigned*)(F.ctl + cw_cnt + 64 * tid), (unsigned)lcnt[tid], RLX_AGENT);
#ifdef DUP_ATOM
        if (tid < NE) lgt[tid] = (float)__hip_atomic_fetch_add((unsigned*)(F.ctl + cw_cnt + 8192 + 64 * tid), (unsigned)lcnt[tid], RLX_AGENT);
#endif
        __syncthreads();
        if (tid < 256) { const int ee = ente[tid]; const size_t pos = (size_t)ee * CAP + gbase[ee] + entp[tid]; lists[pos] = blk * 256 + tid; lgate[pos] = entg[tid]; lrinv[pos] = entr[tid]; }
        __syncthreads();
    }
}
__device__ __forceinline__ void final_phase(Frame& F) {
    const int gw = F.bid * NWAVES + F.wave, NGW = F.G * NWAVES, lane = F.lane;
    const float* H2 = (const float*)(F.ws + WS_H2); const bf16* Y = (const bf16*)(F.ws + WS_YBUF);
    for (int n = gw; n < M; n += NGW) {
        f32x4 v[4]; float s = 0.f;
#pragma unroll
        for (int j = 0; j < 4; ++j) { v[j] = *((const GAS f32x4*)(H2 + (size_t)n * D) + lane + 64 * j);
#pragma unroll
            for (int k = 0; k < 4; ++k) { u32x2 y = *((const GAS u32x2*)(Y + (size_t)(n * 4 + k) * D) + lane + 64 * j);
#ifdef DBG_ZERO_MOE
                y.x = 0u; y.y = 0u;
#endif
                v[j].x += bflo(y.x); v[j].y += bfhi(y.x); v[j].z += bflo(y.y); v[j].w += bfhi(y.y); }
            s += (v[j].x * v[j].x + v[j].y * v[j].y) + (v[j].z * v[j].z + v[j].w * v[j].w); }
        float rstd = 1.f / sqrtf(wave_sum(s) * (1.f / D) + NORM_EPS);
#ifdef DBG_SEL
        { const unsigned cnt = __hip_atomic_load(F.ctl + 12288 + DBG_SEL, RLX_AGENT); rstd *= 0.9f * __log2f(1.f + (float)cnt) * (1.f / 30.f); }
#endif
#pragma unroll
        for (int j = 0; j < 4; ++j) { const f32x4 gg = *((const GAS f32x4*)F.in[I_FG] + lane + 64 * j); *((GAS f32x4*)(F.out + (size_t)n * D) + lane + 64 * j) = v[j] * rstd * gg; }
    }
}

constexpr int NPHASE = 13;
#ifndef P1_GEMM_WGS
#define P1_GEMM_WGS 144
#endif
struct Args { const float* in[34]; float* out; unsigned char* ws; int ph_lo, ph_hi; };
__global__ void __launch_bounds__(NTHR, 2) fwd_kernel(Args args) {
    extern __shared__ __attribute__((aligned(16))) unsigned char lds[];
    Frame F;
    F.lds = (LAS unsigned char*)lds; F.MISC = (volatile LAS unsigned*)(F.lds + MISC_OFF);
    F.tid = threadIdx.x; F.lane = F.tid & 63; F.wave = __builtin_amdgcn_readfirstlane(F.tid >> 6);
    F.G = gridDim.x; F.bid = blockIdx.x; F.ws = args.ws; F.ctl = (gu32*)(args.ws + WS_CTL); F.out = args.out;
#pragma unroll
    for (int i = 0; i < 34; ++i) F.in[i] = args.in[i];
    for (int u = F.tid; u < (LDS_BYTES - MISC_OFF) / 4; u += NTHR) ((LAS unsigned*)(F.lds + MISC_OFF))[u] = 0u;
    __syncthreads();
    XcdBarrier bar = xcd_barrier_post((unsigned*)(F.ctl + CW_BAR), F.MISC + 8);
    const int lo = args.ph_lo, hi = args.ph_hi;
#ifndef PHM
#define PHM 0xffff
#endif
#define IN(k) (((PHM >> (k)) & 1) && lo <= (k) && (k) < hi)
#ifdef DUP_BARRIER
#define SEAM(k) do { if (IN(k) && IN((k) + 1)) { xcd_barrier(bar); if ((k) == DUP_BARRIER || DUP_BARRIER == 99) { xcd_barrier(bar); } } } while (0)
#else
#define SEAM(k) do { if (IN(k) && IN((k) + 1)) xcd_barrier(bar); } while (0)
#endif
    LAS int* lstage = (LAS int*)(F.lds + X_OFF);
    LAS int* moe_tb = (LAS int*)(F.lds + X_OFF + 2048); LAS int* moe_cn = (LAS int*)(F.lds + X_OFF + 2048 + 256); LAS int* moe_rte = (LAS int*)(F.lds + X_OFF + 2048 + 512);

#define RETID() do { int t_ = threadIdx.x; asm volatile("" : "+v"(t_)); F.tid = t_; F.lane = t_ & 63; } while (0)
    if (IN(0)) { RETID(); p0_prologue(F);
#if defined(DUP_PHASE) && DUP_PHASE == 0
        { RETID(); p0_prologue(F);  }
#endif
    } SEAM(0);
    if (IN(1)) { RETID();
        const int NG1 = (F.G == 256) ? P1_GEMM_WGS : F.G;
        if (F.bid < NG1) {
        const bf16* XN = (const bf16*)(F.ws + WS_XN); const bf16* WinT = (const bf16*)(F.ws + WS_WINT); const bf16* MEMN = (const bf16*)(F.ws + WS_MEMN); const bf16* WkvT = (const bf16*)(F.ws + WS_WKVT);
        { pg8::Gemm g{XN, WinT, D, 0, nullptr}; pg8::StaticOrder S; S.init(M, PCOLS, NG1, F.bid, 0); pg8::EpiBf16 E{(bf16*)(F.ws + WS_PROJ), PCOLS};
          pg8::gemm_phase<pg8::EpiBf16, pg8::StaticOrder, true, false>(F.lds, lstage, g, S, E); }
        { pg8::Gemm g{WinT + (size_t)C_VD * D, XN, D, 0, nullptr}; pg8::StaticOrder S; S.init(512, M, NG1, F.bid, 0); pg8::EpiBf16 E{(bf16*)(F.ws + WS_VT), M};
          pg8::gemm_phase<pg8::EpiBf16, pg8::StaticOrder, true, false>(F.lds, lstage, g, S, E); }
        { pg8::Gemm g{MEMN, WkvT, D, 0, nullptr}; pg8::StaticOrder S; S.init(BATCH * MEM, D, NG1, F.bid, 16); pg8::EpiBf16 E{(bf16*)(F.ws + WS_KMEM), D};
          pg8::gemm_phase<pg8::EpiBf16, pg8::StaticOrder, true, false>(F.lds, lstage, g, S, E); }
        { pg8::Gemm g{WkvT + (size_t)D * D, MEMN, D, 0, nullptr}; pg8::StaticOrder S; S.init(D, BATCH * MEM, NG1, F.bid, 8); pg8::EpiBf16 E{(bf16*)(F.ws + WS_VTMEM), BATCH * MEM};
          pg8::gemm_phase<pg8::EpiBf16, pg8::StaticOrder, true, false>(F.lds, lstage, g, S, E); }

        }
        if (NG1 == F.G || F.bid >= NG1) p0_experts(F, NG1 == F.G ? 0 : NG1);
    } SEAM(1);
    if (IN(2)) { RETID(); for (int it = F.bid; it < BATCH * NCHUNK; it += F.G) rk::phase_a(F, it / NCHUNK, it % NCHUNK);
#if defined(DUP_PHASE) && DUP_PHASE == 2
        { RETID(); for (int it = F.bid; it < BATCH * NCHUNK; it += F.G) rk::phase_a(F, it / NCHUNK, it % NCHUNK);  }
#endif
    } SEAM(2);
    if (IN(3)) { RETID();
        for (int it = F.bid; it < BATCH * RH * 4; it += F.G) rk::phase_scan(F, it >> 2, it & 3);
#ifdef DUP_SCAN
        for (int it = F.bid; it < BATCH * RH * 4; it += F.G) rk::phase_scan(F, it >> 2, it & 3);
#endif
        diff_attn_phase(F);
#ifdef DUP_ATTN
        diff_attn_phase(F);
#endif

#if defined(DUP_PHASE) && DUP_PHASE == 3
        { RETID();
        for (int it = F.bid; it < BATCH * RH * 4; it += F.G) rk::phase_scan(F, it >> 2, it & 3);
        diff_attn_phase(F);
     }
#endif
    } SEAM(3);
    if (IN(4)) { RETID(); for (int it = F.bid; it < BATCH * NCHUNK; it += F.G) rk::phase_c(F, it / NCHUNK, it % NCHUNK, F.wave);
#if defined(DUP_PHASE) && DUP_PHASE == 4
        { RETID(); for (int it = F.bid; it < BATCH * NCHUNK; it += F.G) rk::phase_c(F, it / NCHUNK, it % NCHUNK, F.wave);  }
#endif
    } SEAM(4);
    if (IN(5)) { RETID(); pg8::Gemm g{(const bf16*)(F.ws + WS_CAT), (const bf16*)(F.ws + WS_WOUTT), D, 0, nullptr}; pg8::StaticOrder S; S.init(M, D, F.G, F.bid, 0);
        pg8::EpiResid2 E{F.in[I_X], nullptr, nullptr, (bf16*)(F.ws + WS_H1B), (float*)(F.ws + WS_SS1)};
        pg8::gemm_phase<pg8::EpiResid2, pg8::StaticOrder, true, false>(F.lds, lstage, g, S, E);
#if defined(DUP_PHASE) && DUP_PHASE == 5
        { RETID(); pg8::Gemm g{(const bf16*)(F.ws + WS_CAT), (const bf16*)(F.ws + WS_WOUTT), D, 0, nullptr}; pg8::StaticOrder S; S.init(M, D, F.G, F.bid, 0);
        pg8::EpiResid2 E{F.in[I_X], nullptr, nullptr, (bf16*)(F.ws + WS_H1B), (float*)(F.ws + WS_SS1)};
        pg8::gemm_phase<pg8::EpiResid2, pg8::StaticOrder, true, false>(F.lds, lstage, g, S, E);  }
#endif
    } SEAM(5);
    if (IN(6)) { RETID(); pg8::Gemm g{(const bf16*)(F.ws + WS_H1B), (const bf16*)(F.ws + WS_WQT), D, 0, nullptr}; pg8::StaticOrder S; S.init(M, D, F.G, F.bid, 0);
        pg8::EpiRowScaleBf16 E{(bf16*)(F.ws + WS_QX), D, (const float*)(F.ws + WS_SS1), 0.0625f * LOG2E};
        pg8::gemm_phase<pg8::EpiRowScaleBf16, pg8::StaticOrder, true, false>(F.lds, lstage, g, S, E);
#if defined(DUP_PHASE) && DUP_PHASE == 6
        { RETID(); pg8::Gemm g{(const bf16*)(F.ws + WS_H1B), (const bf16*)(F.ws + WS_WQT), D, 0, nullptr}; pg8::StaticOrder S; S.init(M, D, F.G, F.bid, 0);
        pg8::EpiRowScaleBf16 E{(bf16*)(F.ws + WS_QX), D, (const float*)(F.ws + WS_SS1), 0.0625f * LOG2E};
        pg8::gemm_phase<pg8::EpiRowScaleBf16, pg8::StaticOrder, true, false>(F.lds, lstage, g, S, E);  }
#endif
    } SEAM(6);
    if (IN(7)) { RETID(); cross_attn_phase(F);
#if defined(DUP_PHASE) && DUP_PHASE == 7
        { RETID(); cross_attn_phase(F);  }
#endif
    } SEAM(7);
    if (IN(8)) { RETID(); pg8::Gemm g{(const bf16*)(F.ws + WS_XO), (const bf16*)(F.ws + WS_WOT), D, 0, nullptr}; pg8::StaticOrder S; S.init(M, D, F.G, F.bid, 0);
        pg8::EpiResid2T<true> E{nullptr, (const bf16*)(F.ws + WS_H1B), (float*)(F.ws + WS_H2), (bf16*)(F.ws + WS_H2B), (float*)(F.ws + WS_SS3)};
        pg8::gemm_phase<pg8::EpiResid2T<true>, pg8::StaticOrder, true, false>(F.lds, lstage, g, S, E);
#if defined(DUP_PHASE) && DUP_PHASE == 8
        { RETID(); pg8::Gemm g{(const bf16*)(F.ws + WS_XO), (const bf16*)(F.ws + WS_WOT), D, 0, nullptr}; pg8::StaticOrder S; S.init(M, D, F.G, F.bid, 0);
        pg8::EpiResid2T<true> E{nullptr, (const bf16*)(F.ws + WS_H1B), (float*)(F.ws + WS_H2), (bf16*)(F.ws + WS_H2B), (float*)(F.ws + WS_SS3)};
        pg8::gemm_phase<pg8::EpiResid2T<true>, pg8::StaticOrder, true, false>(F.lds, lstage, g, S, E);  }
#endif
    } SEAM(8);
    if (IN(9)) { RETID(); router_phase(F, CW_CNT, WS_LISTS, WS_LGATE);
#if defined(DUP_PHASE) && DUP_PHASE == 9
        { RETID(); router_phase(F, CW_CNT + 4096, WS_YBUF, WS_YBUF + 4 * MiB); }
#endif
    } SEAM(9);
    if (IN(10) || IN(11)) { RETID();
        if (F.tid < NE) moe_cn[F.tid] = (int)__hip_atomic_load(F.ctl + CW_CNT + 64 * F.tid, RLX_AGENT);
        __syncthreads();
        if (F.tid == 0) { int a = 0; for (int e = 0; e < NE; ++e) { moe_tb[e] = a; a += (moe_cn[e] + 255) >> 8; } moe_tb[NE] = a; }
        __syncthreads();
        if (F.tid < MAXRT) { int e = 0; for (int k = 1; k < NE; ++k) e = (F.tid >= moe_tb[k]) ? k : e; moe_rte[F.tid] = e; }
        __syncthreads();
    }
    if (IN(10)) { RETID(); pg8::Gemm g{(const bf16*)(F.ws + WS_H2B), (const bf16*)(F.ws + WS_W1T), D / 2, (size_t)FF * D, (const int*)(F.ws + WS_LISTS)};
        pg8::MoeOrder S{moe_tb, moe_cn, moe_rte, 8, F.G, F.bid, __builtin_amdgcn_readfirstlane(moe_tb[NE])};
        pg8::EpiSwiglu E{F.ws + WS_ACT, F.in[I_B1], (const float*)(F.ws + WS_LRINV), (const int*)(F.ws + WS_LISTS)};
        pg8::gemm_phase<pg8::EpiSwiglu, pg8::MoeOrder, true, true, true>(F.lds, lstage, g, S, E);
#if defined(DUP_PHASE) && DUP_PHASE == 10
        { RETID(); pg8::Gemm g{(const bf16*)(F.ws + WS_H2B), (const bf16*)(F.ws + WS_W1T), D / 2, (size_t)FF * D, (const int*)(F.ws + WS_LISTS)};
        pg8::MoeOrder S{moe_tb, moe_cn, moe_rte, 8, F.G, F.bid, __builtin_amdgcn_readfirstlane(moe_tb[NE])};
        pg8::EpiSwiglu E{F.ws + WS_ACT, F.in[I_B1], (const float*)(F.ws + WS_LRINV), (const int*)(F.ws + WS_LISTS)};
        pg8::gemm_phase<pg8::EpiSwiglu, pg8::MoeOrder, true, true, true>(F.lds, lstage, g, S, E);  }
#endif
    } SEAM(10);
    if (IN(11)) { RETID(); pg8::Gemm g{(const bf16*)(F.ws + WS_ACT), (const bf16*)(F.ws + WS_W2T), FF / 2, (size_t)D * FF / 2, nullptr};
        pg8::MoeOrder S{moe_tb, moe_cn, moe_rte, 4, F.G, F.bid, __builtin_amdgcn_readfirstlane(moe_tb[NE])};
        pg8::EpiMoe2 E{(bf16*)(F.ws + WS_YBUF), F.in[I_B2], (const float*)(F.ws + WS_LGATE), (const int*)(F.ws + WS_LISTS)};
        pg8::gemm_phase<pg8::EpiMoe2, pg8::MoeOrder, true, false, true>(F.lds, lstage, g, S, E);
#if defined(DUP_PHASE) && DUP_PHASE == 112
        { RETID(); pg8::Gemm g{(const bf16*)(F.ws + WS_H2B), (const bf16*)(F.ws + WS_W2T), FF, (size_t)D * FF, (const int*)(F.ws + WS_LISTS)};
        pg8::MoeOrder S{moe_tb, moe_cn, moe_rte, 4, F.G, F.bid, __builtin_amdgcn_readfirstlane(moe_tb[NE])};
        pg8::EpiBf16 E{(bf16*)(F.ws + 532 * MiB), D};
        pg8::gemm_phase<pg8::EpiBf16, pg8::MoeOrder, true, true>(F.lds, lstage, g, S, E);  }
#endif
#if defined(DUP_PHASE) && DUP_PHASE == 11
        { RETID(); pg8::Gemm g{(const bf16*)(F.ws + WS_ACT), (const bf16*)(F.ws + WS_W2T), FF / 2, (size_t)D * FF / 2, nullptr};
        pg8::MoeOrder S{moe_tb, moe_cn, moe_rte, 4, F.G, F.bid, __builtin_amdgcn_readfirstlane(moe_tb[NE])};
        pg8::EpiMoe2 E{(bf16*)(F.ws + WS_YBUF), F.in[I_B2], (const float*)(F.ws + WS_LGATE), (const int*)(F.ws + WS_LISTS)};
        pg8::gemm_phase<pg8::EpiMoe2, pg8::MoeOrder, true, false, true>(F.lds, lstage, g, S, E);  }
#endif
    } SEAM(11);
    if (IN(12)) { RETID(); final_phase(F);
#if defined(DUP_PHASE) && DUP_PHASE == 12
        { RETID(); final_phase(F);  }
#endif
    }
#undef IN
#undef SEAM
}

#ifndef MK_SPLIT
#define MK_SPLIT 0
#endif
extern "C" void kernel_launch(void* const* d_in, const int* in_sizes, int n_in, void* d_out, int out_size, void* d_ws, size_t ws_size, hipStream_t stream) {
    static int grid = 0;
    if (grid == 0) {
        if (n_in != 34 || out_size != M * D || ws_size < WS_END) { fprintf(stderr, "kernel_launch: unexpected shapes (n_in %d out %d ws %zu)\n", n_in, out_size, ws_size); grid = -1; return; }
        int dev = 0, cus = 0, per_cu = 0;
        if (hipGetDevice(&dev) != hipSuccess || hipDeviceGetAttribute(&cus, hipDeviceAttributeMultiprocessorCount, dev) != hipSuccess) { grid = -1; return; }
        if (hipFuncSetAttribute((const void*)fwd_kernel, hipFuncAttributeMaxDynamicSharedMemorySize, LDS_BYTES) != hipSuccess) { fprintf(stderr, "kernel_launch: hipFuncSetAttribute failed\n"); grid = -1; return; }
        if (hipOccupancyMaxActiveBlocksPerMultiprocessor(&per_cu, (const void*)fwd_kernel, NTHR, LDS_BYTES) != hipSuccess || per_cu < 1) fprintf(stderr, "kernel_launch: occupancy query reports %d\n", per_cu);
        (void)hipGetLastError();
        grid = cus;
    }
    if (grid < 0) return;
    (void)hipMemsetAsync((char*)d_ws + WS_CTL, 0, CTL_ZERO_BYTES, stream);
    Args a{};
    for (int i = 0; i < 34; ++i) a.in[i] = (const float*)d_in[i];
    a.out = (float*)d_out; a.ws = (unsigned char*)d_ws;
#if MK_SPLIT
    for (int p = 0; p < NPHASE; ++p) { a.ph_lo = p; a.ph_hi = p + 1; hipLaunchKernelGGL(fwd_kernel, dim3(grid), dim3(NTHR), LDS_BYTES, stream, a); }
#else
    a.ph_lo = 0; a.ph_hi = NPHASE; hipLaunchKernelGGL(fwd_kernel, dim3(grid), dim3(NTHR), LDS_BYTES, stream, a);
#endif
}
```

```cpp
#include <hip/hip_runtime.h>
#include <cstdio>
#include <cstdint>

#define GAS __attribute__((address_space(1)))
#define LAS __attribute__((address_space(3)))
typedef unsigned short bf16;
typedef short bf16x8 __attribute__((ext_vector_type(8)));
typedef short bf16x4 __attribute__((ext_vector_type(4)));
typedef float f32x4 __attribute__((ext_vector_type(4)));
typedef float f32x2 __attribute__((ext_vector_type(2)));
typedef unsigned u32x4 __attribute__((ext_vector_type(4)));
typedef unsigned u32x2 __attribute__((ext_vector_type(2)));
typedef GAS unsigned gu32;
typedef int i32x4 __attribute__((ext_vector_type(4)));
typedef int i32x8 __attribute__((ext_vector_type(8)));
#define RLX_AGENT __ATOMIC_RELAXED, __HIP_MEMORY_SCOPE_AGENT
#define LDS_WAIT() asm volatile("s_waitcnt lgkmcnt(0)" ::: "memory")
#define VM_WAIT() asm volatile("s_waitcnt vmcnt(0)" ::: "memory")

typedef __bf16 bf16x2_t __attribute__((ext_vector_type(2)));
__device__ __forceinline__ unsigned cvt_pk_bf16(float lo, float hi) { const f32x2 v = {lo, hi}; const bf16x2_t b = __builtin_convertvector(v, bf16x2_t); return __builtin_bit_cast(unsigned, b); }
__device__ __forceinline__ unsigned f2bf(float f) { unsigned u = __builtin_bit_cast(unsigned, f); return (u + 0x7fffu + ((u >> 16) & 1u)) >> 16; }
__device__ __forceinline__ unsigned pk2(float lo, float hi) { return f2bf(lo) | (f2bf(hi) << 16); }
__device__ __forceinline__ float bf2f(bf16 b) { return __builtin_bit_cast(float, (unsigned)b << 16); }
__device__ __forceinline__ float bflo(unsigned u) { return __builtin_bit_cast(float, u << 16); }
__device__ __forceinline__ float bfhi(unsigned u) { return __builtin_bit_cast(float, u & 0xffff0000u); }
__device__ __forceinline__ float fexp2(float x) { return __builtin_amdgcn_exp2f(x); }
__device__ __forceinline__ float fexp(float x) { return __builtin_amdgcn_exp2f(x * 1.4426950408889634f); }
__device__ __forceinline__ float frcp(float x) { return __builtin_amdgcn_rcpf(x); }
__device__ __forceinline__ float sigmoidf_(float x) { return frcp(1.0f + fexp(-x)); }
__device__ __forceinline__ unsigned pk4_fp8(float a, float b, float c, float d) {
    a = __builtin_amdgcn_fmed3f(a, -448.f, 448.f); b = __builtin_amdgcn_fmed3f(b, -448.f, 448.f); c = __builtin_amdgcn_fmed3f(c, -448.f, 448.f); d = __builtin_amdgcn_fmed3f(d, -448.f, 448.f);
    int w = 0; w = __builtin_amdgcn_cvt_pk_fp8_f32(a, b, w, false); w = __builtin_amdgcn_cvt_pk_fp8_f32(c, d, w, true); return (unsigned)w; }
__device__ __forceinline__ i32x8 cat8(bf16x8 lo, bf16x8 hi) { const i32x4 a = __builtin_bit_cast(i32x4, lo), b = __builtin_bit_cast(i32x4, hi); return __builtin_shufflevector(a, b, 0, 1, 2, 3, 4, 5, 6, 7); }
constexpr float F8_SA = 16.f, F8_SW = 256.f, F8_SACT = 8.f;
#ifndef F8_SCALE
#define F8_SCALE 0x7F7F7F7F
#endif

namespace pg8 {
constexpr int BM = 256, BK = 64, HALF = 128, HTB = HALF * BK * 2  , STAGE_BYTES = 8 * HTB, NXCD = 8, WGM = 8;
__host__ __device__ __forceinline__ int lds_byte(int r, int c) { const int st = (r >> 4) * 2 + (c >> 5), rr = r & 15, cc = c & 31, ob = rr * 64 + cc * 2; return st * 1024 + (ob ^ (((ob >> 9) & 1) << 5)); }
__host__ __device__ __forceinline__ void stage_rc(int b, int& R, int& C) { const int st = b / 1024, sb = b % 1024, swz = sb ^ (((sb >> 9) & 1) << 5); R = (st >> 1) * 16 + swz / 64; C = (st & 1) * 32 + (swz % 64) / 2; }
__host__ __device__ __forceinline__ int perm32(int rho) { const int n = rho >> 4, i = rho & 15; return 8 * (i >> 2) + 4 * n + (i & 3); }

struct Unit { int pm, pn, e, nvalid, lbase, orow; };
struct Gemm { const bf16* A; const bf16* Bt; int K; size_t bstride; const int* rowlist; };

struct StaticOrder {
    int nM, nN, nwg, G, c;
    __device__ void init(int M, int N, int G_, int c_, int rot) { nM = M / BM; nN = N / BM; nwg = nM * nN; G = G_; c = (c_ + rot) % G_; }
    __device__ bool next(int i, Unit& u) const {
        const long L = (long)i * G + c; if (L >= nwg) return false;
        int wgid = (int)L; { const int q = nwg / NXCD, r = nwg % NXCD, xcd = wgid % NXCD, off = wgid / NXCD; wgid = (xcd < r ? xcd * (q + 1) : r * (q + 1) + (xcd - r) * q) + off; }
        const int nig = WGM * nN, gid = wgid / nig, fm = gid * WGM, gsz = (nM - fm) < WGM ? (nM - fm) : WGM;
        u.pm = fm + ((wgid % nig) % gsz); u.pn = (wgid % nig) / gsz; u.e = 0; u.nvalid = 256; u.lbase = 0; u.orow = u.pm * BM; return true;
    }
};

template <class Epi, class Sched, bool ALIGN_EPI, bool GATHER, bool F8 = false>
__device__ __forceinline__ void gemm_phase(LAS unsigned char* lds, LAS int* lstage  , const Gemm g, const Sched& S, const Epi& E) {
    int tid = threadIdx.x; asm volatile("" : "+v"(tid));
    const int wid = __builtin_amdgcn_readfirstlane(tid >> 6), lane = tid & 63, wr = wid >> 2, wc = wid & 3, fr = lane & 15, fq = lane >> 4;
    const int K = g.K, nt = K / BK;
    unsigned voffB[2], vA[2][2];
#pragma unroll
    for (int i = 0; i < 2; ++i) { int R, C; stage_rc(tid * 16 + i * 8192, R, C); const int Rb = Epi::PERM ? ((R & ~31) + perm32(R & 31)) : R;
        voffB[i] = (unsigned)(Rb * K + C) * 2u;
#pragma unroll
        for (int h = 0; h < 2; ++h) vA[h][i] = (unsigned)((h * HALF + R) * K + C) * 2u; }
    const size_t kstep = (size_t)(BK * 2);
    const size_t hstep = (size_t)HALF * K * 2;
    const size_t tstep = 2 * hstep;
    constexpr int AH1 = GATHER ? 1 : 0; const size_t AH = GATHER ? (size_t)0 : hstep;
    const unsigned ldsw = (unsigned)wid * 1024u;
    const int aoff = lds_byte(wr * 64 + fr, fq * 8), boff = lds_byte(wc * 32 + fr, fq * 8);
#define PG8_SA(b, h) (((b) * 2 + (h)) * HTB)
#define PG8_SB(b, h) ((4 + (b) * 2 + (h)) * HTB)
#define PG8_STAGE_(rs, base, bufoff, off, voff) do { _Pragma("unroll") for (int _i = 0; _i < 2; ++_i) { \
        if constexpr (F8) { unsigned keep_; asm volatile("s_mov_b32 %0, m0\n\ts_mov_b32 m0, %1\n\ts_nop 0\n\tbuffer_load_dwordx4 %2, %3, %4 offen lds\n\ts_mov_b32 m0, %0" \
            : "=&s"(keep_) : "s"(lds32 + (unsigned)(bufoff) + ldsw + (unsigned)_i * 8192u), "v"((voff)[_i]), "s"(rs), "s"((unsigned)(off)) : "memory"); } \
        else __builtin_amdgcn_global_load_lds((const unsigned*)((const char*)(base) + (off) + (voff)[_i]), (LAS unsigned*)(lds + (bufoff) + ldsw + _i * 8192), 16, 0, 0); } } while (0)
#define PG8_STA(bufoff, off, voff) PG8_STAGE_(rsA, g.A, bufoff, off, voff)
#define PG8_STB(bufoff, off, voff) PG8_STAGE_(rsB, g.Bt, bufoff, off, voff)
#define PG8_LDA(dst, b, h) do { _Pragma("unroll") for (int m = 0; m < 4; ++m) _Pragma("unroll") for (int k = 0; k < 2; ++k) dst[m][k] = *(const LAS bf16x8*)(lds + PG8_SA(b, h) + aoff + m * 2048 + k * 1024); } while (0)
#define PG8_LDB(dst, b, h) do { _Pragma("unroll") for (int n = 0; n < 2; ++n) _Pragma("unroll") for (int k = 0; k < 2; ++k) dst[n][k] = *(const LAS bf16x8*)(lds + PG8_SB(b, h) + boff + n * 2048 + k * 1024); } while (0)
#define PG8_MMA(ai, bj, At, Bt) do { __builtin_amdgcn_s_setprio(1); _Pragma("unroll") for (int m = 0; m < 4; ++m) _Pragma("unroll") for (int n = 0; n < 2; ++n) { \
        if constexpr (F8) acc[ai][bj][m][n] = __builtin_amdgcn_mfma_scale_f32_16x16x128_f8f6f4(cat8(Bt[n][0], Bt[n][1]), cat8(At[m][0], At[m][1]), acc[ai][bj][m][n], 0, 0, 0, F8_SCALE, 0, F8_SCALE); \
        else { _Pragma("unroll") for (int k = 0; k < 2; ++k) acc[ai][bj][m][n] = __builtin_amdgcn_mfma_f32_16x16x32_bf16(Bt[n][k], At[m][k], acc[ai][bj][m][n], 0, 0, 0); } } __builtin_amdgcn_s_setprio(0); } while (0)
#define PG8_WAIT_V(n) asm volatile("s_waitcnt vmcnt(" #n ")" ::: "memory")
#define PG8_WAIT_L(n) asm volatile("s_waitcnt lgkmcnt(" #n ")" ::: "memory")
#define PG8_BAR __builtin_amdgcn_s_barrier()
#define PG8_SCHED __builtin_amdgcn_sched_barrier(0)
    Unit cur, nxt; int ui = 0;
    if (!S.next(0, cur)) return;
    f32x4 acc[2][2][4][2];
#pragma unroll
    for (int a = 0; a < 2; ++a)
#pragma unroll
        for (int b = 0; b < 2; ++b)
#pragma unroll
            for (int m = 0; m < 4; ++m)
#pragma unroll
                for (int n = 0; n < 2; ++n) acc[a][b][m][n] = (f32x4){0.f, 0.f, 0.f, 0.f};
    bf16x8 At[4][2], B0[2][2], B1[2][2];
    size_t cA = GATHER ? (size_t)0 : (size_t)cur.pm * tstep;
    size_t cB = ((size_t)cur.e * g.bstride) * 2 + (size_t)cur.pn * tstep;
    const unsigned lds32 = (unsigned)(uintptr_t)lds;
    const __amdgpu_buffer_rsrc_t rsA = __builtin_amdgcn_make_buffer_rsrc((void*)g.A, 0, 0x7fffffff, 0x00020000), rsB = __builtin_amdgcn_make_buffer_rsrc((void*)g.Bt, 0, 0x7fffffff, 0x00020000);
    if constexpr (GATHER) {
        if (wid == 0) { unsigned lo16 = threadIdx.x; asm volatile("" : "+v"(lo16)); lo16 = (lo16 & 63u) * 16u; __builtin_amdgcn_global_load_lds((const unsigned*)((const char*)(g.rowlist + cur.lbase) + lo16), (LAS unsigned*)lstage, 16, 0, 0); }
        PG8_WAIT_V(0); __builtin_amdgcn_s_barrier();
#pragma unroll
        for (int h = 0; h < 2; ++h)
#pragma unroll
            for (int i = 0; i < 2; ++i) { int R, C; stage_rc(tid * 16 + i * 8192, R, C); const int rr = h * HALF + R; const int ent = lstage[rr]; const int src = rr < cur.nvalid ? ((ent >> 2) & 16383) : 0; vA[h][i] = (unsigned)(src * K + C) * 2u; }
        PG8_WAIT_L(0); __builtin_amdgcn_s_barrier();
    }
    PG8_STB(PG8_SB(0, 0), cB, voffB); PG8_STB(PG8_SB(0, 1), cB + hstep, voffB); PG8_STA(PG8_SA(0, 0), cA, vA[0]); PG8_STA(PG8_SA(0, 1), cA + AH, vA[AH1]);
    if (wr == 1) PG8_BAR;
    PG8_WAIT_V(2); PG8_BAR;
    PG8_STB(PG8_SB(1, 0), cB + kstep, voffB); PG8_STA(PG8_SA(1, 0), cA + kstep, vA[0]); PG8_STB(PG8_SB(1, 1), cB + hstep + kstep, voffB);
    PG8_WAIT_V(6); PG8_BAR;
    for (;;) {
        const bool has_next = S.next(ui + 1, nxt);
        const size_t nA = has_next ? (GATHER ? (size_t)0 : (size_t)nxt.pm * tstep) : cA;
        const size_t nB = has_next ? ((size_t)nxt.e * g.bstride) * 2 + (size_t)nxt.pn * tstep : cB;
#pragma unroll 1
        for (int t = 0; t < nt; t += 2) {
            const bool last = (t == nt - 2);
            if constexpr (GATHER) {
                if (t == 0 && has_next && wid == 0) { unsigned lo16 = threadIdx.x; asm volatile("" : "+v"(lo16)); lo16 = (lo16 & 63u) * 16u;
                    __builtin_amdgcn_global_load_lds((const unsigned*)((const char*)(g.rowlist + nxt.lbase) + lo16), (LAS unsigned*)(lstage + 256 * ((ui + 1) & 1)), 16, 0, 0); }
            }
            const size_t a1 = cA + (size_t)(t + 1) * kstep;
            const size_t a2 = last ? nA : cA + (size_t)(t + 2) * kstep; const size_t b2 = last ? nB : cB + (size_t)(t + 2) * kstep;
            const size_t a3 = a2 + kstep; const size_t b3 = b2 + kstep;
            PG8_LDB(B0, 0, 0); PG8_LDB(B1, 0, 1); PG8_SCHED; PG8_LDA(At, 0, 0); PG8_STA(PG8_SA(1, 1), a1 + AH, vA[AH1]);
            if constexpr (GATHER) { if (last && has_next) {
                int tl = tid; asm volatile("" : "+v"(tl));
#pragma unroll
                for (int h = 0; h < 2; ++h)
#pragma unroll
                    for (int i = 0; i < 2; ++i) { int R, C; stage_rc(tl * 16 + i * 8192, R, C); const int rr = h * HALF + R; const int ent = lstage[256 * ((ui + 1) & 1) + rr]; const int src = rr < nxt.nvalid ? ((ent >> 2) & 16383) : 0; vA[h][i] = (unsigned)(src * K + C) * 2u; } } }
            PG8_WAIT_V(8); PG8_WAIT_L(0); PG8_BAR; PG8_MMA(0, 0, At, B0); PG8_MMA(0, 1, At, B1); PG8_BAR; PG8_SCHED;
            PG8_LDA(At, 0, 1); PG8_STB(PG8_SB(0, 0), b2, voffB); PG8_STB(PG8_SB(0, 1), b2 + hstep, voffB); PG8_STA(PG8_SA(0, 0), a2, vA[0]);
            PG8_WAIT_V(8); PG8_WAIT_L(0); PG8_BAR; PG8_MMA(1, 0, At, B0); PG8_MMA(1, 1, At, B1); PG8_BAR; PG8_SCHED;
            PG8_LDB(B0, 1, 0); PG8_LDB(B1, 1, 1); PG8_SCHED; PG8_LDA(At, 1, 0); PG8_STA(PG8_SA(0, 1), a2 + AH, vA[AH1]);
            PG8_WAIT_V(8); PG8_WAIT_L(0); PG8_BAR; PG8_MMA(0, 0, At, B0); PG8_MMA(0, 1, At, B1); PG8_BAR; PG8_SCHED;
            PG8_LDA(At, 1, 1); PG8_STB(PG8_SB(1, 0), b3, voffB); PG8_STB(PG8_SB(1, 1), b3 + hstep, voffB); PG8_STA(PG8_SA(1, 0), a3, vA[0]);
            PG8_WAIT_V(8); PG8_WAIT_L(0); PG8_BAR; PG8_MMA(1, 0, At, B0); PG8_MMA(1, 1, At, B1); PG8_BAR; PG8_SCHED;
        }
        if constexpr (ALIGN_EPI) { if (wr == 0) PG8_BAR; }
        E(acc, cur, wr, wc, fr, fq);
        if (!has_next) break;
#pragma unroll
        for (int a = 0; a < 2; ++a)
#pragma unroll
            for (int b = 0; b < 2; ++b)
#pragma unroll
                for (int m = 0; m < 4; ++m)
#pragma unroll
                    for (int n = 0; n < 2; ++n) acc[a][b][m][n] = (f32x4){0.f, 0.f, 0.f, 0.f};
        cur = nxt; cA = nA; cB = nB; ++ui;
        if constexpr (ALIGN_EPI) { if (wr == 1) PG8_BAR; }
    }
    PG8_WAIT_V(0);
    if constexpr (!ALIGN_EPI) { if (wr == 0) PG8_BAR; }
    PG8_BAR;
#undef PG8_SA
#undef PG8_SB
#undef PG8_STAGE_
#undef PG8_STA
#undef PG8_STB
#undef PG8_LDA
#undef PG8_LDB
#undef PG8_MMA
#undef PG8_WAIT_V
#undef PG8_WAIT_L
#undef PG8_BAR
#undef PG8_SCHED
}
}
constexpr int NWAVES = 8, NTHR = 512;
constexpr int BATCH = 2, T = 8192, D = 1024, M = BATCH * T;
constexpr int CH = 64, NCHUNK = T / CH;
constexpr int RW = 512, RH = 8, RN = 64;
constexpr int DH = 4, DD = 64, DV = 128;
constexpr int SHIFT_COLS = 1792, PCOLS = 2816, IN_COLS = 3328;
constexpr int C_R = 0, C_K = 512, C_V = 1024, C_WD = 1536, C_AD = 1600, C_GD = 1664, C_QD = 1792, C_KD = 2304, C_VD = 2816;
constexpr int MEM = 256, XH = 4, XD = 256;
constexpr int NE = 32, TOPK = 4, FF = 1024, CAP = M;
constexpr int MAXRT = (M * TOPK) / 256 + NE;
constexpr float NORM_EPS = 1e-5f, GN_EPS = 64e-5f, LOG2E = 1.4426950408889634f;
constexpr float LAMBDA_INIT = 0.8f - 0.6f;

constexpr size_t MiB = 1u << 20;
constexpr size_t WS_CTL = 0, CTL_ZERO_BYTES = 1 * MiB;
constexpr size_t WS_SS1 = 250 * MiB + 512 * 1024, WS_SS3 = 251 * MiB;
constexpr size_t WS_WINT = 1 * MiB, WS_WOUTT = 8 * MiB, WS_WQT = 10 * MiB, WS_WKVT = 12 * MiB, WS_WOT = 16 * MiB;
constexpr size_t WS_W2LT = 18 * MiB, WS_A2LT = WS_W2LT + 64 * 1024, WS_G2LT = WS_W2LT + 128 * 1024, WS_RWT = WS_W2LT + 256 * 1024;
constexpr size_t WS_W1T = 20 * MiB, WS_W2T = 148 * MiB;
constexpr size_t WS_LGATE = 212 * MiB, WS_LRINV = 214 * MiB;
constexpr size_t WS_XN = 212 * MiB, WS_MEMN = 244 * MiB, WS_KMEM = 245 * MiB, WS_VTMEM = 246 * MiB;
constexpr size_t WS_LISTS = 247 * MiB, WS_GATES = 249 * MiB, WS_GC = 249 * MiB + 512 * 1024, WS_BS = 250 * MiB;
constexpr size_t WS_PROJ = 252 * MiB, WS_VT = 340 * MiB, WS_QT = 356 * MiB, WS_PT = 372 * MiB, WS_S0 = 388 * MiB, WS_GATE = 404 * MiB, WS_YLOC = 420 * MiB, WS_NN = 452 * MiB;
constexpr size_t WS_CAT = 484 * MiB, WS_H1 = 516 * MiB, WS_H1B = 580 * MiB, WS_QX = 612 * MiB, WS_XO = 644 * MiB, WS_H2 = 676 * MiB, WS_H2B = 740 * MiB;
constexpr size_t WS_ACT = 252 * MiB;
constexpr size_t WS_YBUF = 404 * MiB, WS_END = 772 * MiB;
static_assert(WS_ACT + (size_t)MAXRT * 256 * FF * 2 <= WS_GATE, "ACT overlay");
static_assert(WS_PROJ + (size_t)M * PCOLS * 2 <= WS_VT, "PROJ");
constexpr int CW_TMO = 0, CW_BAR = 4096, CW_CNT = 8192;
static_assert((CW_BAR + 3456) <= CW_CNT && (CW_CNT + 64 * NE) * 4 <= (int)CTL_ZERO_BYTES, "CTL map");

constexpr int RING_BYTES = 131072;
constexpr int X_OFF = RING_BYTES;
constexpr int MISC_OFF = 163840 - 1024;
constexpr int LDS_BYTES = 163840;

__device__ __forceinline__ float row_ss(const float* ssp, int row) {
    const f32x4 a = *(const f32x4*)(ssp + (size_t)row * 16), b = *(const f32x4*)(ssp + (size_t)row * 16 + 4), c = *(const f32x4*)(ssp + (size_t)row * 16 + 8), d = *(const f32x4*)(ssp + (size_t)row * 16 + 12);
    return (((a[0] + a[1]) + (a[2] + a[3])) + ((b[0] + b[1]) + (b[2] + b[3]))) + (((c[0] + c[1]) + (c[2] + c[3])) + ((d[0] + d[1]) + (d[2] + d[3])));
}
namespace pg8 {
struct EpiBf16 {
    static constexpr bool PERM = true;
    bf16* O; int ldc;
    __device__ __forceinline__ void operator()(const f32x4 (&acc)[2][2][4][2], const Unit& u, int wr, int wc, int fr, int fq) const {
        { unsigned tl = threadIdx.x; asm volatile("" : "+v"(tl)); fr = (int)(tl & 15u); fq = (int)((tl >> 4) & 3u); }
        const int col0 = u.pn * BM + wc * 32 + 8 * fq;
#pragma unroll
        for (int ai = 0; ai < 2; ++ai)
#pragma unroll
            for (int m = 0; m < 4; ++m) { bf16* rowp = O + (size_t)(u.orow + ai * HALF + wr * 64 + m * 16 + fr) * ldc + col0;
#pragma unroll
                for (int bj = 0; bj < 2; ++bj) { const f32x4 v0 = acc[ai][bj][m][0], v1 = acc[ai][bj][m][1];
                    u32x4 w; w.x = cvt_pk_bf16(v0[0], v0[1]); w.y = cvt_pk_bf16(v0[2], v0[3]); w.z = cvt_pk_bf16(v1[0], v1[1]); w.w = cvt_pk_bf16(v1[2], v1[3]);
                    *(u32x4*)(rowp + bj * HALF) = w; } }
    }
};
struct EpiRowScaleBf16 {
    static constexpr bool PERM = true;
    bf16* O; int ldc; const float* ss; float scale;
    __device__ __forceinline__ void operator()(const f32x4 (&acc)[2][2][4][2], const Unit& u, int wr, int wc, int fr, int fq) const {
        { unsigned tl = threadIdx.x; asm volatile("" : "+v"(tl)); fr = (int)(tl & 15u); fq = (int)((tl >> 4) & 3u); }
        const int col0 = u.pn * BM + wc * 32 + 8 * fq;
#pragma unroll
        for (int ai = 0; ai < 2; ++ai)
#pragma unroll
            for (int m = 0; m < 4; ++m) { const int row = u.orow + ai * HALF + wr * 64 + m * 16 + fr; bf16* rowp = O + (size_t)row * ldc + col0;
                const float s = scale * __builtin_amdgcn_rsqf(row_ss(ss, row) * (1.0f / D) + NORM_EPS);
#pragma unroll
                for (int bj = 0; bj < 2; ++bj) { const f32x4 v0 = acc[ai][bj][m][0] * s, v1 = acc[ai][bj][m][1] * s;
                    u32x4 w; w.x = cvt_pk_bf16(v0[0], v0[1]); w.y = cvt_pk_bf16(v0[2], v0[3]); w.z = cvt_pk_bf16(v1[0], v1[1]); w.w = cvt_pk_bf16(v1[2], v1[3]);
                    *(u32x4*)(rowp + bj * HALF) = w; } }
    }
};
struct EpiResid {
    static constexpr bool PERM = true;
    const float* base; float* H; bf16* Hb; float* ss;
    __device__ __forceinline__ void operator()(const f32x4 (&acc)[2][2][4][2], const Unit& u, int wr, int wc, int fr, int fq) const {
        { unsigned tl = threadIdx.x; asm volatile("" : "+v"(tl)); fr = (int)(tl & 15u); fq = (int)((tl >> 4) & 3u); }
        const int col0 = u.pn * BM + wc * 32 + 8 * fq;
#pragma unroll
        for (int ai = 0; ai < 2; ++ai)
#pragma unroll
            for (int m = 0; m < 4; ++m) { const int row = u.orow + ai * HALF + wr * 64 + m * 16 + fr; const size_t off = (size_t)row * D + col0; float q = 0.f;
#pragma unroll
                for (int bj = 0; bj < 2; ++bj) {
                    const f32x4 b0 = *(const f32x4*)(base + off + bj * HALF), b1 = *(const f32x4*)(base + off + bj * HALF + 4);
                    const f32x4 v0 = acc[ai][bj][m][0] + b0, v1 = acc[ai][bj][m][1] + b1;
                    *(f32x4*)(H + off + bj * HALF) = v0; *(f32x4*)(H + off + bj * HALF + 4) = v1;
                    u32x4 w; w.x = cvt_pk_bf16(v0[0], v0[1]); w.y = cvt_pk_bf16(v0[2], v0[3]); w.z = cvt_pk_bf16(v1[0], v1[1]); w.w = cvt_pk_bf16(v1[2], v1[3]);
                    *(u32x4*)(Hb + off + bj * HALF) = w;
                    q += (v0[0] * v0[0] + v0[1] * v0[1]) + (v0[2] * v0[2] + v0[3] * v0[3]) + (v1[0] * v1[0] + v1[1] * v1[1]) + (v1[2] * v1[2] + v1[3] * v1[3]); }
                q += __shfl_xor(q, 16); q += __shfl_xor(q, 32);
                if (fq == 0) ss[(size_t)row * 16 + u.pn * 4 + wc] = q; }
    }
};
template <bool HB8>
struct EpiResid2T {
    static constexpr bool PERM = true;
    const float* basef; const bf16* baseb; float* H; bf16* Hb; float* ss; const float* g8;
    __device__ __forceinline__ void operator()(const f32x4 (&acc)[2][2][4][2], const Unit& u, int wr, int wc, int fr, int fq) const {
        { unsigned tl = threadIdx.x; asm volatile("" : "+v"(tl)); fr = (int)(tl & 15u); fq = (int)((tl >> 4) & 3u); }
        const int col0 = u.pn * BM + wc * 32 + 8 * fq;
        f32x4 gs[2][2];
        if constexpr (HB8) {
#pragma unroll
            for (int bj = 0; bj < 2; ++bj) { gs[bj][0] = *(const f32x4*)(g8 + col0 + bj * HALF) * F8_SA; gs[bj][1] = *(const f32x4*)(g8 + col0 + bj * HALF + 4) * F8_SA; } }
#pragma unroll
        for (int ai = 0; ai < 2; ++ai)
#pragma unroll
            for (int m = 0; m < 4; ++m) { const int row = u.orow + ai * HALF + wr * 64 + m * 16 + fr; const size_t off = (size_t)row * D + col0; float q = 0.f;
#pragma unroll
                for (int bj = 0; bj < 2; ++bj) {
                    f32x4 b0, b1;
                    if (basef) { b0 = *(const f32x4*)(basef + off + bj * HALF); b1 = *(const f32x4*)(basef + off + bj * HALF + 4); }
                    else { const u32x4 bb = *(const u32x4*)(baseb + off + bj * HALF); b0 = (f32x4){bflo(bb.x), bfhi(bb.x), bflo(bb.y), bfhi(bb.y)}; b1 = (f32x4){bflo(bb.z), bfhi(bb.z), bflo(bb.w), bfhi(bb.w)}; }
                    const f32x4 v0 = acc[ai][bj][m][0] + b0, v1 = acc[ai][bj][m][1] + b1;
                    if (H) { *(f32x4*)(H + off + bj * HALF) = v0; *(f32x4*)(H + off + bj * HALF + 4) = v1; }
                    if constexpr (HB8) { const f32x4 s0 = v0 * gs[bj][0], s1 = v1 * gs[bj][1]; u32x2 w8; w8.x = pk4_fp8(s0[0], s0[1], s0[2], s0[3]); w8.y = pk4_fp8(s1[0], s1[1], s1[2], s1[3]);
                        *(u32x2*)((unsigned char*)Hb + off + bj * HALF) = w8; }
                    else { u32x4 w; w.x = cvt_pk_bf16(v0[0], v0[1]); w.y = cvt_pk_bf16(v0[2], v0[3]); w.z = cvt_pk_bf16(v1[0], v1[1]); w.w = cvt_pk_bf16(v1[2], v1[3]);
                        *(u32x4*)(Hb + off + bj * HALF) = w; }
                    q += (v0[0] * v0[0] + v0[1] * v0[1]) + (v0[2] * v0[2] + v0[3] * v0[3]) + (v1[0] * v1[0] + v1[1] * v1[1]) + (v1[2] * v1[2] + v1[3] * v1[3]); }
                q += __shfl_xor(q, 16); q += __shfl_xor(q, 32);
                if (fq == 0) ss[(size_t)row * 16 + u.pn * 4 + wc] = q; }
    }
};
using EpiResid2 = EpiResid2T<false>;
struct EpiSwiglu {
    static constexpr bool PERM = true;
    unsigned char* ACT; const float* b1; const float* lrinv; const int* list;
    __device__ __forceinline__ void operator()(const f32x4 (&acc)[2][2][4][2], const Unit& u, int wr, int wc, int fr, int fq) const {
        { unsigned tl = threadIdx.x; asm volatile("" : "+v"(tl)); fr = (int)(tl & 15u); fq = (int)((tl >> 4) & 3u); }
        const int j0 = u.pn * HALF + wc * 32 + 8 * fq; const float* bg = b1 + (size_t)u.e * (2 * FF) + j0; const float* bl = bg + FF;
        const f32x4 g0 = *(const f32x4*)bg, g1 = *(const f32x4*)(bg + 4), l0 = *(const f32x4*)bl, l1 = *(const f32x4*)(bl + 4);
#pragma unroll
        for (int ai = 0; ai < 2; ++ai)
#pragma unroll
            for (int m = 0; m < 4; ++m) { const int rr = ai * HALF + wr * 64 + m * 16 + fr;
                if (rr < u.nvalid) {
                    const float s = lrinv[u.lbase + rr] * (1.0f / (F8_SA * F8_SW));
                    float o[8];
#pragma unroll
                    for (int n = 0; n < 2; ++n)
#pragma unroll
                        for (int j = 0; j < 4; ++j) { float gt = acc[ai][0][m][n][j] * s + (n ? g1[j] : g0[j]), ln = acc[ai][1][m][n][j] * s + (n ? l1[j] : l0[j]);
                            gt = fminf(gt, 7.0f); ln = fminf(fmaxf(ln, -7.0f), 7.0f);
                            o[n * 4 + j] = gt * frcp(1.0f + fexp(-1.702f * gt)) * (ln * F8_SACT + F8_SACT); }
                    u32x2 w; w.x = pk4_fp8(o[0], o[1], o[2], o[3]); w.y = pk4_fp8(o[4], o[5], o[6], o[7]);
                    *(u32x2*)(ACT + (size_t)(u.orow + rr) * FF + j0) = w; } }
        asm volatile("" :: "v"(g0), "v"(g1), "v"(l0), "v"(l1));
    }
};
struct EpiMoe2 {
    static constexpr bool PERM = true;
    bf16* Y; const float* b2; const float* gates; const int* list;
    __device__ __forceinline__ void operator()(const f32x4 (&acc)[2][2][4][2], const Unit& u, int wr, int wc, int fr, int fq) const {
        { unsigned tl = threadIdx.x; asm volatile("" : "+v"(tl)); fr = (int)(tl & 15u); fq = (int)((tl >> 4) & 3u); }
        const int col0 = u.pn * BM + wc * 32 + 8 * fq; const float* bb = b2 + (size_t)u.e * D + col0;
        f32x4 bv[2][2];
#pragma unroll
        for (int bj = 0; bj < 2; ++bj) { bv[bj][0] = *(const f32x4*)(bb + bj * HALF); bv[bj][1] = *(const f32x4*)(bb + bj * HALF + 4); }
#pragma unroll
        for (int ai = 0; ai < 2; ++ai)
#pragma unroll
            for (int m = 0; m < 4; ++m) { const int rr = ai * HALF + wr * 64 + m * 16 + fr;
                if (rr < u.nvalid) {
                    const int ent = list[u.lbase + rr] & 65535; const float gw = gates[u.lbase + rr]; bf16* rowp = Y + (size_t)ent * D + col0;
#pragma unroll
                    for (int bj = 0; bj < 2; ++bj) { const f32x4 v0 = (acc[ai][bj][m][0] * (1.0f / (F8_SACT * F8_SW)) + bv[bj][0]) * gw, v1 = (acc[ai][bj][m][1] * (1.0f / (F8_SACT * F8_SW)) + bv[bj][1]) * gw;
                        u32x4 w; w.x = cvt_pk_bf16(v0[0], v0[1]); w.y = cvt_pk_bf16(v0[2], v0[3]); w.z = cvt_pk_bf16(v1[0], v1[1]); w.w = cvt_pk_bf16(v1[2], v1[3]);
                        *(u32x4*)(rowp + bj * HALF) = w; } } }
        asm volatile("" :: "v"(bv[0][0]), "v"(bv[0][1]), "v"(bv[1][0]), "v"(bv[1][1]));
    }
};
struct MoeOrder {
    const LAS int* tb; const LAS int* cn; const LAS int* rte; int ncol, G, c, ntile;
    __device__ bool next(int i, Unit& u) const {
        const int L = i * G + c, rt = L / ncol, pn = L % ncol; if (rt >= ntile) return false;
        const int e = __builtin_amdgcn_readfirstlane(rte[rt]);
        const int tile = rt - __builtin_amdgcn_readfirstlane(tb[e]), left = __builtin_amdgcn_readfirstlane(cn[e]) - tile * 256;
        u.pm = rt; u.pn = pn; u.e = e; u.nvalid = left < 256 ? left : 256; u.lbase = e * CAP + tile * 256; u.orow = rt * 256; return true;
    }
};
}
#define XB_TMO      128
#define XB_XCNT(j)  (256  + 64 * (j))
#define XB_XSUB(j)  (1280 + 64 * (j))
#define XB_XGEN(j)  (2304 + 64 * (j))
#define XB_TOP      3328
#define XB_TOPGEN   3392
#define XCD_BAR_WORDS 3456
#define XB_SPIN_CAP (1u << 18)

__device__ __forceinline__ unsigned xb_ld(unsigned* p)              { return __hip_atomic_load(p, __ATOMIC_RELAXED, __HIP_MEMORY_SCOPE_AGENT); }
__device__ __forceinline__ unsigned xb_add(unsigned* p, unsigned v) { return __hip_atomic_fetch_add(p, v, __ATOMIC_RELAXED, __HIP_MEMORY_SCOPE_AGENT); }
__device__ __forceinline__ unsigned xb_xcc_id() { return (unsigned)__builtin_amdgcn_s_getreg((3 << 11) | 20) & 0xFu; }
#define XB_SPIN(cond, bar) do { unsigned _sp = 0; while (cond) { __builtin_amdgcn_s_sleep(1); \
    if ((++_sp & 255u) == 0u) { if (xb_ld(&(bar)[XB_TMO])) break; if (_sp > XB_SPIN_CAP) { atomicAdd(&(bar)[XB_TMO], 1u); break; } } } } while (0)

struct XcdBarrier {
    unsigned* bar; unsigned x;
    volatile LAS unsigned* st;
};

__device__ __forceinline__ XcdBarrier xcd_barrier_post(unsigned* bar, volatile LAS unsigned* st) {
    XcdBarrier b; b.bar = bar; b.x = xb_xcc_id(); b.st = st;
    if (threadIdx.x == 0) (void)xb_add(&bar[XB_XCNT(b.x)], 1u);
    return b;
}
__device__ __forceinline__ void xcd_barrier_complete(unsigned* bar, unsigned x, unsigned& nloc, unsigned& nx) {
    const unsigned G = gridDim.x * gridDim.y * gridDim.z;
    unsigned sum, cnt, mine, sp = 0u;
    for (;;) {
        sum = 0u; cnt = 0u; mine = 0u;
#pragma unroll
        for (unsigned j = 0; j < 16; ++j) { const unsigned c = xb_ld(&bar[XB_XCNT(j)]); sum += c; cnt += (c > 0u) ? 1u : 0u; mine = (j == x) ? c : mine; }
        if (sum == G) break;
        __builtin_amdgcn_s_sleep(1);
        if ((++sp & 255u) == 0u) { if (xb_ld(&bar[XB_TMO])) break; if (sp > XB_SPIN_CAP) { atomicAdd(&bar[XB_TMO], 1u); break; } }
    }
    nloc = mine > 0u ? mine : 1u; nx = cnt > 0u ? cnt : 1u;
}

__device__ __forceinline__ void xcd_barrier(const XcdBarrier& b) {
    asm volatile("s_waitcnt vmcnt(0)" ::: "memory");
    __syncthreads();
    if (threadIdx.x == 0) {
        unsigned* bar = b.bar;
        __builtin_amdgcn_s_waitcnt(0);
        unsigned nloc = b.st[0], nx = b.st[1];
        if (nloc == 0u) { xcd_barrier_complete(bar, b.x, nloc, nx); b.st[0] = nloc; b.st[1] = nx; }
        const unsigned old = xb_add(&bar[XB_XSUB(b.x)], 1u);
        const unsigned gen = old / nloc;
        if (old + 1u == (gen + 1u) * nloc) {
            __builtin_amdgcn_fence(__ATOMIC_RELEASE, "agent");
            asm volatile("s_waitcnt vmcnt(0)" ::: "memory");
            const unsigned og = xb_add(&bar[XB_TOP], 1u);
            const unsigned tg = og / nx;
            if (og + 1u == (tg + 1u) * nx) xb_add(&bar[XB_TOPGEN], 1u);
            else XB_SPIN(xb_ld(&bar[XB_TOPGEN]) == tg, bar);
            __builtin_amdgcn_fence(__ATOMIC_ACQUIRE, "agent");
            xb_add(&bar[XB_XGEN(b.x)], 1u);
            asm volatile("s_waitcnt vmcnt(0)" ::: "memory");
        } else {
            XB_SPIN(xb_ld(&bar[XB_XGEN(b.x)]) == gen, bar);
            __builtin_amdgcn_fence(__ATOMIC_ACQUIRE, "agent");
            asm volatile("s_waitcnt vmcnt(0)" ::: "memory");
        }
    }
    __syncthreads();
}
#ifdef DBG_SEL
#define DBGCNT(F, k, cond) do { if (cond) atomicAdd((unsigned*)((F).ctl + 12288 + (k)), 1u); } while (0)
#else
#define DBGCNT(F, k, cond) do { } while (0)
#endif
struct Frame {
    LAS unsigned char* lds;
    volatile LAS unsigned* MISC;
    gu32* ctl;
    unsigned char* ws;
    int tid, lane, wave, G, bid;
    const float* in[34];
    float* out;
};
__device__ __forceinline__ float wave_sum(float v) {
#pragma unroll
    for (int o = 1; o < 64; o <<= 1) v += __shfl_xor(v, o);
    return v;
}
__device__ __forceinline__ float wave_max(float v) {
#pragma unroll
    for (int o = 1; o < 64; o <<= 1) v = fmaxf(v, __shfl_xor(v, o));
    return v;
}
__device__ __forceinline__ void p0_transpose_item(const float* W, int N, const float* gk, bf16* WT, int Kd, int k0, int n0, int drow, LAS float* scr, int lane) {
    float v[32];
#pragma unroll
    for (int i = 0; i < 32; ++i) { const int kk = 2 * i + (lane >> 5); v[i] = W[(size_t)(k0 + kk) * N + n0 + (lane & 31)]; }
    if (gk) {
#pragma unroll
        for (int i = 0; i < 32; ++i) { const int kk = 2 * i + (lane >> 5); v[i] *= gk[k0 + kk]; }
    }
#pragma unroll
    for (int i = 0; i < 32; ++i) { const int kk = 2 * i + (lane >> 5); scr[kk * 33 + (lane & 31)] = v[i]; }
    LDS_WAIT(); asm volatile("" ::: "memory");
    const int c = lane & 7;
#pragma unroll
    for (int j = 0; j < 4; ++j) { const int n = (lane >> 3) + 8 * j; const LAS float* s = scr + (8 * c) * 33 + n;
        u32x4 o; o.x = pk2(s[0 * 33], s[1 * 33]); o.y = pk2(s[2 * 33], s[3 * 33]); o.z = pk2(s[4 * 33], s[5 * 33]); o.w = pk2(s[6 * 33], s[7 * 33]);
        *(GAS u32x4*)(WT + (size_t)(drow + n) * Kd + k0 + 8 * c) = o; }
    LDS_WAIT(); asm volatile("" ::: "memory");
}
__device__ __forceinline__ void p0_transpose_item8(const float* W, int N, float scale, unsigned char* WT, int Kd, int k0, int n0, int drow, int lane) {
    const int g = lane >> 3, q = lane & 7;
    const GAS f32x4* src = (const GAS f32x4*)(W + (size_t)(k0 + 16 * g) * N + n0 + 4 * q);
    f32x4 v[16];
#pragma unroll
    for (int i = 0; i < 16; ++i) v[i] = src[(size_t)i * (N / 4)] * scale;
#pragma unroll
    for (int j = 0; j < 4; ++j) {
        u32x4 o; o.x = pk4_fp8(v[0][j], v[1][j], v[2][j], v[3][j]); o.y = pk4_fp8(v[4][j], v[5][j], v[6][j], v[7][j]);
        o.z = pk4_fp8(v[8][j], v[9][j], v[10][j], v[11][j]); o.w = pk4_fp8(v[12][j], v[13][j], v[14][j], v[15][j]);
        *(GAS u32x4*)(WT + (size_t)(drow + 4 * q + j) * Kd + k0 + 16 * g) = o; }
}
__device__ __forceinline__ void rms_row_to_bf16(const float* xrow, const float* g, bf16* orow, int lane) {
    const GAS f32x4* xr = (const GAS f32x4*)xrow + lane; const GAS f32x4* gr = (const GAS f32x4*)g + lane;
    f32x4 v[4]; float s = 0.f;
#pragma unroll
    for (int j = 0; j < 4; ++j) { v[j] = xr[64 * j]; s += (v[j].x * v[j].x + v[j].y * v[j].y) + (v[j].z * v[j].z + v[j].w * v[j].w); }
    const float rstd = 1.f / sqrtf(wave_sum(s) * (1.f / D) + NORM_EPS);
    GAS unsigned long long* o8 = (GAS unsigned long long*)orow + lane;
#pragma unroll
    for (int j = 0; j < 4; ++j) { const f32x4 gg = gr[64 * j];
        o8[64 * j] = (unsigned long long)pk2(v[j].x * rstd * gg.x, v[j].y * rstd * gg.y) | ((unsigned long long)pk2(v[j].z * rstd * gg.z, v[j].w * rstd * gg.w) << 32); }
}
enum { I_X = 0, I_MEM, I_N1G, I_WIN, I_MU, I_W0, I_W2, I_A0, I_A2, I_G2, I_KK, I_KA, I_RK, I_LNG, I_LNB, I_LQ1, I_LK1, I_LQ2, I_LK2, I_SUBG, I_WOUT, I_N2G, I_MNG, I_WQ, I_WKV, I_WO, I_N3G,
       I_RW, I_RB, I_W1, I_B1, I_W2E, I_B2, I_FG };

__device__ __forceinline__ void p0_prologue(Frame& F) {
    LAS float* scr = (LAS float*)(F.lds + F.wave * 16384);
    const int gw = F.bid * NWAVES + F.wave, NGW = F.G * NWAVES;
    constexpr int I_IN = 16 * (IN_COLS / 32), I_SQ = 16 * 32, I_KV = 16 * 64, I_L64 = 1 * 16, I_L128 = 2 * 16, I_E1 = 16 * 64, I_E2 = 16 * 32;
    constexpr int NITEMS = I_IN + 3 * I_SQ + I_KV + 2 * I_L64 + I_L128;
    for (int it = gw; it < NITEMS; it += NGW) {
        int r = it;
        if (r < I_IN) { const int nb = IN_COLS / 32; p0_transpose_item(F.in[I_WIN], IN_COLS, nullptr, (bf16*)(F.ws + WS_WINT), D, 64 * (r / nb), 32 * (r % nb), 32 * (r % nb), scr, F.lane); continue; } r -= I_IN;
        if (r < I_SQ) { p0_transpose_item(F.in[I_WOUT], D, nullptr, (bf16*)(F.ws + WS_WOUTT), D, 64 * (r / 32), 32 * (r % 32), 32 * (r % 32), scr, F.lane); continue; } r -= I_SQ;
        if (r < I_SQ) { p0_transpose_item(F.in[I_WQ], D, F.in[I_N2G], (bf16*)(F.ws + WS_WQT), D, 64 * (r / 32), 32 * (r % 32), 32 * (r % 32), scr, F.lane); continue; } r -= I_SQ;
        if (r < I_SQ) { p0_transpose_item(F.in[I_WO], D, nullptr, (bf16*)(F.ws + WS_WOT), D, 64 * (r / 32), 32 * (r % 32), 32 * (r % 32), scr, F.lane); continue; } r -= I_SQ;
        if (r < I_KV) { p0_transpose_item(F.in[I_WKV], 2 * D, nullptr, (bf16*)(F.ws + WS_WKVT), D, 64 * (r / 64), 32 * (r % 64), 32 * (r % 64), scr, F.lane); continue; } r -= I_KV;
        if (r < I_L64) { p0_transpose_item(F.in[I_W2], RW, nullptr, (bf16*)(F.ws + WS_W2LT), 64, 0, 32 * r, 32 * r, scr, F.lane); continue; } r -= I_L64;
        if (r < I_L64) { p0_transpose_item(F.in[I_A2], RW, nullptr, (bf16*)(F.ws + WS_A2LT), 64, 0, 32 * r, 32 * r, scr, F.lane); continue; } r -= I_L64;
        p0_transpose_item(F.in[I_G2], RW, nullptr, (bf16*)(F.ws + WS_G2LT), 128, 64 * (r / 16), 32 * (r % 16), 32 * (r % 16), scr, F.lane);
    }
    for (int m = gw; m < M; m += NGW) rms_row_to_bf16(F.in[I_X] + (size_t)m * D, F.in[I_N1G], (bf16*)(F.ws + WS_XN) + (size_t)m * D, F.lane);
    for (int m = gw; m < BATCH * MEM; m += NGW) rms_row_to_bf16(F.in[I_MEM] + (size_t)m * D, F.in[I_MNG], (bf16*)(F.ws + WS_MEMN) + (size_t)m * D, F.lane);
    { float* rwt = (float*)(F.ws + WS_RWT); const int gt = F.bid * NTHR + F.tid;
      for (int i = gt; i < NE * D; i += F.G * NTHR) { const int e = i / D, k = i % D; rwt[i] = F.in[I_RW][k * NE + e] * F.in[I_N3G][k]; } }
}

__device__ __forceinline__ void p0_experts(Frame& F, int wg0) {
    constexpr int I_E1 = 8 * 64, I_E2 = 8 * 32;
    const int gw = (F.bid - wg0) * NWAVES + F.wave, NGW = (F.G - wg0) * NWAVES;
    for (int it = gw; it < NE * (I_E1 + I_E2); it += NGW) {
        const int e = it / (I_E1 + I_E2); int r = it - e * (I_E1 + I_E2);
        if (r < I_E1) {
            const int n0 = 32 * (r % 64), k0 = 128 * (r / 64); const int nn = n0 < FF ? n0 : n0 - FF; const int drow = 256 * (nn / 128) + (n0 < FF ? 0 : 128) + (nn % 128);
            p0_transpose_item8(F.in[I_W1] + (size_t)e * D * 2 * FF, 2 * FF, F8_SW, F.ws + WS_W1T + (size_t)e * 2 * FF * D, D, k0, n0, drow, F.lane);
        } else { r -= I_E1;
            p0_transpose_item8(F.in[I_W2E] + (size_t)e * FF * D, D, F8_SW, F.ws + WS_W2T + (size_t)e * D * FF, FF, 128 * (r / 32), 32 * (r % 32), 32 * (r % 32), F.lane);
        }
    }
}
template <int NMAP, int DQK, int DVV, int NBUF, int PF>
struct AttnBody {
    static constexpr int KROW = DQK * 2, VROW = 128, KCH = DQK / 8;
    static constexpr int KT_BYTES = NMAP * 64 * KROW, VT_BYTES = DVV * VROW, BUF_BYTES = KT_BYTES + VT_BYTES;
    static constexpr int NPK = KT_BYTES / (16 * NTHR), NPV = VT_BYTES / (16 * NTHR), NDMA = NPK + NPV;
    static constexpr int NKS = DQK / 32, NDT = DVV / 16, KB = NKS < 4 ? NKS : 4;
    static_assert(NBUF * BUF_BYTES <= RING_BYTES + 24576, "attention ring exceeds LDS");
    static_assert(NDMA * (NBUF - 1) <= 48 && NBUF >= 2, "vmcnt range; a ring needs two slots");

    __device__ __forceinline__ void dma_tile(LAS unsigned char* slot, const bf16* Kp, int ldk, const bf16* VTp, int ldvt, int key0, int tid, int wave) const {
        asm volatile("" : "+v"(tid));
#pragma unroll
        for (int i = 0; i < NPK; ++i) { const int p = tid + NTHR * i, row = p / KCH, sl = p % KCH, ch = sl ^ ksw(row), mp = row >> 6, key = row & 63;
            __builtin_amdgcn_global_load_lds((const unsigned*)(Kp + (unsigned)((key0 + key) * ldk + mp * DQK + ch * 8)), (LAS unsigned*)(slot + (i * NTHR + wave * 64) * 16), 16, 0, 0); }
#pragma unroll
        for (int i = 0; i < NPV; ++i) { const int p = tid + NTHR * i, dv = p >> 3, sl = p & 7, ch = sl ^ vsw(dv);
            __builtin_amdgcn_global_load_lds((const unsigned*)(VTp + (unsigned)(dv * ldvt + key0 + ch * 8)), (LAS unsigned*)(slot + KT_BYTES + (i * NTHR + wave * 64) * 16), 16, 0, 0); }
    }
    __device__ __forceinline__ static int ksw(int row) { return KCH == 8 ? ((row & 3) | (((row >> 3) & 1) << 2)) : (((row & 1) * 3) | (((row >> 1) & 1) << 2) | (((row >> 3) & 1) << 3)); }
    __device__ __forceinline__ static int vsw(int dv) { return dv & 7; }
    __device__ __forceinline__ static int vt_off(int dv, int ch) { return KT_BYTES + dv * VROW + ((ch ^ vsw(dv)) << 4); }
    __device__ __forceinline__ static int k_off(int row, int ch) { return row * KROW + ((ch ^ ksw(row)) << 4); }
    __device__ __forceinline__ static int sigma(int t4, int m) { return 32 * (t4 >> 1) + 8 * (m >> 2) + 4 * (t4 & 1) + (m & 3); }
    static constexpr int NKB = NKS < 4 ? NKS : 4;
    struct Offs { int kb[NKB]; int vb[2]; };
    __device__ __forceinline__ static Offs make_offs(int lq, int g) { Offs o; const int r0 = 8 * (lq >> 2) + (lq & 3);
#pragma unroll
        for (int j = 0; j < NKB; ++j) o.kb[j] = k_off(r0, 4 * j + g);
        o.vb[0] = vt_off(lq, g); o.vb[1] = vt_off(lq, 4 + g); return o; }

    __device__ __forceinline__ void pv_tile(const LAS unsigned char* buf, bf16x8 (&vf)[PF], const bf16x8 (&pf)[NMAP][2], f32x4 (&o)[NMAP][NDT], const Offs& of) {
#pragma unroll
        for (int f0 = 0; f0 < 2 * NDT; f0 += PF) {
            bf16x8 vn[PF];
            if (f0 + PF < 2 * NDT) {
#pragma unroll
                for (int f = 0; f < PF; ++f) { const int dt = (f0 + PF + f) >> 1, mb = (f0 + PF + f) & 1; vn[f] = *(const LAS bf16x8*)(buf + of.vb[mb] + dt * 16 * VROW); }
            }
#pragma unroll
            for (int f = 0; f < PF; ++f) { const int dt = (f0 + f) >> 1, mb = (f0 + f) & 1;
#pragma unroll
                for (int c = 0; c < NMAP; ++c) o[c][dt] = __builtin_amdgcn_mfma_f32_16x16x32_bf16(vf[f], pf[c][mb], o[c][dt], 0, 0, 0); }
            if (f0 + PF < 2 * NDT) {
#pragma unroll
                for (int f = 0; f < PF; ++f) vf[f] = vn[f];
            }
        }
    }
    __device__ __forceinline__ void vf_first(const LAS unsigned char* buf, bf16x8 (&vf)[PF], const Offs& of) {
#pragma unroll
        for (int f = 0; f < PF; ++f) { const int dt = f >> 1, mb = f & 1; vf[f] = *(const LAS bf16x8*)(buf + of.vb[mb] + dt * 16 * VROW); }
    }
    __device__ __forceinline__ void s_tile(const LAS unsigned char* buf, const bf16x8 (&qf)[NMAP][NKS], float (&mrun)[NMAP], f32x4 (&ol)[NMAP], f32x4 (&o)[NMAP][NDT], bf16x8 (&pf)[NMAP][2], const Offs& of, bool first) {
        constexpr float THR = 8.0f;
        f32x4 s[NMAP][4];
#pragma unroll
        for (int c = 0; c < NMAP; ++c) { const float mi = first ? 0.f : -mrun[c];
#pragma unroll
            for (int t4 = 0; t4 < 4; ++t4) { s[c][t4] = (f32x4){mi, mi, mi, mi};
#pragma unroll
                for (int k0 = 0; k0 < NKS; k0 += KB) { bf16x8 kf[KB];
#pragma unroll
                    for (int ks = 0; ks < KB; ++ks) kf[ks] = *(const LAS bf16x8*)(buf + of.kb[(k0 + ks) & (NKB - 1)] + ((c * 64 + 32 * (t4 >> 1) + 4 * (t4 & 1)) * KROW + ((k0 + ks) / NKB) * NKB * 64));
#pragma unroll
                    for (int ks = 0; ks < KB; ++ks) s[c][t4] = __builtin_amdgcn_mfma_f32_16x16x32_bf16(kf[ks], qf[c][k0 + ks], s[c][t4], 0, 0, 0); } } }
#pragma unroll
        for (int c = 0; c < NMAP; ++c) {
            float mx = __builtin_fmaxf(__builtin_fmaxf(s[c][0][0], s[c][0][1]), s[c][0][2]);
#pragma unroll
            for (int t4 = 0; t4 < 4; ++t4) { if (t4 > 0) mx = __builtin_fmaxf(__builtin_fmaxf(mx, s[c][t4][0]), s[c][t4][1]); mx = __builtin_fmaxf(__builtin_fmaxf(mx, s[c][t4][2]), s[c][t4][3]); }
            { const auto r1 = __builtin_amdgcn_permlane16_swap(__float_as_uint(mx), __float_as_uint(mx), false, false); mx = fmaxf(__uint_as_float(r1[0]), __uint_as_float(r1[1]));
              const auto r2 = __builtin_amdgcn_permlane32_swap(__float_as_uint(mx), __float_as_uint(mx), false, false); mx = fmaxf(__uint_as_float(r2[0]), __uint_as_float(r2[1])); }
            if (first) {
                mrun[c] = mx;
#pragma unroll
                for (int t4 = 0; t4 < 4; ++t4) s[c][t4] = s[c][t4] - mx;
            } else if (__any(mx > THR)) {
                const float d = mx > THR ? mx : 0.f, alpha = fexp2(-d); mrun[c] += d; ol[c] = ol[c] * alpha;
#pragma unroll
                for (int dt = 0; dt < NDT; ++dt) o[c][dt] = o[c][dt] * alpha;
#pragma unroll
                for (int t4 = 0; t4 < 4; ++t4) s[c][t4] = s[c][t4] - d;
            }
#pragma unroll
            for (int t4 = 0; t4 < 4; ++t4)
#pragma unroll
                for (int i = 0; i < 4; ++i) s[c][t4][i] = fexp2(s[c][t4][i]);
#pragma unroll
            for (int mb = 0; mb < 2; ++mb) { u32x4 w; w.x = cvt_pk_bf16(s[c][2 * mb][0], s[c][2 * mb][1]); w.y = cvt_pk_bf16(s[c][2 * mb][2], s[c][2 * mb][3]);
                w.z = cvt_pk_bf16(s[c][2 * mb + 1][0], s[c][2 * mb + 1][1]); w.w = cvt_pk_bf16(s[c][2 * mb + 1][2], s[c][2 * mb + 1][3]); pf[c][mb] = __builtin_bit_cast(bf16x8, w); }
            const bf16x8 ones = (bf16x8){0x3F80, 0x3F80, 0x3F80, 0x3F80, 0x3F80, 0x3F80, 0x3F80, 0x3F80};
            ol[c] = __builtin_amdgcn_mfma_f32_16x16x32_bf16(ones, pf[c][0], ol[c], 0, 0, 0); ol[c] = __builtin_amdgcn_mfma_f32_16x16x32_bf16(ones, pf[c][1], ol[c], 0, 0, 0);
        }
    }

    __device__ __forceinline__ void run(LAS unsigned char* lds, const bf16* Qp, int ldq, float qscale, const bf16* Kp, int ldk, const bf16* VTp, int ldvt, int nkt, int nkt_w, bool late,
                                        f32x4 (&o)[NMAP][NDT], float (&lsum)[NMAP], int tid, int lane) {
        const int g = lane >> 4, lq = lane & 15;
        bf16x8 qf[NMAP][NKS];
#pragma unroll
        for (int c = 0; c < NMAP; ++c)
#pragma unroll
            for (int ks = 0; ks < NKS; ++ks) { const u32x4 raw = *(const GAS u32x4*)(Qp + (size_t)lq * ldq + c * DQK + ks * 32 + g * 8);
                u32x4 w = raw;
                if (qscale != 1.0f) { w.x = cvt_pk_bf16(bflo(raw.x) * qscale, bfhi(raw.x) * qscale); w.y = cvt_pk_bf16(bflo(raw.y) * qscale, bfhi(raw.y) * qscale);
                                      w.z = cvt_pk_bf16(bflo(raw.z) * qscale, bfhi(raw.z) * qscale); w.w = cvt_pk_bf16(bflo(raw.w) * qscale, bfhi(raw.w) * qscale); }
                qf[c][ks] = __builtin_bit_cast(bf16x8, w); }
        float mrun[NMAP]; f32x4 ol[NMAP];
#pragma unroll
        for (int c = 0; c < NMAP; ++c) { mrun[c] = -INFINITY; ol[c] = (f32x4){0.f, 0.f, 0.f, 0.f};
#pragma unroll
            for (int dt = 0; dt < NDT; ++dt) o[c][dt] = (f32x4){0.f, 0.f, 0.f, 0.f}; }
        bf16x8 pfp[NMAP][2];
#pragma unroll
        for (int c = 0; c < NMAP; ++c) { pfp[c][0] = (bf16x8){0, 0, 0, 0, 0, 0, 0, 0}; pfp[c][1] = pfp[c][0]; }

        const int wave = __builtin_amdgcn_readfirstlane(tid >> 6);
        const Offs of = make_offs(lq, g);
#pragma unroll
        for (int j = 0; j < NBUF - 1; ++j) if (j < nkt) dma_tile(lds + j * BUF_BYTES, Kp, ldk, VTp, ldvt, j * 64, tid, wave);
        int bi = 0;
        for (int kt = 0; kt < nkt; ++kt) {
            LAS unsigned char* buf = lds + bi * BUF_BYTES;
            { const int ahead = (nkt - 1 - kt) < (NBUF - 2) ? (nkt - 1 - kt) : (NBUF - 2);
              if (ahead >= 1 && NBUF > 2) asm volatile("s_waitcnt vmcnt(%0)" :: "n"(NDMA) : "memory"); else asm volatile("s_waitcnt vmcnt(0)" ::: "memory"); }
            __builtin_amdgcn_s_barrier(); asm volatile("" ::: "memory");
            if (kt < nkt_w) { bf16x8 vf[PF]; s_tile(buf, qf, mrun, ol, o, pfp, of, kt == 0); vf_first(buf, vf, of);
                { const int kn = kt + NBUF - 1; if (kn < nkt) { const int bn = (bi == 0) ? NBUF - 1 : bi - 1; dma_tile(lds + bn * BUF_BYTES, Kp, ldk, VTp, ldvt, kn * 64, tid, wave); } }
                pv_tile(buf, vf, pfp, o, of); }
            else { const int kn = kt + NBUF - 1; if (kn < nkt) { const int bn = (bi == 0) ? NBUF - 1 : bi - 1; dma_tile(lds + bn * BUF_BYTES, Kp, ldk, VTp, ldvt, kn * 64, tid, wave); } }
            bi = (bi + 1 == NBUF) ? 0 : bi + 1;
        }
        asm volatile("s_waitcnt lgkmcnt(0)" ::: "memory"); __builtin_amdgcn_s_barrier(); asm volatile("" ::: "memory");
#pragma unroll
        for (int c = 0; c < NMAP; ++c) lsum[c] = ol[c][0];
    }
};
typedef float f32x16 __attribute__((ext_vector_type(16)));
struct DiffBody32 {
    static constexpr int KT_BYTES = 2 * 64 * 128, VT_BYTES = 128 * 128, BUF_BYTES = KT_BYTES + VT_BYTES, NBUF = 3, NDMA = 4;
    __device__ __forceinline__ static int swz(int row) { return (row >> 1) & 7; }
    __device__ __forceinline__ static int sigma(int rho) { return 16 * (rho >> 4) + 8 * ((rho >> 2) & 1) + 4 * ((rho >> 3) & 1) + (rho & 3); }
    __device__ __forceinline__ void dma_tile(LAS unsigned char* slot, const bf16* Kp, int ldk, const bf16* VTp, int ldvt, int key0, int tid, int wave) const {
        asm volatile("" : "+v"(tid));
#pragma unroll
        for (int i = 0; i < 2; ++i) { const int p = tid + NTHR * i, row = p >> 3, sl = p & 7, ch = sl ^ swz(row), mp = row >> 6, key = row & 63;
            __builtin_amdgcn_global_load_lds((const unsigned*)(Kp + (unsigned)((key0 + key) * ldk + mp * 64 + ch * 8)), (LAS unsigned*)(slot + (i * NTHR + wave * 64) * 16), 16, 0, 0); }
#pragma unroll
        for (int i = 0; i < 2; ++i) { const int p = tid + NTHR * i, dv = p >> 3, sl = p & 7, ch = sl ^ swz(dv);
            __builtin_amdgcn_global_load_lds((const unsigned*)(VTp + (unsigned)(dv * ldvt + key0 + ch * 8)), (LAS unsigned*)(slot + KT_BYTES + (i * NTHR + wave * 64) * 16), 16, 0, 0); }
    }
    __device__ __forceinline__ void run(LAS unsigned char* lds, const bf16* Qp  , int ldq, float qscale, const bf16* Kp, int ldk, const bf16* VTp, int ldvt,
                                        int nkt, int nkt_w, int c, f32x16 (&o)[4], float& lsum, int tid, int lane) {
        const int r = lane & 31, h = lane >> 5, wave = __builtin_amdgcn_readfirstlane(tid >> 6);
        bf16x8 qf[4];
#pragma unroll
        for (int ks = 0; ks < 4; ++ks) { const u32x4 raw = *(const GAS u32x4*)(Qp + (size_t)r * ldq + ks * 16 + h * 8); u32x4 w;
            w.x = cvt_pk_bf16(bflo(raw.x) * qscale, bfhi(raw.x) * qscale); w.y = cvt_pk_bf16(bflo(raw.y) * qscale, bfhi(raw.y) * qscale);
            w.z = cvt_pk_bf16(bflo(raw.z) * qscale, bfhi(raw.z) * qscale); w.w = cvt_pk_bf16(bflo(raw.w) * qscale, bfhi(raw.w) * qscale); qf[ks] = __builtin_bit_cast(bf16x8, w); }
        int kof[4], vof[4];
        { const int kr = sigma(r);
#pragma unroll
          for (int ks = 0; ks < 4; ++ks) kof[ks] = kr * 128 + (((2 * ks + h) ^ swz(kr)) << 4);
#pragma unroll
          for (int f = 0; f < 4; ++f) vof[f] = KT_BYTES + r * 128 + (((2 * f + h) ^ swz(r)) << 4); }
        float mrun = -INFINITY, ls = 0.f;
#pragma unroll
        for (int db = 0; db < 4; ++db)
#pragma unroll
            for (int i = 0; i < 16; ++i) o[db][i] = 0.f;
#pragma unroll
        for (int j = 0; j < NBUF - 1; ++j) if (j < nkt) dma_tile(lds + j * BUF_BYTES, Kp, ldk, VTp, ldvt, j * 64, tid, wave);
        int bi = 0;
        for (int kt = 0; kt < nkt; ++kt) {
            const LAS unsigned char* buf = lds + bi * BUF_BYTES;
            { const int ahead = (nkt - 1 - kt) < 1 ? (nkt - 1 - kt) : 1;
              if (ahead >= 1) asm volatile("s_waitcnt vmcnt(%0)" :: "n"(NDMA) : "memory"); else asm volatile("s_waitcnt vmcnt(0)" ::: "memory"); }
            __builtin_amdgcn_s_barrier(); asm volatile("" ::: "memory");
            const int kn = kt + NBUF - 1; const int bn = (bi == 0) ? NBUF - 1 : bi - 1;
            if (kt < nkt_w) {
                constexpr float THR = 8.0f; const bool first = (kt == 0);
                f32x16 s[2];
                { const float mi = first ? 0.f : -mrun;
#pragma unroll
                  for (int kb = 0; kb < 2; ++kb) {
#pragma unroll
                      for (int i = 0; i < 16; ++i) s[kb][i] = mi;
                      bf16x8 kf[4];
#pragma unroll
                      for (int ks = 0; ks < 4; ++ks) kf[ks] = *(const LAS bf16x8*)(buf + kof[ks] + (c * 64 + 32 * kb) * 128);
#pragma unroll
                      for (int ks = 0; ks < 4; ++ks) s[kb] = __builtin_amdgcn_mfma_f32_32x32x16_bf16(kf[ks], qf[ks], s[kb], 0, 0, 0); } }
                float mx = __builtin_fmaxf(__builtin_fmaxf(s[0][0], s[0][1]), s[0][2]);
#pragma unroll
                for (int kb = 0; kb < 2; ++kb)
#pragma unroll
                    for (int i = (kb == 0 ? 3 : 0); i + 1 < 16; i += 2) mx = __builtin_fmaxf(__builtin_fmaxf(mx, s[kb][i]), s[kb][i + 1]);
                mx = fmaxf(mx, s[0][15]); mx = fmaxf(mx, s[1][15] > s[1][14] ? s[1][15] : s[1][14]);
                { const auto r2 = __builtin_amdgcn_permlane32_swap(__float_as_uint(mx), __float_as_uint(mx), false, false); mx = fmaxf(__uint_as_float(r2[0]), __uint_as_float(r2[1])); }
                if (first) { mrun = mx; s[0] = s[0] - mx; s[1] = s[1] - mx; }
                else if (__any(mx > THR)) { const float d = mx > THR ? mx : 0.f, alpha = fexp2(-d); mrun += d; ls *= alpha;
#pragma unroll
                    for (int db = 0; db < 4; ++db) o[db] = o[db] * alpha;
                    s[0] = s[0] - d; s[1] = s[1] - d; }
                float ps = 0.f;
#pragma unroll
                for (int kb = 0; kb < 2; ++kb)
#pragma unroll
                    for (int i = 0; i < 16; ++i) { s[kb][i] = fexp2(s[kb][i]); ps += s[kb][i]; }
                ls += ps;
                bf16x8 pf[4];
#pragma unroll
                for (int f = 0; f < 4; ++f) { const int kb = f >> 1, s8 = 8 * (f & 1); u32x4 w;
                    w.x = cvt_pk_bf16(s[kb][s8 + 0], s[kb][s8 + 1]); w.y = cvt_pk_bf16(s[kb][s8 + 2], s[kb][s8 + 3]); w.z = cvt_pk_bf16(s[kb][s8 + 4], s[kb][s8 + 5]); w.w = cvt_pk_bf16(s[kb][s8 + 6], s[kb][s8 + 7]);
                    pf[f] = __builtin_bit_cast(bf16x8, w); }
                bf16x8 vf[4][4];
#pragma unroll
                for (int f = 0; f < 4; ++f) vf[0][f] = *(const LAS bf16x8*)(buf + vof[f]);
                if (kn < nkt) dma_tile(lds + bn * BUF_BYTES, Kp, ldk, VTp, ldvt, kn * 64, tid, wave);
#pragma unroll
                for (int db = 0; db < 4; ++db) {
                    if (db + 1 < 4) {
#pragma unroll
                        for (int f = 0; f < 4; ++f) vf[db + 1][f] = *(const LAS bf16x8*)(buf + vof[f] + (db + 1) * 32 * 128);
                    }
#pragma unroll
                    for (int f = 0; f < 4; ++f) o[db] = __builtin_amdgcn_mfma_f32_32x32x16_bf16(vf[db][f], pf[f], o[db], 0, 0, 0); }
            } else if (kn < nkt) dma_tile(lds + bn * BUF_BYTES, Kp, ldk, VTp, ldvt, kn * 64, tid, wave);
            bi = (bi + 1 == NBUF) ? 0 : bi + 1;
        }
        asm volatile("s_waitcnt lgkmcnt(0)" ::: "memory"); __builtin_amdgcn_s_barrier(); asm volatile("" ::: "memory");
        { const auto r2 = __builtin_amdgcn_permlane32_swap(__float_as_uint(ls), __float_as_uint(ls), false, false); lsum = __uint_as_float(r2[0]) + __uint_as_float(r2[1]); }
    }
};
constexpr int ATTN_MAXU = 2;
__constant__ unsigned short attn_tab[256][ATTN_MAXU] = {
{34,17},
{98,81},
{162,145},
{226,209},
{290,273},
{354,337},
{418,401},
{482,465},
{33,19},
{97,83},
{161,147},
{225,211},
{289,275},
{353,339},
{417,403},
{481,467},
{31,20},
{95,84},
{159,148},
{223,212},
{287,276},
{351,340},
{415,404},
{479,468},
{50,1},
{114,65},
{178,129},
{242,193},
{306,257},
{370,321},
{434,385},
{498,449},
{52,0},
{116,64},
{180,128},
{244,192},
{308,256},
{372,320},
{436,384},
{500,448},
{36,15},
{100,79},
{164,143},
{228,207},
{292,271},
{356,335},
{420,399},
{484,463},
{49,2},
{113,66},
{177,130},
{241,194},
{305,258},
{369,322},
{433,386},
{497,450},
{47,5},
{111,69},
{175,133},
{239,197},
{303,261},
{367,325},
{431,389},
{495,453},
{39,28},
{103,92},
{167,156},
{231,220},
{295,284},
{359,348},
{423,412},
{487,476},
{57,10},
{121,74},
{185,138},
{249,202},
{313,266},
{377,330},
{441,394},
{505,458},
{45,22},
{109,86},
{173,150},
{237,214},
{301,278},
{365,342},
{429,406},
{493,470},
{40,27},
{104,91},
{168,155},
{232,219},
{296,283},
{360,347},
{424,411},
{488,475},
{54,13},
{118,77},
{182,141},
{246,205},
{310,269},
{374,333},
{438,397},
{502,461},
{44,23},
{108,87},
{172,151},
{236,215},
{300,279},
{364,343},
{428,407},
{492,471},
{35,32},
{99,96},
{163,160},
{227,224},
{291,288},
{355,352},
{419,416},
{483,480},
{58,9},
{122,73},
{186,137},
{250,201},
{314,265},
{378,329},
{442,393},
{506,457},
{37,30},
{101,94},
{165,158},
{229,222},
{293,286},
{357,350},
{421,414},
{485,478},
{59,8},
{123,72},
{187,136},
{251,200},
{315,264},
{379,328},
{443,392},
{507,456},
{55,12},
{119,76},
{183,140},
{247,204},
{311,268},
{375,332},
{439,396},
{503,460},
{53,14},
{117,78},
{181,142},
{245,206},
{309,270},
{373,334},
{437,398},
{501,462},
{43,24},
{107,88},
{171,152},
{235,216},
{299,280},
{363,344},
{427,408},
{491,472},
{61,6},
{125,70},
{189,134},
{253,198},
{317,262},
{381,326},
{445,390},
{509,454},
{38,29},
{102,93},
{166,157},
{230,221},
{294,285},
{358,349},
{422,413},
{486,477},
{60,7},
{124,71},
{188,135},
{252,199},
{316,263},
{380,327},
{444,391},
{508,455},
{62,4},
{126,68},
{190,132},
{254,196},
{318,260},
{382,324},
{446,388},
{510,452},
{56,11},
{120,75},
{184,139},
{248,203},
{312,267},
{376,331},
{440,395},
{504,459},
{48,18},
{112,82},
{176,146},
{240,210},
{304,274},
{368,338},
{432,402},
{496,466},
{41,26},
{105,90},
{169,154},
{233,218},
{297,282},
{361,346},
{425,410},
{489,474},
{42,25},
{106,89},
{170,153},
{234,217},
{298,281},
{362,345},
{426,409},
{490,473},
{51,16},
{115,80},
{179,144},
{243,208},
{307,272},
{371,336},
{435,400},
{499,464},
{63,3},
{127,67},
{191,131},
{255,195},
{319,259},
{383,323},
{447,387},
{511,451},
{46,21},
{110,85},
{174,149},
{238,213},
{302,277},
{366,341},
{430,405},
{494,469}};
namespace rk {
constexpr int MS = 144;
constexpr int MB = 64 * MS;
constexpr int O_AB = 0 * MB, O_BB = 1 * MB, O_KB = 2 * MB, O_RB = 3 * MB, O_ABT = 4 * MB, O_VTT = 5 * MB, O_BTT = 6 * MB, O_KTT = 7 * MB, O_AAK = 8 * MB, O_ARB = 9 * MB, O_ARK = 10 * MB;
constexpr int O_TM = O_KB, O_GT = O_AB, O_WTT = O_BB, O_UTT = O_AAK;
constexpr int FS = 66;
constexpr int O_LF = 11 * MB, O_TF = 0;
constexpr int O_LA = O_LF + 64 * FS * 4;
static_assert(O_LA + MB <= RING_BYTES && 64 * FS * 4 <= 2 * MB, "rwkv LDS map");
constexpr int O_LW = X_OFF, O_LG = X_OFF + MB, LGS = 272, O_NRM = O_LG + 64 * LGS, O_BSP = O_NRM + 512, O_C63 = O_BSP + 512;
static_assert(O_C63 + 1024 <= MISC_OFF, "rwkv LDS extras");

template <int NKS>
__device__ __forceinline__ f32x4 mm_tile(const LAS unsigned char* A, int astr, int tr, const LAS unsigned char* B, int bstr, int tc, f32x4 acc, int lq, int g) {
#pragma unroll
    for (int ks = 0; ks < NKS; ++ks) {
        const bf16x8 a = *(const LAS bf16x8*)(A + (16 * tr + lq) * astr + (32 * ks + 8 * g) * 2);
        const bf16x8 b = *(const LAS bf16x8*)(B + (16 * tc + lq) * bstr + (32 * ks + 8 * g) * 2);
        acc = __builtin_amdgcn_mfma_f32_16x16x32_bf16(a, b, acc, 0, 0, 0); }
    return acc;
}
template <int NKS>
__device__ __forceinline__ f32x4 mm_tile_gb(const LAS unsigned char* A, int astr, int tr, const bf16* Bg, int ldb, f32x4 acc, int lq, int g) {
#pragma unroll
    for (int ks = 0; ks < NKS; ++ks) {
        const bf16x8 a = *(const LAS bf16x8*)(A + (16 * tr + lq) * astr + (32 * ks + 8 * g) * 2);
        const bf16x8 b = *(const GAS bf16x8*)(Bg + (size_t)lq * ldb + 32 * ks + 8 * g);
        acc = __builtin_amdgcn_mfma_f32_16x16x32_bf16(a, b, acc, 0, 0, 0); }
    return acc;
}
__device__ __forceinline__ void st_nat(LAS unsigned char* Mx, int t0, int col, const f32x4& v) {
#pragma unroll
    for (int i = 0; i < 4; ++i) *(LAS bf16*)(Mx + (t0 + i) * MS + col * 2) = (bf16)f2bf(v[i]);
}
__device__ __forceinline__ void st_tr(LAS unsigned char* Mx, int t0, int col, const f32x4& v) {
    u32x2 w; w.x = cvt_pk_bf16(v[0], v[1]); w.y = cvt_pk_bf16(v[2], v[3]); *(LAS u32x2*)(Mx + col * MS + t0 * 2) = w;
}

__device__ __forceinline__ void tri_inverse(const LAS float* L, LAS float* Tm, int lane) {
    const int g = lane >> 4, lq = lane & 15;
    {
        float x[16];
#pragma unroll
        for (int r = 0; r < 16; ++r) { float a = (r == lq) ? 1.f : 0.f;
#pragma unroll
            for (int s = 0; s < r; ++s) a += L[(16 * g + r) * FS + 16 * g + s] * x[s];
            x[r] = a; }
#pragma unroll
        for (int r = 0; r < 16; ++r) Tm[(16 * g + r) * FS + 16 * g + lq] = x[r];
    }
#pragma unroll
    for (int d = 1; d < 4; ++d)
#pragma unroll
        for (int i = d; i < 4; ++i) { const int j = i - d;
            f32x4 X = (f32x4){0.f, 0.f, 0.f, 0.f};
#pragma unroll
            for (int m = j; m < i; ++m)
#pragma unroll
                for (int kq = 0; kq < 4; ++kq) X = __builtin_amdgcn_mfma_f32_16x16x4f32(L[(16 * i + lq) * FS + 16 * m + 4 * kq + g], Tm[(16 * m + 4 * kq + g) * FS + 16 * j + lq], X, 0, 0, 0);
            f32x4 R = (f32x4){0.f, 0.f, 0.f, 0.f};
#pragma unroll
            for (int kk = 0; kk < 4; ++kk) R = __builtin_amdgcn_mfma_f32_16x16x4f32(Tm[(16 * i + lq) * FS + 16 * i + 4 * g + kk], X[kk], R, 0, 0, 0);
#pragma unroll
            for (int q = 0; q < 4; ++q) Tm[(16 * i + 4 * g + q) * FS + 16 * j + lq] = R[q];
        }
}

__device__ __forceinline__ void tri_inverse_simple(const LAS float* L, LAS float* Tm, int lane) {
#pragma unroll 1
    for (int t = 0; t < 64; ++t) { float a = (t == lane) ? 1.f : 0.f;
#pragma unroll 1
        for (int s = 0; s < t; ++s) a += L[t * FS + s] * Tm[s * FS + lane];
        Tm[t * FS + lane] = a; }
}
__device__ __forceinline__ float mixf(unsigned short cur, unsigned short prev, float mu) { const float c = bf2f(cur), p = bf2f(prev); return c + (p - c) * mu; }

__device__ __forceinline__ void phase_a(Frame& F, int b, int c) {
    LAS unsigned char* lds = F.lds;
    const int tid = F.tid, lane = F.lane, w = F.wave, g = lane >> 4, lq = lane & 15;
    const bf16* PROJ = (const bf16*)(F.ws + WS_PROJ);
    const int n0 = b * T + c * CH;
    const bool first = (c == 0);
    const float* mu = F.in[I_MU]; bf16* GATEp = (bf16*)(F.ws + WS_GATE);
    {
        const int t = tid >> 3, c0 = (tid & 7) * 32; const unsigned oc = (unsigned)(n0 + t) * PCOLS + C_WD + c0; const bool hasp = !(first && t == 0); const unsigned op = hasp ? oc - PCOLS : oc; const float* mup = mu + C_WD + c0;
#pragma unroll
        for (int q = 0; q < 4; ++q) {
            const u32x4 cu = *(const GAS u32x4*)(PROJ + (oc + q * 8)); u32x4 pv = *(const GAS u32x4*)(PROJ + (op + q * 8)); if (!hasp) pv = (u32x4){0u, 0u, 0u, 0u};
            const f32x4 m0 = *(const GAS f32x4*)(mup + q * 8), m1 = *(const GAS f32x4*)(mup + q * 8 + 4);
            float o[8];
#pragma unroll
            for (int k = 0; k < 4; ++k) { const unsigned cw = cu[k], pw = pv[k];
                const float x0 = bflo(cw) + (bflo(pw) - bflo(cw)) * (k < 2 ? m0[2 * k] : m1[2 * k - 4]), x1 = bfhi(cw) + (bfhi(pw) - bfhi(cw)) * (k < 2 ? m0[2 * k + 1] : m1[2 * k - 3]);
                if (c0 < 64) { o[2 * k] = 1.f - 2.f * frcp(fexp(2.f * x0) + 1.f); o[2 * k + 1] = 1.f - 2.f * frcp(fexp(2.f * x1) + 1.f); }
                else if (c0 < 128) { o[2 * k] = x0; o[2 * k + 1] = x1; }
                else { o[2 * k] = sigmoidf_(x0); o[2 * k + 1] = sigmoidf_(x1); } }
            u32x4 wv; wv.x = cvt_pk_bf16(o[0], o[1]); wv.y = cvt_pk_bf16(o[2], o[3]); wv.z = cvt_pk_bf16(o[4], o[5]); wv.w = cvt_pk_bf16(o[6], o[7]);
            LAS unsigned char* dst = (c0 < 64) ? lds + O_LW + t * MS + (c0 + q * 8) * 2 : (c0 < 128) ? lds + O_LA + t * MS + (c0 - 64 + q * 8) * 2 : lds + O_LG + t * LGS + (c0 - 128 + q * 8) * 2;
            *(LAS u32x4*)dst = wv; }
    }
    __syncthreads();
    const int tr = w >> 1, tcb = 2 * (w & 1);
    LAS float* EF = (LAS float*)(lds + O_LF);
    LAS float* NRM = (LAS float*)(lds + O_NRM); LAS float* BSP = (LAS float*)(lds + O_BSP); LAS float* TT = (LAS float*)(lds + O_C63);
#pragma unroll 1
    for (int h = 0; h < RH; ++h) {
        const int item = (b * RH + h) * NCHUNK + c;
        float ev[2][4], av[2][4], rv[2][4], kv[2][4], vv[2][4], kkr[2][4];
        float nrm_p[4] = {0.f, 0.f, 0.f, 0.f};
#pragma unroll
        for (int x = 0; x < 2; ++x) { const int tc = tcb + x, hj = h * RN + 16 * tc + lq;
            f32x4 wl = (f32x4){0.f, 0.f, 0.f, 0.f}, al = wl, gl = wl;
            wl = mm_tile_gb<2>(lds + O_LW, MS, tr, (const bf16*)(F.ws + WS_W2LT) + (size_t)(h * RN + 16 * tc) * 64, 64, wl, lq, g);
            al = mm_tile_gb<2>(lds + O_LA, MS, tr, (const bf16*)(F.ws + WS_A2LT) + (size_t)(h * RN + 16 * tc) * 64, 64, al, lq, g);
            gl = mm_tile_gb<4>(lds + O_LG, LGS, tr, (const bf16*)(F.ws + WS_G2LT) + (size_t)(h * RN + 16 * tc) * 128, 128, gl, lq, g);
            const float w0 = F.in[I_W0][hj], a0 = F.in[I_A0][hj], kkw = F.in[I_KK][hj];
            const float mur = mu[C_R + hj], muk = mu[C_K + hj], muv = mu[C_V + hj];
#pragma unroll
            for (int i = 0; i < 4; ++i) { const int t = 16 * tr + 4 * g + i; const bool hasp = !(first && t == 0); const unsigned oc = (unsigned)(n0 + t) * PCOLS + hj, op = hasp ? oc - PCOLS : oc;
                const float xw = -(w0 + wl[i]); const float sp = xw > 20.f ? xw : __logf(1.f + fexp(xw)); ev[x][i] = fexp(-sp - 0.5f);
                av[x][i] = sigmoidf_(a0 + al[i]);
                GATEp[(unsigned)(n0 + t) * RW + hj] = (bf16)f2bf(gl[i]);
                const unsigned short rc = PROJ[oc + C_R], kc = PROJ[oc + C_K], vc = PROJ[oc + C_V]; unsigned short rp = PROJ[op + C_R], kp = PROJ[op + C_K], vp = PROJ[op + C_V];
                if (!hasp) { rp = 0; kp = 0; vp = 0; }
                rv[x][i] = mixf(rc, rp, mur); kv[x][i] = mixf(kc, kp, muk); vv[x][i] = mixf(vc, vp, muv);
                kkr[x][i] = kv[x][i] * kkw; nrm_p[i] += kkr[x][i] * kkr[x][i]; }
        }
#pragma unroll
        for (int i = 0; i < 4; ++i) { float q = nrm_p[i]; q += __shfl_xor(q, 1); q += __shfl_xor(q, 2); q += __shfl_xor(q, 4); q += __shfl_xor(q, 8); if (lq == 0) NRM[(16 * tr + 4 * g + i) * 2 + (w & 1)] = q; }
        float cs[2][4];
#pragma unroll
        for (int x = 0; x < 2; ++x) { cs[x][0] = ev[x][0]; cs[x][1] = cs[x][0] + ev[x][1]; cs[x][2] = cs[x][1] + ev[x][2]; cs[x][3] = cs[x][2] + ev[x][3];
            float a = cs[x][3]; const float b1 = __shfl(a, lane - 16); a += (g >= 1) ? b1 : 0.f; const float b2 = __shfl(a, lane - 32); a += (g >= 2) ? b2 : 0.f;
            const float ex = a - cs[x][3];
#pragma unroll
            for (int i = 0; i < 4; ++i) cs[x][i] += ex;
            if (g == 3) TT[tr * 64 + 16 * (tcb + x) + lq] = a; }
        __syncthreads();
        float bs_p[4] = {0.f, 0.f, 0.f, 0.f};
#pragma unroll
        for (int x = 0; x < 2; ++x) { const int tc = tcb + x, j = 16 * tc + lq, hj = h * RN + j; const float ka = F.in[I_KA][hj], rk = F.in[I_RK][hj];
            const float t0v = TT[j], t1v = TT[64 + j], t2v = TT[128 + j], t3v = TT[192 + j]; const float c63 = (t0v + t1v) + (t2v + t3v);
            const float cbase = (tr > 0 ? t0v : 0.f) + (tr > 1 ? t1v : 0.f) + (tr > 2 ? t2v : 0.f);
            if (tr == 3 && g == 3) ((float*)(F.ws + WS_GC))[(size_t)item * 64 + j] = fexp(-c63);
            f32x4 ab, bb, kb, rb, bt, kt, vx;
#pragma unroll
            for (int i = 0; i < 4; ++i) { const int t = 16 * tr + 4 * g + i; const float cin = cs[x][i] + cbase, cex = cin - ev[x][i];
                const float nr = NRM[t * 2] + NRM[t * 2 + 1]; const float kk = kkr[x][i] / fmaxf(sqrtf(nr), 1e-12f);
                DBGCNT(F, 2, !(nr > 1e-6f && nr < 1e6f)); DBGCNT(F, 3, !(fabsf(kk) <= 1.001f)); DBGCNT(F, 6, !(ev[x][i] > 0.f && ev[x][i] < 0.62f && av[x][i] > 0.f && av[x][i] < 1.f)); DBGCNT(F, 8, !(fabsf(rv[x][i]) < 100.f && fabsf(kv[x][i]) < 100.f && fabsf(vv[x][i]) < 100.f)); DBGCNT(F, 9, !(cin >= 0.f && cin < 40.f && c63 >= cin));
                const float a = av[x][i], k2 = kv[x][i] * (1.f + (a - 1.f) * ka);
                const float gin = fexp(-cin), ginv = fexp(cin), gex = fexp(-cex), grel = fexp(cin - c63);
                ab[i] = -kk * gex; bb[i] = kk * a * ginv; kb[i] = k2 * ginv; rb[i] = rv[x][i] * gin; bt[i] = kk * a * grel; kt[i] = k2 * grel; vx[i] = vv[x][i];
                bs_p[i] += rv[x][i] * k2 * rk; }
            const int t0 = 16 * tr + 4 * g;
            st_nat(lds + O_AB, t0, j, ab); st_nat(lds + O_BB, t0, j, bb); st_nat(lds + O_KB, t0, j, kb); st_nat(lds + O_RB, t0, j, rb);
            st_tr(lds + O_ABT, t0, j, ab); st_tr(lds + O_VTT, t0, j, vx); st_tr(lds + O_BTT, t0, j, bt); st_tr(lds + O_KTT, t0, j, kt);
        }
#pragma unroll
        for (int i = 0; i < 4; ++i) { float q = bs_p[i]; q += __shfl_xor(q, 1); q += __shfl_xor(q, 2); q += __shfl_xor(q, 4); q += __shfl_xor(q, 8); if (lq == 0) BSP[(16 * tr + 4 * g + i) * 2 + (w & 1)] = q; }
        __syncthreads();
        if (tid < 64) ((float*)(F.ws + WS_BS))[(size_t)(n0 + tid) * RH + h] = BSP[tid * 2] + BSP[tid * 2 + 1];
#pragma unroll
        for (int x = 0; x < 2; ++x) { const int tc = tcb + x; f32x4 l = (f32x4){0.f, 0.f, 0.f, 0.f}, ak = l, rbm = l, rkm = l;
            if (tc <= tr) {
                l = mm_tile<2>(lds + O_AB, MS, tr, lds + O_BB, MS, tc, l, lq, g); ak = mm_tile<2>(lds + O_AB, MS, tr, lds + O_KB, MS, tc, ak, lq, g);
                rbm = mm_tile<2>(lds + O_RB, MS, tr, lds + O_BB, MS, tc, rbm, lq, g); rkm = mm_tile<2>(lds + O_RB, MS, tr, lds + O_KB, MS, tc, rkm, lq, g);
                const int s = 16 * tc + lq;
#pragma unroll
                for (int i = 0; i < 4; ++i) { const int t = 16 * tr + 4 * g + i; if (s >= t) { l[i] = 0.f; ak[i] = 0.f; } if (s > t) { rbm[i] = 0.f; rkm[i] = 0.f; } }
            }
            const int t0 = 16 * tr + 4 * g, s = 16 * tc + lq;
#pragma unroll
            for (int i = 0; i < 4; ++i) { EF[(t0 + i) * FS + s] = l[i]; DBGCNT(F, 7, !(fabsf(l[i]) <= 1.01f)); DBGCNT(F, 10, !(fabsf(ak[i]) < 300.f && fabsf(rbm[i]) < 300.f && fabsf(rkm[i]) < 300.f)); }
            st_nat(lds + O_AAK, t0, s, ak); st_nat(lds + O_ARB, t0, s, rbm); st_nat(lds + O_ARK, t0, s, rkm);
        }
        __syncthreads();
#ifdef DBG_SIMPLE_TRI
        if (w == 0) tri_inverse_simple(EF, (LAS float*)(lds + O_TF), lane);
#else
        if (w == 0) tri_inverse(EF, (LAS float*)(lds + O_TF), lane);
#endif
        __syncthreads();
        { const int t = tid >> 3, s0 = (tid & 7) * 8; const LAS float* tp = (const LAS float*)(lds + O_TF) + t * FS + s0; float o[8];
#pragma unroll
          for (int k = 0; k < 8; ++k) { o[k] = ((s0 >> 4) > (t >> 4)) ? 0.f : tp[k]; DBGCNT(F, 4, !(fabsf(o[k]) < 50.f)); }
          u32x4 wv; wv.x = cvt_pk_bf16(o[0], o[1]); wv.y = cvt_pk_bf16(o[2], o[3]); wv.z = cvt_pk_bf16(o[4], o[5]); wv.w = cvt_pk_bf16(o[6], o[7]);
          __syncthreads();
          *(LAS u32x4*)(lds + O_TM + t * MS + s0 * 2) = wv; }
        __syncthreads();
#pragma unroll
        for (int x = 0; x < 2; ++x) { const int tc = tcb + x; f32x4 gg = (f32x4){0.f, 0.f, 0.f, 0.f}, wt = gg;
            gg = mm_tile<2>(lds + O_AAK, MS, tr, lds + O_VTT, MS, tc, gg, lq, g); wt = mm_tile<2>(lds + O_TM, MS, tr, lds + O_ABT, MS, tc, wt, lq, g);
#pragma unroll
            for (int i = 0; i < 4; ++i) { DBGCNT(F, 12, !(fabsf(gg[i]) < 1e3f)); DBGCNT(F, 13, !(fabsf(wt[i]) < 1e2f)); }
            st_tr(lds + O_GT, 16 * tr + 4 * g, 16 * tc + lq, gg); st_tr(lds + O_WTT, 16 * tr + 4 * g, 16 * tc + lq, wt); }
        __syncthreads();
#pragma unroll
        for (int x = 0; x < 2; ++x) { const int tc = tcb + x; f32x4 ut = (f32x4){0.f, 0.f, 0.f, 0.f};
            ut = mm_tile<2>(lds + O_TM, MS, tr, lds + O_GT, MS, tc, ut, lq, g);
#pragma unroll
            for (int i = 0; i < 4; ++i) DBGCNT(F, 14, !(fabsf(ut[i]) < 1e3f));
            st_tr(lds + O_UTT, 16 * tr + 4 * g, 16 * tc + lq, ut); }
        __syncthreads();
#pragma unroll
        for (int x = 0; x < 2; ++x) { const int tc = tcb + x, t0 = 16 * tr + 4 * g, cj = 16 * tc + lq;
            f32x4 qt = (f32x4){0.f, 0.f, 0.f, 0.f}, yl = qt, pp = qt, nn = qt;
            qt = mm_tile<2>(lds + O_ARB, MS, tr, lds + O_WTT, MS, tc, qt, lq, g);
            yl = mm_tile<2>(lds + O_ARB, MS, tr, lds + O_UTT, MS, tc, yl, lq, g);
#ifdef DBG_SEL
            { f32x4 y2 = (f32x4){0.f, 0.f, 0.f, 0.f}; y2 = mm_tile<2>(lds + O_ARK, MS, tr, lds + O_VTT, MS, tc, y2, lq, g);
#pragma unroll
              for (int i = 0; i < 4; ++i) { DBGCNT(F, 15, !(fabsf(yl[i]) < 1e4f)); DBGCNT(F, 16, !(fabsf(y2[i]) < 1e4f)); }
#pragma unroll
              for (int ks = 0; ks < 2; ++ks) { const bf16x8 a1 = *(const LAS bf16x8*)(lds + O_ARB + (16 * tr + lq) * MS + (32 * ks + 8 * g) * 2), a2 = *(const LAS bf16x8*)(lds + O_ARK + (16 * tr + lq) * MS + (32 * ks + 8 * g) * 2);
                  const bf16x8 b1 = *(const LAS bf16x8*)(lds + O_UTT + (16 * tc + lq) * MS + (32 * ks + 8 * g) * 2), b2 = *(const LAS bf16x8*)(lds + O_VTT + (16 * tc + lq) * MS + (32 * ks + 8 * g) * 2);
#pragma unroll
                  for (int j = 0; j < 8; ++j) { DBGCNT(F, 17, !(fabsf(bf2f((bf16)a1[j])) < 300.f)); DBGCNT(F, 18, !(fabsf(bf2f((bf16)a2[j])) < 300.f)); DBGCNT(F, 19, !(fabsf(bf2f((bf16)b1[j])) < 1e3f)); DBGCNT(F, 20, !(fabsf(bf2f((bf16)b2[j])) < 100.f)); } } }
#endif
            yl = mm_tile<2>(lds + O_ARK, MS, tr, lds + O_VTT, MS, tc, yl, lq, g);
            pp = mm_tile<2>(lds + O_WTT, MS, tr, lds + O_BTT, MS, tc, pp, lq, g);
            nn = mm_tile<2>(lds + O_UTT, MS, tr, lds + O_BTT, MS, tc, nn, lq, g); nn = mm_tile<2>(lds + O_VTT, MS, tr, lds + O_KTT, MS, tc, nn, lq, g);
            bf16* QT = (bf16*)(F.ws + WS_QT) + (size_t)item * 4096; float* YL = (float*)(F.ws + WS_YLOC) + (size_t)item * 4096;
            bf16* PT = (bf16*)(F.ws + WS_PT) + (size_t)item * 4096; float* NNp = (float*)(F.ws + WS_NN) + (size_t)item * 4096;
#pragma unroll
            for (int i = 0; i < 4; ++i) { const float rbv = bf2f(*(const LAS bf16*)(lds + O_RB + (t0 + i) * MS + cj * 2));
                DBGCNT(F, 5, !(fabsf(yl[i]) < 1e4f)); DBGCNT(F, 11, !(fabsf(nn[i]) < 1e4f && fabsf(pp[i]) < 1e2f && fabsf(qt[i]) < 1e4f));
                QT[(unsigned)((t0 + i) * 64 + cj)] = (bf16)f2bf(qt[i] + rbv); YL[(unsigned)((t0 + i) * 64 + cj)] = yl[i]; NNp[(unsigned)((t0 + i) * 64 + cj)] = nn[i]; }
            u32x2 pw; pw.x = cvt_pk_bf16(pp[0], pp[1]); pw.y = cvt_pk_bf16(pp[2], pp[3]); *(GAS u32x2*)(PT + (unsigned)(cj * 64 + t0)) = pw;
        }
        __syncthreads();
    }
}

constexpr int SC_PT = 0, SC_NN = 8192, SC_GC = 12288, SC_DUM = 12544, SC_SLOT = 12800, SC_DEPTH = 8;
static_assert(SC_DEPTH * SC_SLOT <= RING_BYTES, "scan ring");
__device__ __forceinline__ void scan_issue(LAS unsigned char* ring, const unsigned char* ws, int bh, int vg, int c, int w, int lane) {
    const size_t item = (size_t)bh * NCHUNK + c; LAS unsigned char* slot = ring + (c & (SC_DEPTH - 1)) * SC_SLOT;
#pragma unroll
    for (int k = 0; k < 2; ++k) { const int id = 2 * (w - 1) + k;
        if (id < 8) { const int p = 64 * id + lane, r = p >> 3, sl = p & 7, ch = sl ^ (r & 7);
            __builtin_amdgcn_global_load_lds((const unsigned*)((const bf16*)(ws + WS_PT) + item * 4096 + r * 64 + ch * 8), (LAS unsigned*)(slot + SC_PT + 1024 * id), 16, 0, 0); }
        else if (id < 12) { const int q = id - 8, p = 64 * q + lane, r = p >> 4, sl = p & 15, ch = sl ^ (r & 15);
            __builtin_amdgcn_global_load_lds((const unsigned*)((const float*)(ws + WS_NN) + item * 4096 + (16 * vg + r) * 64 + ch * 4), (LAS unsigned*)(slot + SC_NN + 1024 * q), 16, 0, 0); }
        else { __builtin_amdgcn_global_load_lds((const unsigned*)((const float*)(ws + WS_GC) + item * 64 + lane), (LAS unsigned*)(slot + (id == 12 ? SC_GC : SC_DUM)), 4, 0, 0); }
    }
}
__device__ __forceinline__ void phase_scan(Frame& F, int bh, int vg) {
    const int lane = F.lane, w = F.wave, g = lane >> 4, lq = lane & 15;
    LAS unsigned char* ring = F.lds;
    f32x4 S[4];
#pragma unroll
    for (int kt = 0; kt < 4; ++kt) S[kt] = (f32x4){0.f, 0.f, 0.f, 0.f};
    const int v = 16 * vg + lq;
    if (w >= 1) {
#pragma unroll 1
        for (int c = 0; c < SC_DEPTH - 1; ++c) scan_issue(ring, F.ws, bh, vg, c, w, lane);
    }
#pragma unroll 1
    for (int c = 0; c < NCHUNK; ++c) {
        if (c <= NCHUNK - SC_DEPTH + 1) asm volatile("s_waitcnt vmcnt(12)" ::: "memory"); else asm volatile("s_waitcnt vmcnt(0)" ::: "memory");
        __builtin_amdgcn_s_barrier(); asm volatile("" ::: "memory");
        if (w >= 1 && c + SC_DEPTH - 1 < NCHUNK) scan_issue(ring, F.ws, bh, vg, c + SC_DEPTH - 1, w, lane);
        if (w == 0) {
            const LAS unsigned char* slot = ring + (c & (SC_DEPTH - 1)) * SC_SLOT; const size_t item = (size_t)bh * NCHUNK + c;
            bf16* S0 = (bf16*)(F.ws + WS_S0) + item * 4096;
            bf16x8 sf[2];
#pragma unroll
            for (int kt = 0; kt < 4; ++kt) { u32x2 wv; wv.x = cvt_pk_bf16(S[kt][0], S[kt][1]); wv.y = cvt_pk_bf16(S[kt][2], S[kt][3]); *(GAS u32x2*)(S0 + (size_t)v * 64 + 16 * kt + 4 * g) = wv; }
#pragma unroll
            for (int mb = 0; mb < 2; ++mb) { u32x4 wv; wv.x = cvt_pk_bf16(S[2 * mb][0], S[2 * mb][1]); wv.y = cvt_pk_bf16(S[2 * mb][2], S[2 * mb][3]);
                wv.z = cvt_pk_bf16(S[2 * mb + 1][0], S[2 * mb + 1][1]); wv.w = cvt_pk_bf16(S[2 * mb + 1][2], S[2 * mb + 1][3]); sf[mb] = __builtin_bit_cast(bf16x8, wv); }
#pragma unroll
            for (int kt = 0; kt < 4; ++kt) { const int k2 = 16 * kt + lq;
                const f32x4 nv = *(const LAS f32x4*)(slot + SC_NN + lq * 256 + (((4 * kt + g) ^ lq) << 4));
                const f32x4 gc = *(const LAS f32x4*)(slot + SC_GC + (16 * kt + 4 * g) * 4);
                f32x4 a = S[kt] * gc + nv;
#pragma unroll
                for (int mb = 0; mb < 2; ++mb) {
                    const u32x2 lo = *(const LAS u32x2*)(slot + SC_PT + k2 * 128 + (((4 * mb + (g >> 1)) ^ (k2 & 7)) << 4) + 8 * (g & 1));
                    const u32x2 hi = *(const LAS u32x2*)(slot + SC_PT + k2 * 128 + (((4 * mb + 2 + (g >> 1)) ^ (k2 & 7)) << 4) + 8 * (g & 1));
                    const bf16x8 pf = __builtin_bit_cast(bf16x8, (u32x4){lo.x, lo.y, hi.x, hi.y});
                    a = __builtin_amdgcn_mfma_f32_16x16x32_bf16(pf, sf[mb], a, 0, 0, 0); }
                S[kt] = a; }
        }
    }
    asm volatile("s_waitcnt vmcnt(0) lgkmcnt(0)" ::: "memory"); __builtin_amdgcn_s_barrier(); asm volatile("" ::: "memory");
}

__device__ __forceinline__ void phase_c(Frame& F, int b, int c, int h) {
    const int lane = F.lane, g = lane >> 4, lq = lane & 15;
    const size_t item = (size_t)(b * RH + h) * NCHUNK + c; const int n0 = b * T + c * CH;
    const bf16* QT = (const bf16*)(F.ws + WS_QT) + item * 4096; const bf16* S0 = (const bf16*)(F.ws + WS_S0) + item * 4096; const float* YL = (const float*)(F.ws + WS_YLOC) + item * 4096;
    const bf16* PROJ = (const bf16*)(F.ws + WS_PROJ); const float* mu = F.in[I_MU];
    bf16x8 sb[4][2];
#pragma unroll
    for (int tc = 0; tc < 4; ++tc)
#pragma unroll
        for (int ks = 0; ks < 2; ++ks) sb[tc][ks] = *(const GAS bf16x8*)(S0 + (size_t)(16 * tc + lq) * 64 + 32 * ks + 8 * g);
#pragma unroll 1
    for (int tr = 0; tr < 4; ++tr) {
        bf16x8 qa[2];
#pragma unroll
        for (int ks = 0; ks < 2; ++ks) qa[ks] = *(const GAS bf16x8*)(QT + (size_t)(16 * tr + lq) * 64 + 32 * ks + 8 * g);
        f32x4 y[4];
#pragma unroll
        for (int tc = 0; tc < 4; ++tc) {
#pragma unroll
            for (int i = 0; i < 4; ++i) { y[tc][i] = YL[(size_t)(16 * tr + 4 * g + i) * 64 + 16 * tc + lq]; DBGCNT(F, 0, !(fabsf(y[tc][i]) < 1e4f)); }
#ifndef DBG_NO_STATE
#pragma unroll
            for (int ks = 0; ks < 2; ++ks) y[tc] = __builtin_amdgcn_mfma_f32_16x16x32_bf16(qa[ks], sb[tc][ks], y[tc], 0, 0, 0);
#endif
            }
#pragma unroll
        for (int i = 0; i < 4; ++i) { const int t = 16 * tr + 4 * g + i, n = n0 + t;
            float s = (y[0][i] + y[1][i]) + (y[2][i] + y[3][i]); s += __shfl_xor(s, 1); s += __shfl_xor(s, 2); s += __shfl_xor(s, 4); s += __shfl_xor(s, 8);
            const float mean = s * (1.f / 64.f); float q = 0.f;
#pragma unroll
            for (int tc = 0; tc < 4; ++tc) { const float dlt = y[tc][i] - mean; q += dlt * dlt; }
            q += __shfl_xor(q, 1); q += __shfl_xor(q, 2); q += __shfl_xor(q, 4); q += __shfl_xor(q, 8);
            const float rstd = __builtin_amdgcn_rsqf(q * (1.f / 64.f) + GN_EPS);
            const float bsv = ((const float*)(F.ws + WS_BS))[(size_t)n * RH + h];
            const bool hasp = !(c == 0 && t == 0); const bf16* rowc = PROJ + (size_t)n * PCOLS; const bf16* rowp = hasp ? rowc - PCOLS : rowc;
#pragma unroll
            for (int tc = 0; tc < 4; ++tc) { const int hv = h * RN + 16 * tc + lq;
                const unsigned short vc = rowc[C_V + hv]; unsigned short vp = rowp[C_V + hv]; if (!hasp) vp = 0;
                const float vm = mixf(vc, vp, mu[C_V + hv]);
                const float yn = (y[tc][i] - mean) * rstd * F.in[I_LNG][hv] + F.in[I_LNB][hv];
                const float gt = bf2f(((const bf16*)(F.ws + WS_GATE))[(size_t)n * RW + hv]);
                float ov = (yn + bsv * vm) * gt;
#ifdef DBG_ZERO_RWKV
                ov = 0.f;
#endif
#ifdef DBG_PROBE
                ov = (DBG_PROBE == 1) ? gt : (DBG_PROBE == 2) ? bsv : (DBG_PROBE == 3) ? yn : (DBG_PROBE == 4) ? y[tc][i] : (DBG_PROBE == 5) ? 0.02f * (y[tc][i] - mean) : (DBG_PROBE == 6) ? 0.02f * y[tc][i] : vm;
#endif
#ifdef DBG_SCRUB_RWKV
                if (!(fabsf(ov) < 1e30f)) ov = 0.f;
#endif
                ((bf16*)(F.ws + WS_CAT))[(size_t)n * D + hv] = (bf16)f2bf(ov); }
        }
    }
}
}
__device__ __forceinline__ void diff_attn_phase(Frame& F) {
    const int lane = F.lane, w = F.wave, r = lane & 31, h = lane >> 5, rg = w >> 1, c = w & 1;
    float lam;
    { const float a = F.in[I_LQ1][lane] * F.in[I_LK1][lane], b2 = F.in[I_LQ2][lane] * F.in[I_LK2][lane]; lam = fexp(wave_sum(a)) - fexp(wave_sum(b2)) + LAMBDA_INIT; }
    const bf16* PROJ = (const bf16*)(F.ws + WS_PROJ); const bf16* VT = (const bf16*)(F.ws + WS_VT); bf16* CAT = (bf16*)(F.ws + WS_CAT);
    LAS float* xch = (LAS float*)F.lds;
    const bool tab = (F.G == 256);
    for (int p = F.bid; p < 256; p += F.G) {
#pragma unroll 1
        for (int s = 0; s < 2; ++s) { int bh, qb;
            if (tab) { const int u = attn_tab[F.bid][s]; if (u == 0xFFFF) break; bh = u >> 6; qb = u & 63; }
            else { bh = p >> 5; const int j = p & 31; qb = s ? 63 - j : j; }
            const int b = bh >> 2, hd = bh & 3; const int row0 = b * T + 128 * qb + 32 * rg;
            DiffBody32 body; f32x16 o[4]; float ls;
            const int nkt = 2 * qb + 2, nkt_w = (rg < 2) ? nkt - 1 : nkt;
            body.run(F.lds, PROJ + (size_t)row0 * PCOLS + C_QD + hd * 128 + c * 64, PCOLS, 0.125f * LOG2E, PROJ + (size_t)(b * T) * PCOLS + C_KD + hd * 128, PCOLS,
                     VT + (size_t)(hd * DV) * M + b * T, M, nkt, nkt_w, c, o, ls, F.tid, lane);
            if (c == 1) { const float sc = lam / ls;
#pragma unroll
                for (int db = 0; db < 4; ++db)
#pragma unroll
                    for (int i = 0; i < 16; ++i) xch[(rg * 64 + db * 16 + i) * 64 + lane] = o[db][i] * sc; }
            asm volatile("s_waitcnt lgkmcnt(0)" ::: "memory"); __builtin_amdgcn_s_barrier(); asm volatile("" ::: "memory");
            if (c == 0) { const float i0 = 1.f / ls; float q = 0.f;
#pragma unroll
                for (int db = 0; db < 4; ++db)
#pragma unroll
                    for (int i = 0; i < 16; ++i) { const float v = o[db][i] * i0 - xch[(rg * 64 + db * 16 + i) * 64 + lane]; o[db][i] = v; q += v * v; }
                { const auto r2 = __builtin_amdgcn_permlane32_swap(__float_as_uint(q), __float_as_uint(q), false, false); q = __uint_as_float(r2[0]) + __uint_as_float(r2[1]); }
                const float rstd = __builtin_amdgcn_rsqf(q * (1.f / DV) + NORM_EPS) * (1.f - LAMBDA_INIT);
                bf16* orow = CAT + (size_t)(row0 + r) * D + RW + hd * DV;
#pragma unroll
                for (int db = 0; db < 4; ++db)
#pragma unroll
                    for (int t = 0; t < 4; ++t) { const int dv = 32 * db + 8 * t + 4 * h; const f32x4 sg = *(const GAS f32x4*)(F.in[I_SUBG] + dv);
                        u32x2 wv; wv.x = cvt_pk_bf16(o[db][4 * t] * rstd * sg[0], o[db][4 * t + 1] * rstd * sg[1]); wv.y = cvt_pk_bf16(o[db][4 * t + 2] * rstd * sg[2], o[db][4 * t + 3] * rstd * sg[3]);
#ifdef DBG_ZERO_DIFF
                        wv.x = 0u; wv.y = 0u;
#endif
                        *(GAS u32x2*)(orow + dv) = wv; } }
            asm volatile("s_waitcnt lgkmcnt(0)" ::: "memory"); __builtin_amdgcn_s_barrier(); asm volatile("" ::: "memory");
        }
    }
}
__device__ __forceinline__ void cross_attn_phase(Frame& F, const int* ubase, int nunit) {
    typedef AttnBody<1, XD, XD, 2, 8> Body;
    const int lane = F.lane, w = F.wave, g = lane >> 4, lq = lane & 15;
    const bf16* QX = (const bf16*)(F.ws + WS_QX); const bf16* KM = (const bf16*)(F.ws + WS_KMEM); const bf16* VTM = (const bf16*)(F.ws + WS_VTMEM); bf16* XO = (bf16*)(F.ws + WS_XO);
#pragma unroll 1
    for (int uu = 0; uu < 2 * nunit; ++uu) { const int u = ubase[uu >> 1] + (uu & 1); const int bh = u >> 6, rb = u & 63, b = bh >> 2, h = bh & 3; const int row0 = b * T + 128 * rb + 16 * w;
        Body body; f32x4 o[1][16]; float ls[1];
        body.run(F.lds, QX + (size_t)row0 * D + h * XD, D, 1.0f, KM + (size_t)(b * MEM) * D + h * XD, D, VTM + (size_t)(h * XD) * (BATCH * MEM) + b * MEM, BATCH * MEM, 4, 4, false, o, ls, F.tid, lane);
        const float inv = 1.f / ls[0]; bf16* orow = XO + (size_t)(row0 + lq) * D + h * XD;
#pragma unroll
        for (int dt = 0; dt < 16; ++dt) { const f32x4 y = o[0][dt] * inv; u32x2 wv; wv.x = cvt_pk_bf16(y[0], y[1]); wv.y = cvt_pk_bf16(y[2], y[3]);
#ifdef DBG_ZERO_XATTN
            wv.x = 0u; wv.y = 0u;
#endif
            *(GAS u32x2*)(orow + 16 * dt + 4 * g) = wv; }
    }
}

constexpr int RT_LCNT = X_OFF + 4096, RT_GBASE = RT_LCNT + 128, RT_ENTE = RT_GBASE + 128, RT_ENTP = RT_ENTE + 1024, RT_LGT = RT_ENTP + 1024;
__device__ __forceinline__ void router_phase(Frame& F, int cw_cnt, size_t ws_lists, size_t ws_gates) {
    const int lane = F.lane, w = F.wave, tid = F.tid;
    LAS int* lcnt = (LAS int*)(F.lds + RT_LCNT); LAS int* gbase = (LAS int*)(F.lds + RT_GBASE); LAS int* ente = (LAS int*)(F.lds + RT_ENTE); LAS int* entp = (LAS int*)(F.lds + RT_ENTP); LAS float* lgt = (LAS float*)(F.lds + RT_LGT);
    const float* H2 = (const float*)(F.ws + WS_H2); const float* RWT = (const float*)(F.ws + WS_RWT); const float* SS3 = (const float*)(F.ws + WS_SS3);
    int* lists = (int*)(F.ws + ws_lists); float* lgate = (float*)(F.ws + ws_gates); float* lrinv = lgate + (size_t)NE * CAP;
    LAS float* entg = (LAS float*)(F.lds + RT_LGT + 8448); LAS float* entr = entg + 256;
#pragma unroll 1
    for (int blk = F.bid; blk < M / 64; blk += F.G) {
        if (tid < NE) lcnt[tid] = 0;
        __syncthreads();
        const int nb = blk * 64 + w * 8;
        { const int tt = w >> 1, et = w & 1, lq = lane & 15, g = lane >> 4;
          const f32x4* ap = (const f32x4*)(H2 + (size_t)(blk * 64 + tt * 16 + lq) * D + 4 * g); const f32x4* bp = (const f32x4*)(RWT + (size_t)(et * 16 + lq) * D + 4 * g);
          f32x4 acc0 = (f32x4){0.f, 0.f, 0.f, 0.f}, acc1 = acc0;
#pragma unroll 8
          for (int j = 0; j < D / 16; j += 2) { const f32x4 a0 = ap[4 * j], b0 = bp[4 * j], a1 = ap[4 * j + 4], b1 = bp[4 * j + 4];
#pragma unroll
              for (int m = 0; m < 4; ++m) { acc0 = __builtin_amdgcn_mfma_f32_16x16x4f32(a0[m], b0[m], acc0, 0, 0, 0); acc1 = __builtin_amdgcn_mfma_f32_16x16x4f32(a1[m], b1[m], acc1, 0, 0, 0); } }
#pragma unroll
          for (int i = 0; i < 4; ++i) { const int tok = tt * 16 + 4 * g + i; lgt[tok * 33 + et * 16 + lq] = acc0[i] + acc1[i]; } }
        __syncthreads();
        if (lane < 8) { const int tl = w * 8 + lane, n = blk * 64 + tl;
            const float rinv = __builtin_amdgcn_rsqf(row_ss(SS3, n) * (1.f / D) + NORM_EPS);
            float v0 = -INFINITY, v1 = -INFINITY, v2 = -INFINITY, v3 = -INFINITY; int e0 = 0, e1 = 0, e2 = 0, e3 = 0;
#pragma unroll
            for (int e = 0; e < NE; ++e) { float x = lgt[tl * 33 + e] * rinv + F.in[I_RB][e]; if (!(x == x)) x = -3.0e38f;
                const bool c0 = x > v0, c1 = x > v1, c2 = x > v2, c3 = x > v3;
                v3 = c3 ? (c2 ? v2 : x) : v3; e3 = c3 ? (c2 ? e2 : e) : e3;
                v2 = c2 ? (c1 ? v1 : x) : v2; e2 = c2 ? (c1 ? e1 : e) : e2;
                v1 = c1 ? (c0 ? v0 : x) : v1; e1 = c1 ? (c0 ? e0 : e) : e1;
                v0 = c0 ? x : v0; e0 = c0 ? e : e0; }
            const float x1 = fexp(v1 - v0), x2 = fexp(v2 - v0), x3 = fexp(v3 - v0); const float inv = 1.f / (1.f + x1 + x2 + x3);
            const int es[4] = {e0, e1, e2, e3}; const float gs[4] = {inv, x1 * inv, x2 * inv, x3 * inv};
#pragma unroll
            for (int k = 0; k < 4; ++k) { const int li = tl * 4 + k; const int lp = __hip_atomic_fetch_add(&lcnt[es[k]], 1, __ATOMIC_RELAXED, __HIP_MEMORY_SCOPE_WORKGROUP); ente[li] = es[k]; entp[li] = lp; entg[li] = gs[k]; entr[li] = rinv; }
        }
        __syncthreads();
        if (tid < NE) gbase[tid] = (int)__hip_atomic_fetch_add((unsigned*)(F.ctl + cw_cnt + 64 * tid), (unsigned)lcnt[tid], RLX_AGENT);
#ifdef DUP_ATOM
        if (tid < NE) lgt[tid] = (float)__hip_atomic_fetch_add((unsigned*)(F.ctl + cw_cnt + 8192 + 64 * tid), (unsigned)lcnt[tid], RLX_AGENT);
#endif
        __syncthreads();
        if (tid < 256) { const int ee = ente[tid]; const size_t pos = (size_t)ee * CAP + gbase[ee] + entp[tid]; lists[pos] = blk * 256 + tid; lgate[pos] = entg[tid]; lrinv[pos] = entr[tid]; }
        __syncthreads();
    }
}
__device__ __forceinline__ void final_phase(Frame& F) {
    const int gw = F.bid * NWAVES + F.wave, NGW = F.G * NWAVES, lane = F.lane;
    const float* H2 = (const float*)(F.ws + WS_H2); const bf16* Y = (const bf16*)(F.ws + WS_YBUF);
    for (int n = gw; n < M; n += NGW) {
        f32x4 v[4]; float s = 0.f;
#pragma unroll
        for (int j = 0; j < 4; ++j) { v[j] = *((const GAS f32x4*)(H2 + (size_t)n * D) + lane + 64 * j);
#pragma unroll
            for (int k = 0; k < 4; ++k) { u32x2 y = *((const GAS u32x2*)(Y + (size_t)(n * 4 + k) * D) + lane + 64 * j);
#ifdef DBG_ZERO_MOE
                y.x = 0u; y.y = 0u;
#endif
                v[j].x += bflo(y.x); v[j].y += bfhi(y.x); v[j].z += bflo(y.y); v[j].w += bfhi(y.y); }
            s += (v[j].x * v[j].x + v[j].y * v[j].y) + (v[j].z * v[j].z + v[j].w * v[j].w); }
        float rstd = 1.f / sqrtf(wave_sum(s) * (1.f / D) + NORM_EPS);
#ifdef DBG_SEL
        { const unsigned cnt = __hip_atomic_load(F.ctl + 12288 + DBG_SEL, RLX_AGENT); rstd *= 0.9f * __log2f(1.f + (float)cnt) * (1.f / 30.f); }
#endif
#pragma unroll
        for (int j = 0; j < 4; ++j) { const f32x4 gg = *((const GAS f32x4*)F.in[I_FG] + lane + 64 * j); *((GAS f32x4*)(F.out + (size_t)n * D) + lane + 64 * j) = v[j] * rstd * gg; }
    }
}

constexpr int NPHASE = 13;
#ifndef P1_GEMM_WGS
#define P1_GEMM_WGS 144
#endif
struct Args { const float* in[34]; float* out; unsigned char* ws; int ph_lo, ph_hi; };
__global__ void __launch_bounds__(NTHR, 2) fwd_kernel(Args args) {
    extern __shared__ __attribute__((aligned(16))) unsigned char lds[];
    Frame F;
    F.lds = (LAS unsigned char*)lds; F.MISC = (volatile LAS unsigned*)(F.lds + MISC_OFF);
    F.tid = threadIdx.x; F.lane = F.tid & 63; F.wave = __builtin_amdgcn_readfirstlane(F.tid >> 6);
    F.G = gridDim.x; F.bid = blockIdx.x; F.ws = args.ws; F.ctl = (gu32*)(args.ws + WS_CTL); F.out = args.out;
#pragma unroll
    for (int i = 0; i < 34; ++i) F.in[i] = args.in[i];
    for (int u = F.tid; u < (LDS_BYTES - MISC_OFF) / 4; u += NTHR) ((LAS unsigned*)(F.lds + MISC_OFF))[u] = 0u;
    __syncthreads();
    XcdBarrier bar = xcd_barrier_post((unsigned*)(F.ctl + CW_BAR), F.MISC + 8);
    const int lo = args.ph_lo, hi = args.ph_hi;
#ifndef PHM
#define PHM 0xffff
#endif
#define IN(k) (((PHM >> (k)) & 1) && lo <= (k) && (k) < hi)
#ifdef DUP_BARRIER
#define SEAM(k) do { if (IN(k) && IN((k) + 1)) { xcd_barrier(bar); if ((k) == DUP_BARRIER || DUP_BARRIER == 99) { xcd_barrier(bar); } } } while (0)
#else
#define SEAM(k) do { if (IN(k) && IN((k) + 1)) xcd_barrier(bar); } while (0)
#endif
    LAS int* lstage = (LAS int*)(F.lds + X_OFF);
    LAS int* moe_tb = (LAS int*)(F.lds + X_OFF + 2048); LAS int* moe_cn = (LAS int*)(F.lds + X_OFF + 2048 + 256); LAS int* moe_rte = (LAS int*)(F.lds + X_OFF + 2048 + 512);

#define RETID() do { int t_ = threadIdx.x; asm volatile("" : "+v"(t_)); F.tid = t_; F.lane = t_ & 63; } while (0)
    if (IN(0)) { RETID(); p0_prologue(F);
#if defined(DUP_PHASE) && DUP_PHASE == 0
        { RETID(); p0_prologue(F);  }
#endif
    } SEAM(0);
    if (IN(1)) { RETID();
        const int NG1 = (F.G == 256) ? P1_GEMM_WGS : F.G;
        if (F.bid < NG1) {
        const bf16* XN = (const bf16*)(F.ws + WS_XN); const bf16* WinT = (const bf16*)(F.ws + WS_WINT); const bf16* MEMN = (const bf16*)(F.ws + WS_MEMN); const bf16* WkvT = (const bf16*)(F.ws + WS_WKVT);
        { pg8::Gemm g{XN, WinT, D, 0, nullptr}; pg8::StaticOrder S; S.init(M, PCOLS, NG1, F.bid, 0); pg8::EpiBf16 E{(bf16*)(F.ws + WS_PROJ), PCOLS};
          pg8::gemm_phase<pg8::EpiBf16, pg8::StaticOrder, true, false>(F.lds, lstage, g, S, E); }
        { pg8::Gemm g{WinT + (size_t)C_VD * D, XN, D, 0, nullptr}; pg8::StaticOrder S; S.init(512, M, NG1, F.bid, 0); pg8::EpiBf16 E{(bf16*)(F.ws + WS_VT), M};
          pg8::gemm_phase<pg8::EpiBf16, pg8::StaticOrder, true, false>(F.lds, lstage, g, S, E); }
        { pg8::Gemm g{MEMN, WkvT, D, 0, nullptr}; pg8::StaticOrder S; S.init(BATCH * MEM, D, NG1, F.bid, 16); pg8::EpiBf16 E{(bf16*)(F.ws + WS_KMEM), D};
          pg8::gemm_phase<pg8::EpiBf16, pg8::StaticOrder, true, false>(F.lds, lstage, g, S, E); }
        { pg8::Gemm g{WkvT + (size_t)D * D, MEMN, D, 0, nullptr}; pg8::StaticOrder S; S.init(D, BATCH * MEM, NG1, F.bid, 8); pg8::EpiBf16 E{(bf16*)(F.ws + WS_VTMEM), BATCH * MEM};
          pg8::gemm_phase<pg8::EpiBf16, pg8::StaticOrder, true, false>(F.lds, lstage, g, S, E); }

        }
        if (NG1 == F.G || F.bid >= NG1) p0_experts(F, NG1 == F.G ? 0 : NG1);
    } SEAM(1);
    if (IN(2)) { RETID(); for (int it = F.bid; it < BATCH * NCHUNK; it += F.G) rk::phase_a(F, it / NCHUNK, it % NCHUNK);
#if defined(DUP_PHASE) && DUP_PHASE == 2
        { RETID(); for (int it = F.bid; it < BATCH * NCHUNK; it += F.G) rk::phase_a(F, it / NCHUNK, it % NCHUNK);  }
#endif
    } SEAM(2);
    if (IN(3)) { RETID();
        for (int it = F.bid; it < BATCH * RH * 4; it += F.G) rk::phase_scan(F, it >> 2, it & 3);
#ifdef DUP_SCAN
        for (int it = F.bid; it < BATCH * RH * 4; it += F.G) rk::phase_scan(F, it >> 2, it & 3);
#endif
        diff_attn_phase(F);
#ifdef DUP_ATTN
        diff_attn_phase(F);
#endif

#if defined(DUP_PHASE) && DUP_PHASE == 3
        { RETID();
        for (int it = F.bid; it < BATCH * RH * 4; it += F.G) rk::phase_scan(F, it >> 2, it & 3);
        diff_attn_phase(F);
     }
#endif
    } SEAM(3);
    if (IN(4)) { RETID(); for (int it = F.bid; it < BATCH * NCHUNK; it += F.G) rk::phase_c(F, it / NCHUNK, it % NCHUNK, F.wave);
#if defined(DUP_PHASE) && DUP_PHASE == 4
        { RETID(); for (int it = F.bid; it < BATCH * NCHUNK; it += F.G) rk::phase_c(F, it / NCHUNK, it % NCHUNK, F.wave);  }
#endif
    } SEAM(4);
    if (IN(5)) { RETID(); pg8::Gemm g{(const bf16*)(F.ws + WS_CAT), (const bf16*)(F.ws + WS_WOUTT), D, 0, nullptr}; pg8::StaticOrder S; S.init(M, D, F.G, F.bid, 0);
        pg8::EpiResid2 E{F.in[I_X], nullptr, nullptr, (bf16*)(F.ws + WS_H1B), (float*)(F.ws + WS_SS1), nullptr};
        pg8::gemm_phase<pg8::EpiResid2, pg8::StaticOrder, true, false>(F.lds, lstage, g, S, E);
#if defined(DUP_PHASE) && DUP_PHASE == 5
        { RETID(); pg8::Gemm g{(const bf16*)(F.ws + WS_CAT), (const bf16*)(F.ws + WS_WOUTT), D, 0, nullptr}; pg8::StaticOrder S; S.init(M, D, F.G, F.bid, 0);
        pg8::EpiResid2 E{F.in[I_X], nullptr, nullptr, (bf16*)(F.ws + WS_H1B), (float*)(F.ws + WS_SS1), nullptr};
        pg8::gemm_phase<pg8::EpiResid2, pg8::StaticOrder, true, false>(F.lds, lstage, g, S, E);  }
#endif
    } SEAM(5);
    if (IN(6)) { RETID(); pg8::Gemm g{(const bf16*)(F.ws + WS_H1B), (const bf16*)(F.ws + WS_WQT), D, 0, nullptr}; pg8::StaticOrder S; S.init(M, D, F.G, F.bid, 0);
        pg8::EpiRowScaleBf16 E{(bf16*)(F.ws + WS_QX), D, (const float*)(F.ws + WS_SS1), 0.0625f * LOG2E};
        pg8::gemm_phase<pg8::EpiRowScaleBf16, pg8::StaticOrder, true, false>(F.lds, lstage, g, S, E);
        __builtin_amdgcn_fence(__ATOMIC_RELEASE, "workgroup"); __syncthreads(); __builtin_amdgcn_fence(__ATOMIC_ACQUIRE, "workgroup");
        RETID();
        int ub[4]; int nu = 0; pg8::Unit u;
#pragma unroll
        for (int i = 0; i < 4; ++i) if (S.next(i, u)) { ub[i] = ((u.pm >> 5) * 4 + u.pn) * 64 + 2 * (u.pm & 31); nu = i + 1; } else ub[i] = 0;
        cross_attn_phase(F, ub, nu);
    } SEAM(7);
    if (IN(8)) { RETID(); pg8::Gemm g{(const bf16*)(F.ws + WS_XO), (const bf16*)(F.ws + WS_WOT), D, 0, nullptr}; pg8::StaticOrder S; S.init(M, D, F.G, F.bid, 0);
        pg8::EpiResid2T<true> E{nullptr, (const bf16*)(F.ws + WS_H1B), (float*)(F.ws + WS_H2), (bf16*)(F.ws + WS_H2B), (float*)(F.ws + WS_SS3), F.in[I_N3G]};
        pg8::gemm_phase<pg8::EpiResid2T<true>, pg8::StaticOrder, true, false>(F.lds, lstage, g, S, E);
#if defined(DUP_PHASE) && DUP_PHASE == 8
        { RETID(); pg8::Gemm g{(const bf16*)(F.ws + WS_XO), (const bf16*)(F.ws + WS_WOT), D, 0, nullptr}; pg8::StaticOrder S; S.init(M, D, F.G, F.bid, 0);
        pg8::EpiResid2T<true> E{nullptr, (const bf16*)(F.ws + WS_H1B), (float*)(F.ws + WS_H2), (bf16*)(F.ws + WS_H2B), (float*)(F.ws + WS_SS3), F.in[I_N3G]};
        pg8::gemm_phase<pg8::EpiResid2T<true>, pg8::StaticOrder, true, false>(F.lds, lstage, g, S, E);  }
#endif
    } SEAM(8);
    if (IN(9)) { RETID(); router_phase(F, CW_CNT, WS_LISTS, WS_LGATE);
#if defined(DUP_PHASE) && DUP_PHASE == 9
        { RETID(); router_phase(F, CW_CNT + 4096, WS_YBUF, WS_YBUF + 4 * MiB); }
#endif
    } SEAM(9);
    if (IN(10) || IN(11)) { RETID();
        if (F.tid < NE) moe_cn[F.tid] = (int)__hip_atomic_load(F.ctl + CW_CNT + 64 * F.tid, RLX_AGENT);
        __syncthreads();
        if (F.tid == 0) { int a = 0; for (int e = 0; e < NE; ++e) { moe_tb[e] = a; a += (moe_cn[e] + 255) >> 8; } moe_tb[NE] = a; }
        __syncthreads();
        if (F.tid < MAXRT) { int e = 0; for (int k = 1; k < NE; ++k) e = (F.tid >= moe_tb[k]) ? k : e; moe_rte[F.tid] = e; }
        __syncthreads();
    }
    if (IN(10)) { RETID(); pg8::Gemm g{(const bf16*)(F.ws + WS_H2B), (const bf16*)(F.ws + WS_W1T), D / 2, (size_t)FF * D, (const int*)(F.ws + WS_LISTS)};
        pg8::MoeOrder S{moe_tb, moe_cn, moe_rte, 8, F.G, F.bid, __builtin_amdgcn_readfirstlane(moe_tb[NE])};
        pg8::EpiSwiglu E{F.ws + WS_ACT, F.in[I_B1], (const float*)(F.ws + WS_LRINV), (const int*)(F.ws + WS_LISTS)};
        pg8::gemm_phase<pg8::EpiSwiglu, pg8::MoeOrder, true, true, true>(F.lds, lstage, g, S, E);
#if defined(DUP_PHASE) && DUP_PHASE == 10
        { RETID(); pg8::Gemm g{(const bf16*)(F.ws + WS_H2B), (const bf16*)(F.ws + WS_W1T), D / 2, (size_t)FF * D, (const int*)(F.ws + WS_LISTS)};
        pg8::MoeOrder S{moe_tb, moe_cn, moe_rte, 8, F.G, F.bid, __builtin_amdgcn_readfirstlane(moe_tb[NE])};
        pg8::EpiSwiglu E{F.ws + WS_ACT, F.in[I_B1], (const float*)(F.ws + WS_LRINV), (const int*)(F.ws + WS_LISTS)};
        pg8::gemm_phase<pg8::EpiSwiglu, pg8::MoeOrder, true, true, true>(F.lds, lstage, g, S, E);  }
#endif
    } SEAM(10);
    if (IN(11)) { RETID(); pg8::Gemm g{(const bf16*)(F.ws + WS_ACT), (const bf16*)(F.ws + WS_W2T), FF / 2, (size_t)D * FF / 2, nullptr};
        pg8::MoeOrder S{moe_tb, moe_cn, moe_rte, 4, F.G, F.bid, __builtin_amdgcn_readfirstlane(moe_tb[NE])};
        pg8::EpiMoe2 E{(bf16*)(F.ws + WS_YBUF), F.in[I_B2], (const float*)(F.ws + WS_LGATE), (const int*)(F.ws + WS_LISTS)};
        pg8::gemm_phase<pg8::EpiMoe2, pg8::MoeOrder, true, false, true>(F.lds, lstage, g, S, E);
#if defined(DUP_PHASE) && DUP_PHASE == 112
        { RETID(); pg8::Gemm g{(const bf16*)(F.ws + WS_H2B), (const bf16*)(F.ws + WS_W2T), FF, (size_t)D * FF, (const int*)(F.ws + WS_LISTS)};
        pg8::MoeOrder S{moe_tb, moe_cn, moe_rte, 4, F.G, F.bid, __builtin_amdgcn_readfirstlane(moe_tb[NE])};
        pg8::EpiBf16 E{(bf16*)(F.ws + 532 * MiB), D};
        pg8::gemm_phase<pg8::EpiBf16, pg8::MoeOrder, true, true>(F.lds, lstage, g, S, E);  }
#endif
#if defined(DUP_PHASE) && DUP_PHASE == 11
        { RETID(); pg8::Gemm g{(const bf16*)(F.ws + WS_ACT), (const bf16*)(F.ws + WS_W2T), FF / 2, (size_t)D * FF / 2, nullptr};
        pg8::MoeOrder S{moe_tb, moe_cn, moe_rte, 4, F.G, F.bid, __builtin_amdgcn_readfirstlane(moe_tb[NE])};
        pg8::EpiMoe2 E{(bf16*)(F.ws + WS_YBUF), F.in[I_B2], (const float*)(F.ws + WS_LGATE), (const int*)(F.ws + WS_LISTS)};
        pg8::gemm_phase<pg8::EpiMoe2, pg8::MoeOrder, true, false, true>(F.lds, lstage, g, S, E);  }
#endif
    } SEAM(11);
    if (IN(12)) { RETID(); final_phase(F);
#if defined(DUP_PHASE) && DUP_PHASE == 12
        { RETID(); final_phase(F);  }
#endif
    }
#undef IN
#undef SEAM
}

#ifndef MK_SPLIT
#define MK_SPLIT 0
#endif
extern "C" void kernel_launch(void* const* d_in, const int* in_sizes, int n_in, void* d_out, int out_size, void* d_ws, size_t ws_size, hipStream_t stream) {
    static int grid = 0;
    if (grid == 0) {
        if (n_in != 34 || out_size != M * D || ws_size < WS_END) { fprintf(stderr, "kernel_launch: unexpected shapes (n_in %d out %d ws %zu)\n", n_in, out_size, ws_size); grid = -1; return; }
        int dev = 0, cus = 0, per_cu = 0;
        if (hipGetDevice(&dev) != hipSuccess || hipDeviceGetAttribute(&cus, hipDeviceAttributeMultiprocessorCount, dev) != hipSuccess) { grid = -1; return; }
        if (hipFuncSetAttribute((const void*)fwd_kernel, hipFuncAttributeMaxDynamicSharedMemorySize, LDS_BYTES) != hipSuccess) { fprintf(stderr, "kernel_launch: hipFuncSetAttribute failed\n"); grid = -1; return; }
        if (hipOccupancyMaxActiveBlocksPerMultiprocessor(&per_cu, (const void*)fwd_kernel, NTHR, LDS_BYTES) != hipSuccess || per_cu < 1) fprintf(stderr, "kernel_launch: occupancy query reports %d\n", per_cu);
        (void)hipGetLastError();
        grid = cus;
    }
    if (grid < 0) return;
    (void)hipMemsetAsync((char*)d_ws + WS_CTL, 0, CTL_ZERO_BYTES, stream);
    Args a{};
    for (int i = 0; i < 34; ++i) a.in[i] = (const float*)d_in[i];
    a.out = (float*)d_out; a.ws = (unsigned char*)d_ws;
#if MK_SPLIT
    for (int p = 0; p < NPHASE; ++p) { a.ph_lo = p; a.ph_hi = p + 1; hipLaunchKernelGGL(fwd_kernel, dim3(grid), dim3(NTHR), LDS_BYTES, stream, a); }
#else
    a.ph_lo = 0; a.ph_hi = NPHASE; hipLaunchKernelGGL(fwd_kernel, dim3(grid), dim3(NTHR), LDS_BYTES, stream, a);
#endif
}
```

```cpp
#include <hip/hip_runtime.h>
#include <cstdio>
#include <cstdint>

#define GAS __attribute__((address_space(1)))
#define LAS __attribute__((address_space(3)))
typedef unsigned short bf16;
typedef short bf16x8 __attribute__((ext_vector_type(8)));
typedef short bf16x4 __attribute__((ext_vector_type(4)));
typedef float f32x4 __attribute__((ext_vector_type(4)));
typedef float f32x2 __attribute__((ext_vector_type(2)));
typedef unsigned u32x4 __attribute__((ext_vector_type(4)));
typedef unsigned u32x2 __attribute__((ext_vector_type(2)));
typedef GAS unsigned gu32;
typedef int i32x4 __attribute__((ext_vector_type(4)));
typedef int i32x8 __attribute__((ext_vector_type(8)));
#define RLX_AGENT __ATOMIC_RELAXED, __HIP_MEMORY_SCOPE_AGENT
#define LDS_WAIT() asm volatile("s_waitcnt lgkmcnt(0)" ::: "memory")
#define VM_WAIT() asm volatile("s_waitcnt vmcnt(0)" ::: "memory")

typedef __bf16 bf16x2_t __attribute__((ext_vector_type(2)));
__device__ __forceinline__ unsigned cvt_pk_bf16(float lo, float hi) { const f32x2 v = {lo, hi}; const bf16x2_t b = __builtin_convertvector(v, bf16x2_t); return __builtin_bit_cast(unsigned, b); }
__device__ __forceinline__ unsigned f2bf(float f) { unsigned u = __builtin_bit_cast(unsigned, f); return (u + 0x7fffu + ((u >> 16) & 1u)) >> 16; }
__device__ __forceinline__ unsigned pk2(float lo, float hi) { return f2bf(lo) | (f2bf(hi) << 16); }
__device__ __forceinline__ float bf2f(bf16 b) { return __builtin_bit_cast(float, (unsigned)b << 16); }
__device__ __forceinline__ float bflo(unsigned u) { return __builtin_bit_cast(float, u << 16); }
__device__ __forceinline__ float bfhi(unsigned u) { return __builtin_bit_cast(float, u & 0xffff0000u); }
__device__ __forceinline__ float fexp2(float x) { return __builtin_amdgcn_exp2f(x); }
__device__ __forceinline__ float fexp(float x) { return __builtin_amdgcn_exp2f(x * 1.4426950408889634f); }
__device__ __forceinline__ float frcp(float x) { return __builtin_amdgcn_rcpf(x); }
__device__ __forceinline__ float sigmoidf_(float x) { return frcp(1.0f + fexp(-x)); }
__device__ __forceinline__ unsigned pk4_fp8(float a, float b, float c, float d) {
    a = __builtin_amdgcn_fmed3f(a, -448.f, 448.f); b = __builtin_amdgcn_fmed3f(b, -448.f, 448.f); c = __builtin_amdgcn_fmed3f(c, -448.f, 448.f); d = __builtin_amdgcn_fmed3f(d, -448.f, 448.f);
    int w = 0; w = __builtin_amdgcn_cvt_pk_fp8_f32(a, b, w, false); w = __builtin_amdgcn_cvt_pk_fp8_f32(c, d, w, true); return (unsigned)w; }
__device__ __forceinline__ i32x8 cat8(bf16x8 lo, bf16x8 hi) { const i32x4 a = __builtin_bit_cast(i32x4, lo), b = __builtin_bit_cast(i32x4, hi); return __builtin_shufflevector(a, b, 0, 1, 2, 3, 4, 5, 6, 7); }
constexpr float F8_SA = 16.f, F8_SW = 256.f, F8_SACT = 8.f;
#ifndef F8_SCALE
#define F8_SCALE 0x7F7F7F7F
#endif

namespace pg8 {
constexpr int BM = 256, BK = 64, HALF = 128, HTB = HALF * BK * 2  , STAGE_BYTES = 8 * HTB, NXCD = 8, WGM = 8;
__host__ __device__ __forceinline__ int lds_byte(int r, int c) { const int st = (r >> 4) * 2 + (c >> 5), rr = r & 15, cc = c & 31, ob = rr * 64 + cc * 2; return st * 1024 + (ob ^ (((ob >> 9) & 1) << 5)); }
__host__ __device__ __forceinline__ void stage_rc(int b, int& R, int& C) { const int st = b / 1024, sb = b % 1024, swz = sb ^ (((sb >> 9) & 1) << 5); R = (st >> 1) * 16 + swz / 64; C = (st & 1) * 32 + (swz % 64) / 2; }
__host__ __device__ __forceinline__ int perm32(int rho) { const int n = rho >> 4, i = rho & 15; return 8 * (i >> 2) + 4 * n + (i & 3); }

struct Unit { int pm, pn, e, nvalid, lbase, orow; };
struct Gemm { const bf16* A; const bf16* Bt; int K; size_t bstride; const int* rowlist; };

struct StaticOrder {
    int nM, nN, nwg, G, c;
    __device__ void init(int M, int N, int G_, int c_, int rot) { nM = M / BM; nN = N / BM; nwg = nM * nN; G = G_; c = (c_ + rot) % G_; }
    __device__ bool next(int i, Unit& u) const {
        const long L = (long)i * G + c; if (L >= nwg) return false;
        int wgid = (int)L; { const int q = nwg / NXCD, r = nwg % NXCD, xcd = wgid % NXCD, off = wgid / NXCD; wgid = (xcd < r ? xcd * (q + 1) : r * (q + 1) + (xcd - r) * q) + off; }
        const int nig = WGM * nN, gid = wgid / nig, fm = gid * WGM, gsz = (nM - fm) < WGM ? (nM - fm) : WGM;
        u.pm = fm + ((wgid % nig) % gsz); u.pn = (wgid % nig) / gsz; u.e = 0; u.nvalid = 256; u.lbase = 0; u.orow = u.pm * BM; return true;
    }
};

template <class Epi, class Sched, bool ALIGN_EPI, bool GATHER, bool F8 = false>
__device__ __forceinline__ void gemm_phase(LAS unsigned char* lds, LAS int* lstage  , const Gemm g, const Sched& S, const Epi& E) {
    int tid = threadIdx.x; asm volatile("" : "+v"(tid));
    const int wid = __builtin_amdgcn_readfirstlane(tid >> 6), lane = tid & 63, wr = wid >> 2, wc = wid & 3, fr = lane & 15, fq = lane >> 4;
    const int K = g.K, nt = K / BK;
    unsigned voffB[2], vA[2][2];
#pragma unroll
    for (int i = 0; i < 2; ++i) { int R, C; stage_rc(tid * 16 + i * 8192, R, C); const int Rb = Epi::PERM ? ((R & ~31) + perm32(R & 31)) : R;
        voffB[i] = (unsigned)(Rb * K + C) * 2u;
#pragma unroll
        for (int h = 0; h < 2; ++h) vA[h][i] = (unsigned)((h * HALF + R) * K + C) * 2u; }
    const size_t kstep = (size_t)(BK * 2);
    const size_t hstep = (size_t)HALF * K * 2;
    const size_t tstep = 2 * hstep;
    constexpr int AH1 = GATHER ? 1 : 0; const size_t AH = GATHER ? (size_t)0 : hstep;
    const unsigned ldsw = (unsigned)wid * 1024u;
    const int aoff = lds_byte(wr * 64 + fr, fq * 8), boff = lds_byte(wc * 32 + fr, fq * 8);
#define PG8_SA(b, h) (((b) * 2 + (h)) * HTB)
#define PG8_SB(b, h) ((4 + (b) * 2 + (h)) * HTB)
#define PG8_STAGE_(rs, base, bufoff, off, voff) do { _Pragma("unroll") for (int _i = 0; _i < 2; ++_i) { \
        if constexpr (F8) { unsigned keep_; asm volatile("s_mov_b32 %0, m0\n\ts_mov_b32 m0, %1\n\ts_nop 0\n\tbuffer_load_dwordx4 %2, %3, %4 offen lds\n\ts_mov_b32 m0, %0" \
            : "=&s"(keep_) : "s"(lds32 + (unsigned)(bufoff) + ldsw + (unsigned)_i * 8192u), "v"((voff)[_i]), "s"(rs), "s"((unsigned)(off)) : "memory"); } \
        else __builtin_amdgcn_global_load_lds((const unsigned*)((const char*)(base) + (off) + (voff)[_i]), (LAS unsigned*)(lds + (bufoff) + ldsw + _i * 8192), 16, 0, 0); } } while (0)
#define PG8_STA(bufoff, off, voff) PG8_STAGE_(rsA, g.A, bufoff, off, voff)
#define PG8_STB(bufoff, off, voff) PG8_STAGE_(rsB, g.Bt, bufoff, off, voff)
#define PG8_LDA(dst, b, h) do { _Pragma("unroll") for (int m = 0; m < 4; ++m) _Pragma("unroll") for (int k = 0; k < 2; ++k) dst[m][k] = *(const LAS bf16x8*)(lds + PG8_SA(b, h) + aoff + m * 2048 + k * 1024); } while (0)
#define PG8_LDB(dst, b, h) do { _Pragma("unroll") for (int n = 0; n < 2; ++n) _Pragma("unroll") for (int k = 0; k < 2; ++k) dst[n][k] = *(const LAS bf16x8*)(lds + PG8_SB(b, h) + boff + n * 2048 + k * 1024); } while (0)
#define PG8_MMA(ai, bj, At, Bt) do { __builtin_amdgcn_s_setprio(1); _Pragma("unroll") for (int m = 0; m < 4; ++m) _Pragma("unroll") for (int n = 0; n < 2; ++n) { \
        if constexpr (F8) acc[ai][bj][m][n] = __builtin_amdgcn_mfma_scale_f32_16x16x128_f8f6f4(cat8(Bt[n][0], Bt[n][1]), cat8(At[m][0], At[m][1]), acc[ai][bj][m][n], 0, 0, 0, F8_SCALE, 0, F8_SCALE); \
        else { _Pragma("unroll") for (int k = 0; k < 2; ++k) acc[ai][bj][m][n] = __builtin_amdgcn_mfma_f32_16x16x32_bf16(Bt[n][k], At[m][k], acc[ai][bj][m][n], 0, 0, 0); } } __builtin_amdgcn_s_setprio(0); } while (0)
#define PG8_WAIT_V(n) asm volatile("s_waitcnt vmcnt(" #n ")" ::: "memory")
#define PG8_WAIT_L(n) asm volatile("s_waitcnt lgkmcnt(" #n ")" ::: "memory")
#define PG8_BAR __builtin_amdgcn_s_barrier()
#define PG8_SCHED __builtin_amdgcn_sched_barrier(0)
    Unit cur, nxt; int ui = 0;
    if (!S.next(0, cur)) return;
    f32x4 acc[2][2][4][2];
#pragma unroll
    for (int a = 0; a < 2; ++a)
#pragma unroll
        for (int b = 0; b < 2; ++b)
#pragma unroll
            for (int m = 0; m < 4; ++m)
#pragma unroll
                for (int n = 0; n < 2; ++n) acc[a][b][m][n] = (f32x4){0.f, 0.f, 0.f, 0.f};
    bf16x8 At[4][2], B0[2][2], B1[2][2];
    size_t cA = GATHER ? (size_t)0 : (size_t)cur.pm * tstep;
    size_t cB = ((size_t)cur.e * g.bstride) * 2 + (size_t)cur.pn * tstep;
    const unsigned lds32 = (unsigned)(uintptr_t)lds;
    const __amdgpu_buffer_rsrc_t rsA = __builtin_amdgcn_make_buffer_rsrc((void*)g.A, 0, 0x7fffffff, 0x00020000), rsB = __builtin_amdgcn_make_buffer_rsrc((void*)g.Bt, 0, 0x7fffffff, 0x00020000);
    if constexpr (GATHER) {
        if (wid == 0) { unsigned lo16 = threadIdx.x; asm volatile("" : "+v"(lo16)); lo16 = (lo16 & 63u) * 16u; __builtin_amdgcn_global_load_lds((const unsigned*)((const char*)(g.rowlist + cur.lbase) + lo16), (LAS unsigned*)lstage, 16, 0, 0); }
        PG8_WAIT_V(0); __builtin_amdgcn_s_barrier();
#pragma unroll
        for (int h = 0; h < 2; ++h)
#pragma unroll
            for (int i = 0; i < 2; ++i) { int R, C; stage_rc(tid * 16 + i * 8192, R, C); const int rr = h * HALF + R; const int ent = lstage[rr]; const int src = rr < cur.nvalid ? ((ent >> 2) & 16383) : 0; vA[h][i] = (unsigned)(src * K + C) * 2u; }
        PG8_WAIT_L(0); __builtin_amdgcn_s_barrier();
    }
    PG8_STB(PG8_SB(0, 0), cB, voffB); PG8_STB(PG8_SB(0, 1), cB + hstep, voffB); PG8_STA(PG8_SA(0, 0), cA, vA[0]); PG8_STA(PG8_SA(0, 1), cA + AH, vA[AH1]);
    if (wr == 1) PG8_BAR;
    PG8_WAIT_V(2); PG8_BAR;
    PG8_STB(PG8_SB(1, 0), cB + kstep, voffB); PG8_STA(PG8_SA(1, 0), cA + kstep, vA[0]); PG8_STB(PG8_SB(1, 1), cB + hstep + kstep, voffB);
    PG8_WAIT_V(6); PG8_BAR;
    for (;;) {
        const bool has_next = S.next(ui + 1, nxt);
        const size_t nA = has_next ? (GATHER ? (size_t)0 : (size_t)nxt.pm * tstep) : cA;
        const size_t nB = has_next ? ((size_t)nxt.e * g.bstride) * 2 + (size_t)nxt.pn * tstep : cB;
#pragma unroll 1
        for (int t = 0; t < nt; t += 2) {
            const bool last = (t == nt - 2);
            if constexpr (GATHER) {
                if (t == 0 && has_next && wid == 0) { unsigned lo16 = threadIdx.x; asm volatile("" : "+v"(lo16)); lo16 = (lo16 & 63u) * 16u;
                    __builtin_amdgcn_global_load_lds((const unsigned*)((const char*)(g.rowlist + nxt.lbase) + lo16), (LAS unsigned*)(lstage + 256 * ((ui + 1) & 1)), 16, 0, 0); }
            }
            const size_t a1 = cA + (size_t)(t + 1) * kstep;
            const size_t a2 = last ? nA : cA + (size_t)(t + 2) * kstep; const size_t b2 = last ? nB : cB + (size_t)(t + 2) * kstep;
            const size_t a3 = a2 + kstep; const size_t b3 = b2 + kstep;
            PG8_LDB(B0, 0, 0); PG8_LDB(B1, 0, 1); PG8_SCHED; PG8_LDA(At, 0, 0); PG8_STA(PG8_SA(1, 1), a1 + AH, vA[AH1]);
            if constexpr (GATHER) { if (last && has_next) {
                int tl = tid; asm volatile("" : "+v"(tl));
#pragma unroll
                for (int h = 0; h < 2; ++h)
#pragma unroll
                    for (int i = 0; i < 2; ++i) { int R, C; stage_rc(tl * 16 + i * 8192, R, C); const int rr = h * HALF + R; const int ent = lstage[256 * ((ui + 1) & 1) + rr]; const int src = rr < nxt.nvalid ? ((ent >> 2) & 16383) : 0; vA[h][i] = (unsigned)(src * K + C) * 2u; } } }
            PG8_WAIT_V(8); PG8_WAIT_L(0); PG8_BAR; PG8_MMA(0, 0, At, B0); PG8_MMA(0, 1, At, B1); PG8_BAR; PG8_SCHED;
            PG8_LDA(At, 0, 1); PG8_STB(PG8_SB(0, 0), b2, voffB); PG8_STB(PG8_SB(0, 1), b2 + hstep, voffB); PG8_STA(PG8_SA(0, 0), a2, vA[0]);
            PG8_WAIT_V(8); PG8_WAIT_L(0); PG8_BAR; PG8_MMA(1, 0, At, B0); PG8_MMA(1, 1, At, B1); PG8_BAR; PG8_SCHED;
            PG8_LDB(B0, 1, 0); PG8_LDB(B1, 1, 1); PG8_SCHED; PG8_LDA(At, 1, 0); PG8_STA(PG8_SA(0, 1), a2 + AH, vA[AH1]);
            PG8_WAIT_V(8); PG8_WAIT_L(0); PG8_BAR; PG8_MMA(0, 0, At, B0); PG8_MMA(0, 1, At, B1); PG8_BAR; PG8_SCHED;
            PG8_LDA(At, 1, 1); PG8_STB(PG8_SB(1, 0), b3, voffB); PG8_STB(PG8_SB(1, 1), b3 + hstep, voffB); PG8_STA(PG8_SA(1, 0), a3, vA[0]);
            PG8_WAIT_V(8); PG8_WAIT_L(0); PG8_BAR; PG8_MMA(1, 0, At, B0); PG8_MMA(1, 1, At, B1); PG8_BAR; PG8_SCHED;
        }
        if constexpr (ALIGN_EPI) { if (wr == 0) PG8_BAR; }
        E(acc, cur, wr, wc, fr, fq);
        if (!has_next) break;
#pragma unroll
        for (int a = 0; a < 2; ++a)
#pragma unroll
            for (int b = 0; b < 2; ++b)
#pragma unroll
                for (int m = 0; m < 4; ++m)
#pragma unroll
                    for (int n = 0; n < 2; ++n) acc[a][b][m][n] = (f32x4){0.f, 0.f, 0.f, 0.f};
        cur = nxt; cA = nA; cB = nB; ++ui;
        if constexpr (ALIGN_EPI) { if (wr == 1) PG8_BAR; }
    }
    PG8_WAIT_V(0);
    if constexpr (!ALIGN_EPI) { if (wr == 0) PG8_BAR; }
    PG8_BAR;
#undef PG8_SA
#undef PG8_SB
#undef PG8_STAGE_
#undef PG8_STA
#undef PG8_STB
#undef PG8_LDA
#undef PG8_LDB
#undef PG8_MMA
#undef PG8_WAIT_V
#undef PG8_WAIT_L
#undef PG8_BAR
#undef PG8_SCHED
}
}
constexpr int NWAVES = 8, NTHR = 512;
constexpr int BATCH = 2, T = 8192, D = 1024, M = BATCH * T;
constexpr int CH = 64, NCHUNK = T / CH;
constexpr int RW = 512, RH = 8, RN = 64;
constexpr int DH = 4, DD = 64, DV = 128;
constexpr int SHIFT_COLS = 1792, PCOLS = 2816, IN_COLS = 3328;
constexpr int C_R = 0, C_K = 512, C_V = 1024, C_WD = 1536, C_AD = 1600, C_GD = 1664, C_QD = 1792, C_KD = 2304, C_VD = 2816;
constexpr int MEM = 256, XH = 4, XD = 256;
constexpr int NE = 32, TOPK = 4, FF = 1024, CAP = M;
constexpr int MAXRT = (M * TOPK) / 256 + NE;
constexpr float NORM_EPS = 1e-5f, GN_EPS = 64e-5f, LOG2E = 1.4426950408889634f;
constexpr float LAMBDA_INIT = 0.8f - 0.6f;

constexpr size_t MiB = 1u << 20;
constexpr size_t WS_CTL = 0, CTL_ZERO_BYTES = 1 * MiB;
constexpr size_t WS_SS1 = 250 * MiB + 512 * 1024, WS_SS3 = 251 * MiB;
constexpr size_t WS_WINT = 1 * MiB, WS_WOUTT = 8 * MiB, WS_WQT = 10 * MiB, WS_WKVT = 12 * MiB, WS_WOT = 16 * MiB;
constexpr size_t WS_W2LT = 18 * MiB, WS_A2LT = WS_W2LT + 64 * 1024, WS_G2LT = WS_W2LT + 128 * 1024, WS_RWT = WS_W2LT + 256 * 1024;
constexpr size_t WS_W1T = 20 * MiB, WS_W2T = 148 * MiB;
constexpr size_t WS_LGATE = 212 * MiB, WS_LRINV = 214 * MiB;
constexpr size_t WS_XN = 212 * MiB, WS_MEMN = 244 * MiB, WS_KMEM = 245 * MiB, WS_VTMEM = 246 * MiB;
constexpr size_t WS_LISTS = 247 * MiB, WS_GATES = 249 * MiB, WS_GC = 249 * MiB + 512 * 1024, WS_BS = 250 * MiB;
constexpr size_t WS_PROJ = 252 * MiB, WS_VT = 340 * MiB, WS_QT = 356 * MiB, WS_PT = 372 * MiB, WS_S0 = 388 * MiB, WS_GATE = 404 * MiB, WS_YLOC = 420 * MiB, WS_NN = 452 * MiB;
constexpr size_t WS_CAT = 484 * MiB, WS_H1 = 516 * MiB, WS_H1B = 580 * MiB, WS_QX = 612 * MiB, WS_XO = 644 * MiB, WS_H2 = 676 * MiB, WS_H2B = 740 * MiB;
constexpr size_t WS_ACT = 252 * MiB;
constexpr size_t WS_YBUF = 404 * MiB, WS_END = 772 * MiB;
static_assert(WS_ACT + (size_t)MAXRT * 256 * FF * 2 <= WS_GATE, "ACT overlay");
static_assert(WS_PROJ + (size_t)M * PCOLS * 2 <= WS_VT, "PROJ");
constexpr int CW_TMO = 0, CW_BAR = 4096, CW_CNT = 8192;
static_assert((CW_BAR + 3456) <= CW_CNT && (CW_CNT + 64 * NE) * 4 <= (int)CTL_ZERO_BYTES, "CTL map");

constexpr int RING_BYTES = 131072;
constexpr int X_OFF = RING_BYTES;
constexpr int MISC_OFF = 163840 - 1024;
constexpr int LDS_BYTES = 163840;

__device__ __forceinline__ float row_ss(const float* ssp, int row) {
    const f32x4 a = *(const f32x4*)(ssp + (size_t)row * 16), b = *(const f32x4*)(ssp + (size_t)row * 16 + 4), c = *(const f32x4*)(ssp + (size_t)row * 16 + 8), d = *(const f32x4*)(ssp + (size_t)row * 16 + 12);
    return (((a[0] + a[1]) + (a[2] + a[3])) + ((b[0] + b[1]) + (b[2] + b[3]))) + (((c[0] + c[1]) + (c[2] + c[3])) + ((d[0] + d[1]) + (d[2] + d[3])));
}
namespace pg8 {
struct EpiBf16 {
    static constexpr bool PERM = true;
    bf16* O; int ldc;
    __device__ __forceinline__ void operator()(const f32x4 (&acc)[2][2][4][2], const Unit& u, int wr, int wc, int fr, int fq) const {
        { unsigned tl = threadIdx.x; asm volatile("" : "+v"(tl)); fr = (int)(tl & 15u); fq = (int)((tl >> 4) & 3u); }
        const int col0 = u.pn * BM + wc * 32 + 8 * fq;
#pragma unroll
        for (int ai = 0; ai < 2; ++ai)
#pragma unroll
            for (int m = 0; m < 4; ++m) { bf16* rowp = O + (size_t)(u.orow + ai * HALF + wr * 64 + m * 16 + fr) * ldc + col0;
#pragma unroll
                for (int bj = 0; bj < 2; ++bj) { const f32x4 v0 = acc[ai][bj][m][0], v1 = acc[ai][bj][m][1];
                    u32x4 w; w.x = cvt_pk_bf16(v0[0], v0[1]); w.y = cvt_pk_bf16(v0[2], v0[3]); w.z = cvt_pk_bf16(v1[0], v1[1]); w.w = cvt_pk_bf16(v1[2], v1[3]);
                    *(u32x4*)(rowp + bj * HALF) = w; } }
    }
};
struct EpiRowScaleBf16 {
    static constexpr bool PERM = true;
    bf16* O; int ldc; const float* ss; float scale;
    __device__ __forceinline__ void operator()(const f32x4 (&acc)[2][2][4][2], const Unit& u, int wr, int wc, int fr, int fq) const {
        { unsigned tl = threadIdx.x; asm volatile("" : "+v"(tl)); fr = (int)(tl & 15u); fq = (int)((tl >> 4) & 3u); }
        const int col0 = u.pn * BM + wc * 32 + 8 * fq;
#pragma unroll
        for (int ai = 0; ai < 2; ++ai)
#pragma unroll
            for (int m = 0; m < 4; ++m) { const int row = u.orow + ai * HALF + wr * 64 + m * 16 + fr; bf16* rowp = O + (size_t)row * ldc + col0;
                const float s = scale * __builtin_amdgcn_rsqf(row_ss(ss, row) * (1.0f / D) + NORM_EPS);
#pragma unroll
                for (int bj = 0; bj < 2; ++bj) { const f32x4 v0 = acc[ai][bj][m][0] * s, v1 = acc[ai][bj][m][1] * s;
                    u32x4 w; w.x = cvt_pk_bf16(v0[0], v0[1]); w.y = cvt_pk_bf16(v0[2], v0[3]); w.z = cvt_pk_bf16(v1[0], v1[1]); w.w = cvt_pk_bf16(v1[2], v1[3]);
                    *(u32x4*)(rowp + bj * HALF) = w; } }
    }
};
struct EpiResid {
    static constexpr bool PERM = true;
    const float* base; float* H; bf16* Hb; float* ss;
    __device__ __forceinline__ void operator()(const f32x4 (&acc)[2][2][4][2], const Unit& u, int wr, int wc, int fr, int fq) const {
        { unsigned tl = threadIdx.x; asm volatile("" : "+v"(tl)); fr = (int)(tl & 15u); fq = (int)((tl >> 4) & 3u); }
        const int col0 = u.pn * BM + wc * 32 + 8 * fq;
#pragma unroll
        for (int ai = 0; ai < 2; ++ai)
#pragma unroll
            for (int m = 0; m < 4; ++m) { const int row = u.orow + ai * HALF + wr * 64 + m * 16 + fr; const size_t off = (size_t)row * D + col0; float q = 0.f;
#pragma unroll
                for (int bj = 0; bj < 2; ++bj) {
                    const f32x4 b0 = *(const f32x4*)(base + off + bj * HALF), b1 = *(const f32x4*)(base + off + bj * HALF + 4);
                    const f32x4 v0 = acc[ai][bj][m][0] + b0, v1 = acc[ai][bj][m][1] + b1;
                    *(f32x4*)(H + off + bj * HALF) = v0; *(f32x4*)(H + off + bj * HALF + 4) = v1;
                    u32x4 w; w.x = cvt_pk_bf16(v0[0], v0[1]); w.y = cvt_pk_bf16(v0[2], v0[3]); w.z = cvt_pk_bf16(v1[0], v1[1]); w.w = cvt_pk_bf16(v1[2], v1[3]);
                    *(u32x4*)(Hb + off + bj * HALF) = w;
                    q += (v0[0] * v0[0] + v0[1] * v0[1]) + (v0[2] * v0[2] + v0[3] * v0[3]) + (v1[0] * v1[0] + v1[1] * v1[1]) + (v1[2] * v1[2] + v1[3] * v1[3]); }
                q += __shfl_xor(q, 16); q += __shfl_xor(q, 32);
                if (fq == 0) ss[(size_t)row * 16 + u.pn * 4 + wc] = q; }
    }
};
template <int M8>
struct EpiResid2T {
    static constexpr bool PERM = true; static constexpr bool HB8 = (M8 == 1);
    const float* basef; const bf16* baseb; float* H; bf16* Hb; float* ss; const float* g8; unsigned char* H8; float ascale;
    __device__ __forceinline__ void operator()(const f32x4 (&acc)[2][2][4][2], const Unit& u, int wr, int wc, int fr, int fq) const {
        { unsigned tl = threadIdx.x; asm volatile("" : "+v"(tl)); fr = (int)(tl & 15u); fq = (int)((tl >> 4) & 3u); }
        const int col0 = u.pn * BM + wc * 32 + 8 * fq;
        f32x4 gs[2][2];
        if constexpr (HB8) {
#pragma unroll
            for (int bj = 0; bj < 2; ++bj) { gs[bj][0] = *(const f32x4*)(g8 + col0 + bj * HALF) * F8_SA; gs[bj][1] = *(const f32x4*)(g8 + col0 + bj * HALF + 4) * F8_SA; } }
#pragma unroll
        for (int ai = 0; ai < 2; ++ai)
#pragma unroll
            for (int m = 0; m < 4; ++m) { const int row = u.orow + ai * HALF + wr * 64 + m * 16 + fr; const size_t off = (size_t)row * D + col0; float q = 0.f;
#pragma unroll
                for (int bj = 0; bj < 2; ++bj) {
                    f32x4 b0, b1;
                    if (basef) { b0 = *(const f32x4*)(basef + off + bj * HALF); b1 = *(const f32x4*)(basef + off + bj * HALF + 4); }
                    else { const u32x4 bb = *(const u32x4*)(baseb + off + bj * HALF); b0 = (f32x4){bflo(bb.x), bfhi(bb.x), bflo(bb.y), bfhi(bb.y)}; b1 = (f32x4){bflo(bb.z), bfhi(bb.z), bflo(bb.w), bfhi(bb.w)}; }
                    const f32x4 v0 = acc[ai][bj][m][0] * ascale + b0, v1 = acc[ai][bj][m][1] * ascale + b1;
                    if (H) { *(f32x4*)(H + off + bj * HALF) = v0; *(f32x4*)(H + off + bj * HALF + 4) = v1; }
                    if constexpr (M8 == 1) { const f32x4 s0 = v0 * gs[bj][0], s1 = v1 * gs[bj][1]; u32x2 w8; w8.x = pk4_fp8(s0[0], s0[1], s0[2], s0[3]); w8.y = pk4_fp8(s1[0], s1[1], s1[2], s1[3]);
                        *(u32x2*)(H8 + off + bj * HALF) = w8; }
                    if constexpr (M8 == 2) { const f32x4 s0 = v0 * F8_SA, s1 = v1 * F8_SA; u32x2 w8; w8.x = pk4_fp8(s0[0], s0[1], s0[2], s0[3]); w8.y = pk4_fp8(s1[0], s1[1], s1[2], s1[3]);
                        *(u32x2*)(H8 + off + bj * HALF) = w8; }
                    if constexpr (M8 != 1) { u32x4 w; w.x = cvt_pk_bf16(v0[0], v0[1]); w.y = cvt_pk_bf16(v0[2], v0[3]); w.z = cvt_pk_bf16(v1[0], v1[1]); w.w = cvt_pk_bf16(v1[2], v1[3]);
                        *(u32x4*)(Hb + off + bj * HALF) = w; }
                    q += (v0[0] * v0[0] + v0[1] * v0[1]) + (v0[2] * v0[2] + v0[3] * v0[3]) + (v1[0] * v1[0] + v1[1] * v1[1]) + (v1[2] * v1[2] + v1[3] * v1[3]); }
                q += __shfl_xor(q, 16); q += __shfl_xor(q, 32);
                if (fq == 0) ss[(size_t)row * 16 + u.pn * 4 + wc] = q; }
    }
};
using EpiResid2 = EpiResid2T<0>;
constexpr float F8_SXO = 128.f;
struct EpiSwiglu {
    static constexpr bool PERM = true; static constexpr float LOG2E_ = 1.4426950408889634f;
    unsigned char* ACT; const float* b1; const float* lrinv; const int* list;
    __device__ __forceinline__ void operator()(const f32x4 (&acc)[2][2][4][2], const Unit& u, int wr, int wc, int fr, int fq) const {
        { unsigned tl = threadIdx.x; asm volatile("" : "+v"(tl)); fr = (int)(tl & 15u); fq = (int)((tl >> 4) & 3u); }
        const int j0 = u.pn * HALF + wc * 32 + 8 * fq; const float* bg = b1 + (size_t)u.e * (2 * FF) + j0; const float* bl = bg + FF;
        const f32x4 g0 = *(const f32x4*)bg, g1 = *(const f32x4*)(bg + 4), l0 = *(const f32x4*)bl, l1 = *(const f32x4*)(bl + 4);
#pragma unroll
        for (int ai = 0; ai < 2; ++ai)
#pragma unroll
            for (int m = 0; m < 4; ++m) { const int rr = ai * HALF + wr * 64 + m * 16 + fr;
                if (rr < u.nvalid) {
                    const float s = lrinv[u.lbase + rr] * (1.0f / (F8_SA * F8_SW));
                    u32x2 w;
#pragma unroll
                    for (int n = 0; n < 2; ++n) {
                        f32x4 gt = acc[ai][0][m][n] * s + (n ? g1 : g0), ln = acc[ai][1][m][n] * s + (n ? l1 : l0);
#pragma unroll
                        for (int j = 0; j < 4; ++j) { gt[j] = fminf(gt[j], 7.0f); ln[j] = __builtin_amdgcn_fmed3f(ln[j], -7.0f, 7.0f); }
                        f32x4 ex = gt * (-1.702f * LOG2E_);
#pragma unroll
                        for (int j = 0; j < 4; ++j) ex[j] = fexp2(ex[j]);
                        ex = ex + 1.0f;
#pragma unroll
                        for (int j = 0; j < 4; ++j) ex[j] = frcp(ex[j]);
                        const f32x4 o = (gt * ex) * (ln * F8_SACT + F8_SACT);
                        int pk = 0; pk = __builtin_amdgcn_cvt_pk_fp8_f32(o[0], o[1], pk, false); pk = __builtin_amdgcn_cvt_pk_fp8_f32(o[2], o[3], pk, true);
                        if (n == 0) w.x = (unsigned)pk; else w.y = (unsigned)pk; }
                    *(u32x2*)(ACT + (size_t)(u.orow + rr) * FF + j0) = w; } }
        asm volatile("" :: "v"(g0), "v"(g1), "v"(l0), "v"(l1));
    }
};
struct EpiMoe2 {
    static constexpr bool PERM = true;
    bf16* Y; const float* b2; const float* gates; const int* list;
    __device__ __forceinline__ void operator()(const f32x4 (&acc)[2][2][4][2], const Unit& u, int wr, int wc, int fr, int fq) const {
        { unsigned tl = threadIdx.x; asm volatile("" : "+v"(tl)); fr = (int)(tl & 15u); fq = (int)((tl >> 4) & 3u); }
        const int col0 = u.pn * BM + wc * 32 + 8 * fq; const float* bb = b2 + (size_t)u.e * D + col0;
        f32x4 bv[2][2];
#pragma unroll
        for (int bj = 0; bj < 2; ++bj) { bv[bj][0] = *(const f32x4*)(bb + bj * HALF); bv[bj][1] = *(const f32x4*)(bb + bj * HALF + 4); }
#pragma unroll
        for (int ai = 0; ai < 2; ++ai)
#pragma unroll
            for (int m = 0; m < 4; ++m) { const int rr = ai * HALF + wr * 64 + m * 16 + fr;
                if (rr < u.nvalid) {
                    const int ent = list[u.lbase + rr] & 65535; const float gw = gates[u.lbase + rr]; bf16* rowp = Y + (size_t)ent * D + col0;
#pragma unroll
                    for (int bj = 0; bj < 2; ++bj) { const f32x4 v0 = (acc[ai][bj][m][0] * (1.0f / (F8_SACT * F8_SW)) + bv[bj][0]) * gw, v1 = (acc[ai][bj][m][1] * (1.0f / (F8_SACT * F8_SW)) + bv[bj][1]) * gw;
                        u32x4 w; w.x = cvt_pk_bf16(v0[0], v0[1]); w.y = cvt_pk_bf16(v0[2], v0[3]); w.z = cvt_pk_bf16(v1[0], v1[1]); w.w = cvt_pk_bf16(v1[2], v1[3]);
                        *(u32x4*)(rowp + bj * HALF) = w; } } }
        asm volatile("" :: "v"(bv[0][0]), "v"(bv[0][1]), "v"(bv[1][0]), "v"(bv[1][1]));
    }
};
struct MoeOrder {
    const LAS int* tb; const LAS int* cn; const LAS int* rte; int ncol, G, c, ntile;
    __device__ bool next(int i, Unit& u) const {
        const int L = i * G + c, rt = L / ncol, pn = L % ncol; if (rt >= ntile) return false;
        const int e = __builtin_amdgcn_readfirstlane(rte[rt]);
        const int tile = rt - __builtin_amdgcn_readfirstlane(tb[e]), left = __builtin_amdgcn_readfirstlane(cn[e]) - tile * 256;
        u.pm = rt; u.pn = pn; u.e = e; u.nvalid = left < 256 ? left : 256; u.lbase = e * CAP + tile * 256; u.orow = rt * 256; return true;
    }
};
}
#define XB_TMO      128
#define XB_XCNT(j)  (256  + 64 * (j))
#define XB_XSUB(j)  (1280 + 64 * (j))
#define XB_XGEN(j)  (2304 + 64 * (j))
#define XB_TOP      3328
#define XB_TOPGEN   3392
#define XCD_BAR_WORDS 3456
#define XB_SPIN_CAP (1u << 18)

__device__ __forceinline__ unsigned xb_ld(unsigned* p)              { return __hip_atomic_load(p, __ATOMIC_RELAXED, __HIP_MEMORY_SCOPE_AGENT); }
__device__ __forceinline__ unsigned xb_add(unsigned* p, unsigned v) { return __hip_atomic_fetch_add(p, v, __ATOMIC_RELAXED, __HIP_MEMORY_SCOPE_AGENT); }
__device__ __forceinline__ unsigned xb_xcc_id() { return (unsigned)__builtin_amdgcn_s_getreg((3 << 11) | 20) & 0xFu; }
#define XB_SPIN(cond, bar) do { unsigned _sp = 0; while (cond) { __builtin_amdgcn_s_sleep(1); \
    if ((++_sp & 255u) == 0u) { if (xb_ld(&(bar)[XB_TMO])) break; if (_sp > XB_SPIN_CAP) { atomicAdd(&(bar)[XB_TMO], 1u); break; } } } } while (0)

struct XcdBarrier {
    unsigned* bar; unsigned x;
    volatile LAS unsigned* st;
};

__device__ __forceinline__ XcdBarrier xcd_barrier_post(unsigned* bar, volatile LAS unsigned* st) {
    XcdBarrier b; b.bar = bar; b.x = xb_xcc_id(); b.st = st;
    if (threadIdx.x == 0) (void)xb_add(&bar[XB_XCNT(b.x)], 1u);
    return b;
}
__device__ __forceinline__ void xcd_barrier_complete(unsigned* bar, unsigned x, unsigned& nloc, unsigned& nx) {
    const unsigned G = gridDim.x * gridDim.y * gridDim.z;
    unsigned sum, cnt, mine, sp = 0u;
    for (;;) {
        sum = 0u; cnt = 0u; mine = 0u;
#pragma unroll
        for (unsigned j = 0; j < 16; ++j) { const unsigned c = xb_ld(&bar[XB_XCNT(j)]); sum += c; cnt += (c > 0u) ? 1u : 0u; mine = (j == x) ? c : mine; }
        if (sum == G) break;
        __builtin_amdgcn_s_sleep(1);
        if ((++sp & 255u) == 0u) { if (xb_ld(&bar[XB_TMO])) break; if (sp > XB_SPIN_CAP) { atomicAdd(&bar[XB_TMO], 1u); break; } }
    }
    nloc = mine > 0u ? mine : 1u; nx = cnt > 0u ? cnt : 1u;
}

__device__ __forceinline__ void xcd_barrier(const XcdBarrier& b) {
    asm volatile("s_waitcnt vmcnt(0)" ::: "memory");
    __syncthreads();
    if (threadIdx.x == 0) {
        unsigned* bar = b.bar;
        __builtin_amdgcn_s_waitcnt(0);
        unsigned nloc = b.st[0], nx = b.st[1];
        if (nloc == 0u) { xcd_barrier_complete(bar, b.x, nloc, nx); b.st[0] = nloc; b.st[1] = nx; }
        const unsigned old = xb_add(&bar[XB_XSUB(b.x)], 1u);
        const unsigned gen = old / nloc;
        if (old + 1u == (gen + 1u) * nloc) {
            __builtin_amdgcn_fence(__ATOMIC_RELEASE, "agent");
            asm volatile("s_waitcnt vmcnt(0)" ::: "memory");
            const unsigned og = xb_add(&bar[XB_TOP], 1u);
            const unsigned tg = og / nx;
            if (og + 1u == (tg + 1u) * nx) xb_add(&bar[XB_TOPGEN], 1u);
            else XB_SPIN(xb_ld(&bar[XB_TOPGEN]) == tg, bar);
            __builtin_amdgcn_fence(__ATOMIC_ACQUIRE, "agent");
            xb_add(&bar[XB_XGEN(b.x)], 1u);
            asm volatile("s_waitcnt vmcnt(0)" ::: "memory");
        } else {
            XB_SPIN(xb_ld(&bar[XB_XGEN(b.x)]) == gen, bar);
            __builtin_amdgcn_fence(__ATOMIC_ACQUIRE, "agent");
            asm volatile("s_waitcnt vmcnt(0)" ::: "memory");
        }
    }
    __syncthreads();
}
#ifdef DBG_SEL
#define DBGCNT(F, k, cond) do { if (cond) atomicAdd((unsigned*)((F).ctl + 12288 + (k)), 1u); } while (0)
#else
#define DBGCNT(F, k, cond) do { } while (0)
#endif
struct Frame {
    LAS unsigned char* lds;
    volatile LAS unsigned* MISC;
    gu32* ctl;
    unsigned char* ws;
    int tid, lane, wave, G, bid;
    const float* in[34];
    float* out;
};
__device__ __forceinline__ float wave_sum(float v) {
#pragma unroll
    for (int o = 1; o < 64; o <<= 1) v += __shfl_xor(v, o);
    return v;
}
__device__ __forceinline__ float wave_max(float v) {
#pragma unroll
    for (int o = 1; o < 64; o <<= 1) v = fmaxf(v, __shfl_xor(v, o));
    return v;
}
__device__ __forceinline__ void p0_transpose_item(const float* W, int N, const float* gk, bf16* WT, int Kd, int k0, int n0, int drow, LAS float* scr, int lane) {
    float v[32];
#pragma unroll
    for (int i = 0; i < 32; ++i) { const int kk = 2 * i + (lane >> 5); v[i] = W[(size_t)(k0 + kk) * N + n0 + (lane & 31)]; }
    if (gk) {
#pragma unroll
        for (int i = 0; i < 32; ++i) { const int kk = 2 * i + (lane >> 5); v[i] *= gk[k0 + kk]; }
    }
#pragma unroll
    for (int i = 0; i < 32; ++i) { const int kk = 2 * i + (lane >> 5); scr[kk * 33 + (lane & 31)] = v[i]; }
    LDS_WAIT(); asm volatile("" ::: "memory");
    const int c = lane & 7;
#pragma unroll
    for (int j = 0; j < 4; ++j) { const int n = (lane >> 3) + 8 * j; const LAS float* s = scr + (8 * c) * 33 + n;
        u32x4 o; o.x = pk2(s[0 * 33], s[1 * 33]); o.y = pk2(s[2 * 33], s[3 * 33]); o.z = pk2(s[4 * 33], s[5 * 33]); o.w = pk2(s[6 * 33], s[7 * 33]);
        *(GAS u32x4*)(WT + (size_t)(drow + n) * Kd + k0 + 8 * c) = o; }
    LDS_WAIT(); asm volatile("" ::: "memory");
}
__device__ __forceinline__ void p0_transpose_item8(const float* W, int N, float scale, unsigned char* WT, int Kd, int k0, int n0, int drow, int lane) {
    const int g = lane >> 3, q = lane & 7;
    const GAS f32x4* src = (const GAS f32x4*)(W + (size_t)(k0 + 16 * g) * N + n0 + 4 * q);
    f32x4 v[16];
#pragma unroll
    for (int i = 0; i < 16; ++i) v[i] = src[(size_t)i * (N / 4)] * scale;
#pragma unroll
    for (int j = 0; j < 4; ++j) {
        u32x4 o; o.x = pk4_fp8(v[0][j], v[1][j], v[2][j], v[3][j]); o.y = pk4_fp8(v[4][j], v[5][j], v[6][j], v[7][j]);
        o.z = pk4_fp8(v[8][j], v[9][j], v[10][j], v[11][j]); o.w = pk4_fp8(v[12][j], v[13][j], v[14][j], v[15][j]);
        *(GAS u32x4*)(WT + (size_t)(drow + 4 * q + j) * Kd + k0 + 16 * g) = o; }
}
__device__ __forceinline__ void p0_transpose_item8(const float* W, int N, const float* gk, float scale, unsigned char* WT, int Kd, int k0, int n0, int lane) {
    const int g = lane >> 3, q = lane & 7;
    const GAS f32x4* src = (const GAS f32x4*)(W + (size_t)(k0 + 16 * g) * N + n0 + 4 * q);
    f32x4 v[16];
#pragma unroll
    for (int i = 0; i < 16; ++i) v[i] = src[(size_t)i * (N / 4)] * scale;
    if (gk) {
#pragma unroll
        for (int i4 = 0; i4 < 4; ++i4) { const f32x4 gg = *(const GAS f32x4*)(gk + k0 + 16 * g + 4 * i4);
#pragma unroll
            for (int i = 0; i < 4; ++i) v[4 * i4 + i] = v[4 * i4 + i] * gg[i]; } }
#pragma unroll
    for (int j = 0; j < 4; ++j) {
        u32x4 o; o.x = pk4_fp8(v[0][j], v[1][j], v[2][j], v[3][j]); o.y = pk4_fp8(v[4][j], v[5][j], v[6][j], v[7][j]);
        o.z = pk4_fp8(v[8][j], v[9][j], v[10][j], v[11][j]); o.w = pk4_fp8(v[12][j], v[13][j], v[14][j], v[15][j]);
        *(GAS u32x4*)(WT + (size_t)(n0 + 4 * q + j) * Kd + k0 + 16 * g) = o; }
}
__device__ __forceinline__ void rms_row_to_bf16(const float* xrow, const float* g, bf16* orow, int lane) {
    const GAS f32x4* xr = (const GAS f32x4*)xrow + lane; const GAS f32x4* gr = (const GAS f32x4*)g + lane;
    f32x4 v[4]; float s = 0.f;
#pragma unroll
    for (int j = 0; j < 4; ++j) { v[j] = xr[64 * j]; s += (v[j].x * v[j].x + v[j].y * v[j].y) + (v[j].z * v[j].z + v[j].w * v[j].w); }
    const float rstd = 1.f / sqrtf(wave_sum(s) * (1.f / D) + NORM_EPS);
    GAS unsigned long long* o8 = (GAS unsigned long long*)orow + lane;
#pragma unroll
    for (int j = 0; j < 4; ++j) { const f32x4 gg = gr[64 * j];
        o8[64 * j] = (unsigned long long)pk2(v[j].x * rstd * gg.x, v[j].y * rstd * gg.y) | ((unsigned long long)pk2(v[j].z * rstd * gg.z, v[j].w * rstd * gg.w) << 32); }
}
enum { I_X = 0, I_MEM, I_N1G, I_WIN, I_MU, I_W0, I_W2, I_A0, I_A2, I_G2, I_KK, I_KA, I_RK, I_LNG, I_LNB, I_LQ1, I_LK1, I_LQ2, I_LK2, I_SUBG, I_WOUT, I_N2G, I_MNG, I_WQ, I_WKV, I_WO, I_N3G,
       I_RW, I_RB, I_W1, I_B1, I_W2E, I_B2, I_FG };

__device__ __forceinline__ void p0_prologue(Frame& F) {
    LAS float* scr = (LAS float*)(F.lds + F.wave * 16384);
    const int gw = F.bid * NWAVES + F.wave, NGW = F.G * NWAVES;
    constexpr int I_IN = 16 * (IN_COLS / 32), I_SQ = 16 * 32, I_KV = 16 * 64, I_L64 = 1 * 16, I_L128 = 2 * 16, I_E1 = 16 * 64, I_E2 = 16 * 32;
    constexpr int I_S8 = 8 * 32;
    constexpr int NITEMS = I_IN + I_SQ + 2 * I_S8 + I_KV + 2 * I_L64 + I_L128;
    for (int it = gw; it < NITEMS; it += NGW) {
        int r = it;
        if (r < I_IN) { const int nb = IN_COLS / 32; p0_transpose_item(F.in[I_WIN], IN_COLS, nullptr, (bf16*)(F.ws + WS_WINT), D, 64 * (r / nb), 32 * (r % nb), 32 * (r % nb), scr, F.lane); continue; } r -= I_IN;
        if (r < I_SQ) { p0_transpose_item(F.in[I_WOUT], D, nullptr, (bf16*)(F.ws + WS_WOUTT), D, 64 * (r / 32), 32 * (r % 32), 32 * (r % 32), scr, F.lane); continue; } r -= I_SQ;
        if (r < I_S8) { p0_transpose_item8(F.in[I_WQ], D, F.in[I_N2G], F8_SW, F.ws + WS_WQT, D, 128 * (r / 32), 32 * (r % 32), F.lane); continue; } r -= I_S8;
        if (r < I_S8) { p0_transpose_item8(F.in[I_WO], D, nullptr, F8_SW, F.ws + WS_WOT, D, 128 * (r / 32), 32 * (r % 32), F.lane); continue; } r -= I_S8;
        if (r < I_KV) { p0_transpose_item(F.in[I_WKV], 2 * D, nullptr, (bf16*)(F.ws + WS_WKVT), D, 64 * (r / 64), 32 * (r % 64), 32 * (r % 64), scr, F.lane); continue; } r -= I_KV;
        if (r < I_L64) { p0_transpose_item(F.in[I_W2], RW, nullptr, (bf16*)(F.ws + WS_W2LT), 64, 0, 32 * r, 32 * r, scr, F.lane); continue; } r -= I_L64;
        if (r < I_L64) { p0_transpose_item(F.in[I_A2], RW, nullptr, (bf16*)(F.ws + WS_A2LT), 64, 0, 32 * r, 32 * r, scr, F.lane); continue; } r -= I_L64;
        p0_transpose_item(F.in[I_G2], RW, nullptr, (bf16*)(F.ws + WS_G2LT), 128, 64 * (r / 16), 32 * (r % 16), 32 * (r % 16), scr, F.lane);
    }
    for (int m = gw; m < M; m += NGW) rms_row_to_bf16(F.in[I_X] + (size_t)m * D, F.in[I_N1G], (bf16*)(F.ws + WS_XN) + (size_t)m * D, F.lane);
    for (int m = gw; m < BATCH * MEM; m += NGW) rms_row_to_bf16(F.in[I_MEM] + (size_t)m * D, F.in[I_MNG], (bf16*)(F.ws + WS_MEMN) + (size_t)m * D, F.lane);
    { float* rwt = (float*)(F.ws + WS_RWT); const int gt = F.bid * NTHR + F.tid;
      for (int i = gt; i < NE * D; i += F.G * NTHR) { const int e = i / D, k = i % D; rwt[i] = F.in[I_RW][k * NE + e] * F.in[I_N3G][k]; } }
}

__device__ __forceinline__ void p0_experts(Frame& F, int wg0) {
    constexpr int I_E1 = 8 * 64, I_E2 = 8 * 32;
    const int gw = (F.bid - wg0) * NWAVES + F.wave, NGW = (F.G - wg0) * NWAVES;
    for (int it = gw; it < NE * (I_E1 + I_E2); it += NGW) {
        const int e = it / (I_E1 + I_E2); int r = it - e * (I_E1 + I_E2);
        if (r < I_E1) {
            const int n0 = 32 * (r % 64), k0 = 128 * (r / 64); const int nn = n0 < FF ? n0 : n0 - FF; const int drow = 256 * (nn / 128) + (n0 < FF ? 0 : 128) + (nn % 128);
            p0_transpose_item8(F.in[I_W1] + (size_t)e * D * 2 * FF, 2 * FF, F8_SW, F.ws + WS_W1T + (size_t)e * 2 * FF * D, D, k0, n0, drow, F.lane);
        } else { r -= I_E1;
            p0_transpose_item8(F.in[I_W2E] + (size_t)e * FF * D, D, F8_SW, F.ws + WS_W2T + (size_t)e * D * FF, FF, 128 * (r / 32), 32 * (r % 32), 32 * (r % 32), F.lane);
        }
    }
}
template <int NMAP, int DQK, int DVV, int NBUF, int PF>
struct AttnBody {
    static constexpr int KROW = DQK * 2, VROW = 128, KCH = DQK / 8;
    static constexpr int KT_BYTES = NMAP * 64 * KROW, VT_BYTES = DVV * VROW, BUF_BYTES = KT_BYTES + VT_BYTES;
    static constexpr int NPK = KT_BYTES / (16 * NTHR), NPV = VT_BYTES / (16 * NTHR), NDMA = NPK + NPV;
    static constexpr int NKS = DQK / 32, NDT = DVV / 16, KB = NKS < 4 ? NKS : 4;
    static_assert(NBUF * BUF_BYTES <= RING_BYTES + 24576, "attention ring exceeds LDS");
    static_assert(NDMA * (NBUF - 1) <= 48 && NBUF >= 2, "vmcnt range; a ring needs two slots");

    __device__ __forceinline__ void dma_tile(LAS unsigned char* slot, const bf16* Kp, int ldk, const bf16* VTp, int ldvt, int key0, int tid, int wave) const {
        asm volatile("" : "+v"(tid));
#pragma unroll
        for (int i = 0; i < NPK; ++i) { const int p = tid + NTHR * i, row = p / KCH, sl = p % KCH, ch = sl ^ ksw(row), mp = row >> 6, key = row & 63;
            __builtin_amdgcn_global_load_lds((const unsigned*)(Kp + (unsigned)((key0 + key) * ldk + mp * DQK + ch * 8)), (LAS unsigned*)(slot + (i * NTHR + wave * 64) * 16), 16, 0, 0); }
#pragma unroll
        for (int i = 0; i < NPV; ++i) { const int p = tid + NTHR * i, dv = p >> 3, sl = p & 7, ch = sl ^ vsw(dv);
            __builtin_amdgcn_global_load_lds((const unsigned*)(VTp + (unsigned)(dv * ldvt + key0 + ch * 8)), (LAS unsigned*)(slot + KT_BYTES + (i * NTHR + wave * 64) * 16), 16, 0, 0); }
    }
    __device__ __forceinline__ static int ksw(int row) { return KCH == 8 ? ((row & 3) | (((row >> 3) & 1) << 2)) : (((row & 1) * 3) | (((row >> 1) & 1) << 2) | (((row >> 3) & 1) << 3)); }
    __device__ __forceinline__ static int vsw(int dv) { return dv & 7; }
    __device__ __forceinline__ static int vt_off(int dv, int ch) { return KT_BYTES + dv * VROW + ((ch ^ vsw(dv)) << 4); }
    __device__ __forceinline__ static int k_off(int row, int ch) { return row * KROW + ((ch ^ ksw(row)) << 4); }
    __device__ __forceinline__ static int sigma(int t4, int m) { return 32 * (t4 >> 1) + 8 * (m >> 2) + 4 * (t4 & 1) + (m & 3); }
    static constexpr int NKB = NKS < 4 ? NKS : 4;
    struct Offs { int kb[NKB]; int vb[2]; };
    __device__ __forceinline__ static Offs make_offs(int lq, int g) { Offs o; const int r0 = 8 * (lq >> 2) + (lq & 3);
#pragma unroll
        for (int j = 0; j < NKB; ++j) o.kb[j] = k_off(r0, 4 * j + g);
        o.vb[0] = vt_off(lq, g); o.vb[1] = vt_off(lq, 4 + g); return o; }

    __device__ __forceinline__ void pv_tile(const LAS unsigned char* buf, bf16x8 (&vf)[PF], const bf16x8 (&pf)[NMAP][2], f32x4 (&o)[NMAP][NDT], const Offs& of) {
#pragma unroll
        for (int f0 = 0; f0 < 2 * NDT; f0 += PF) {
            bf16x8 vn[PF];
            if (f0 + PF < 2 * NDT) {
#pragma unroll
                for (int f = 0; f < PF; ++f) { const int dt = (f0 + PF + f) >> 1, mb = (f0 + PF + f) & 1; vn[f] = *(const LAS bf16x8*)(buf + of.vb[mb] + dt * 16 * VROW); }
            }
#pragma unroll
            for (int f = 0; f < PF; ++f) { const int dt = (f0 + f) >> 1, mb = (f0 + f) & 1;
#pragma unroll
                for (int c = 0; c < NMAP; ++c) o[c][dt] = __builtin_amdgcn_mfma_f32_16x16x32_bf16(vf[f], pf[c][mb], o[c][dt], 0, 0, 0); }
            if (f0 + PF < 2 * NDT) {
#pragma unroll
                for (int f = 0; f < PF; ++f) vf[f] = vn[f];
            }
        }
    }
    __device__ __forceinline__ void vf_first(const LAS unsigned char* buf, bf16x8 (&vf)[PF], const Offs& of) {
#pragma unroll
        for (int f = 0; f < PF; ++f) { const int dt = f >> 1, mb = f & 1; vf[f] = *(const LAS bf16x8*)(buf + of.vb[mb] + dt * 16 * VROW); }
    }
    __device__ __forceinline__ void s_tile(const LAS unsigned char* buf, const bf16x8 (&qf)[NMAP][NKS], float (&mrun)[NMAP], f32x4 (&ol)[NMAP], f32x4 (&o)[NMAP][NDT], bf16x8 (&pf)[NMAP][2], const Offs& of, bool first) {
        constexpr float THR = 8.0f;
        f32x4 s[NMAP][4];
#pragma unroll
        for (int c = 0; c < NMAP; ++c) { const float mi = first ? 0.f : -mrun[c];
#pragma unroll
            for (int t4 = 0; t4 < 4; ++t4) { s[c][t4] = (f32x4){mi, mi, mi, mi};
#pragma unroll
                for (int k0 = 0; k0 < NKS; k0 += KB) { bf16x8 kf[KB];
#pragma unroll
                    for (int ks = 0; ks < KB; ++ks) kf[ks] = *(const LAS bf16x8*)(buf + of.kb[(k0 + ks) & (NKB - 1)] + ((c * 64 + 32 * (t4 >> 1) + 4 * (t4 & 1)) * KROW + ((k0 + ks) / NKB) * NKB * 64));
#pragma unroll
                    for (int ks = 0; ks < KB; ++ks) s[c][t4] = __builtin_amdgcn_mfma_f32_16x16x32_bf16(kf[ks], qf[c][k0 + ks], s[c][t4], 0, 0, 0); } } }
#pragma unroll
        for (int c = 0; c < NMAP; ++c) {
            float mx = __builtin_fmaxf(__builtin_fmaxf(s[c][0][0], s[c][0][1]), s[c][0][2]);
#pragma unroll
            for (int t4 = 0; t4 < 4; ++t4) { if (t4 > 0) mx = __builtin_fmaxf(__builtin_fmaxf(mx, s[c][t4][0]), s[c][t4][1]); mx = __builtin_fmaxf(__builtin_fmaxf(mx, s[c][t4][2]), s[c][t4][3]); }
            { const auto r1 = __builtin_amdgcn_permlane16_swap(__float_as_uint(mx), __float_as_uint(mx), false, false); mx = fmaxf(__uint_as_float(r1[0]), __uint_as_float(r1[1]));
              const auto r2 = __builtin_amdgcn_permlane32_swap(__float_as_uint(mx), __float_as_uint(mx), false, false); mx = fmaxf(__uint_as_float(r2[0]), __uint_as_float(r2[1])); }
            if (first) {
                mrun[c] = mx;
#pragma unroll
                for (int t4 = 0; t4 < 4; ++t4) s[c][t4] = s[c][t4] - mx;
            } else if (__any(mx > THR)) {
                const float d = mx > THR ? mx : 0.f, alpha = fexp2(-d); mrun[c] += d; ol[c] = ol[c] * alpha;
#pragma unroll
                for (int dt = 0; dt < NDT; ++dt) o[c][dt] = o[c][dt] * alpha;
#pragma unroll
                for (int t4 = 0; t4 < 4; ++t4) s[c][t4] = s[c][t4] - d;
            }
#pragma unroll
            for (int t4 = 0; t4 < 4; ++t4)
#pragma unroll
                for (int i = 0; i < 4; ++i) s[c][t4][i] = fexp2(s[c][t4][i]);
#pragma unroll
            for (int mb = 0; mb < 2; ++mb) { u32x4 w; w.x = cvt_pk_bf16(s[c][2 * mb][0], s[c][2 * mb][1]); w.y = cvt_pk_bf16(s[c][2 * mb][2], s[c][2 * mb][3]);
                w.z = cvt_pk_bf16(s[c][2 * mb + 1][0], s[c][2 * mb + 1][1]); w.w = cvt_pk_bf16(s[c][2 * mb + 1][2], s[c][2 * mb + 1][3]); pf[c][mb] = __builtin_bit_cast(bf16x8, w); }
            const bf16x8 ones = (bf16x8){0x3F80, 0x3F80, 0x3F80, 0x3F80, 0x3F80, 0x3F80, 0x3F80, 0x3F80};
            ol[c] = __builtin_amdgcn_mfma_f32_16x16x32_bf16(ones, pf[c][0], ol[c], 0, 0, 0); ol[c] = __builtin_amdgcn_mfma_f32_16x16x32_bf16(ones, pf[c][1], ol[c], 0, 0, 0);
        }
    }

    __device__ __forceinline__ void run(LAS unsigned char* lds, const bf16* Qp, int ldq, float qscale, const bf16* Kp, int ldk, const bf16* VTp, int ldvt, int nkt, int nkt_w, bool late,
                                        f32x4 (&o)[NMAP][NDT], float (&lsum)[NMAP], int tid, int lane) {
        const int g = lane >> 4, lq = lane & 15;
        bf16x8 qf[NMAP][NKS];
#pragma unroll
        for (int c = 0; c < NMAP; ++c)
#pragma unroll
            for (int ks = 0; ks < NKS; ++ks) { const u32x4 raw = *(const GAS u32x4*)(Qp + (size_t)lq * ldq + c * DQK + ks * 32 + g * 8);
                u32x4 w = raw;
                if (qscale != 1.0f) { w.x = cvt_pk_bf16(bflo(raw.x) * qscale, bfhi(raw.x) * qscale); w.y = cvt_pk_bf16(bflo(raw.y) * qscale, bfhi(raw.y) * qscale);
                                      w.z = cvt_pk_bf16(bflo(raw.z) * qscale, bfhi(raw.z) * qscale); w.w = cvt_pk_bf16(bflo(raw.w) * qscale, bfhi(raw.w) * qscale); }
                qf[c][ks] = __builtin_bit_cast(bf16x8, w); }
        float mrun[NMAP]; f32x4 ol[NMAP];
#pragma unroll
        for (int c = 0; c < NMAP; ++c) { mrun[c] = -INFINITY; ol[c] = (f32x4){0.f, 0.f, 0.f, 0.f};
#pragma unroll
            for (int dt = 0; dt < NDT; ++dt) o[c][dt] = (f32x4){0.f, 0.f, 0.f, 0.f}; }
        bf16x8 pfp[NMAP][2];
#pragma unroll
        for (int c = 0; c < NMAP; ++c) { pfp[c][0] = (bf16x8){0, 0, 0, 0, 0, 0, 0, 0}; pfp[c][1] = pfp[c][0]; }

        const int wave = __builtin_amdgcn_readfirstlane(tid >> 6);
        const Offs of = make_offs(lq, g);
#pragma unroll
        for (int j = 0; j < NBUF - 1; ++j) if (j < nkt) dma_tile(lds + j * BUF_BYTES, Kp, ldk, VTp, ldvt, j * 64, tid, wave);
        int bi = 0;
        for (int kt = 0; kt < nkt; ++kt) {
            LAS unsigned char* buf = lds + bi * BUF_BYTES;
            { const int ahead = (nkt - 1 - kt) < (NBUF - 2) ? (nkt - 1 - kt) : (NBUF - 2);
              if (ahead >= 1 && NBUF > 2) asm volatile("s_waitcnt vmcnt(%0)" :: "n"(NDMA) : "memory"); else asm volatile("s_waitcnt vmcnt(0)" ::: "memory"); }
            __builtin_amdgcn_s_barrier(); asm volatile("" ::: "memory");
            if (kt < nkt_w) { bf16x8 vf[PF]; s_tile(buf, qf, mrun, ol, o, pfp, of, kt == 0); vf_first(buf, vf, of);
                { const int kn = kt + NBUF - 1; if (kn < nkt) { const int bn = (bi == 0) ? NBUF - 1 : bi - 1; dma_tile(lds + bn * BUF_BYTES, Kp, ldk, VTp, ldvt, kn * 64, tid, wave); } }
                pv_tile(buf, vf, pfp, o, of); }
            else { const int kn = kt + NBUF - 1; if (kn < nkt) { const int bn = (bi == 0) ? NBUF - 1 : bi - 1; dma_tile(lds + bn * BUF_BYTES, Kp, ldk, VTp, ldvt, kn * 64, tid, wave); } }
            bi = (bi + 1 == NBUF) ? 0 : bi + 1;
        }
        asm volatile("s_waitcnt lgkmcnt(0)" ::: "memory"); __builtin_amdgcn_s_barrier(); asm volatile("" ::: "memory");
#pragma unroll
        for (int c = 0; c < NMAP; ++c) lsum[c] = ol[c][0];
    }
};
typedef float f32x16 __attribute__((ext_vector_type(16)));
struct DiffBody32 {
    static constexpr int KT_BYTES = 2 * 64 * 128, VT_BYTES = 128 * 128, BUF_BYTES = KT_BYTES + VT_BYTES, NBUF = 3, NDMA = 4;
    __device__ __forceinline__ static int swz(int row) { return (row >> 1) & 7; }
    __device__ __forceinline__ static int sigma(int rho) { return 16 * (rho >> 4) + 8 * ((rho >> 2) & 1) + 4 * ((rho >> 3) & 1) + (rho & 3); }
    __device__ __forceinline__ void dma_tile(LAS unsigned char* slot, const bf16* Kp, int ldk, const bf16* VTp, int ldvt, int key0, int tid, int wave) const {
        asm volatile("" : "+v"(tid));
#pragma unroll
        for (int i = 0; i < 2; ++i) { const int p = tid + NTHR * i, row = p >> 3, sl = p & 7, ch = sl ^ swz(row), mp = row >> 6, key = row & 63;
            __builtin_amdgcn_global_load_lds((const unsigned*)(Kp + (unsigned)((key0 + key) * ldk + mp * 64 + ch * 8)), (LAS unsigned*)(slot + (i * NTHR + wave * 64) * 16), 16, 0, 0); }
#pragma unroll
        for (int i = 0; i < 2; ++i) { const int p = tid + NTHR * i, dv = p >> 3, sl = p & 7, ch = sl ^ swz(dv);
            __builtin_amdgcn_global_load_lds((const unsigned*)(VTp + (unsigned)(dv * ldvt + key0 + ch * 8)), (LAS unsigned*)(slot + KT_BYTES + (i * NTHR + wave * 64) * 16), 16, 0, 0); }
    }
    __device__ __forceinline__ void run(LAS unsigned char* lds, const bf16* Qp  , int ldq, float qscale, const bf16* Kp, int ldk, const bf16* VTp, int ldvt,
                                        int nkt, int nkt_w, int c, f32x16 (&o)[4], float& lsum, int tid, int lane) {
        const int r = lane & 31, h = lane >> 5, wave = __builtin_amdgcn_readfirstlane(tid >> 6);
        bf16x8 qf[4];
#pragma unroll
        for (int ks = 0; ks < 4; ++ks) { const u32x4 raw = *(const GAS u32x4*)(Qp + (size_t)r * ldq + ks * 16 + h * 8); u32x4 w;
            w.x = cvt_pk_bf16(bflo(raw.x) * qscale, bfhi(raw.x) * qscale); w.y = cvt_pk_bf16(bflo(raw.y) * qscale, bfhi(raw.y) * qscale);
            w.z = cvt_pk_bf16(bflo(raw.z) * qscale, bfhi(raw.z) * qscale); w.w = cvt_pk_bf16(bflo(raw.w) * qscale, bfhi(raw.w) * qscale); qf[ks] = __builtin_bit_cast(bf16x8, w); }
        int kof[4], vof[4];
        { const int kr = sigma(r);
#pragma unroll
          for (int ks = 0; ks < 4; ++ks) kof[ks] = kr * 128 + (((2 * ks + h) ^ swz(kr)) << 4);
#pragma unroll
          for (int f = 0; f < 4; ++f) vof[f] = KT_BYTES + r * 128 + (((2 * f + h) ^ swz(r)) << 4); }
        float mrun = -INFINITY, ls = 0.f;
#pragma unroll
        for (int db = 0; db < 4; ++db)
#pragma unroll
            for (int i = 0; i < 16; ++i) o[db][i] = 0.f;
#pragma unroll
        for (int j = 0; j < NBUF - 1; ++j) if (j < nkt) dma_tile(lds + j * BUF_BYTES, Kp, ldk, VTp, ldvt, j * 64, tid, wave);
        int bi = 0;
        for (int kt = 0; kt < nkt; ++kt) {
            const LAS unsigned char* buf = lds + bi * BUF_BYTES;
            { const int ahead = (nkt - 1 - kt) < 1 ? (nkt - 1 - kt) : 1;
              if (ahead >= 1) asm volatile("s_waitcnt vmcnt(%0)" :: "n"(NDMA) : "memory"); else asm volatile("s_waitcnt vmcnt(0)" ::: "memory"); }
            __builtin_amdgcn_s_barrier(); asm volatile("" ::: "memory");
            const int kn = kt + NBUF - 1; const int bn = (bi == 0) ? NBUF - 1 : bi - 1;
            if (kt < nkt_w) {
                constexpr float THR = 8.0f; const bool first = (kt == 0);
                f32x16 s[2];
                { const float mi = first ? 0.f : -mrun;
#pragma unroll
                  for (int kb = 0; kb < 2; ++kb) {
#pragma unroll
                      for (int i = 0; i < 16; ++i) s[kb][i] = mi;
                      bf16x8 kf[4];
#pragma unroll
                      for (int ks = 0; ks < 4; ++ks) kf[ks] = *(const LAS bf16x8*)(buf + kof[ks] + (c * 64 + 32 * kb) * 128);
#pragma unroll
                      for (int ks = 0; ks < 4; ++ks) s[kb] = __builtin_amdgcn_mfma_f32_32x32x16_bf16(kf[ks], qf[ks], s[kb], 0, 0, 0); } }
                float mx = __builtin_fmaxf(__builtin_fmaxf(s[0][0], s[0][1]), s[0][2]);
#pragma unroll
                for (int kb = 0; kb < 2; ++kb)
#pragma unroll
                    for (int i = (kb == 0 ? 3 : 0); i + 1 < 16; i += 2) mx = __builtin_fmaxf(__builtin_fmaxf(mx, s[kb][i]), s[kb][i + 1]);
                mx = fmaxf(mx, s[0][15]); mx = fmaxf(mx, s[1][15] > s[1][14] ? s[1][15] : s[1][14]);
                { const auto r2 = __builtin_amdgcn_permlane32_swap(__float_as_uint(mx), __float_as_uint(mx), false, false); mx = fmaxf(__uint_as_float(r2[0]), __uint_as_float(r2[1])); }
                if (first) { mrun = mx; s[0] = s[0] - mx; s[1] = s[1] - mx; }
                else if (__any(mx > THR)) { const float d = mx > THR ? mx : 0.f, alpha = fexp2(-d); mrun += d; ls *= alpha;
#pragma unroll
                    for (int db = 0; db < 4; ++db) o[db] = o[db] * alpha;
                    s[0] = s[0] - d; s[1] = s[1] - d; }
                float ps = 0.f;
#pragma unroll
                for (int kb = 0; kb < 2; ++kb)
#pragma unroll
                    for (int i = 0; i < 16; ++i) { s[kb][i] = fexp2(s[kb][i]); ps += s[kb][i]; }
                ls += ps;
                bf16x8 pf[4];
#pragma unroll
                for (int f = 0; f < 4; ++f) { const int kb = f >> 1, s8 = 8 * (f & 1); u32x4 w;
                    w.x = cvt_pk_bf16(s[kb][s8 + 0], s[kb][s8 + 1]); w.y = cvt_pk_bf16(s[kb][s8 + 2], s[kb][s8 + 3]); w.z = cvt_pk_bf16(s[kb][s8 + 4], s[kb][s8 + 5]); w.w = cvt_pk_bf16(s[kb][s8 + 6], s[kb][s8 + 7]);
                    pf[f] = __builtin_bit_cast(bf16x8, w); }
                bf16x8 vf[4][4];
#pragma unroll
                for (int f = 0; f < 4; ++f) vf[0][f] = *(const LAS bf16x8*)(buf + vof[f]);
                if (kn < nkt) dma_tile(lds + bn * BUF_BYTES, Kp, ldk, VTp, ldvt, kn * 64, tid, wave);
#pragma unroll
                for (int db = 0; db < 4; ++db) {
                    if (db + 1 < 4) {
#pragma unroll
                        for (int f = 0; f < 4; ++f) vf[db + 1][f] = *(const LAS bf16x8*)(buf + vof[f] + (db + 1) * 32 * 128);
                    }
#pragma unroll
                    for (int f = 0; f < 4; ++f) o[db] = __builtin_amdgcn_mfma_f32_32x32x16_bf16(vf[db][f], pf[f], o[db], 0, 0, 0); }
            } else if (kn < nkt) dma_tile(lds + bn * BUF_BYTES, Kp, ldk, VTp, ldvt, kn * 64, tid, wave);
            bi = (bi + 1 == NBUF) ? 0 : bi + 1;
        }
        asm volatile("s_waitcnt lgkmcnt(0)" ::: "memory"); __builtin_amdgcn_s_barrier(); asm volatile("" ::: "memory");
        { const auto r2 = __builtin_amdgcn_permlane32_swap(__float_as_uint(ls), __float_as_uint(ls), false, false); lsum = __uint_as_float(r2[0]) + __uint_as_float(r2[1]); }
    }
};
constexpr int ATTN_MAXU = 2;
__constant__ unsigned short attn_tab[256][ATTN_MAXU] = {
{34,17},
{98,81},
{162,145},
{226,209},
{290,273},
{354,337},
{418,401},
{482,465},
{33,19},
{97,83},
{161,147},
{225,211},
{289,275},
{353,339},
{417,403},
{481,467},
{31,20},
{95,84},
{159,148},
{223,212},
{287,276},
{351,340},
{415,404},
{479,468},
{50,1},
{114,65},
{178,129},
{242,193},
{306,257},
{370,321},
{434,385},
{498,449},
{52,0},
{116,64},
{180,128},
{244,192},
{308,256},
{372,320},
{436,384},
{500,448},
{36,15},
{100,79},
{164,143},
{228,207},
{292,271},
{356,335},
{420,399},
{484,463},
{49,2},
{113,66},
{177,130},
{241,194},
{305,258},
{369,322},
{433,386},
{497,450},
{47,5},
{111,69},
{175,133},
{239,197},
{303,261},
{367,325},
{431,389},
{495,453},
{39,28},
{103,92},
{167,156},
{231,220},
{295,284},
{359,348},
{423,412},
{487,476},
{57,10},
{121,74},
{185,138},
{249,202},
{313,266},
{377,330},
{441,394},
{505,458},
{45,22},
{109,86},
{173,150},
{237,214},
{301,278},
{365,342},
{429,406},
{493,470},
{40,27},
{104,91},
{168,155},
{232,219},
{296,283},
{360,347},
{424,411},
{488,475},
{54,13},
{118,77},
{182,141},
{246,205},
{310,269},
{374,333},
{438,397},
{502,461},
{44,23},
{108,87},
{172,151},
{236,215},
{300,279},
{364,343},
{428,407},
{492,471},
{35,32},
{99,96},
{163,160},
{227,224},
{291,288},
{355,352},
{419,416},
{483,480},
{58,9},
{122,73},
{186,137},
{250,201},
{314,265},
{378,329},
{442,393},
{506,457},
{37,30},
{101,94},
{165,158},
{229,222},
{293,286},
{357,350},
{421,414},
{485,478},
{59,8},
{123,72},
{187,136},
{251,200},
{315,264},
{379,328},
{443,392},
{507,456},
{55,12},
{119,76},
{183,140},
{247,204},
{311,268},
{375,332},
{439,396},
{503,460},
{53,14},
{117,78},
{181,142},
{245,206},
{309,270},
{373,334},
{437,398},
{501,462},
{43,24},
{107,88},
{171,152},
{235,216},
{299,280},
{363,344},
{427,408},
{491,472},
{61,6},
{125,70},
{189,134},
{253,198},
{317,262},
{381,326},
{445,390},
{509,454},
{38,29},
{102,93},
{166,157},
{230,221},
{294,285},
{358,349},
{422,413},
{486,477},
{60,7},
{124,71},
{188,135},
{252,199},
{316,263},
{380,327},
{444,391},
{508,455},
{62,4},
{126,68},
{190,132},
{254,196},
{318,260},
{382,324},
{446,388},
{510,452},
{56,11},
{120,75},
{184,139},
{248,203},
{312,267},
{376,331},
{440,395},
{504,459},
{48,18},
{112,82},
{176,146},
{240,210},
{304,274},
{368,338},
{432,402},
{496,466},
{41,26},
{105,90},
{169,154},
{233,218},
{297,282},
{361,346},
{425,410},
{489,474},
{42,25},
{106,89},
{170,153},
{234,217},
{298,281},
{362,345},
{426,409},
{490,473},
{51,16},
{115,80},
{179,144},
{243,208},
{307,272},
{371,336},
{435,400},
{499,464},
{63,3},
{127,67},
{191,131},
{255,195},
{319,259},
{383,323},
{447,387},
{511,451},
{46,21},
{110,85},
{174,149},
{238,213},
{302,277},
{366,341},
{430,405},
{494,469}};
namespace rk {
constexpr int MS = 144;
constexpr int MB = 64 * MS;
constexpr int O_AB = 0 * MB, O_BB = 1 * MB, O_KB = 2 * MB, O_RB = 3 * MB, O_ABT = 4 * MB, O_VTT = 5 * MB, O_BTT = 6 * MB, O_KTT = 7 * MB, O_AAK = 8 * MB, O_ARB = 9 * MB, O_ARK = 10 * MB;
constexpr int O_TM = O_KB, O_GT = O_AB, O_WTT = O_BB, O_UTT = O_AAK;
constexpr int FS = 66;
constexpr int O_LF = 11 * MB, O_TF = 0;
constexpr int O_LA = O_LF + 64 * FS * 4;
static_assert(O_LA + MB <= RING_BYTES && 64 * FS * 4 <= 2 * MB, "rwkv LDS map");
constexpr int O_LW = X_OFF, O_LG = X_OFF + MB, LGS = 272, O_NRM = O_LG + 64 * LGS, O_BSP = O_NRM + 512, O_C63 = O_BSP + 512;
static_assert(O_C63 + 1024 <= MISC_OFF, "rwkv LDS extras");

template <int NKS>
__device__ __forceinline__ f32x4 mm_tile(const LAS unsigned char* A, int astr, int tr, const LAS unsigned char* B, int bstr, int tc, f32x4 acc, int lq, int g) {
#pragma unroll
    for (int ks = 0; ks < NKS; ++ks) {
        const bf16x8 a = *(const LAS bf16x8*)(A + (16 * tr + lq) * astr + (32 * ks + 8 * g) * 2);
        const bf16x8 b = *(const LAS bf16x8*)(B + (16 * tc + lq) * bstr + (32 * ks + 8 * g) * 2);
        acc = __builtin_amdgcn_mfma_f32_16x16x32_bf16(a, b, acc, 0, 0, 0); }
    return acc;
}
template <int NKS>
__device__ __forceinline__ f32x4 mm_tile_gb(const LAS unsigned char* A, int astr, int tr, const bf16* Bg, int ldb, f32x4 acc, int lq, int g) {
#pragma unroll
    for (int ks = 0; ks < NKS; ++ks) {
        const bf16x8 a = *(const LAS bf16x8*)(A + (16 * tr + lq) * astr + (32 * ks + 8 * g) * 2);
        const bf16x8 b = *(const GAS bf16x8*)(Bg + (size_t)lq * ldb + 32 * ks + 8 * g);
        acc = __builtin_amdgcn_mfma_f32_16x16x32_bf16(a, b, acc, 0, 0, 0); }
    return acc;
}
__device__ __forceinline__ void st_nat(LAS unsigned char* Mx, int t0, int col, const f32x4& v) {
#pragma unroll
    for (int i = 0; i < 4; ++i) *(LAS bf16*)(Mx + (t0 + i) * MS + col * 2) = (bf16)f2bf(v[i]);
}
__device__ __forceinline__ void st_tr(LAS unsigned char* Mx, int t0, int col, const f32x4& v) {
    u32x2 w; w.x = cvt_pk_bf16(v[0], v[1]); w.y = cvt_pk_bf16(v[2], v[3]); *(LAS u32x2*)(Mx + col * MS + t0 * 2) = w;
}

__device__ __forceinline__ void tri_inverse(const LAS float* L, LAS float* Tm, int lane) {
    const int g = lane >> 4, lq = lane & 15;
    {
        float x[16];
#pragma unroll
        for (int r = 0; r < 16; ++r) { float a = (r == lq) ? 1.f : 0.f;
#pragma unroll
            for (int s = 0; s < r; ++s) a += L[(16 * g + r) * FS + 16 * g + s] * x[s];
            x[r] = a; }
#pragma unroll
        for (int r = 0; r < 16; ++r) Tm[(16 * g + r) * FS + 16 * g + lq] = x[r];
    }
#pragma unroll
    for (int d = 1; d < 4; ++d)
#pragma unroll
        for (int i = d; i < 4; ++i) { const int j = i - d;
            f32x4 X = (f32x4){0.f, 0.f, 0.f, 0.f};
#pragma unroll
            for (int m = j; m < i; ++m)
#pragma unroll
                for (int kq = 0; kq < 4; ++kq) X = __builtin_amdgcn_mfma_f32_16x16x4f32(L[(16 * i + lq) * FS + 16 * m + 4 * kq + g], Tm[(16 * m + 4 * kq + g) * FS + 16 * j + lq], X, 0, 0, 0);
            f32x4 R = (f32x4){0.f, 0.f, 0.f, 0.f};
#pragma unroll
            for (int kk = 0; kk < 4; ++kk) R = __builtin_amdgcn_mfma_f32_16x16x4f32(Tm[(16 * i + lq) * FS + 16 * i + 4 * g + kk], X[kk], R, 0, 0, 0);
#pragma unroll
            for (int q = 0; q < 4; ++q) Tm[(16 * i + 4 * g + q) * FS + 16 * j + lq] = R[q];
        }
}

__device__ __forceinline__ void tri_inverse_simple(const LAS float* L, LAS float* Tm, int lane) {
#pragma unroll 1
    for (int t = 0; t < 64; ++t) { float a = (t == lane) ? 1.f : 0.f;
#pragma unroll 1
        for (int s = 0; s < t; ++s) a += L[t * FS + s] * Tm[s * FS + lane];
        Tm[t * FS + lane] = a; }
}
__device__ __forceinline__ float mixf(unsigned short cur, unsigned short prev, float mu) { const float c = bf2f(cur), p = bf2f(prev); return c + (p - c) * mu; }

__device__ __forceinline__ void phase_a(Frame& F, int b, int c) {
    LAS unsigned char* lds = F.lds;
    const int tid = F.tid, lane = F.lane, w = F.wave, g = lane >> 4, lq = lane & 15;
    const bf16* PROJ = (const bf16*)(F.ws + WS_PROJ);
    const int n0 = b * T + c * CH;
    const bool first = (c == 0);
    const float* mu = F.in[I_MU]; bf16* GATEp = (bf16*)(F.ws + WS_GATE);
    {
        const int t = tid >> 3, c0 = (tid & 7) * 32; const unsigned oc = (unsigned)(n0 + t) * PCOLS + C_WD + c0; const bool hasp = !(first && t == 0); const unsigned op = hasp ? oc - PCOLS : oc; const float* mup = mu + C_WD + c0;
#pragma unroll
        for (int q = 0; q < 4; ++q) {
            const u32x4 cu = *(const GAS u32x4*)(PROJ + (oc + q * 8)); u32x4 pv = *(const GAS u32x4*)(PROJ + (op + q * 8)); if (!hasp) pv = (u32x4){0u, 0u, 0u, 0u};
            const f32x4 m0 = *(const GAS f32x4*)(mup + q * 8), m1 = *(const GAS f32x4*)(mup + q * 8 + 4);
            float o[8];
#pragma unroll
            for (int k = 0; k < 4; ++k) { const unsigned cw = cu[k], pw = pv[k];
                const float x0 = bflo(cw) + (bflo(pw) - bflo(cw)) * (k < 2 ? m0[2 * k] : m1[2 * k - 4]), x1 = bfhi(cw) + (bfhi(pw) - bfhi(cw)) * (k < 2 ? m0[2 * k + 1] : m1[2 * k - 3]);
                if (c0 < 64) { o[2 * k] = 1.f - 2.f * frcp(fexp(2.f * x0) + 1.f); o[2 * k + 1] = 1.f - 2.f * frcp(fexp(2.f * x1) + 1.f); }
                else if (c0 < 128) { o[2 * k] = x0; o[2 * k + 1] = x1; }
                else { o[2 * k] = sigmoidf_(x0); o[2 * k + 1] = sigmoidf_(x1); } }
            u32x4 wv; wv.x = cvt_pk_bf16(o[0], o[1]); wv.y = cvt_pk_bf16(o[2], o[3]); wv.z = cvt_pk_bf16(o[4], o[5]); wv.w = cvt_pk_bf16(o[6], o[7]);
            LAS unsigned char* dst = (c0 < 64) ? lds + O_LW + t * MS + (c0 + q * 8) * 2 : (c0 < 128) ? lds + O_LA + t * MS + (c0 - 64 + q * 8) * 2 : lds + O_LG + t * LGS + (c0 - 128 + q * 8) * 2;
            *(LAS u32x4*)dst = wv; }
    }
    __syncthreads();
    const int tr = w >> 1, tcb = 2 * (w & 1);
    LAS float* EF = (LAS float*)(lds + O_LF);
    LAS float* NRM = (LAS float*)(lds + O_NRM); LAS float* BSP = (LAS float*)(lds + O_BSP); LAS float* TT = (LAS float*)(lds + O_C63);
#pragma unroll 1
    for (int h = 0; h < RH; ++h) {
        const int item = (b * RH + h) * NCHUNK + c;
        float ev[2][4], av[2][4], rv[2][4], kv[2][4], vv[2][4], kkr[2][4];
        float nrm_p[4] = {0.f, 0.f, 0.f, 0.f};
#pragma unroll
        for (int x = 0; x < 2; ++x) { const int tc = tcb + x, hj = h * RN + 16 * tc + lq;
            f32x4 wl = (f32x4){0.f, 0.f, 0.f, 0.f}, al = wl, gl = wl;
            wl = mm_tile_gb<2>(lds + O_LW, MS, tr, (const bf16*)(F.ws + WS_W2LT) + (size_t)(h * RN + 16 * tc) * 64, 64, wl, lq, g);
            al = mm_tile_gb<2>(lds + O_LA, MS, tr, (const bf16*)(F.ws + WS_A2LT) + (size_t)(h * RN + 16 * tc) * 64, 64, al, lq, g);
            gl = mm_tile_gb<4>(lds + O_LG, LGS, tr, (const bf16*)(F.ws + WS_G2LT) + (size_t)(h * RN + 16 * tc) * 128, 128, gl, lq, g);
            const float w0 = F.in[I_W0][hj], a0 = F.in[I_A0][hj], kkw = F.in[I_KK][hj];
            const float mur = mu[C_R + hj], muk = mu[C_K + hj], muv = mu[C_V + hj];
#pragma unroll
            for (int i = 0; i < 4; ++i) { const int t = 16 * tr + 4 * g + i; const bool hasp = !(first && t == 0); const unsigned oc = (unsigned)(n0 + t) * PCOLS + hj, op = hasp ? oc - PCOLS : oc;
                const float xw = -(w0 + wl[i]); const float sp = xw > 20.f ? xw : __logf(1.f + fexp(xw)); ev[x][i] = fexp(-sp - 0.5f);
                av[x][i] = sigmoidf_(a0 + al[i]);
                GATEp[(unsigned)(n0 + t) * RW + hj] = (bf16)f2bf(gl[i]);
                const unsigned short rc = PROJ[oc + C_R], kc = PROJ[oc + C_K], vc = PROJ[oc + C_V]; unsigned short rp = PROJ[op + C_R], kp = PROJ[op + C_K], vp = PROJ[op + C_V];
                if (!hasp) { rp = 0; kp = 0; vp = 0; }
                rv[x][i] = mixf(rc, rp, mur); kv[x][i] = mixf(kc, kp, muk); vv[x][i] = mixf(vc, vp, muv);
                kkr[x][i] = kv[x][i] * kkw; nrm_p[i] += kkr[x][i] * kkr[x][i]; }
        }
#pragma unroll
        for (int i = 0; i < 4; ++i) { float q = nrm_p[i]; q += __shfl_xor(q, 1); q += __shfl_xor(q, 2); q += __shfl_xor(q, 4); q += __shfl_xor(q, 8); if (lq == 0) NRM[(16 * tr + 4 * g + i) * 2 + (w & 1)] = q; }
        float cs[2][4];
#pragma unroll
        for (int x = 0; x < 2; ++x) { cs[x][0] = ev[x][0]; cs[x][1] = cs[x][0] + ev[x][1]; cs[x][2] = cs[x][1] + ev[x][2]; cs[x][3] = cs[x][2] + ev[x][3];
            float a = cs[x][3]; const float b1 = __shfl(a, lane - 16); a += (g >= 1) ? b1 : 0.f; const float b2 = __shfl(a, lane - 32); a += (g >= 2) ? b2 : 0.f;
            const float ex = a - cs[x][3];
#pragma unroll
            for (int i = 0; i < 4; ++i) cs[x][i] += ex;
            if (g == 3) TT[tr * 64 + 16 * (tcb + x) + lq] = a; }
        __syncthreads();
        float bs_p[4] = {0.f, 0.f, 0.f, 0.f};
#pragma unroll
        for (int x = 0; x < 2; ++x) { const int tc = tcb + x, j = 16 * tc + lq, hj = h * RN + j; const float ka = F.in[I_KA][hj], rk = F.in[I_RK][hj];
            const float t0v = TT[j], t1v = TT[64 + j], t2v = TT[128 + j], t3v = TT[192 + j]; const float c63 = (t0v + t1v) + (t2v + t3v);
            const float cbase = (tr > 0 ? t0v : 0.f) + (tr > 1 ? t1v : 0.f) + (tr > 2 ? t2v : 0.f);
            if (tr == 3 && g == 3) ((float*)(F.ws + WS_GC))[(size_t)item * 64 + j] = fexp(-c63);
            f32x4 ab, bb, kb, rb, bt, kt, vx;
#pragma unroll
            for (int i = 0; i < 4; ++i) { const int t = 16 * tr + 4 * g + i; const float cin = cs[x][i] + cbase, cex = cin - ev[x][i];
                const float nr = NRM[t * 2] + NRM[t * 2 + 1]; const float kk = kkr[x][i] / fmaxf(sqrtf(nr), 1e-12f);
                DBGCNT(F, 2, !(nr > 1e-6f && nr < 1e6f)); DBGCNT(F, 3, !(fabsf(kk) <= 1.001f)); DBGCNT(F, 6, !(ev[x][i] > 0.f && ev[x][i] < 0.62f && av[x][i] > 0.f && av[x][i] < 1.f)); DBGCNT(F, 8, !(fabsf(rv[x][i]) < 100.f && fabsf(kv[x][i]) < 100.f && fabsf(vv[x][i]) < 100.f)); DBGCNT(F, 9, !(cin >= 0.f && cin < 40.f && c63 >= cin));
                const float a = av[x][i], k2 = kv[x][i] * (1.f + (a - 1.f) * ka);
                const float gin = fexp(-cin), ginv = fexp(cin), gex = fexp(-cex), grel = fexp(cin - c63);
                ab[i] = -kk * gex; bb[i] = kk * a * ginv; kb[i] = k2 * ginv; rb[i] = rv[x][i] * gin; bt[i] = kk * a * grel; kt[i] = k2 * grel; vx[i] = vv[x][i];
                bs_p[i] += rv[x][i] * k2 * rk; }
            const int t0 = 16 * tr + 4 * g;
            st_nat(lds + O_AB, t0, j, ab); st_nat(lds + O_BB, t0, j, bb); st_nat(lds + O_KB, t0, j, kb); st_nat(lds + O_RB, t0, j, rb);
            st_tr(lds + O_ABT, t0, j, ab); st_tr(lds + O_VTT, t0, j, vx); st_tr(lds + O_BTT, t0, j, bt); st_tr(lds + O_KTT, t0, j, kt);
        }
#pragma unroll
        for (int i = 0; i < 4; ++i) { float q = bs_p[i]; q += __shfl_xor(q, 1); q += __shfl_xor(q, 2); q += __shfl_xor(q, 4); q += __shfl_xor(q, 8); if (lq == 0) BSP[(16 * tr + 4 * g + i) * 2 + (w & 1)] = q; }
        __syncthreads();
        if (tid < 64) ((float*)(F.ws + WS_BS))[(size_t)(n0 + tid) * RH + h] = BSP[tid * 2] + BSP[tid * 2 + 1];
#pragma unroll
        for (int x = 0; x < 2; ++x) { const int tc = tcb + x; f32x4 l = (f32x4){0.f, 0.f, 0.f, 0.f}, ak = l, rbm = l, rkm = l;
            if (tc <= tr) {
                l = mm_tile<2>(lds + O_AB, MS, tr, lds + O_BB, MS, tc, l, lq, g); ak = mm_tile<2>(lds + O_AB, MS, tr, lds + O_KB, MS, tc, ak, lq, g);
                rbm = mm_tile<2>(lds + O_RB, MS, tr, lds + O_BB, MS, tc, rbm, lq, g); rkm = mm_tile<2>(lds + O_RB, MS, tr, lds + O_KB, MS, tc, rkm, lq, g);
                const int s = 16 * tc + lq;
#pragma unroll
                for (int i = 0; i < 4; ++i) { const int t = 16 * tr + 4 * g + i; if (s >= t) { l[i] = 0.f; ak[i] = 0.f; } if (s > t) { rbm[i] = 0.f; rkm[i] = 0.f; } }
            }
            const int t0 = 16 * tr + 4 * g, s = 16 * tc + lq;
#pragma unroll
            for (int i = 0; i < 4; ++i) { EF[(t0 + i) * FS + s] = l[i]; DBGCNT(F, 7, !(fabsf(l[i]) <= 1.01f)); DBGCNT(F, 10, !(fabsf(ak[i]) < 300.f && fabsf(rbm[i]) < 300.f && fabsf(rkm[i]) < 300.f)); }
            st_nat(lds + O_AAK, t0, s, ak); st_nat(lds + O_ARB, t0, s, rbm); st_nat(lds + O_ARK, t0, s, rkm);
        }
        __syncthreads();
#ifdef DBG_SIMPLE_TRI
        if (w == 0) tri_inverse_simple(EF, (LAS float*)(lds + O_TF), lane);
#else
        if (w == 0) tri_inverse(EF, (LAS float*)(lds + O_TF), lane);
#endif
        __syncthreads();
        { const int t = tid >> 3, s0 = (tid & 7) * 8; const LAS float* tp = (const LAS float*)(lds + O_TF) + t * FS + s0; float o[8];
#pragma unroll
          for (int k = 0; k < 8; ++k) { o[k] = ((s0 >> 4) > (t >> 4)) ? 0.f : tp[k]; DBGCNT(F, 4, !(fabsf(o[k]) < 50.f)); }
          u32x4 wv; wv.x = cvt_pk_bf16(o[0], o[1]); wv.y = cvt_pk_bf16(o[2], o[3]); wv.z = cvt_pk_bf16(o[4], o[5]); wv.w = cvt_pk_bf16(o[6], o[7]);
          __syncthreads();
          *(LAS u32x4*)(lds + O_TM + t * MS + s0 * 2) = wv; }
        __syncthreads();
#pragma unroll
        for (int x = 0; x < 2; ++x) { const int tc = tcb + x; f32x4 gg = (f32x4){0.f, 0.f, 0.f, 0.f}, wt = gg;
            gg = mm_tile<2>(lds + O_AAK, MS, tr, lds + O_VTT, MS, tc, gg, lq, g); wt = mm_tile<2>(lds + O_TM, MS, tr, lds + O_ABT, MS, tc, wt, lq, g);
#pragma unroll
            for (int i = 0; i < 4; ++i) { DBGCNT(F, 12, !(fabsf(gg[i]) < 1e3f)); DBGCNT(F, 13, !(fabsf(wt[i]) < 1e2f)); }
            st_tr(lds + O_GT, 16 * tr + 4 * g, 16 * tc + lq, gg); st_tr(lds + O_WTT, 16 * tr + 4 * g, 16 * tc + lq, wt); }
        __syncthreads();
#pragma unroll
        for (int x = 0; x < 2; ++x) { const int tc = tcb + x; f32x4 ut = (f32x4){0.f, 0.f, 0.f, 0.f};
            ut = mm_tile<2>(lds + O_TM, MS, tr, lds + O_GT, MS, tc, ut, lq, g);
#pragma unroll
            for (int i = 0; i < 4; ++i) DBGCNT(F, 14, !(fabsf(ut[i]) < 1e3f));
            st_tr(lds + O_UTT, 16 * tr + 4 * g, 16 * tc + lq, ut); }
        __syncthreads();
#pragma unroll
        for (int x = 0; x < 2; ++x) { const int tc = tcb + x, t0 = 16 * tr + 4 * g, cj = 16 * tc + lq;
            f32x4 qt = (f32x4){0.f, 0.f, 0.f, 0.f}, yl = qt, pp = qt, nn = qt;
            qt = mm_tile<2>(lds + O_ARB, MS, tr, lds + O_WTT, MS, tc, qt, lq, g);
            yl = mm_tile<2>(lds + O_ARB, MS, tr, lds + O_UTT, MS, tc, yl, lq, g);
#ifdef DBG_SEL
            { f32x4 y2 = (f32x4){0.f, 0.f, 0.f, 0.f}; y2 = mm_tile<2>(lds + O_ARK, MS, tr, lds + O_VTT, MS, tc, y2, lq, g);
#pragma unroll
              for (int i = 0; i < 4; ++i) { DBGCNT(F, 15, !(fabsf(yl[i]) < 1e4f)); DBGCNT(F, 16, !(fabsf(y2[i]) < 1e4f)); }
#pragma unroll
              for (int ks = 0; ks < 2; ++ks) { const bf16x8 a1 = *(const LAS bf16x8*)(lds + O_ARB + (16 * tr + lq) * MS + (32 * ks + 8 * g) * 2), a2 = *(const LAS bf16x8*)(lds + O_ARK + (16 * tr + lq) * MS + (32 * ks + 8 * g) * 2);
                  const bf16x8 b1 = *(const LAS bf16x8*)(lds + O_UTT + (16 * tc + lq) * MS + (32 * ks + 8 * g) * 2), b2 = *(const LAS bf16x8*)(lds + O_VTT + (16 * tc + lq) * MS + (32 * ks + 8 * g) * 2);
#pragma unroll
                  for (int j = 0; j < 8; ++j) { DBGCNT(F, 17, !(fabsf(bf2f((bf16)a1[j])) < 300.f)); DBGCNT(F, 18, !(fabsf(bf2f((bf16)a2[j])) < 300.f)); DBGCNT(F, 19, !(fabsf(bf2f((bf16)b1[j])) < 1e3f)); DBGCNT(F, 20, !(fabsf(bf2f((bf16)b2[j])) < 100.f)); } } }
#endif
            yl = mm_tile<2>(lds + O_ARK, MS, tr, lds + O_VTT, MS, tc, yl, lq, g);
            pp = mm_tile<2>(lds + O_WTT, MS, tr, lds + O_BTT, MS, tc, pp, lq, g);
            nn = mm_tile<2>(lds + O_UTT, MS, tr, lds + O_BTT, MS, tc, nn, lq, g); nn = mm_tile<2>(lds + O_VTT, MS, tr, lds + O_KTT, MS, tc, nn, lq, g);
            bf16* QT = (bf16*)(F.ws + WS_QT) + (size_t)item * 4096; float* YL = (float*)(F.ws + WS_YLOC) + (size_t)item * 4096;
            bf16* PT = (bf16*)(F.ws + WS_PT) + (size_t)item * 4096; float* NNp = (float*)(F.ws + WS_NN) + (size_t)item * 4096;
#pragma unroll
            for (int i = 0; i < 4; ++i) { const float rbv = bf2f(*(const LAS bf16*)(lds + O_RB + (t0 + i) * MS + cj * 2));
                DBGCNT(F, 5, !(fabsf(yl[i]) < 1e4f)); DBGCNT(F, 11, !(fabsf(nn[i]) < 1e4f && fabsf(pp[i]) < 1e2f && fabsf(qt[i]) < 1e4f));
                QT[(unsigned)((t0 + i) * 64 + cj)] = (bf16)f2bf(qt[i] + rbv); YL[(unsigned)((t0 + i) * 64 + cj)] = yl[i]; NNp[(unsigned)((t0 + i) * 64 + cj)] = nn[i]; }
            u32x2 pw; pw.x = cvt_pk_bf16(pp[0], pp[1]); pw.y = cvt_pk_bf16(pp[2], pp[3]); *(GAS u32x2*)(PT + (unsigned)(cj * 64 + t0)) = pw;
        }
        __syncthreads();
    }
}

constexpr int SC_PT = 0, SC_NN = 8192, SC_GC = 12288, SC_DUM = 12544, SC_SLOT = 12800, SC_DEPTH = 8;
static_assert(SC_DEPTH * SC_SLOT <= RING_BYTES, "scan ring");
__device__ __forceinline__ void scan_issue(LAS unsigned char* ring, const unsigned char* ws, int bh, int vg, int c, int w, int lane) {
    const size_t item = (size_t)bh * NCHUNK + c; LAS unsigned char* slot = ring + (c & (SC_DEPTH - 1)) * SC_SLOT;
#pragma unroll
    for (int k = 0; k < 2; ++k) { const int id = 2 * (w - 1) + k;
        if (id < 8) { const int p = 64 * id + lane, r = p >> 3, sl = p & 7, ch = sl ^ (r & 7);
            __builtin_amdgcn_global_load_lds((const unsigned*)((const bf16*)(ws + WS_PT) + item * 4096 + r * 64 + ch * 8), (LAS unsigned*)(slot + SC_PT + 1024 * id), 16, 0, 0); }
        else if (id < 12) { const int q = id - 8, p = 64 * q + lane, r = p >> 4, sl = p & 15, ch = sl ^ (r & 15);
            __builtin_amdgcn_global_load_lds((const unsigned*)((const float*)(ws + WS_NN) + item * 4096 + (16 * vg + r) * 64 + ch * 4), (LAS unsigned*)(slot + SC_NN + 1024 * q), 16, 0, 0); }
        else { __builtin_amdgcn_global_load_lds((const unsigned*)((const float*)(ws + WS_GC) + item * 64 + lane), (LAS unsigned*)(slot + (id == 12 ? SC_GC : SC_DUM)), 4, 0, 0); }
    }
}
__device__ __forceinline__ void phase_scan(Frame& F, int bh, int vg) {
    const int lane = F.lane, w = F.wave, g = lane >> 4, lq = lane & 15;
    LAS unsigned char* ring = F.lds;
    f32x4 S[4];
#pragma unroll
    for (int kt = 0; kt < 4; ++kt) S[kt] = (f32x4){0.f, 0.f, 0.f, 0.f};
    const int v = 16 * vg + lq;
    if (w >= 1) {
#pragma unroll 1
        for (int c = 0; c < SC_DEPTH - 1; ++c) scan_issue(ring, F.ws, bh, vg, c, w, lane);
    }
#pragma unroll 1
    for (int c = 0; c < NCHUNK; ++c) {
        if (c <= NCHUNK - SC_DEPTH + 1) asm volatile("s_waitcnt vmcnt(12)" ::: "memory"); else asm volatile("s_waitcnt vmcnt(0)" ::: "memory");
        __builtin_amdgcn_s_barrier(); asm volatile("" ::: "memory");
        if (w >= 1 && c + SC_DEPTH - 1 < NCHUNK) scan_issue(ring, F.ws, bh, vg, c + SC_DEPTH - 1, w, lane);
        if (w == 0) {
            const LAS unsigned char* slot = ring + (c & (SC_DEPTH - 1)) * SC_SLOT; const size_t item = (size_t)bh * NCHUNK + c;
            bf16* S0 = (bf16*)(F.ws + WS_S0) + item * 4096;
            bf16x8 sf[2];
#pragma unroll
            for (int kt = 0; kt < 4; ++kt) { u32x2 wv; wv.x = cvt_pk_bf16(S[kt][0], S[kt][1]); wv.y = cvt_pk_bf16(S[kt][2], S[kt][3]); *(GAS u32x2*)(S0 + (size_t)v * 64 + 16 * kt + 4 * g) = wv; }
#pragma unroll
            for (int mb = 0; mb < 2; ++mb) { u32x4 wv; wv.x = cvt_pk_bf16(S[2 * mb][0], S[2 * mb][1]); wv.y = cvt_pk_bf16(S[2 * mb][2], S[2 * mb][3]);
                wv.z = cvt_pk_bf16(S[2 * mb + 1][0], S[2 * mb + 1][1]); wv.w = cvt_pk_bf16(S[2 * mb + 1][2], S[2 * mb + 1][3]); sf[mb] = __builtin_bit_cast(bf16x8, wv); }
#pragma unroll
            for (int kt = 0; kt < 4; ++kt) { const int k2 = 16 * kt + lq;
                const f32x4 nv = *(const LAS f32x4*)(slot + SC_NN + lq * 256 + (((4 * kt + g) ^ lq) << 4));
                const f32x4 gc = *(const LAS f32x4*)(slot + SC_GC + (16 * kt + 4 * g) * 4);
                f32x4 a = S[kt] * gc + nv;
#pragma unroll
                for (int mb = 0; mb < 2; ++mb) {
                    const u32x2 lo = *(const LAS u32x2*)(slot + SC_PT + k2 * 128 + (((4 * mb + (g >> 1)) ^ (k2 & 7)) << 4) + 8 * (g & 1));
                    const u32x2 hi = *(const LAS u32x2*)(slot + SC_PT + k2 * 128 + (((4 * mb + 2 + (g >> 1)) ^ (k2 & 7)) << 4) + 8 * (g & 1));
                    const bf16x8 pf = __builtin_bit_cast(bf16x8, (u32x4){lo.x, lo.y, hi.x, hi.y});
                    a = __builtin_amdgcn_mfma_f32_16x16x32_bf16(pf, sf[mb], a, 0, 0, 0); }
                S[kt] = a; }
        }
    }
    asm volatile("s_waitcnt vmcnt(0) lgkmcnt(0)" ::: "memory"); __builtin_amdgcn_s_barrier(); asm volatile("" ::: "memory");
}

__device__ __forceinline__ void phase_c(Frame& F, int b, int c, int h) {
    const int lane = F.lane, g = lane >> 4, lq = lane & 15;
    const size_t item = (size_t)(b * RH + h) * NCHUNK + c; const int n0 = b * T + c * CH;
    const bf16* QT = (const bf16*)(F.ws + WS_QT) + item * 4096; const bf16* S0 = (const bf16*)(F.ws + WS_S0) + item * 4096; const float* YL = (const float*)(F.ws + WS_YLOC) + item * 4096;
    const bf16* PROJ = (const bf16*)(F.ws + WS_PROJ); const float* mu = F.in[I_MU];
    bf16x8 sb[4][2];
#pragma unroll
    for (int tc = 0; tc < 4; ++tc)
#pragma unroll
        for (int ks = 0; ks < 2; ++ks) sb[tc][ks] = *(const GAS bf16x8*)(S0 + (size_t)(16 * tc + lq) * 64 + 32 * ks + 8 * g);
#pragma unroll 1
    for (int tr = 0; tr < 4; ++tr) {
        bf16x8 qa[2];
#pragma unroll
        for (int ks = 0; ks < 2; ++ks) qa[ks] = *(const GAS bf16x8*)(QT + (size_t)(16 * tr + lq) * 64 + 32 * ks + 8 * g);
        f32x4 y[4];
#pragma unroll
        for (int tc = 0; tc < 4; ++tc) {
#pragma unroll
            for (int i = 0; i < 4; ++i) { y[tc][i] = YL[(size_t)(16 * tr + 4 * g + i) * 64 + 16 * tc + lq]; DBGCNT(F, 0, !(fabsf(y[tc][i]) < 1e4f)); }
#ifndef DBG_NO_STATE
#pragma unroll
            for (int ks = 0; ks < 2; ++ks) y[tc] = __builtin_amdgcn_mfma_f32_16x16x32_bf16(qa[ks], sb[tc][ks], y[tc], 0, 0, 0);
#endif
            }
#pragma unroll
        for (int i = 0; i < 4; ++i) { const int t = 16 * tr + 4 * g + i, n = n0 + t;
            float s = (y[0][i] + y[1][i]) + (y[2][i] + y[3][i]); s += __shfl_xor(s, 1); s += __shfl_xor(s, 2); s += __shfl_xor(s, 4); s += __shfl_xor(s, 8);
            const float mean = s * (1.f / 64.f); float q = 0.f;
#pragma unroll
            for (int tc = 0; tc < 4; ++tc) { const float dlt = y[tc][i] - mean; q += dlt * dlt; }
            q += __shfl_xor(q, 1); q += __shfl_xor(q, 2); q += __shfl_xor(q, 4); q += __shfl_xor(q, 8);
            const float rstd = __builtin_amdgcn_rsqf(q * (1.f / 64.f) + GN_EPS);
            const float bsv = ((const float*)(F.ws + WS_BS))[(size_t)n * RH + h];
            const bool hasp = !(c == 0 && t == 0); const bf16* rowc = PROJ + (size_t)n * PCOLS; const bf16* rowp = hasp ? rowc - PCOLS : rowc;
#pragma unroll
            for (int tc = 0; tc < 4; ++tc) { const int hv = h * RN + 16 * tc + lq;
                const unsigned short vc = rowc[C_V + hv]; unsigned short vp = rowp[C_V + hv]; if (!hasp) vp = 0;
                const float vm = mixf(vc, vp, mu[C_V + hv]);
                const float yn = (y[tc][i] - mean) * rstd * F.in[I_LNG][hv] + F.in[I_LNB][hv];
                const float gt = bf2f(((const bf16*)(F.ws + WS_GATE))[(size_t)n * RW + hv]);
                float ov = (yn + bsv * vm) * gt;
#ifdef DBG_ZERO_RWKV
                ov = 0.f;
#endif
#ifdef DBG_PROBE
                ov = (DBG_PROBE == 1) ? gt : (DBG_PROBE == 2) ? bsv : (DBG_PROBE == 3) ? yn : (DBG_PROBE == 4) ? y[tc][i] : (DBG_PROBE == 5) ? 0.02f * (y[tc][i] - mean) : (DBG_PROBE == 6) ? 0.02f * y[tc][i] : vm;
#endif
#ifdef DBG_SCRUB_RWKV
                if (!(fabsf(ov) < 1e30f)) ov = 0.f;
#endif
                ((bf16*)(F.ws + WS_CAT))[(size_t)n * D + hv] = (bf16)f2bf(ov); }
        }
    }
}
}
__device__ __forceinline__ void diff_attn_phase(Frame& F) {
    const int lane = F.lane, w = F.wave, r = lane & 31, h = lane >> 5, rg = w >> 1, c = w & 1;
    float lam;
    { const float a = F.in[I_LQ1][lane] * F.in[I_LK1][lane], b2 = F.in[I_LQ2][lane] * F.in[I_LK2][lane]; lam = fexp(wave_sum(a)) - fexp(wave_sum(b2)) + LAMBDA_INIT; }
    const bf16* PROJ = (const bf16*)(F.ws + WS_PROJ); const bf16* VT = (const bf16*)(F.ws + WS_VT); bf16* CAT = (bf16*)(F.ws + WS_CAT);
    LAS float* xch = (LAS float*)F.lds;
    const bool tab = (F.G == 256);
    for (int p = F.bid; p < 256; p += F.G) {
#pragma unroll 1
        for (int s = 0; s < 2; ++s) { int bh, qb;
            if (tab) { const int u = attn_tab[F.bid][s]; if (u == 0xFFFF) break; bh = u >> 6; qb = u & 63; }
            else { bh = p >> 5; const int j = p & 31; qb = s ? 63 - j : j; }
            const int b = bh >> 2, hd = bh & 3; const int row0 = b * T + 128 * qb + 32 * rg;
            DiffBody32 body; f32x16 o[4]; float ls;
            const int nkt = 2 * qb + 2, nkt_w = (rg < 2) ? nkt - 1 : nkt;
            body.run(F.lds, PROJ + (size_t)row0 * PCOLS + C_QD + hd * 128 + c * 64, PCOLS, 0.125f * LOG2E, PROJ + (size_t)(b * T) * PCOLS + C_KD + hd * 128, PCOLS,
                     VT + (size_t)(hd * DV) * M + b * T, M, nkt, nkt_w, c, o, ls, F.tid, lane);
            if (c == 1) { const float sc = lam / ls;
#pragma unroll
                for (int db = 0; db < 4; ++db)
#pragma unroll
                    for (int i = 0; i < 16; ++i) xch[(rg * 64 + db * 16 + i) * 64 + lane] = o[db][i] * sc; }
            asm volatile("s_waitcnt lgkmcnt(0)" ::: "memory"); __builtin_amdgcn_s_barrier(); asm volatile("" ::: "memory");
            if (c == 0) { const float i0 = 1.f / ls; float q = 0.f;
#pragma unroll
                for (int db = 0; db < 4; ++db)
#pragma unroll
                    for (int i = 0; i < 16; ++i) { const float v = o[db][i] * i0 - xch[(rg * 64 + db * 16 + i) * 64 + lane]; o[db][i] = v; q += v * v; }
                { const auto r2 = __builtin_amdgcn_permlane32_swap(__float_as_uint(q), __float_as_uint(q), false, false); q = __uint_as_float(r2[0]) + __uint_as_float(r2[1]); }
                const float rstd = __builtin_amdgcn_rsqf(q * (1.f / DV) + NORM_EPS) * (1.f - LAMBDA_INIT);
                bf16* orow = CAT + (size_t)(row0 + r) * D + RW + hd * DV;
#pragma unroll
                for (int db = 0; db < 4; ++db)
#pragma unroll
                    for (int t = 0; t < 4; ++t) { const int dv = 32 * db + 8 * t + 4 * h; const f32x4 sg = *(const GAS f32x4*)(F.in[I_SUBG] + dv);
                        u32x2 wv; wv.x = cvt_pk_bf16(o[db][4 * t] * rstd * sg[0], o[db][4 * t + 1] * rstd * sg[1]); wv.y = cvt_pk_bf16(o[db][4 * t + 2] * rstd * sg[2], o[db][4 * t + 3] * rstd * sg[3]);
#ifdef DBG_ZERO_DIFF
                        wv.x = 0u; wv.y = 0u;
#endif
                        *(GAS u32x2*)(orow + dv) = wv; } }
            asm volatile("s_waitcnt lgkmcnt(0)" ::: "memory"); __builtin_amdgcn_s_barrier(); asm volatile("" ::: "memory");
        }
    }
}
__device__ __forceinline__ void cross_attn_phase(Frame& F, const int* ubase, int nunit) {
    typedef AttnBody<1, XD, XD, 2, 8> Body;
    const int lane = F.lane, w = F.wave, g = lane >> 4, lq = lane & 15;
    const bf16* QX = (const bf16*)(F.ws + WS_QX); const bf16* KM = (const bf16*)(F.ws + WS_KMEM); const bf16* VTM = (const bf16*)(F.ws + WS_VTMEM); bf16* XO = (bf16*)(F.ws + WS_XO);
#pragma unroll 1
    for (int uu = 0; uu < 2 * nunit; ++uu) { const int u = ubase[uu >> 1] + (uu & 1); const int bh = u >> 6, rb = u & 63, b = bh >> 2, h = bh & 3; const int row0 = b * T + 128 * rb + 16 * w;
        Body body; f32x4 o[1][16]; float ls[1];
        body.run(F.lds, QX + (size_t)row0 * D + h * XD, D, 1.0f, KM + (size_t)(b * MEM) * D + h * XD, D, VTM + (size_t)(h * XD) * (BATCH * MEM) + b * MEM, BATCH * MEM, 4, 4, false, o, ls, F.tid, lane);
        const float inv = pg8::F8_SXO / ls[0]; unsigned char* orow = (unsigned char*)XO + (size_t)(row0 + lq) * D + h * XD;
#pragma unroll
        for (int dt = 0; dt < 16; ++dt) { const f32x4 y = o[0][dt] * inv; *(GAS unsigned*)(orow + 16 * dt + 4 * g) = pk4_fp8(y[0], y[1], y[2], y[3]); }
    }
}

constexpr int RT_LCNT = X_OFF + 4096, RT_GBASE = RT_LCNT + 128, RT_ENTE = RT_GBASE + 128, RT_ENTP = RT_ENTE + 1024, RT_LGT = RT_ENTP + 1024;
__device__ __forceinline__ void router_phase(Frame& F, int cw_cnt, size_t ws_lists, size_t ws_gates) {
    const int lane = F.lane, w = F.wave, tid = F.tid;
    LAS int* lcnt = (LAS int*)(F.lds + RT_LCNT); LAS int* gbase = (LAS int*)(F.lds + RT_GBASE); LAS int* ente = (LAS int*)(F.lds + RT_ENTE); LAS int* entp = (LAS int*)(F.lds + RT_ENTP); LAS float* lgt = (LAS float*)(F.lds + RT_LGT);
    const float* H2 = (const float*)(F.ws + WS_H2); const float* RWT = (const float*)(F.ws + WS_RWT); const float* SS3 = (const float*)(F.ws + WS_SS3);
    int* lists = (int*)(F.ws + ws_lists); float* lgate = (float*)(F.ws + ws_gates); float* lrinv = lgate + (size_t)NE * CAP;
    LAS float* entg = (LAS float*)(F.lds + RT_LGT + 8448); LAS float* entr = entg + 256;
#pragma unroll 1
    for (int blk = F.bid; blk < M / 64; blk += F.G) {
        if (tid < NE) lcnt[tid] = 0;
        __syncthreads();
        const int nb = blk * 64 + w * 8;
        { const int tt = w >> 1, et = w & 1, lq = lane & 15, g = lane >> 4;
          const f32x4* ap = (const f32x4*)(H2 + (size_t)(blk * 64 + tt * 16 + lq) * D + 4 * g); const f32x4* bp = (const f32x4*)(RWT + (size_t)(et * 16 + lq) * D + 4 * g);
          f32x4 acc0 = (f32x4){0.f, 0.f, 0.f, 0.f}, acc1 = acc0;
#pragma unroll 8
          for (int j = 0; j < D / 16; j += 2) { const f32x4 a0 = ap[4 * j], b0 = bp[4 * j], a1 = ap[4 * j + 4], b1 = bp[4 * j + 4];
#pragma unroll
              for (int m = 0; m < 4; ++m) { acc0 = __builtin_amdgcn_mfma_f32_16x16x4f32(a0[m], b0[m], acc0, 0, 0, 0); acc1 = __builtin_amdgcn_mfma_f32_16x16x4f32(a1[m], b1[m], acc1, 0, 0, 0); } }
#pragma unroll
          for (int i = 0; i < 4; ++i) { const int tok = tt * 16 + 4 * g + i; lgt[tok * 33 + et * 16 + lq] = acc0[i] + acc1[i]; } }
        __syncthreads();
        if (lane < 8) { const int tl = w * 8 + lane, n = blk * 64 + tl;
            const float rinv = __builtin_amdgcn_rsqf(row_ss(SS3, n) * (1.f / D) + NORM_EPS);
            float v0 = -INFINITY, v1 = -INFINITY, v2 = -INFINITY, v3 = -INFINITY; int e0 = 0, e1 = 0, e2 = 0, e3 = 0;
#pragma unroll
            for (int e = 0; e < NE; ++e) { float x = lgt[tl * 33 + e] * rinv + F.in[I_RB][e]; if (!(x == x)) x = -3.0e38f;
                const bool c0 = x > v0, c1 = x > v1, c2 = x > v2, c3 = x > v3;
                v3 = c3 ? (c2 ? v2 : x) : v3; e3 = c3 ? (c2 ? e2 : e) : e3;
                v2 = c2 ? (c1 ? v1 : x) : v2; e2 = c2 ? (c1 ? e1 : e) : e2;
                v1 = c1 ? (c0 ? v0 : x) : v1; e1 = c1 ? (c0 ? e0 : e) : e1;
                v0 = c0 ? x : v0; e0 = c0 ? e : e0; }
            const float x1 = fexp(v1 - v0), x2 = fexp(v2 - v0), x3 = fexp(v3 - v0); const float inv = 1.f / (1.f + x1 + x2 + x3);
            const int es[4] = {e0, e1, e2, e3}; const float gs[4] = {inv, x1 * inv, x2 * inv, x3 * inv};
#pragma unroll
            for (int k = 0; k < 4; ++k) { const int li = tl * 4 + k; const int lp = __hip_atomic_fetch_add(&lcnt[es[k]], 1, __ATOMIC_RELAXED, __HIP_MEMORY_SCOPE_WORKGROUP); ente[li] = es[k]; entp[li] = lp; entg[li] = gs[k]; entr[li] = rinv; }
        }
        __syncthreads();
        if (tid < NE) gbase[tid] = (int)__hip_atomic_fetch_add((unsigned*)(F.ctl + cw_cnt + 64 * tid), (unsigned)lcnt[tid], RLX_AGENT);
#ifdef DUP_ATOM
        if (tid < NE) lgt[tid] = (float)__hip_atomic_fetch_add((unsigned*)(F.ctl + cw_cnt + 8192 + 64 * tid), (unsigned)lcnt[tid], RLX_AGENT);
#endif
        __syncthreads();
        if (tid < 256) { const int ee = ente[tid]; const size_t pos = (size_t)ee * CAP + gbase[ee] + entp[tid]; lists[pos] = blk * 256 + tid; lgate[pos] = entg[tid]; lrinv[pos] = entr[tid]; }
        __syncthreads();
    }
}
__device__ __forceinline__ void final_phase(Frame& F) {
    const int gw = F.bid * NWAVES + F.wave, NGW = F.G * NWAVES, lane = F.lane;
    const float* H2 = (const float*)(F.ws + WS_H2); const bf16* Y = (const bf16*)(F.ws + WS_YBUF);
    for (int n = gw; n < M; n += NGW) {
        f32x4 v[4]; float s = 0.f;
#pragma unroll
        for (int j = 0; j < 4; ++j) { v[j] = *((const GAS f32x4*)(H2 + (size_t)n * D) + lane + 64 * j);
#pragma unroll
            for (int k = 0; k < 4; ++k) { u32x2 y = *((const GAS u32x2*)(Y + (size_t)(n * 4 + k) * D) + lane + 64 * j);
#ifdef DBG_ZERO_MOE
                y.x = 0u; y.y = 0u;
#endif
                v[j].x += bflo(y.x); v[j].y += bfhi(y.x); v[j].z += bflo(y.y); v[j].w += bfhi(y.y); }
            s += (v[j].x * v[j].x + v[j].y * v[j].y) + (v[j].z * v[j].z + v[j].w * v[j].w); }
        float rstd = 1.f / sqrtf(wave_sum(s) * (1.f / D) + NORM_EPS);
#ifdef DBG_SEL
        { const unsigned cnt = __hip_atomic_load(F.ctl + 12288 + DBG_SEL, RLX_AGENT); rstd *= 0.9f * __log2f(1.f + (float)cnt) * (1.f / 30.f); }
#endif
#pragma unroll
        for (int j = 0; j < 4; ++j) { const f32x4 gg = *((const GAS f32x4*)F.in[I_FG] + lane + 64 * j); *((GAS f32x4*)(F.out + (size_t)n * D) + lane + 64 * j) = v[j] * rstd * gg; }
    }
}

constexpr int NPHASE = 13;
#ifndef P1_GEMM_WGS
#define P1_GEMM_WGS 144
#endif
struct Args { const float* in[34]; float* out; unsigned char* ws; int ph_lo, ph_hi; };
__global__ void __launch_bounds__(NTHR, 2) fwd_kernel(Args args) {
    extern __shared__ __attribute__((aligned(16))) unsigned char lds[];
    Frame F;
    F.lds = (LAS unsigned char*)lds; F.MISC = (volatile LAS unsigned*)(F.lds + MISC_OFF);
    F.tid = threadIdx.x; F.lane = F.tid & 63; F.wave = __builtin_amdgcn_readfirstlane(F.tid >> 6);
    F.G = gridDim.x; F.bid = blockIdx.x; F.ws = args.ws; F.ctl = (gu32*)(args.ws + WS_CTL); F.out = args.out;
#pragma unroll
    for (int i = 0; i < 34; ++i) F.in[i] = args.in[i];
    for (int u = F.tid; u < (LDS_BYTES - MISC_OFF) / 4; u += NTHR) ((LAS unsigned*)(F.lds + MISC_OFF))[u] = 0u;
    __syncthreads();
    XcdBarrier bar = xcd_barrier_post((unsigned*)(F.ctl + CW_BAR), F.MISC + 8);
    const int lo = args.ph_lo, hi = args.ph_hi;
#ifndef PHM
#define PHM 0xffff
#endif
#define IN(k) (((PHM >> (k)) & 1) && lo <= (k) && (k) < hi)
#ifdef DUP_BARRIER
#define SEAM(k) do { if (IN(k) && IN((k) + 1)) { xcd_barrier(bar); if ((k) == DUP_BARRIER || DUP_BARRIER == 99) { xcd_barrier(bar); } } } while (0)
#else
#define SEAM(k) do { if (IN(k) && IN((k) + 1)) xcd_barrier(bar); } while (0)
#endif
    LAS int* lstage = (LAS int*)(F.lds + X_OFF);
    LAS int* moe_tb = (LAS int*)(F.lds + X_OFF + 2048); LAS int* moe_cn = (LAS int*)(F.lds + X_OFF + 2048 + 256); LAS int* moe_rte = (LAS int*)(F.lds + X_OFF + 2048 + 512);

#define RETID() do { int t_ = threadIdx.x; asm volatile("" : "+v"(t_)); F.tid = t_; F.lane = t_ & 63; } while (0)
    if (IN(0)) { RETID(); p0_prologue(F);
#if defined(DUP_PHASE) && DUP_PHASE == 0
        { RETID(); p0_prologue(F);  }
#endif
    } SEAM(0);
    if (IN(1)) { RETID();
        const int NG1 = (F.G == 256) ? P1_GEMM_WGS : F.G;
        if (F.bid < NG1) {
        const bf16* XN = (const bf16*)(F.ws + WS_XN); const bf16* WinT = (const bf16*)(F.ws + WS_WINT); const bf16* MEMN = (const bf16*)(F.ws + WS_MEMN); const bf16* WkvT = (const bf16*)(F.ws + WS_WKVT);
        { pg8::Gemm g{XN, WinT, D, 0, nullptr}; pg8::StaticOrder S; S.init(M, PCOLS, NG1, F.bid, 0); pg8::EpiBf16 E{(bf16*)(F.ws + WS_PROJ), PCOLS};
          pg8::gemm_phase<pg8::EpiBf16, pg8::StaticOrder, true, false>(F.lds, lstage, g, S, E); }
        { pg8::Gemm g{WinT + (size_t)C_VD * D, XN, D, 0, nullptr}; pg8::StaticOrder S; S.init(512, M, NG1, F.bid, 0); pg8::EpiBf16 E{(bf16*)(F.ws + WS_VT), M};
          pg8::gemm_phase<pg8::EpiBf16, pg8::StaticOrder, true, false>(F.lds, lstage, g, S, E); }
        { pg8::Gemm g{MEMN, WkvT, D, 0, nullptr}; pg8::StaticOrder S; S.init(BATCH * MEM, D, NG1, F.bid, 16); pg8::EpiBf16 E{(bf16*)(F.ws + WS_KMEM), D};
          pg8::gemm_phase<pg8::EpiBf16, pg8::StaticOrder, true, false>(F.lds, lstage, g, S, E); }
        { pg8::Gemm g{WkvT + (size_t)D * D, MEMN, D, 0, nullptr}; pg8::StaticOrder S; S.init(D, BATCH * MEM, NG1, F.bid, 8); pg8::EpiBf16 E{(bf16*)(F.ws + WS_VTMEM), BATCH * MEM};
          pg8::gemm_phase<pg8::EpiBf16, pg8::StaticOrder, true, false>(F.lds, lstage, g, S, E); }

        }
        if (NG1 == F.G || F.bid >= NG1) p0_experts(F, NG1 == F.G ? 0 : NG1);
    } SEAM(1);
    if (IN(2)) { RETID(); for (int it = F.bid; it < BATCH * NCHUNK; it += F.G) rk::phase_a(F, it / NCHUNK, it % NCHUNK);
#if defined(DUP_PHASE) && DUP_PHASE == 2
        { RETID(); for (int it = F.bid; it < BATCH * NCHUNK; it += F.G) rk::phase_a(F, it / NCHUNK, it % NCHUNK);  }
#endif
    } SEAM(2);
    if (IN(3)) { RETID();
        for (int it = F.bid; it < BATCH * RH * 4; it += F.G) rk::phase_scan(F, it >> 2, it & 3);
#ifdef DUP_SCAN
        for (int it = F.bid; it < BATCH * RH * 4; it += F.G) rk::phase_scan(F, it >> 2, it & 3);
#endif
        diff_attn_phase(F);
#ifdef DUP_ATTN
        diff_attn_phase(F);
#endif

#if defined(DUP_PHASE) && DUP_PHASE == 3
        { RETID();
        for (int it = F.bid; it < BATCH * RH * 4; it += F.G) rk::phase_scan(F, it >> 2, it & 3);
        diff_attn_phase(F);
     }
#endif
    } SEAM(3);
    if (IN(4)) { RETID(); for (int it = F.bid; it < BATCH * NCHUNK; it += F.G) rk::phase_c(F, it / NCHUNK, it % NCHUNK, F.wave);
#if defined(DUP_PHASE) && DUP_PHASE == 4
        { RETID(); for (int it = F.bid; it < BATCH * NCHUNK; it += F.G) rk::phase_c(F, it / NCHUNK, it % NCHUNK, F.wave);  }
#endif
    } SEAM(4);
    if (IN(5)) { RETID(); pg8::Gemm g{(const bf16*)(F.ws + WS_CAT), (const bf16*)(F.ws + WS_WOUTT), D, 0, nullptr}; pg8::StaticOrder S; S.init(M, D, F.G, F.bid, 0);
        pg8::EpiResid2T<2> E{F.in[I_X], nullptr, nullptr, (bf16*)(F.ws + WS_H1B), (float*)(F.ws + WS_SS1), nullptr, F.ws + WS_H1, 1.0f};
        pg8::gemm_phase<pg8::EpiResid2T<2>, pg8::StaticOrder, true, false>(F.lds, lstage, g, S, E);
#if defined(DUP_PHASE) && DUP_PHASE == 5
        { RETID(); pg8::Gemm g{(const bf16*)(F.ws + WS_CAT), (const bf16*)(F.ws + WS_WOUTT), D, 0, nullptr}; pg8::StaticOrder S; S.init(M, D, F.G, F.bid, 0);
        pg8::EpiResid2T<2> E{F.in[I_X], nullptr, nullptr, (bf16*)(F.ws + WS_H1B), (float*)(F.ws + WS_SS1), nullptr, F.ws + WS_H1, 1.0f};
        pg8::gemm_phase<pg8::EpiResid2T<2>, pg8::StaticOrder, true, false>(F.lds, lstage, g, S, E);  }
#endif
    } SEAM(5);
    if (IN(6)) { RETID(); pg8::Gemm g{(const bf16*)(F.ws + WS_H1), (const bf16*)(F.ws + WS_WQT), D / 2, 0, nullptr}; pg8::StaticOrder S; S.init(M, D, F.G, F.bid, 0);
        pg8::EpiRowScaleBf16 E{(bf16*)(F.ws + WS_QX), D, (const float*)(F.ws + WS_SS1), 0.0625f * LOG2E / (F8_SA * F8_SW)};
        pg8::gemm_phase<pg8::EpiRowScaleBf16, pg8::StaticOrder, true, false, true>(F.lds, lstage, g, S, E);
        __builtin_amdgcn_fence(__ATOMIC_RELEASE, "workgroup"); __syncthreads(); __builtin_amdgcn_fence(__ATOMIC_ACQUIRE, "workgroup");
        RETID();
        int ub[4]; int nu = 0; pg8::Unit u;
#pragma unroll
        for (int i = 0; i < 4; ++i) if (S.next(i, u)) { ub[i] = ((u.pm >> 5) * 4 + u.pn) * 64 + 2 * (u.pm & 31); nu = i + 1; } else ub[i] = 0;
        cross_attn_phase(F, ub, nu);
    } SEAM(7);
    if (IN(8)) { RETID(); pg8::Gemm g{(const bf16*)(F.ws + WS_XO), (const bf16*)(F.ws + WS_WOT), D / 2, 0, nullptr}; pg8::StaticOrder S; S.init(M, D, F.G, F.bid, 0);
        pg8::EpiResid2T<1> E{nullptr, (const bf16*)(F.ws + WS_H1B), (float*)(F.ws + WS_H2), nullptr, (float*)(F.ws + WS_SS3), F.in[I_N3G], F.ws + WS_H2B, 1.0f / (pg8::F8_SXO * F8_SW)};
        pg8::gemm_phase<pg8::EpiResid2T<1>, pg8::StaticOrder, true, false, true>(F.lds, lstage, g, S, E);
#if defined(DUP_PHASE) && DUP_PHASE == 8
        { RETID(); pg8::Gemm g{(const bf16*)(F.ws + WS_XO), (const bf16*)(F.ws + WS_WOT), D / 2, 0, nullptr}; pg8::StaticOrder S; S.init(M, D, F.G, F.bid, 0);
        pg8::EpiResid2T<1> E{nullptr, (const bf16*)(F.ws + WS_H1B), (float*)(F.ws + WS_H2), nullptr, (float*)(F.ws + WS_SS3), F.in[I_N3G], F.ws + WS_H2B, 1.0f / (pg8::F8_SXO * F8_SW)};
        pg8::gemm_phase<pg8::EpiResid2T<1>, pg8::StaticOrder, true, false, true>(F.lds, lstage, g, S, E);  }
#endif
    } SEAM(8);
    if (IN(9)) { RETID(); router_phase(F, CW_CNT, WS_LISTS, WS_LGATE);
#if defined(DUP_PHASE) && DUP_PHASE == 9
        { RETID(); router_phase(F, CW_CNT + 4096, WS_YBUF, WS_YBUF + 4 * MiB); }
#endif
    } SEAM(9);
    if (IN(10) || IN(11)) { RETID();
        if (F.tid < NE) moe_cn[F.tid] = (int)__hip_atomic_load(F.ctl + CW_CNT + 64 * F.tid, RLX_AGENT);
        __syncthreads();
        if (F.tid == 0) { int a = 0; for (int e = 0; e < NE; ++e) { moe_tb[e] = a; a += (moe_cn[e] + 255) >> 8; } moe_tb[NE] = a; }
        __syncthreads();
        if (F.tid < MAXRT) { int e = 0; for (int k = 1; k < NE; ++k) e = (F.tid >= moe_tb[k]) ? k : e; moe_rte[F.tid] = e; }
        __syncthreads();
    }
    if (IN(10)) { RETID(); pg8::Gemm g{(const bf16*)(F.ws + WS_H2B), (const bf16*)(F.ws + WS_W1T), D / 2, (size_t)FF * D, (const int*)(F.ws + WS_LISTS)};
        pg8::MoeOrder S{moe_tb, moe_cn, moe_rte, 8, F.G, F.bid, __builtin_amdgcn_readfirstlane(moe_tb[NE])};
        pg8::EpiSwiglu E{F.ws + WS_ACT, F.in[I_B1], (const float*)(F.ws + WS_LRINV), (const int*)(F.ws + WS_LISTS)};
        pg8::gemm_phase<pg8::EpiSwiglu, pg8::MoeOrder, true, true, true>(F.lds, lstage, g, S, E);
#if defined(DUP_PHASE) && DUP_PHASE == 10
        { RETID(); pg8::Gemm g{(const bf16*)(F.ws + WS_H2B), (const bf16*)(F.ws + WS_W1T), D / 2, (size_t)FF * D, (const int*)(F.ws + WS_LISTS)};
        pg8::MoeOrder S{moe_tb, moe_cn, moe_rte, 8, F.G, F.bid, __builtin_amdgcn_readfirstlane(moe_tb[NE])};
        pg8::EpiSwiglu E{F.ws + WS_ACT, F.in[I_B1], (const float*)(F.ws + WS_LRINV), (const int*)(F.ws + WS_LISTS)};
        pg8::gemm_phase<pg8::EpiSwiglu, pg8::MoeOrder, true, true, true>(F.lds, lstage, g, S, E);  }
#endif
    } SEAM(10);
    if (IN(11)) { RETID(); pg8::Gemm g{(const bf16*)(F.ws + WS_ACT), (const bf16*)(F.ws + WS_W2T), FF / 2, (size_t)D * FF / 2, nullptr};
        pg8::MoeOrder S{moe_tb, moe_cn, moe_rte, 4, F.G, F.bid, __builtin_amdgcn_readfirstlane(moe_tb[NE])};
        pg8::EpiMoe2 E{(bf16*)(F.ws + WS_YBUF), F.in[I_B2], (const float*)(F.ws + WS_LGATE), (const int*)(F.ws + WS_LISTS)};
        pg8::gemm_phase<pg8::EpiMoe2, pg8::MoeOrder, true, false, true>(F.lds, lstage, g, S, E);
#if defined(DUP_PHASE) && DUP_PHASE == 112
        { RETID(); pg8::Gemm g{(const bf16*)(F.ws + WS_H2B), (const bf16*)(F.ws + WS_W2T), FF, (size_t)D * FF, (const int*)(F.ws + WS_LISTS)};
        pg8::MoeOrder S{moe_tb, moe_cn, moe_rte, 4, F.G, F.bid, __builtin_amdgcn_readfirstlane(moe_tb[NE])};
        pg8::EpiBf16 E{(bf16*)(F.ws + 532 * MiB), D};
        pg8::gemm_phase<pg8::EpiBf16, pg8::MoeOrder, true, true>(F.lds, lstage, g, S, E);  }
#endif
#if defined(DUP_PHASE) && DUP_PHASE == 11
        { RETID(); pg8::Gemm g{(const bf16*)(F.ws + WS_ACT), (const bf16*)(F.ws + WS_W2T), FF / 2, (size_t)D * FF / 2, nullptr};
        pg8::MoeOrder S{moe_tb, moe_cn, moe_rte, 4, F.G, F.bid, __builtin_amdgcn_readfirstlane(moe_tb[NE])};
        pg8::EpiMoe2 E{(bf16*)(F.ws + WS_YBUF), F.in[I_B2], (const float*)(F.ws + WS_LGATE), (const int*)(F.ws + WS_LISTS)};
        pg8::gemm_phase<pg8::EpiMoe2, pg8::MoeOrder, true, false, true>(F.lds, lstage, g, S, E);  }
#endif
    } SEAM(11);
    if (IN(12)) { RETID(); final_phase(F);
#if defined(DUP_PHASE) && DUP_PHASE == 12
        { RETID(); final_phase(F);  }
#endif
    }
#undef IN
#undef SEAM
}

#ifndef MK_SPLIT
#define MK_SPLIT 0
#endif
extern "C" void kernel_launch(void* const* d_in, const int* in_sizes, int n_in, void* d_out, int out_size, void* d_ws, size_t ws_size, hipStream_t stream) {
    static int grid = 0;
    if (grid == 0) {
        if (n_in != 34 || out_size != M * D || ws_size < WS_END) { fprintf(stderr, "kernel_launch: unexpected shapes (n_in %d out %d ws %zu)\n", n_in, out_size, ws_size); grid = -1; return; }
        int dev = 0, cus = 0, per_cu = 0;
        if (hipGetDevice(&dev) != hipSuccess || hipDeviceGetAttribute(&cus, hipDeviceAttributeMultiprocessorCount, dev) != hipSuccess) { grid = -1; return; }
        if (hipFuncSetAttribute((const void*)fwd_kernel, hipFuncAttributeMaxDynamicSharedMemorySize, LDS_BYTES) != hipSuccess) { fprintf(stderr, "kernel_launch: hipFuncSetAttribute failed\n"); grid = -1; return; }
        if (hipOccupancyMaxActiveBlocksPerMultiprocessor(&per_cu, (const void*)fwd_kernel, NTHR, LDS_BYTES) != hipSuccess || per_cu < 1) fprintf(stderr, "kernel_launch: occupancy query reports %d\n", per_cu);
        (void)hipGetLastError();
        grid = cus;
    }
    if (grid < 0) return;
    (void)hipMemsetAsync((char*)d_ws + WS_CTL, 0, CTL_ZERO_BYTES, stream);
    Args a{};
    for (int i = 0; i < 34; ++i) a.in[i] = (const float*)d_in[i];
    a.out = (float*)d_out; a.ws = (unsigned char*)d_ws;
#if MK_SPLIT
    for (int p = 0; p < NPHASE; ++p) { a.ph_lo = p; a.ph_hi = p + 1; hipLaunchKernelGGL(fwd_kernel, dim3(grid), dim3(NTHR), LDS_BYTES, stream, a); }
#else
    a.ph_lo = 0; a.ph_hi = NPHASE; hipLaunchKernelGGL(fwd_kernel, dim3(grid), dim3(NTHR), LDS_BYTES, stream, a);
#endif
}
```

```cpp
#include <hip/hip_runtime.h>
#include <cstdio>
#include <cstdint>

#define GAS __attribute__((address_space(1)))
#define LAS __attribute__((address_space(3)))
typedef unsigned short bf16;
typedef short bf16x8 __attribute__((ext_vector_type(8)));
typedef short bf16x4 __attribute__((ext_vector_type(4)));
typedef float f32x4 __attribute__((ext_vector_type(4)));
typedef float f32x2 __attribute__((ext_vector_type(2)));
typedef unsigned u32x4 __attribute__((ext_vector_type(4)));
typedef unsigned u32x2 __attribute__((ext_vector_type(2)));
typedef GAS unsigned gu32;
typedef int i32x4 __attribute__((ext_vector_type(4)));
typedef int i32x8 __attribute__((ext_vector_type(8)));
#define RLX_AGENT __ATOMIC_RELAXED, __HIP_MEMORY_SCOPE_AGENT
#define LDS_WAIT() asm volatile("s_waitcnt lgkmcnt(0)" ::: "memory")
#define VM_WAIT() asm volatile("s_waitcnt vmcnt(0)" ::: "memory")

typedef __bf16 bf16x2_t __attribute__((ext_vector_type(2)));
__device__ __forceinline__ unsigned cvt_pk_bf16(float lo, float hi) { const f32x2 v = {lo, hi}; const bf16x2_t b = __builtin_convertvector(v, bf16x2_t); return __builtin_bit_cast(unsigned, b); }
__device__ __forceinline__ unsigned f2bf(float f) { unsigned u = __builtin_bit_cast(unsigned, f); return (u + 0x7fffu + ((u >> 16) & 1u)) >> 16; }
__device__ __forceinline__ unsigned pk2(float lo, float hi) { return f2bf(lo) | (f2bf(hi) << 16); }
__device__ __forceinline__ float bf2f(bf16 b) { return __builtin_bit_cast(float, (unsigned)b << 16); }
__device__ __forceinline__ float bflo(unsigned u) { return __builtin_bit_cast(float, u << 16); }
__device__ __forceinline__ float bfhi(unsigned u) { return __builtin_bit_cast(float, u & 0xffff0000u); }
__device__ __forceinline__ float fexp2(float x) { return __builtin_amdgcn_exp2f(x); }
__device__ __forceinline__ float fexp(float x) { return __builtin_amdgcn_exp2f(x * 1.4426950408889634f); }
__device__ __forceinline__ float frcp(float x) { return __builtin_amdgcn_rcpf(x); }
__device__ __forceinline__ float sigmoidf_(float x) { return frcp(1.0f + fexp(-x)); }
__device__ __forceinline__ unsigned pk4_fp8(float a, float b, float c, float d) {
    a = __builtin_amdgcn_fmed3f(a, -448.f, 448.f); b = __builtin_amdgcn_fmed3f(b, -448.f, 448.f); c = __builtin_amdgcn_fmed3f(c, -448.f, 448.f); d = __builtin_amdgcn_fmed3f(d, -448.f, 448.f);
    int w = 0; w = __builtin_amdgcn_cvt_pk_fp8_f32(a, b, w, false); w = __builtin_amdgcn_cvt_pk_fp8_f32(c, d, w, true); return (unsigned)w; }
__device__ __forceinline__ i32x8 cat8(bf16x8 lo, bf16x8 hi) { const i32x4 a = __builtin_bit_cast(i32x4, lo), b = __builtin_bit_cast(i32x4, hi); return __builtin_shufflevector(a, b, 0, 1, 2, 3, 4, 5, 6, 7); }
constexpr float F8_SA = 16.f, F8_SW = 256.f, F8_SACT = 8.f;
#ifndef F8_SCALE
#define F8_SCALE 0x7F7F7F7F
#endif

namespace pg8 {
constexpr int BM = 256, BK = 64, HALF = 128, HTB = HALF * BK * 2  , STAGE_BYTES = 8 * HTB, NXCD = 8, WGM = 8;
__host__ __device__ __forceinline__ int lds_byte(int r, int c) { const int st = (r >> 4) * 2 + (c >> 5), rr = r & 15, cc = c & 31, ob = rr * 64 + cc * 2; return st * 1024 + (ob ^ (((ob >> 9) & 1) << 5)); }
__host__ __device__ __forceinline__ void stage_rc(int b, int& R, int& C) { const int st = b / 1024, sb = b % 1024, swz = sb ^ (((sb >> 9) & 1) << 5); R = (st >> 1) * 16 + swz / 64; C = (st & 1) * 32 + (swz % 64) / 2; }
__host__ __device__ __forceinline__ int perm32(int rho) { const int n = rho >> 4, i = rho & 15; return 8 * (i >> 2) + 4 * n + (i & 3); }

struct Unit { int pm, pn, e, nvalid, lbase, orow; };
struct Gemm { const bf16* A; const bf16* Bt; int K; size_t bstride; const int* rowlist; };

struct StaticOrder {
    int nM, nN, nwg, G, c;
    __device__ __forceinline__ void init(int M, int N, int G_, int c_, int rot) { nM = M / BM; nN = N / BM; nwg = nM * nN; G = G_; c = (c_ + rot) % G_; }
    __device__ __forceinline__ bool next(int i, Unit& u) const {
        const long L = (long)i * G + c; if (L >= nwg) return false;
        int wgid = (int)L; { const int q = nwg / NXCD, r = nwg % NXCD, xcd = wgid % NXCD, off = wgid / NXCD; wgid = (xcd < r ? xcd * (q + 1) : r * (q + 1) + (xcd - r) * q) + off; }
        const int nig = WGM * nN, gid = wgid / nig, fm = gid * WGM, gsz = (nM - fm) < WGM ? (nM - fm) : WGM;
        u.pm = fm + ((wgid % nig) % gsz); u.pn = (wgid % nig) / gsz; u.e = 0; u.nvalid = 256; u.lbase = 0; u.orow = u.pm * BM; return true;
    }
};

template <class Epi, class Sched, bool ALIGN_EPI, bool GATHER, bool F8 = false>
__device__ __forceinline__ void gemm_phase(LAS unsigned char* lds, LAS int* lstage  , const Gemm g, const Sched& S, const Epi& E) {
    int tid = threadIdx.x; asm volatile("" : "+v"(tid));
    const int wid = __builtin_amdgcn_readfirstlane(tid >> 6), lane = tid & 63, wr = wid >> 2, wc = wid & 3, fr = lane & 15, fq = lane >> 4;
    const int K = g.K, nt = K / BK;
    unsigned voffB[2], vA[2][2];
#pragma unroll
    for (int i = 0; i < 2; ++i) { int R, C; stage_rc(tid * 16 + i * 8192, R, C); const int Rb = Epi::PERM ? ((R & ~31) + perm32(R & 31)) : R;
        voffB[i] = (unsigned)(Rb * K + C) * 2u;
#pragma unroll
        for (int h = 0; h < 2; ++h) vA[h][i] = (unsigned)((h * HALF + R) * K + C) * 2u; }
    const size_t kstep = (size_t)(BK * 2);
    const size_t hstep = (size_t)HALF * K * 2;
    const size_t tstep = 2 * hstep;
    constexpr int AH1 = GATHER ? 1 : 0; const size_t AH = GATHER ? (size_t)0 : hstep;
    const unsigned ldsw = (unsigned)wid * 1024u;
    const int aoff = lds_byte(wr * 64 + fr, fq * 8), boff = lds_byte(wc * 32 + fr, fq * 8);
#define PG8_SA(b, h) (((b) * 2 + (h)) * HTB)
#define PG8_SB(b, h) ((4 + (b) * 2 + (h)) * HTB)
#define PG8_STAGE_(rs, base, bufoff, off, voff) do { _Pragma("unroll") for (int _i = 0; _i < 2; ++_i) { \
        if constexpr (F8) { unsigned keep_; asm volatile("s_mov_b32 %0, m0\n\ts_mov_b32 m0, %1\n\ts_nop 0\n\tbuffer_load_dwordx4 %2, %3, %4 offen lds\n\ts_mov_b32 m0, %0" \
            : "=&s"(keep_) : "s"(lds32 + (unsigned)(bufoff) + ldsw + (unsigned)_i * 8192u), "v"((voff)[_i]), "s"(rs), "s"((unsigned)(off)) : "memory"); } \
        else __builtin_amdgcn_global_load_lds((const unsigned*)((const char*)(base) + (off) + (voff)[_i]), (LAS unsigned*)(lds + (bufoff) + ldsw + _i * 8192), 16, 0, 0); } } while (0)
#define PG8_STA(bufoff, off, voff) PG8_STAGE_(rsA, g.A, bufoff, off, voff)
#define PG8_STB(bufoff, off, voff) PG8_STAGE_(rsB, g.Bt, bufoff, off, voff)
#define PG8_LDA(dst, b, h) do { _Pragma("unroll") for (int m = 0; m < 4; ++m) _Pragma("unroll") for (int k = 0; k < 2; ++k) dst[m][k] = *(const LAS bf16x8*)(lds + PG8_SA(b, h) + aoff + m * 2048 + k * 1024); } while (0)
#define PG8_LDB(dst, b, h) do { _Pragma("unroll") for (int n = 0; n < 2; ++n) _Pragma("unroll") for (int k = 0; k < 2; ++k) dst[n][k] = *(const LAS bf16x8*)(lds + PG8_SB(b, h) + boff + n * 2048 + k * 1024); } while (0)
#define PG8_MMA(ai, bj, At, Bt) do { __builtin_amdgcn_s_setprio(1); _Pragma("unroll") for (int m = 0; m < 4; ++m) _Pragma("unroll") for (int n = 0; n < 2; ++n) { \
        if constexpr (F8) acc[ai][bj][m][n] = __builtin_amdgcn_mfma_scale_f32_16x16x128_f8f6f4(cat8(Bt[n][0], Bt[n][1]), cat8(At[m][0], At[m][1]), acc[ai][bj][m][n], 0, 0, 0, F8_SCALE, 0, F8_SCALE); \
        else { _Pragma("unroll") for (int k = 0; k < 2; ++k) acc[ai][bj][m][n] = __builtin_amdgcn_mfma_f32_16x16x32_bf16(Bt[n][k], At[m][k], acc[ai][bj][m][n], 0, 0, 0); } } __builtin_amdgcn_s_setprio(0); } while (0)
#define PG8_WAIT_V(n) asm volatile("s_waitcnt vmcnt(" #n ")" ::: "memory")
#define PG8_WAIT_L(n) asm volatile("s_waitcnt lgkmcnt(" #n ")" ::: "memory")
#define PG8_BAR __builtin_amdgcn_s_barrier()
#define PG8_SCHED __builtin_amdgcn_sched_barrier(0)
    Unit cur, nxt; int ui = 0;
    if (!S.next(0, cur)) return;
    f32x4 acc[2][2][4][2];
#pragma unroll
    for (int a = 0; a < 2; ++a)
#pragma unroll
        for (int b = 0; b < 2; ++b)
#pragma unroll
            for (int m = 0; m < 4; ++m)
#pragma unroll
                for (int n = 0; n < 2; ++n) acc[a][b][m][n] = (f32x4){0.f, 0.f, 0.f, 0.f};
    bf16x8 At[4][2], B0[2][2], B1[2][2];
    size_t cA = GATHER ? (size_t)0 : (size_t)cur.pm * tstep;
    size_t cB = ((size_t)cur.e * g.bstride) * 2 + (size_t)cur.pn * tstep;
    const unsigned lds32 = (unsigned)(uintptr_t)lds;
    const __amdgpu_buffer_rsrc_t rsA = __builtin_amdgcn_make_buffer_rsrc((void*)g.A, 0, 0x7fffffff, 0x00020000), rsB = __builtin_amdgcn_make_buffer_rsrc((void*)g.Bt, 0, 0x7fffffff, 0x00020000);
    if constexpr (GATHER) {
        if (wid == 0) { unsigned lo16 = threadIdx.x; asm volatile("" : "+v"(lo16)); lo16 = (lo16 & 63u) * 16u; __builtin_amdgcn_global_load_lds((const unsigned*)((const char*)(g.rowlist + cur.lbase) + lo16), (LAS unsigned*)lstage, 16, 0, 0); }
        PG8_WAIT_V(0); __builtin_amdgcn_s_barrier();
#pragma unroll
        for (int h = 0; h < 2; ++h)
#pragma unroll
            for (int i = 0; i < 2; ++i) { int R, C; stage_rc(tid * 16 + i * 8192, R, C); const int rr = h * HALF + R; const int ent = lstage[rr]; const int src = rr < cur.nvalid ? ((ent >> 2) & 16383) : 0; vA[h][i] = (unsigned)(src * K + C) * 2u; }
        PG8_WAIT_L(0); __builtin_amdgcn_s_barrier();
    }
    PG8_STB(PG8_SB(0, 0), cB, voffB); PG8_STB(PG8_SB(0, 1), cB + hstep, voffB); PG8_STA(PG8_SA(0, 0), cA, vA[0]); PG8_STA(PG8_SA(0, 1), cA + AH, vA[AH1]);
    if (wr == 1) PG8_BAR;
    PG8_WAIT_V(2); PG8_BAR;
    PG8_STB(PG8_SB(1, 0), cB + kstep, voffB); PG8_STA(PG8_SA(1, 0), cA + kstep, vA[0]); PG8_STB(PG8_SB(1, 1), cB + hstep + kstep, voffB);
    PG8_WAIT_V(6); PG8_BAR;
    for (;;) {
        const bool has_next = S.next(ui + 1, nxt);
        const size_t nA = has_next ? (GATHER ? (size_t)0 : (size_t)nxt.pm * tstep) : cA;
        const size_t nB = has_next ? ((size_t)nxt.e * g.bstride) * 2 + (size_t)nxt.pn * tstep : cB;
#pragma unroll 1
        for (int t = 0; t < nt; t += 2) {
            const bool last = (t == nt - 2);
            if constexpr (GATHER) {
                if (t == 0 && has_next && wid == 0) { unsigned lo16 = threadIdx.x; asm volatile("" : "+v"(lo16)); lo16 = (lo16 & 63u) * 16u;
                    __builtin_amdgcn_global_load_lds((const unsigned*)((const char*)(g.rowlist + nxt.lbase) + lo16), (LAS unsigned*)(lstage + 256 * ((ui + 1) & 1)), 16, 0, 0); }
            }
            const size_t a1 = cA + (size_t)(t + 1) * kstep;
            const size_t a2 = last ? nA : cA + (size_t)(t + 2) * kstep; const size_t b2 = last ? nB : cB + (size_t)(t + 2) * kstep;
            const size_t a3 = a2 + kstep; const size_t b3 = b2 + kstep;
            PG8_LDB(B0, 0, 0); PG8_LDB(B1, 0, 1); PG8_SCHED; PG8_LDA(At, 0, 0); PG8_STA(PG8_SA(1, 1), a1 + AH, vA[AH1]);
            if constexpr (GATHER) { if (last && has_next) {
                int tl = tid; asm volatile("" : "+v"(tl));
#pragma unroll
                for (int h = 0; h < 2; ++h)
#pragma unroll
                    for (int i = 0; i < 2; ++i) { int R, C; stage_rc(tl * 16 + i * 8192, R, C); const int rr = h * HALF + R; const int ent = lstage[256 * ((ui + 1) & 1) + rr]; const int src = rr < nxt.nvalid ? ((ent >> 2) & 16383) : 0; vA[h][i] = (unsigned)(src * K + C) * 2u; } } }
            PG8_WAIT_V(8); PG8_WAIT_L(0); PG8_BAR; PG8_MMA(0, 0, At, B0); PG8_MMA(0, 1, At, B1); PG8_BAR; PG8_SCHED;
            PG8_LDA(At, 0, 1); PG8_STB(PG8_SB(0, 0), b2, voffB); PG8_STB(PG8_SB(0, 1), b2 + hstep, voffB); PG8_STA(PG8_SA(0, 0), a2, vA[0]);
            PG8_WAIT_V(8); PG8_WAIT_L(0); PG8_BAR; PG8_MMA(1, 0, At, B0); PG8_MMA(1, 1, At, B1); PG8_BAR; PG8_SCHED;
            PG8_LDB(B0, 1, 0); PG8_LDB(B1, 1, 1); PG8_SCHED; PG8_LDA(At, 1, 0); PG8_STA(PG8_SA(0, 1), a2 + AH, vA[AH1]);
            PG8_WAIT_V(8); PG8_WAIT_L(0); PG8_BAR; PG8_MMA(0, 0, At, B0); PG8_MMA(0, 1, At, B1); PG8_BAR; PG8_SCHED;
            PG8_LDA(At, 1, 1); PG8_STB(PG8_SB(1, 0), b3, voffB); PG8_STB(PG8_SB(1, 1), b3 + hstep, voffB); PG8_STA(PG8_SA(1, 0), a3, vA[0]);
            PG8_WAIT_V(8); PG8_WAIT_L(0); PG8_BAR; PG8_MMA(1, 0, At, B0); PG8_MMA(1, 1, At, B1); PG8_BAR; PG8_SCHED;
        }
        if constexpr (ALIGN_EPI) { if (wr == 0) PG8_BAR; }
        E(acc, cur, wr, wc, fr, fq);
        if (!has_next) break;
#pragma unroll
        for (int a = 0; a < 2; ++a)
#pragma unroll
            for (int b = 0; b < 2; ++b)
#pragma unroll
                for (int m = 0; m < 4; ++m)
#pragma unroll
                    for (int n = 0; n < 2; ++n) acc[a][b][m][n] = (f32x4){0.f, 0.f, 0.f, 0.f};
        cur = nxt; cA = nA; cB = nB; ++ui;
        if constexpr (ALIGN_EPI) { if (wr == 1) PG8_BAR; }
    }
    PG8_WAIT_V(0);
    if constexpr (!ALIGN_EPI) { if (wr == 0) PG8_BAR; }
    PG8_BAR;
#undef PG8_SA
#undef PG8_SB
#undef PG8_STAGE_
#undef PG8_STA
#undef PG8_STB
#undef PG8_LDA
#undef PG8_LDB
#undef PG8_MMA
#undef PG8_WAIT_V
#undef PG8_WAIT_L
#undef PG8_BAR
#undef PG8_SCHED
}
}
constexpr int NWAVES = 8, NTHR = 512;
constexpr int BATCH = 2, T = 8192, D = 1024, M = BATCH * T;
constexpr int CH = 64, NCHUNK = T / CH;
constexpr int RW = 512, RH = 8, RN = 64;
constexpr int DH = 4, DD = 64, DV = 128;
constexpr int SHIFT_COLS = 1792, PCOLS = 2816, IN_COLS = 3328;
constexpr int C_R = 0, C_K = 512, C_V = 1024, C_WD = 1536, C_AD = 1600, C_GD = 1664, C_QD = 1792, C_KD = 2304, C_VD = 2816;
constexpr int MEM = 256, XH = 4, XD = 256;
constexpr int NE = 32, TOPK = 4, FF = 1024, CAP = M;
constexpr int MAXRT = (M * TOPK) / 256 + NE;
constexpr float NORM_EPS = 1e-5f, GN_EPS = 64e-5f, LOG2E = 1.4426950408889634f;
constexpr float LAMBDA_INIT = 0.8f - 0.6f;

constexpr size_t MiB = 1u << 20;
constexpr size_t WS_CTL = 0, CTL_ZERO_BYTES = 1 * MiB;
constexpr size_t WS_SS1 = 250 * MiB + 512 * 1024, WS_SS3 = 251 * MiB;
constexpr size_t WS_WINT = 1 * MiB, WS_WOUTT = 8 * MiB, WS_WQT = 10 * MiB, WS_WKVT = 12 * MiB, WS_WOT = 16 * MiB;
constexpr size_t WS_W2LT = 18 * MiB, WS_A2LT = WS_W2LT + 64 * 1024, WS_G2LT = WS_W2LT + 128 * 1024, WS_RWT = WS_W2LT + 256 * 1024;
constexpr size_t WS_W1T = 20 * MiB, WS_W2T = 148 * MiB;
constexpr size_t WS_LGATE = 212 * MiB, WS_LRINV = 214 * MiB;
constexpr size_t WS_XN = 212 * MiB, WS_MEMN = 244 * MiB, WS_KMEM = 245 * MiB, WS_VTMEM = 246 * MiB;
constexpr size_t WS_LISTS = 247 * MiB, WS_GATES = 249 * MiB, WS_GC = 249 * MiB + 512 * 1024, WS_BS = 250 * MiB;
constexpr size_t WS_PROJ = 252 * MiB, WS_VT = 340 * MiB, WS_QT = 356 * MiB, WS_PT = 372 * MiB, WS_S0 = 388 * MiB, WS_GATE = 404 * MiB, WS_YLOC = 420 * MiB, WS_NN = 452 * MiB;
constexpr size_t WS_CAT = 484 * MiB, WS_H1 = 516 * MiB, WS_H1B = 580 * MiB, WS_QX = 612 * MiB, WS_XO = 644 * MiB, WS_H2 = 676 * MiB, WS_H2B = 740 * MiB;
constexpr size_t WS_ACT = 252 * MiB;
constexpr size_t WS_YBUF = 404 * MiB, WS_END = 772 * MiB;
static_assert(WS_ACT + (size_t)MAXRT * 256 * FF * 2 <= WS_GATE, "ACT overlay");
static_assert(WS_PROJ + (size_t)M * PCOLS * 2 <= WS_VT, "PROJ");
constexpr int CW_TMO = 0, CW_BAR = 4096, CW_CNT = 8192;
static_assert((CW_BAR + 3456) <= CW_CNT && (CW_CNT + 64 * NE) * 4 <= (int)CTL_ZERO_BYTES, "CTL map");

constexpr int RING_BYTES = 131072;
constexpr int X_OFF = RING_BYTES;
constexpr int MISC_OFF = 163840 - 1024;
constexpr int LDS_BYTES = 163840;

__device__ __forceinline__ float row_ss(const float* ssp, int row) {
    const f32x4 a = *(const f32x4*)(ssp + (size_t)row * 16), b = *(const f32x4*)(ssp + (size_t)row * 16 + 4), c = *(const f32x4*)(ssp + (size_t)row * 16 + 8), d = *(const f32x4*)(ssp + (size_t)row * 16 + 12);
    return (((a[0] + a[1]) + (a[2] + a[3])) + ((b[0] + b[1]) + (b[2] + b[3]))) + (((c[0] + c[1]) + (c[2] + c[3])) + ((d[0] + d[1]) + (d[2] + d[3])));
}
namespace pg8 {
struct EpiBf16 {
    static constexpr bool PERM = true;
    bf16* O; int ldc;
    __device__ __forceinline__ void operator()(const f32x4 (&acc)[2][2][4][2], const Unit& u, int wr, int wc, int fr, int fq) const {
        { unsigned tl = threadIdx.x; asm volatile("" : "+v"(tl)); fr = (int)(tl & 15u); fq = (int)((tl >> 4) & 3u); }
        const int col0 = u.pn * BM + wc * 32 + 8 * fq;
#pragma unroll
        for (int ai = 0; ai < 2; ++ai)
#pragma unroll
            for (int m = 0; m < 4; ++m) { bf16* rowp = O + (size_t)(u.orow + ai * HALF + wr * 64 + m * 16 + fr) * ldc + col0;
#pragma unroll
                for (int bj = 0; bj < 2; ++bj) { const f32x4 v0 = acc[ai][bj][m][0], v1 = acc[ai][bj][m][1];
                    u32x4 w; w.x = cvt_pk_bf16(v0[0], v0[1]); w.y = cvt_pk_bf16(v0[2], v0[3]); w.z = cvt_pk_bf16(v1[0], v1[1]); w.w = cvt_pk_bf16(v1[2], v1[3]);
                    *(u32x4*)(rowp + bj * HALF) = w; } }
    }
};
struct EpiRowScaleBf16 {
    static constexpr bool PERM = true;
    bf16* O; int ldc; const float* ss; float scale;
    __device__ __forceinline__ void operator()(const f32x4 (&acc)[2][2][4][2], const Unit& u, int wr, int wc, int fr, int fq) const {
        { unsigned tl = threadIdx.x; asm volatile("" : "+v"(tl)); fr = (int)(tl & 15u); fq = (int)((tl >> 4) & 3u); }
        const int col0 = u.pn * BM + wc * 32 + 8 * fq;
#pragma unroll
        for (int ai = 0; ai < 2; ++ai)
#pragma unroll
            for (int m = 0; m < 4; ++m) { const int row = u.orow + ai * HALF + wr * 64 + m * 16 + fr; bf16* rowp = O + (size_t)row * ldc + col0;
                const float s = scale * __builtin_amdgcn_rsqf(row_ss(ss, row) * (1.0f / D) + NORM_EPS);
#pragma unroll
                for (int bj = 0; bj < 2; ++bj) { const f32x4 v0 = acc[ai][bj][m][0] * s, v1 = acc[ai][bj][m][1] * s;
                    u32x4 w; w.x = cvt_pk_bf16(v0[0], v0[1]); w.y = cvt_pk_bf16(v0[2], v0[3]); w.z = cvt_pk_bf16(v1[0], v1[1]); w.w = cvt_pk_bf16(v1[2], v1[3]);
                    *(u32x4*)(rowp + bj * HALF) = w; } }
    }
};
struct EpiResid {
    static constexpr bool PERM = true;
    const float* base; float* H; bf16* Hb; float* ss;
    __device__ __forceinline__ void operator()(const f32x4 (&acc)[2][2][4][2], const Unit& u, int wr, int wc, int fr, int fq) const {
        { unsigned tl = threadIdx.x; asm volatile("" : "+v"(tl)); fr = (int)(tl & 15u); fq = (int)((tl >> 4) & 3u); }
        const int col0 = u.pn * BM + wc * 32 + 8 * fq;
#pragma unroll
        for (int ai = 0; ai < 2; ++ai)
#pragma unroll
            for (int m = 0; m < 4; ++m) { const int row = u.orow + ai * HALF + wr * 64 + m * 16 + fr; const size_t off = (size_t)row * D + col0; float q = 0.f;
#pragma unroll
                for (int bj = 0; bj < 2; ++bj) {
                    const f32x4 b0 = *(const f32x4*)(base + off + bj * HALF), b1 = *(const f32x4*)(base + off + bj * HALF + 4);
                    const f32x4 v0 = acc[ai][bj][m][0] + b0, v1 = acc[ai][bj][m][1] + b1;
                    *(f32x4*)(H + off + bj * HALF) = v0; *(f32x4*)(H + off + bj * HALF + 4) = v1;
                    u32x4 w; w.x = cvt_pk_bf16(v0[0], v0[1]); w.y = cvt_pk_bf16(v0[2], v0[3]); w.z = cvt_pk_bf16(v1[0], v1[1]); w.w = cvt_pk_bf16(v1[2], v1[3]);
                    *(u32x4*)(Hb + off + bj * HALF) = w;
                    q += (v0[0] * v0[0] + v0[1] * v0[1]) + (v0[2] * v0[2] + v0[3] * v0[3]) + (v1[0] * v1[0] + v1[1] * v1[1]) + (v1[2] * v1[2] + v1[3] * v1[3]); }
                q += __shfl_xor(q, 16); q += __shfl_xor(q, 32);
                if (fq == 0) ss[(size_t)row * 16 + u.pn * 4 + wc] = q; }
    }
};
template <int M8>
struct EpiResid2T {
    static constexpr bool PERM = true; static constexpr bool HB8 = (M8 == 1);
    const float* basef; const bf16* baseb; float* H; bf16* Hb; float* ss; const float* g8; unsigned char* H8; float ascale;
    __device__ __forceinline__ void operator()(const f32x4 (&acc)[2][2][4][2], const Unit& u, int wr, int wc, int fr, int fq) const {
        { unsigned tl = threadIdx.x; asm volatile("" : "+v"(tl)); fr = (int)(tl & 15u); fq = (int)((tl >> 4) & 3u); }
        const int col0 = u.pn * BM + wc * 32 + 8 * fq;
        f32x4 gs[2][2];
        if constexpr (HB8) {
#pragma unroll
            for (int bj = 0; bj < 2; ++bj) { gs[bj][0] = *(const f32x4*)(g8 + col0 + bj * HALF) * F8_SA; gs[bj][1] = *(const f32x4*)(g8 + col0 + bj * HALF + 4) * F8_SA; } }
#pragma unroll
        for (int ai = 0; ai < 2; ++ai)
#pragma unroll
            for (int m = 0; m < 4; ++m) { const int row = u.orow + ai * HALF + wr * 64 + m * 16 + fr; const size_t off = (size_t)row * D + col0; float q = 0.f;
#pragma unroll
                for (int bj = 0; bj < 2; ++bj) {
                    f32x4 b0, b1;
                    if (basef) { b0 = *(const f32x4*)(basef + off + bj * HALF); b1 = *(const f32x4*)(basef + off + bj * HALF + 4); }
                    else { const u32x4 bb = *(const u32x4*)(baseb + off + bj * HALF); b0 = (f32x4){bflo(bb.x), bfhi(bb.x), bflo(bb.y), bfhi(bb.y)}; b1 = (f32x4){bflo(bb.z), bfhi(bb.z), bflo(bb.w), bfhi(bb.w)}; }
                    const f32x4 v0 = acc[ai][bj][m][0] * ascale + b0, v1 = acc[ai][bj][m][1] * ascale + b1;
                    if (H) { *(f32x4*)(H + off + bj * HALF) = v0; *(f32x4*)(H + off + bj * HALF + 4) = v1; }
                    if constexpr (M8 == 1) { const f32x4 s0 = v0 * gs[bj][0], s1 = v1 * gs[bj][1]; u32x2 w8; w8.x = pk4_fp8(s0[0], s0[1], s0[2], s0[3]); w8.y = pk4_fp8(s1[0], s1[1], s1[2], s1[3]);
                        *(u32x2*)(H8 + off + bj * HALF) = w8; }
                    if constexpr (M8 == 2) { const f32x4 s0 = v0 * F8_SA, s1 = v1 * F8_SA; u32x2 w8; w8.x = pk4_fp8(s0[0], s0[1], s0[2], s0[3]); w8.y = pk4_fp8(s1[0], s1[1], s1[2], s1[3]);
                        *(u32x2*)(H8 + off + bj * HALF) = w8; }
                    if constexpr (M8 != 1) { u32x4 w; w.x = cvt_pk_bf16(v0[0], v0[1]); w.y = cvt_pk_bf16(v0[2], v0[3]); w.z = cvt_pk_bf16(v1[0], v1[1]); w.w = cvt_pk_bf16(v1[2], v1[3]);
                        *(u32x4*)(Hb + off + bj * HALF) = w; }
                    q += (v0[0] * v0[0] + v0[1] * v0[1]) + (v0[2] * v0[2] + v0[3] * v0[3]) + (v1[0] * v1[0] + v1[1] * v1[1]) + (v1[2] * v1[2] + v1[3] * v1[3]); }
                q += __shfl_xor(q, 16); q += __shfl_xor(q, 32);
                if (fq == 0) ss[(size_t)row * 16 + u.pn * 4 + wc] = q; }
    }
};
using EpiResid2 = EpiResid2T<0>;
constexpr float F8_SXO = 128.f;
struct EpiSwiglu {
    static constexpr bool PERM = true; static constexpr float LOG2E_ = 1.4426950408889634f;
    unsigned char* ACT; const float* b1; const float* lrinv; const int* list;
    __device__ __forceinline__ void operator()(const f32x4 (&acc)[2][2][4][2], const Unit& u, int wr, int wc, int fr, int fq) const {
        { unsigned tl = threadIdx.x; asm volatile("" : "+v"(tl)); fr = (int)(tl & 15u); fq = (int)((tl >> 4) & 3u); }
        const int j0 = u.pn * HALF + wc * 32 + 8 * fq; const float* bg = b1 + (size_t)u.e * (2 * FF) + j0; const float* bl = bg + FF;
        const f32x4 g0 = *(const f32x4*)bg, g1 = *(const f32x4*)(bg + 4), l0 = *(const f32x4*)bl, l1 = *(const f32x4*)(bl + 4);
        float sr[2][4];
#pragma unroll
        for (int ai = 0; ai < 2; ++ai)
#pragma unroll
            for (int m = 0; m < 4; ++m) sr[ai][m] = lrinv[u.lbase + ai * HALF + wr * 64 + m * 16 + fr];
#pragma unroll
        for (int ai = 0; ai < 2; ++ai)
#pragma unroll
            for (int m = 0; m < 4; ++m) { const int rr = ai * HALF + wr * 64 + m * 16 + fr;
                if (rr < u.nvalid) {
                    const float s = sr[ai][m] * (1.0f / (F8_SA * F8_SW));
                    u32x2 w;
#pragma unroll
                    for (int n = 0; n < 2; ++n) {
                        f32x4 gt = acc[ai][0][m][n] * s + (n ? g1 : g0), ln = acc[ai][1][m][n] * s + (n ? l1 : l0);
#pragma unroll
                        for (int j = 0; j < 4; ++j) { gt[j] = fminf(gt[j], 7.0f); ln[j] = __builtin_amdgcn_fmed3f(ln[j], -7.0f, 7.0f); }
                        f32x4 ex = gt * (-1.702f * LOG2E_);
#pragma unroll
                        for (int j = 0; j < 4; ++j) ex[j] = fexp2(ex[j]);
                        ex = ex + 1.0f;
#pragma unroll
                        for (int j = 0; j < 4; ++j) ex[j] = frcp(ex[j]);
                        const f32x4 o = (gt * ex) * (ln * F8_SACT + F8_SACT);
                        int pk = 0; pk = __builtin_amdgcn_cvt_pk_fp8_f32(o[0], o[1], pk, false); pk = __builtin_amdgcn_cvt_pk_fp8_f32(o[2], o[3], pk, true);
                        if (n == 0) w.x = (unsigned)pk; else w.y = (unsigned)pk; }
                    *(u32x2*)(ACT + (size_t)(u.orow + rr) * FF + j0) = w; } }
        asm volatile("" :: "v"(g0), "v"(g1), "v"(l0), "v"(l1));
    }
};
struct EpiMoe2 {
    static constexpr bool PERM = true;
    bf16* Y; const float* b2; const float* gates; const int* list;
    __device__ __forceinline__ void operator()(const f32x4 (&acc)[2][2][4][2], const Unit& u, int wr, int wc, int fr, int fq) const {
        { unsigned tl = threadIdx.x; asm volatile("" : "+v"(tl)); fr = (int)(tl & 15u); fq = (int)((tl >> 4) & 3u); }
        const int col0 = u.pn * BM + wc * 32 + 8 * fq; const float* bb = b2 + (size_t)u.e * D + col0;
        f32x4 bv[2][2];
#pragma unroll
        for (int bj = 0; bj < 2; ++bj) { bv[bj][0] = *(const f32x4*)(bb + bj * HALF); bv[bj][1] = *(const f32x4*)(bb + bj * HALF + 4); }
        int en[2][4]; float gt[2][4];
#pragma unroll
        for (int ai = 0; ai < 2; ++ai)
#pragma unroll
            for (int m = 0; m < 4; ++m) { const int ix = u.lbase + ai * HALF + wr * 64 + m * 16 + fr; en[ai][m] = list[ix]; gt[ai][m] = gates[ix]; }
#pragma unroll
        for (int ai = 0; ai < 2; ++ai)
#pragma unroll
            for (int m = 0; m < 4; ++m) { const int rr = ai * HALF + wr * 64 + m * 16 + fr;
                if (rr < u.nvalid) {
                    const int ent = en[ai][m] & 65535; const float gw = gt[ai][m]; bf16* rowp = Y + (size_t)ent * D + col0;
#pragma unroll
                    for (int bj = 0; bj < 2; ++bj) { const f32x4 v0 = (acc[ai][bj][m][0] * (1.0f / (F8_SACT * F8_SW)) + bv[bj][0]) * gw, v1 = (acc[ai][bj][m][1] * (1.0f / (F8_SACT * F8_SW)) + bv[bj][1]) * gw;
                        u32x4 w; w.x = cvt_pk_bf16(v0[0], v0[1]); w.y = cvt_pk_bf16(v0[2], v0[3]); w.z = cvt_pk_bf16(v1[0], v1[1]); w.w = cvt_pk_bf16(v1[2], v1[3]);
                        *(u32x4*)(rowp + bj * HALF) = w; } } }
        asm volatile("" :: "v"(bv[0][0]), "v"(bv[0][1]), "v"(bv[1][0]), "v"(bv[1][1]));
    }
};
struct MoeOrder {
    const LAS int* tb; const LAS int* cn; const LAS int* rte; int ncol, G, c, ntile;
    __device__ __forceinline__ bool next(int i, Unit& u) const {
        const int L = i * G + c, rt = L / ncol, pn = L % ncol; if (rt >= ntile) return false;
        const int e = __builtin_amdgcn_readfirstlane(rte[rt]);
        const int tile = rt - __builtin_amdgcn_readfirstlane(tb[e]), left = __builtin_amdgcn_readfirstlane(cn[e]) - tile * 256;
        u.pm = rt; u.pn = pn; u.e = e; u.nvalid = left < 256 ? left : 256; u.lbase = e * CAP + tile * 256; u.orow = rt * 256; return true;
    }
};
}
#define XB_TMO      128
#define XB_XCNT(j)  (256  + 64 * (j))
#define XB_XSUB(j)  (1280 + 64 * (j))
#define XB_XGEN(j)  (2304 + 64 * (j))
#define XB_TOP      3328
#define XB_TOPGEN   3392
#define XCD_BAR_WORDS 3456
#define XB_SPIN_CAP (1u << 18)

__device__ __forceinline__ unsigned xb_ld(unsigned* p)              { return __hip_atomic_load(p, __ATOMIC_RELAXED, __HIP_MEMORY_SCOPE_AGENT); }
__device__ __forceinline__ unsigned xb_add(unsigned* p, unsigned v) { return __hip_atomic_fetch_add(p, v, __ATOMIC_RELAXED, __HIP_MEMORY_SCOPE_AGENT); }
__device__ __forceinline__ unsigned xb_xcc_id() { return (unsigned)__builtin_amdgcn_s_getreg((3 << 11) | 20) & 0xFu; }
#define XB_SPIN(cond, bar) do { unsigned _sp = 0; while (cond) { __builtin_amdgcn_s_sleep(1); \
    if ((++_sp & 255u) == 0u) { if (xb_ld(&(bar)[XB_TMO])) break; if (_sp > XB_SPIN_CAP) { atomicAdd(&(bar)[XB_TMO], 1u); break; } } } } while (0)

struct XcdBarrier {
    unsigned* bar; unsigned x;
    volatile LAS unsigned* st;
};

__device__ __forceinline__ XcdBarrier xcd_barrier_post(unsigned* bar, volatile LAS unsigned* st) {
    XcdBarrier b; b.bar = bar; b.x = xb_xcc_id(); b.st = st;
    if (threadIdx.x == 0) (void)xb_add(&bar[XB_XCNT(b.x)], 1u);
    return b;
}
__device__ __forceinline__ void xcd_barrier_complete(unsigned* bar, unsigned x, unsigned& nloc, unsigned& nx) {
    const unsigned G = gridDim.x * gridDim.y * gridDim.z;
    unsigned sum, cnt, mine, sp = 0u;
    for (;;) {
        sum = 0u; cnt = 0u; mine = 0u;
#pragma unroll
        for (unsigned j = 0; j < 16; ++j) { const unsigned c = xb_ld(&bar[XB_XCNT(j)]); sum += c; cnt += (c > 0u) ? 1u : 0u; mine = (j == x) ? c : mine; }
        if (sum == G) break;
        __builtin_amdgcn_s_sleep(1);
        if ((++sp & 255u) == 0u) { if (xb_ld(&bar[XB_TMO])) break; if (sp > XB_SPIN_CAP) { atomicAdd(&bar[XB_TMO], 1u); break; } }
    }
    nloc = mine > 0u ? mine : 1u; nx = cnt > 0u ? cnt : 1u;
}

__device__ __forceinline__ void xcd_barrier(const XcdBarrier& b) {
    asm volatile("s_waitcnt vmcnt(0)" ::: "memory");
    __syncthreads();
    if (threadIdx.x == 0) {
        unsigned* bar = b.bar;
        __builtin_amdgcn_s_waitcnt(0);
        unsigned nloc = b.st[0], nx = b.st[1];
        if (nloc == 0u) { xcd_barrier_complete(bar, b.x, nloc, nx); b.st[0] = nloc; b.st[1] = nx; }
        const unsigned old = xb_add(&bar[XB_XSUB(b.x)], 1u);
        const unsigned gen = old / nloc;
        if (old + 1u == (gen + 1u) * nloc) {
            __builtin_amdgcn_fence(__ATOMIC_RELEASE, "agent");
            asm volatile("s_waitcnt vmcnt(0)" ::: "memory");
            const unsigned og = xb_add(&bar[XB_TOP], 1u);
            const unsigned tg = og / nx;
            if (og + 1u == (tg + 1u) * nx) xb_add(&bar[XB_TOPGEN], 1u);
            else XB_SPIN(xb_ld(&bar[XB_TOPGEN]) == tg, bar);
            __builtin_amdgcn_fence(__ATOMIC_ACQUIRE, "agent");
            xb_add(&bar[XB_XGEN(b.x)], 1u);
            asm volatile("s_waitcnt vmcnt(0)" ::: "memory");
        } else {
            XB_SPIN(xb_ld(&bar[XB_XGEN(b.x)]) == gen, bar);
            __builtin_amdgcn_fence(__ATOMIC_ACQUIRE, "agent");
            asm volatile("s_waitcnt vmcnt(0)" ::: "memory");
        }
    }
    __syncthreads();
}
#ifdef DBG_SEL
#define DBGCNT(F, k, cond) do { if (cond) atomicAdd((unsigned*)((F).ctl + 12288 + (k)), 1u); } while (0)
#else
#define DBGCNT(F, k, cond) do { } while (0)
#endif
struct Frame {
    LAS unsigned char* lds;
    volatile LAS unsigned* MISC;
    gu32* ctl;
    unsigned char* ws;
    int tid, lane, wave, G, bid;
    const float* in[34];
    float* out;
};
__device__ __forceinline__ float wave_sum(float v) {
#pragma unroll
    for (int o = 1; o < 64; o <<= 1) v += __shfl_xor(v, o);
    return v;
}
__device__ __forceinline__ float wave_max(float v) {
#pragma unroll
    for (int o = 1; o < 64; o <<= 1) v = fmaxf(v, __shfl_xor(v, o));
    return v;
}
__device__ __forceinline__ void p0_transpose_item(const float* W, int N, const float* gk, bf16* WT, int Kd, int k0, int n0, int drow, LAS float* scr, int lane) {
    float v[32];
#pragma unroll
    for (int i = 0; i < 32; ++i) { const int kk = 2 * i + (lane >> 5); v[i] = W[(size_t)(k0 + kk) * N + n0 + (lane & 31)]; }
    if (gk) {
#pragma unroll
        for (int i = 0; i < 32; ++i) { const int kk = 2 * i + (lane >> 5); v[i] *= gk[k0 + kk]; }
    }
#pragma unroll
    for (int i = 0; i < 32; ++i) { const int kk = 2 * i + (lane >> 5); scr[kk * 33 + (lane & 31)] = v[i]; }
    LDS_WAIT(); asm volatile("" ::: "memory");
    const int c = lane & 7;
#pragma unroll
    for (int j = 0; j < 4; ++j) { const int n = (lane >> 3) + 8 * j; const LAS float* s = scr + (8 * c) * 33 + n;
        u32x4 o; o.x = pk2(s[0 * 33], s[1 * 33]); o.y = pk2(s[2 * 33], s[3 * 33]); o.z = pk2(s[4 * 33], s[5 * 33]); o.w = pk2(s[6 * 33], s[7 * 33]);
        *(GAS u32x4*)(WT + (size_t)(drow + n) * Kd + k0 + 8 * c) = o; }
    LDS_WAIT(); asm volatile("" ::: "memory");
}
__device__ __forceinline__ void p0_transpose_item8(const float* W, int N, float scale, unsigned char* WT, int Kd, int k0, int n0, int drow, int lane) {
    const int g = lane >> 3, q = lane & 7;
    const GAS f32x4* src = (const GAS f32x4*)(W + (size_t)(k0 + 16 * g) * N + n0 + 4 * q);
    f32x4 v[16];
#pragma unroll
    for (int i = 0; i < 16; ++i) v[i] = src[(size_t)i * (N / 4)] * scale;
#pragma unroll
    for (int j = 0; j < 4; ++j) {
        u32x4 o; o.x = pk4_fp8(v[0][j], v[1][j], v[2][j], v[3][j]); o.y = pk4_fp8(v[4][j], v[5][j], v[6][j], v[7][j]);
        o.z = pk4_fp8(v[8][j], v[9][j], v[10][j], v[11][j]); o.w = pk4_fp8(v[12][j], v[13][j], v[14][j], v[15][j]);
        *(GAS u32x4*)(WT + (size_t)(drow + 4 * q + j) * Kd + k0 + 16 * g) = o; }
}
__device__ __forceinline__ void p0_transpose_item8(const float* W, int N, const float* gk, float scale, unsigned char* WT, int Kd, int k0, int n0, int lane) {
    const int g = lane >> 3, q = lane & 7;
    const GAS f32x4* src = (const GAS f32x4*)(W + (size_t)(k0 + 16 * g) * N + n0 + 4 * q);
    f32x4 v[16];
#pragma unroll
    for (int i = 0; i < 16; ++i) v[i] = src[(size_t)i * (N / 4)] * scale;
    if (gk) {
#pragma unroll
        for (int i4 = 0; i4 < 4; ++i4) { const f32x4 gg = *(const GAS f32x4*)(gk + k0 + 16 * g + 4 * i4);
#pragma unroll
            for (int i = 0; i < 4; ++i) v[4 * i4 + i] = v[4 * i4 + i] * gg[i]; } }
#pragma unroll
    for (int j = 0; j < 4; ++j) {
        u32x4 o; o.x = pk4_fp8(v[0][j], v[1][j], v[2][j], v[3][j]); o.y = pk4_fp8(v[4][j], v[5][j], v[6][j], v[7][j]);
        o.z = pk4_fp8(v[8][j], v[9][j], v[10][j], v[11][j]); o.w = pk4_fp8(v[12][j], v[13][j], v[14][j], v[15][j]);
        *(GAS u32x4*)(WT + (size_t)(n0 + 4 * q + j) * Kd + k0 + 16 * g) = o; }
}
__device__ __forceinline__ void rms_row_to_bf16(const float* xrow, const float* g, bf16* orow, int lane) {
    const GAS f32x4* xr = (const GAS f32x4*)xrow + lane; const GAS f32x4* gr = (const GAS f32x4*)g + lane;
    f32x4 v[4]; float s = 0.f;
#pragma unroll
    for (int j = 0; j < 4; ++j) { v[j] = xr[64 * j]; s += (v[j].x * v[j].x + v[j].y * v[j].y) + (v[j].z * v[j].z + v[j].w * v[j].w); }
    const float rstd = 1.f / sqrtf(wave_sum(s) * (1.f / D) + NORM_EPS);
    GAS unsigned long long* o8 = (GAS unsigned long long*)orow + lane;
#pragma unroll
    for (int j = 0; j < 4; ++j) { const f32x4 gg = gr[64 * j];
        o8[64 * j] = (unsigned long long)pk2(v[j].x * rstd * gg.x, v[j].y * rstd * gg.y) | ((unsigned long long)pk2(v[j].z * rstd * gg.z, v[j].w * rstd * gg.w) << 32); }
}
enum { I_X = 0, I_MEM, I_N1G, I_WIN, I_MU, I_W0, I_W2, I_A0, I_A2, I_G2, I_KK, I_KA, I_RK, I_LNG, I_LNB, I_LQ1, I_LK1, I_LQ2, I_LK2, I_SUBG, I_WOUT, I_N2G, I_MNG, I_WQ, I_WKV, I_WO, I_N3G,
       I_RW, I_RB, I_W1, I_B1, I_W2E, I_B2, I_FG };

__device__ __forceinline__ void p0_prologue(Frame& F) {
    LAS float* scr = (LAS float*)(F.lds + F.wave * 16384);
    const int gw = F.bid * NWAVES + F.wave, NGW = F.G * NWAVES;
    constexpr int I_IN = 16 * (IN_COLS / 32), I_SQ = 16 * 32, I_KV = 16 * 64, I_L64 = 1 * 16, I_L128 = 2 * 16, I_E1 = 16 * 64, I_E2 = 16 * 32;
    constexpr int I_S8 = 8 * 32;
    constexpr int NITEMS = I_IN + I_SQ + 2 * I_S8 + I_KV + 2 * I_L64 + I_L128;
    for (int it = gw; it < NITEMS; it += NGW) {
        int r = it;
        if (r < I_IN) { const int nb = IN_COLS / 32; p0_transpose_item(F.in[I_WIN], IN_COLS, nullptr, (bf16*)(F.ws + WS_WINT), D, 64 * (r / nb), 32 * (r % nb), 32 * (r % nb), scr, F.lane); continue; } r -= I_IN;
        if (r < I_SQ) { p0_transpose_item(F.in[I_WOUT], D, nullptr, (bf16*)(F.ws + WS_WOUTT), D, 64 * (r / 32), 32 * (r % 32), 32 * (r % 32), scr, F.lane); continue; } r -= I_SQ;
        if (r < I_S8) { p0_transpose_item8(F.in[I_WQ], D, F.in[I_N2G], F8_SW, F.ws + WS_WQT, D, 128 * (r / 32), 32 * (r % 32), F.lane); continue; } r -= I_S8;
        if (r < I_S8) { p0_transpose_item8(F.in[I_WO], D, nullptr, F8_SW, F.ws + WS_WOT, D, 128 * (r / 32), 32 * (r % 32), F.lane); continue; } r -= I_S8;
        if (r < I_KV) { p0_transpose_item(F.in[I_WKV], 2 * D, nullptr, (bf16*)(F.ws + WS_WKVT), D, 64 * (r / 64), 32 * (r % 64), 32 * (r % 64), scr, F.lane); continue; } r -= I_KV;
        if (r < I_L64) { p0_transpose_item(F.in[I_W2], RW, nullptr, (bf16*)(F.ws + WS_W2LT), 64, 0, 32 * r, 32 * r, scr, F.lane); continue; } r -= I_L64;
        if (r < I_L64) { p0_transpose_item(F.in[I_A2], RW, nullptr, (bf16*)(F.ws + WS_A2LT), 64, 0, 32 * r, 32 * r, scr, F.lane); continue; } r -= I_L64;
        p0_transpose_item(F.in[I_G2], RW, nullptr, (bf16*)(F.ws + WS_G2LT), 128, 64 * (r / 16), 32 * (r % 16), 32 * (r % 16), scr, F.lane);
    }
    for (int m = gw; m < M; m += NGW) rms_row_to_bf16(F.in[I_X] + (size_t)m * D, F.in[I_N1G], (bf16*)(F.ws + WS_XN) + (size_t)m * D, F.lane);
    for (int m = gw; m < BATCH * MEM; m += NGW) rms_row_to_bf16(F.in[I_MEM] + (size_t)m * D, F.in[I_MNG], (bf16*)(F.ws + WS_MEMN) + (size_t)m * D, F.lane);
    { float* rwt = (float*)(F.ws + WS_RWT); const int gt = F.bid * NTHR + F.tid;
      for (int i = gt; i < NE * D; i += F.G * NTHR) { const int e = i / D, k = i % D; rwt[i] = F.in[I_RW][k * NE + e] * F.in[I_N3G][k]; } }
}

__device__ __forceinline__ void p0_experts(Frame& F, int wg0) {
    constexpr int I_E1 = 8 * 64, I_E2 = 8 * 32;
    const int gw = (F.bid - wg0) * NWAVES + F.wave, NGW = (F.G - wg0) * NWAVES;
    for (int it = gw; it < NE * (I_E1 + I_E2); it += NGW) {
        const int e = it / (I_E1 + I_E2); int r = it - e * (I_E1 + I_E2);
        if (r < I_E1) {
            const int n0 = 32 * (r % 64), k0 = 128 * (r / 64); const int nn = n0 < FF ? n0 : n0 - FF; const int drow = 256 * (nn / 128) + (n0 < FF ? 0 : 128) + (nn % 128);
            p0_transpose_item8(F.in[I_W1] + (size_t)e * D * 2 * FF, 2 * FF, F8_SW, F.ws + WS_W1T + (size_t)e * 2 * FF * D, D, k0, n0, drow, F.lane);
        } else { r -= I_E1;
            p0_transpose_item8(F.in[I_W2E] + (size_t)e * FF * D, D, F8_SW, F.ws + WS_W2T + (size_t)e * D * FF, FF, 128 * (r / 32), 32 * (r % 32), 32 * (r % 32), F.lane);
        }
    }
}
template <int NMAP, int DQK, int DVV, int NBUF, int PF>
struct AttnBody {
    static constexpr int KROW = DQK * 2, VROW = 128, KCH = DQK / 8;
    static constexpr int KT_BYTES = NMAP * 64 * KROW, VT_BYTES = DVV * VROW, BUF_BYTES = KT_BYTES + VT_BYTES;
    static constexpr int NPK = KT_BYTES / (16 * NTHR), NPV = VT_BYTES / (16 * NTHR), NDMA = NPK + NPV;
    static constexpr int NKS = DQK / 32, NDT = DVV / 16, KB = NKS < 4 ? NKS : 4;
    static_assert(NBUF * BUF_BYTES <= RING_BYTES + 24576, "attention ring exceeds LDS");
    static_assert(NDMA * (NBUF - 1) <= 48 && NBUF >= 2, "vmcnt range; a ring needs two slots");

    __device__ __forceinline__ void dma_tile(LAS unsigned char* slot, const bf16* Kp, int ldk, const bf16* VTp, int ldvt, int key0, int tid, int wave) const {
        asm volatile("" : "+v"(tid));
#pragma unroll
        for (int i = 0; i < NPK; ++i) { const int p = tid + NTHR * i, row = p / KCH, sl = p % KCH, ch = sl ^ ksw(row), mp = row >> 6, key = row & 63;
            __builtin_amdgcn_global_load_lds((const unsigned*)(Kp + (unsigned)((key0 + key) * ldk + mp * DQK + ch * 8)), (LAS unsigned*)(slot + (i * NTHR + wave * 64) * 16), 16, 0, 0); }
#pragma unroll
        for (int i = 0; i < NPV; ++i) { const int p = tid + NTHR * i, dv = p >> 3, sl = p & 7, ch = sl ^ vsw(dv);
            __builtin_amdgcn_global_load_lds((const unsigned*)(VTp + (unsigned)(dv * ldvt + key0 + ch * 8)), (LAS unsigned*)(slot + KT_BYTES + (i * NTHR + wave * 64) * 16), 16, 0, 0); }
    }
    __device__ __forceinline__ static int ksw(int row) { return KCH == 8 ? ((row & 3) | (((row >> 3) & 1) << 2)) : (((row & 1) * 3) | (((row >> 1) & 1) << 2) | (((row >> 3) & 1) << 3)); }
    __device__ __forceinline__ static int vsw(int dv) { return dv & 7; }
    __device__ __forceinline__ static int vt_off(int dv, int ch) { return KT_BYTES + dv * VROW + ((ch ^ vsw(dv)) << 4); }
    __device__ __forceinline__ static int k_off(int row, int ch) { return row * KROW + ((ch ^ ksw(row)) << 4); }
    __device__ __forceinline__ static int sigma(int t4, int m) { return 32 * (t4 >> 1) + 8 * (m >> 2) + 4 * (t4 & 1) + (m & 3); }
    static constexpr int NKB = NKS < 4 ? NKS : 4;
    struct Offs { int kb[NKB]; int vb[2]; };
    __device__ __forceinline__ static Offs make_offs(int lq, int g) { Offs o; const int r0 = 8 * (lq >> 2) + (lq & 3);
#pragma unroll
        for (int j = 0; j < NKB; ++j) o.kb[j] = k_off(r0, 4 * j + g);
        o.vb[0] = vt_off(lq, g); o.vb[1] = vt_off(lq, 4 + g); return o; }

    __device__ __forceinline__ void pv_tile(const LAS unsigned char* buf, bf16x8 (&vf)[PF], const bf16x8 (&pf)[NMAP][2], f32x4 (&o)[NMAP][NDT], const Offs& of) {
#pragma unroll
        for (int f0 = 0; f0 < 2 * NDT; f0 += PF) {
            bf16x8 vn[PF];
            if (f0 + PF < 2 * NDT) {
#pragma unroll
                for (int f = 0; f < PF; ++f) { const int dt = (f0 + PF + f) >> 1, mb = (f0 + PF + f) & 1; vn[f] = *(const LAS bf16x8*)(buf + of.vb[mb] + dt * 16 * VROW); }
            }
#pragma unroll
            for (int f = 0; f < PF; ++f) { const int dt = (f0 + f) >> 1, mb = (f0 + f) & 1;
#pragma unroll
                for (int c = 0; c < NMAP; ++c) o[c][dt] = __builtin_amdgcn_mfma_f32_16x16x32_bf16(vf[f], pf[c][mb], o[c][dt], 0, 0, 0); }
            if (f0 + PF < 2 * NDT) {
#pragma unroll
                for (int f = 0; f < PF; ++f) vf[f] = vn[f];
            }
        }
    }
    __device__ __forceinline__ void vf_first(const LAS unsigned char* buf, bf16x8 (&vf)[PF], const Offs& of) {
#pragma unroll
        for (int f = 0; f < PF; ++f) { const int dt = f >> 1, mb = f & 1; vf[f] = *(const LAS bf16x8*)(buf + of.vb[mb] + dt * 16 * VROW); }
    }
    __device__ __forceinline__ void s_tile(const LAS unsigned char* buf, const bf16x8 (&qf)[NMAP][NKS], float (&mrun)[NMAP], f32x4 (&ol)[NMAP], f32x4 (&o)[NMAP][NDT], bf16x8 (&pf)[NMAP][2], const Offs& of, bool first) {
        constexpr float THR = 8.0f;
        f32x4 s[NMAP][4];
#pragma unroll
        for (int c = 0; c < NMAP; ++c) { const float mi = first ? 0.f : -mrun[c];
#pragma unroll
            for (int t4 = 0; t4 < 4; ++t4) { s[c][t4] = (f32x4){mi, mi, mi, mi};
#pragma unroll
                for (int k0 = 0; k0 < NKS; k0 += KB) { bf16x8 kf[KB];
#pragma unroll
                    for (int ks = 0; ks < KB; ++ks) kf[ks] = *(const LAS bf16x8*)(buf + of.kb[(k0 + ks) & (NKB - 1)] + ((c * 64 + 32 * (t4 >> 1) + 4 * (t4 & 1)) * KROW + ((k0 + ks) / NKB) * NKB * 64));
#pragma unroll
                    for (int ks = 0; ks < KB; ++ks) s[c][t4] = __builtin_amdgcn_mfma_f32_16x16x32_bf16(kf[ks], qf[c][k0 + ks], s[c][t4], 0, 0, 0); } } }
#pragma unroll
        for (int c = 0; c < NMAP; ++c) {
            float mx = __builtin_fmaxf(__builtin_fmaxf(s[c][0][0], s[c][0][1]), s[c][0][2]);
#pragma unroll
            for (int t4 = 0; t4 < 4; ++t4) { if (t4 > 0) mx = __builtin_fmaxf(__builtin_fmaxf(mx, s[c][t4][0]), s[c][t4][1]); mx = __builtin_fmaxf(__builtin_fmaxf(mx, s[c][t4][2]), s[c][t4][3]); }
            { const auto r1 = __builtin_amdgcn_permlane16_swap(__float_as_uint(mx), __float_as_uint(mx), false, false); mx = fmaxf(__uint_as_float(r1[0]), __uint_as_float(r1[1]));
              const auto r2 = __builtin_amdgcn_permlane32_swap(__float_as_uint(mx), __float_as_uint(mx), false, false); mx = fmaxf(__uint_as_float(r2[0]), __uint_as_float(r2[1])); }
            if (first) {
                mrun[c] = mx;
#pragma unroll
                for (int t4 = 0; t4 < 4; ++t4) s[c][t4] = s[c][t4] - mx;
            } else if (__any(mx > THR)) {
                const float d = mx > THR ? mx : 0.f, alpha = fexp2(-d); mrun[c] += d; ol[c] = ol[c] * alpha;
#pragma unroll
                for (int dt = 0; dt < NDT; ++dt) o[c][dt] = o[c][dt] * alpha;
#pragma unroll
                for (int t4 = 0; t4 < 4; ++t4) s[c][t4] = s[c][t4] - d;
            }
#pragma unroll
            for (int t4 = 0; t4 < 4; ++t4)
#pragma unroll
                for (int i = 0; i < 4; ++i) s[c][t4][i] = fexp2(s[c][t4][i]);
#pragma unroll
            for (int mb = 0; mb < 2; ++mb) { u32x4 w; w.x = cvt_pk_bf16(s[c][2 * mb][0], s[c][2 * mb][1]); w.y = cvt_pk_bf16(s[c][2 * mb][2], s[c][2 * mb][3]);
                w.z = cvt_pk_bf16(s[c][2 * mb + 1][0], s[c][2 * mb + 1][1]); w.w = cvt_pk_bf16(s[c][2 * mb + 1][2], s[c][2 * mb + 1][3]); pf[c][mb] = __builtin_bit_cast(bf16x8, w); }
            const bf16x8 ones = (bf16x8){0x3F80, 0x3F80, 0x3F80, 0x3F80, 0x3F80, 0x3F80, 0x3F80, 0x3F80};
            ol[c] = __builtin_amdgcn_mfma_f32_16x16x32_bf16(ones, pf[c][0], ol[c], 0, 0, 0); ol[c] = __builtin_amdgcn_mfma_f32_16x16x32_bf16(ones, pf[c][1], ol[c], 0, 0, 0);
        }
    }

    __device__ __forceinline__ void run(LAS unsigned char* lds, const bf16* Qp, int ldq, float qscale, const bf16* Kp, int ldk, const bf16* VTp, int ldvt, int nkt, int nkt_w, bool late,
                                        f32x4 (&o)[NMAP][NDT], float (&lsum)[NMAP], int tid, int lane) {
        const int g = lane >> 4, lq = lane & 15;
        bf16x8 qf[NMAP][NKS];
#pragma unroll
        for (int c = 0; c < NMAP; ++c)
#pragma unroll
            for (int ks = 0; ks < NKS; ++ks) { const u32x4 raw = *(const GAS u32x4*)(Qp + (size_t)lq * ldq + c * DQK + ks * 32 + g * 8);
                u32x4 w = raw;
                if (qscale != 1.0f) { w.x = cvt_pk_bf16(bflo(raw.x) * qscale, bfhi(raw.x) * qscale); w.y = cvt_pk_bf16(bflo(raw.y) * qscale, bfhi(raw.y) * qscale);
                                      w.z = cvt_pk_bf16(bflo(raw.z) * qscale, bfhi(raw.z) * qscale); w.w = cvt_pk_bf16(bflo(raw.w) * qscale, bfhi(raw.w) * qscale); }
                qf[c][ks] = __builtin_bit_cast(bf16x8, w); }
        float mrun[NMAP]; f32x4 ol[NMAP];
#pragma unroll
        for (int c = 0; c < NMAP; ++c) { mrun[c] = -INFINITY; ol[c] = (f32x4){0.f, 0.f, 0.f, 0.f};
#pragma unroll
            for (int dt = 0; dt < NDT; ++dt) o[c][dt] = (f32x4){0.f, 0.f, 0.f, 0.f}; }
        bf16x8 pfp[NMAP][2];
#pragma unroll
        for (int c = 0; c < NMAP; ++c) { pfp[c][0] = (bf16x8){0, 0, 0, 0, 0, 0, 0, 0}; pfp[c][1] = pfp[c][0]; }

        const int wave = __builtin_amdgcn_readfirstlane(tid >> 6);
        const Offs of = make_offs(lq, g);
#pragma unroll
        for (int j = 0; j < NBUF - 1; ++j) if (j < nkt) dma_tile(lds + j * BUF_BYTES, Kp, ldk, VTp, ldvt, j * 64, tid, wave);
        int bi = 0;
        for (int kt = 0; kt < nkt; ++kt) {
            LAS unsigned char* buf = lds + bi * BUF_BYTES;
            { const int ahead = (nkt - 1 - kt) < (NBUF - 2) ? (nkt - 1 - kt) : (NBUF - 2);
              if (ahead >= 1 && NBUF > 2) asm volatile("s_waitcnt vmcnt(%0)" :: "n"(NDMA) : "memory"); else asm volatile("s_waitcnt vmcnt(0)" ::: "memory"); }
            __builtin_amdgcn_s_barrier(); asm volatile("" ::: "memory");
            if (kt < nkt_w) { bf16x8 vf[PF]; s_tile(buf, qf, mrun, ol, o, pfp, of, kt == 0); vf_first(buf, vf, of);
                { const int kn = kt + NBUF - 1; if (kn < nkt) { const int bn = (bi == 0) ? NBUF - 1 : bi - 1; dma_tile(lds + bn * BUF_BYTES, Kp, ldk, VTp, ldvt, kn * 64, tid, wave); } }
                pv_tile(buf, vf, pfp, o, of); }
            else { const int kn = kt + NBUF - 1; if (kn < nkt) { const int bn = (bi == 0) ? NBUF - 1 : bi - 1; dma_tile(lds + bn * BUF_BYTES, Kp, ldk, VTp, ldvt, kn * 64, tid, wave); } }
            bi = (bi + 1 == NBUF) ? 0 : bi + 1;
        }
        asm volatile("s_waitcnt lgkmcnt(0)" ::: "memory"); __builtin_amdgcn_s_barrier(); asm volatile("" ::: "memory");
#pragma unroll
        for (int c = 0; c < NMAP; ++c) lsum[c] = ol[c][0];
    }
};
typedef float f32x16 __attribute__((ext_vector_type(16)));
struct DiffBody32 {
    static constexpr int KT_BYTES = 2 * 64 * 128, VT_BYTES = 128 * 128, BUF_BYTES = KT_BYTES + VT_BYTES, NBUF = 3, NDMA = 4;
    __device__ __forceinline__ static int swz(int row) { return (row >> 1) & 7; }
    __device__ __forceinline__ static int sigma(int rho) { return 16 * (rho >> 4) + 8 * ((rho >> 2) & 1) + 4 * ((rho >> 3) & 1) + (rho & 3); }
    __device__ __forceinline__ void dma_tile(LAS unsigned char* slot, const bf16* Kp, int ldk, const bf16* VTp, int ldvt, int key0, int tid, int wave) const {
        asm volatile("" : "+v"(tid));
#pragma unroll
        for (int i = 0; i < 2; ++i) { const int p = tid + NTHR * i, row = p >> 3, sl = p & 7, ch = sl ^ swz(row), mp = row >> 6, key = row & 63;
            __builtin_amdgcn_global_load_lds((const unsigned*)(Kp + (unsigned)((key0 + key) * ldk + mp * 64 + ch * 8)), (LAS unsigned*)(slot + (i * NTHR + wave * 64) * 16), 16, 0, 0); }
#pragma unroll
        for (int i = 0; i < 2; ++i) { const int p = tid + NTHR * i, dv = p >> 3, sl = p & 7, ch = sl ^ swz(dv);
            __builtin_amdgcn_global_load_lds((const unsigned*)(VTp + (unsigned)(dv * ldvt + key0 + ch * 8)), (LAS unsigned*)(slot + KT_BYTES + (i * NTHR + wave * 64) * 16), 16, 0, 0); }
    }
    __device__ __forceinline__ void run(LAS unsigned char* lds, const bf16* Qp  , int ldq, float qscale, const bf16* Kp, int ldk, const bf16* VTp, int ldvt,
                                        int nkt, int nkt_w, int c, f32x16 (&o)[4], float& lsum, int tid, int lane) {
        const int r = lane & 31, h = lane >> 5, wave = __builtin_amdgcn_readfirstlane(tid >> 6);
        bf16x8 qf[4];
#pragma unroll
        for (int ks = 0; ks < 4; ++ks) { const u32x4 raw = *(const GAS u32x4*)(Qp + (size_t)r * ldq + ks * 16 + h * 8); u32x4 w;
            w.x = cvt_pk_bf16(bflo(raw.x) * qscale, bfhi(raw.x) * qscale); w.y = cvt_pk_bf16(bflo(raw.y) * qscale, bfhi(raw.y) * qscale);
            w.z = cvt_pk_bf16(bflo(raw.z) * qscale, bfhi(raw.z) * qscale); w.w = cvt_pk_bf16(bflo(raw.w) * qscale, bfhi(raw.w) * qscale); qf[ks] = __builtin_bit_cast(bf16x8, w); }
        int kof[4], vof[4];
        { const int kr = sigma(r);
#pragma unroll
          for (int ks = 0; ks < 4; ++ks) kof[ks] = kr * 128 + (((2 * ks + h) ^ swz(kr)) << 4);
#pragma unroll
          for (int f = 0; f < 4; ++f) vof[f] = KT_BYTES + r * 128 + (((2 * f + h) ^ swz(r)) << 4); }
        float mrun = -INFINITY, ls = 0.f;
#pragma unroll
        for (int db = 0; db < 4; ++db)
#pragma unroll
            for (int i = 0; i < 16; ++i) o[db][i] = 0.f;
#pragma unroll
        for (int j = 0; j < NBUF - 1; ++j) if (j < nkt) dma_tile(lds + j * BUF_BYTES, Kp, ldk, VTp, ldvt, j * 64, tid, wave);
        int bi = 0;
        for (int kt = 0; kt < nkt; ++kt) {
            const LAS unsigned char* buf = lds + bi * BUF_BYTES;
            { const int ahead = (nkt - 1 - kt) < 1 ? (nkt - 1 - kt) : 1;
              if (ahead >= 1) asm volatile("s_waitcnt vmcnt(%0)" :: "n"(NDMA) : "memory"); else asm volatile("s_waitcnt vmcnt(0)" ::: "memory"); }
            __builtin_amdgcn_s_barrier(); asm volatile("" ::: "memory");
            const int kn = kt + NBUF - 1; const int bn = (bi == 0) ? NBUF - 1 : bi - 1;
            if (kt < nkt_w) {
                constexpr float THR = 8.0f; const bool first = (kt == 0);
                f32x16 s[2];
                { const float mi = first ? 0.f : -mrun;
#pragma unroll
                  for (int kb = 0; kb < 2; ++kb) {
#pragma unroll
                      for (int i = 0; i < 16; ++i) s[kb][i] = mi;
                      bf16x8 kf[4];
#pragma unroll
                      for (int ks = 0; ks < 4; ++ks) kf[ks] = *(const LAS bf16x8*)(buf + kof[ks] + (c * 64 + 32 * kb) * 128);
#pragma unroll
                      for (int ks = 0; ks < 4; ++ks) s[kb] = __builtin_amdgcn_mfma_f32_32x32x16_bf16(kf[ks], qf[ks], s[kb], 0, 0, 0); } }
                float mx = __builtin_fmaxf(__builtin_fmaxf(s[0][0], s[0][1]), s[0][2]);
#pragma unroll
                for (int kb = 0; kb < 2; ++kb)
#pragma unroll
                    for (int i = (kb == 0 ? 3 : 0); i + 1 < 16; i += 2) mx = __builtin_fmaxf(__builtin_fmaxf(mx, s[kb][i]), s[kb][i + 1]);
                mx = fmaxf(mx, s[0][15]); mx = fmaxf(mx, s[1][15] > s[1][14] ? s[1][15] : s[1][14]);
                { const auto r2 = __builtin_amdgcn_permlane32_swap(__float_as_uint(mx), __float_as_uint(mx), false, false); mx = fmaxf(__uint_as_float(r2[0]), __uint_as_float(r2[1])); }
                if (first) { mrun = mx; s[0] = s[0] - mx; s[1] = s[1] - mx; }
                else if (__any(mx > THR)) { const float d = mx > THR ? mx : 0.f, alpha = fexp2(-d); mrun += d; ls *= alpha;
#pragma unroll
                    for (int db = 0; db < 4; ++db) o[db] = o[db] * alpha;
                    s[0] = s[0] - d; s[1] = s[1] - d; }
                float ps = 0.f;
#pragma unroll
                for (int kb = 0; kb < 2; ++kb)
#pragma unroll
                    for (int i = 0; i < 16; ++i) { s[kb][i] = fexp2(s[kb][i]); ps += s[kb][i]; }
                ls += ps;
                bf16x8 pf[4];
#pragma unroll
                for (int f = 0; f < 4; ++f) { const int kb = f >> 1, s8 = 8 * (f & 1); u32x4 w;
                    w.x = cvt_pk_bf16(s[kb][s8 + 0], s[kb][s8 + 1]); w.y = cvt_pk_bf16(s[kb][s8 + 2], s[kb][s8 + 3]); w.z = cvt_pk_bf16(s[kb][s8 + 4], s[kb][s8 + 5]); w.w = cvt_pk_bf16(s[kb][s8 + 6], s[kb][s8 + 7]);
                    pf[f] = __builtin_bit_cast(bf16x8, w); }
                bf16x8 vf[4][4];
#pragma unroll
                for (int f = 0; f < 4; ++f) vf[0][f] = *(const LAS bf16x8*)(buf + vof[f]);
                if (kn < nkt) dma_tile(lds + bn * BUF_BYTES, Kp, ldk, VTp, ldvt, kn * 64, tid, wave);
#pragma unroll
                for (int db = 0; db < 4; ++db) {
                    if (db + 1 < 4) {
#pragma unroll
                        for (int f = 0; f < 4; ++f) vf[db + 1][f] = *(const LAS bf16x8*)(buf + vof[f] + (db + 1) * 32 * 128);
                    }
#pragma unroll
                    for (int f = 0; f < 4; ++f) o[db] = __builtin_amdgcn_mfma_f32_32x32x16_bf16(vf[db][f], pf[f], o[db], 0, 0, 0); }
            } else if (kn < nkt) dma_tile(lds + bn * BUF_BYTES, Kp, ldk, VTp, ldvt, kn * 64, tid, wave);
            bi = (bi + 1 == NBUF) ? 0 : bi + 1;
        }
        asm volatile("s_waitcnt lgkmcnt(0)" ::: "memory"); __builtin_amdgcn_s_barrier(); asm volatile("" ::: "memory");
        { const auto r2 = __builtin_amdgcn_permlane32_swap(__float_as_uint(ls), __float_as_uint(ls), false, false); lsum = __uint_as_float(r2[0]) + __uint_as_float(r2[1]); }
    }
};
constexpr int ATTN_MAXU = 2;
__constant__ unsigned short attn_tab[256][ATTN_MAXU] = {
{34,17},
{98,81},
{162,145},
{226,209},
{290,273},
{354,337},
{418,401},
{482,465},
{33,19},
{97,83},
{161,147},
{225,211},
{289,275},
{353,339},
{417,403},
{481,467},
{31,20},
{95,84},
{159,148},
{223,212},
{287,276},
{351,340},
{415,404},
{479,468},
{50,1},
{114,65},
{178,129},
{242,193},
{306,257},
{370,321},
{434,385},
{498,449},
{52,0},
{116,64},
{180,128},
{244,192},
{308,256},
{372,320},
{436,384},
{500,448},
{36,15},
{100,79},
{164,143},
{228,207},
{292,271},
{356,335},
{420,399},
{484,463},
{49,2},
{113,66},
{177,130},
{241,194},
{305,258},
{369,322},
{433,386},
{497,450},
{47,5},
{111,69},
{175,133},
{239,197},
{303,261},
{367,325},
{431,389},
{495,453},
{39,28},
{103,92},
{167,156},
{231,220},
{295,284},
{359,348},
{423,412},
{487,476},
{57,10},
{121,74},
{185,138},
{249,202},
{313,266},
{377,330},
{441,394},
{505,458},
{45,22},
{109,86},
{173,150},
{237,214},
{301,278},
{365,342},
{429,406},
{493,470},
{40,27},
{104,91},
{168,155},
{232,219},
{296,283},
{360,347},
{424,411},
{488,475},
{54,13},
{118,77},
{182,141},
{246,205},
{310,269},
{374,333},
{438,397},
{502,461},
{44,23},
{108,87},
{172,151},
{236,215},
{300,279},
{364,343},
{428,407},
{492,471},
{35,32},
{99,96},
{163,160},
{227,224},
{291,288},
{355,352},
{419,416},
{483,480},
{58,9},
{122,73},
{186,137},
{250,201},
{314,265},
{378,329},
{442,393},
{506,457},
{37,30},
{101,94},
{165,158},
{229,222},
{293,286},
{357,350},
{421,414},
{485,478},
{59,8},
{123,72},
{187,136},
{251,200},
{315,264},
{379,328},
{443,392},
{507,456},
{55,12},
{119,76},
{183,140},
{247,204},
{311,268},
{375,332},
{439,396},
{503,460},
{53,14},
{117,78},
{181,142},
{245,206},
{309,270},
{373,334},
{437,398},
{501,462},
{43,24},
{107,88},
{171,152},
{235,216},
{299,280},
{363,344},
{427,408},
{491,472},
{61,6},
{125,70},
{189,134},
{253,198},
{317,262},
{381,326},
{445,390},
{509,454},
{38,29},
{102,93},
{166,157},
{230,221},
{294,285},
{358,349},
{422,413},
{486,477},
{60,7},
{124,71},
{188,135},
{252,199},
{316,263},
{380,327},
{444,391},
{508,455},
{62,4},
{126,68},
{190,132},
{254,196},
{318,260},
{382,324},
{446,388},
{510,452},
{56,11},
{120,75},
{184,139},
{248,203},
{312,267},
{376,331},
{440,395},
{504,459},
{48,18},
{112,82},
{176,146},
{240,210},
{304,274},
{368,338},
{432,402},
{496,466},
{41,26},
{105,90},
{169,154},
{233,218},
{297,282},
{361,346},
{425,410},
{489,474},
{42,25},
{106,89},
{170,153},
{234,217},
{298,281},
{362,345},
{426,409},
{490,473},
{51,16},
{115,80},
{179,144},
{243,208},
{307,272},
{371,336},
{435,400},
{499,464},
{63,3},
{127,67},
{191,131},
{255,195},
{319,259},
{383,323},
{447,387},
{511,451},
{46,21},
{110,85},
{174,149},
{238,213},
{302,277},
{366,341},
{430,405},
{494,469}};
namespace rk {
constexpr int MS = 144;
constexpr int MB = 64 * MS;
constexpr int O_AB = 0 * MB, O_BB = 1 * MB, O_KB = 2 * MB, O_RB = 3 * MB, O_ABT = 4 * MB, O_VTT = 5 * MB, O_BTT = 6 * MB, O_KTT = 7 * MB, O_AAK = 8 * MB, O_ARB = 9 * MB, O_ARK = 10 * MB;
constexpr int O_TM = O_KB, O_GT = O_AB, O_WTT = O_BB, O_UTT = O_AAK;
constexpr int FS = 66;
constexpr int O_LF = 11 * MB, O_TF = 0;
constexpr int O_LA = O_LF + 64 * FS * 4;
static_assert(O_LA + MB <= RING_BYTES && 64 * FS * 4 <= 2 * MB, "rwkv LDS map");
constexpr int O_LW = X_OFF, O_LG = X_OFF + MB, LGS = 272, O_NRM = O_LG + 64 * LGS, O_BSP = O_NRM + 512, O_C63 = O_BSP + 512;
static_assert(O_C63 + 1024 <= MISC_OFF, "rwkv LDS extras");

template <int NKS>
__device__ __forceinline__ f32x4 mm_tile(const LAS unsigned char* A, int astr, int tr, const LAS unsigned char* B, int bstr, int tc, f32x4 acc, int lq, int g) {
#pragma unroll
    for (int ks = 0; ks < NKS; ++ks) {
        const bf16x8 a = *(const LAS bf16x8*)(A + (16 * tr + lq) * astr + (32 * ks + 8 * g) * 2);
        const bf16x8 b = *(const LAS bf16x8*)(B + (16 * tc + lq) * bstr + (32 * ks + 8 * g) * 2);
        acc = __builtin_amdgcn_mfma_f32_16x16x32_bf16(a, b, acc, 0, 0, 0); }
    return acc;
}
template <int NKS>
__device__ __forceinline__ f32x4 mm_tile_gb(const LAS unsigned char* A, int astr, int tr, const bf16* Bg, int ldb, f32x4 acc, int lq, int g) {
#pragma unroll
    for (int ks = 0; ks < NKS; ++ks) {
        const bf16x8 a = *(const LAS bf16x8*)(A + (16 * tr + lq) * astr + (32 * ks + 8 * g) * 2);
        const bf16x8 b = *(const GAS bf16x8*)(Bg + (size_t)lq * ldb + 32 * ks + 8 * g);
        acc = __builtin_amdgcn_mfma_f32_16x16x32_bf16(a, b, acc, 0, 0, 0); }
    return acc;
}
__device__ __forceinline__ void st_nat(LAS unsigned char* Mx, int t0, int col, const f32x4& v) {
#pragma unroll
    for (int i = 0; i < 4; ++i) *(LAS bf16*)(Mx + (t0 + i) * MS + col * 2) = (bf16)f2bf(v[i]);
}
__device__ __forceinline__ void st_tr(LAS unsigned char* Mx, int t0, int col, const f32x4& v) {
    u32x2 w; w.x = cvt_pk_bf16(v[0], v[1]); w.y = cvt_pk_bf16(v[2], v[3]); *(LAS u32x2*)(Mx + col * MS + t0 * 2) = w;
}

__device__ __forceinline__ void tri_inverse(const LAS float* L, LAS float* Tm, int lane) {
    const int g = lane >> 4, lq = lane & 15;
    {
        float x[16];
#pragma unroll
        for (int r = 0; r < 16; ++r) { float a = (r == lq) ? 1.f : 0.f;
#pragma unroll
            for (int s = 0; s < r; ++s) a += L[(16 * g + r) * FS + 16 * g + s] * x[s];
            x[r] = a; }
#pragma unroll
        for (int r = 0; r < 16; ++r) Tm[(16 * g + r) * FS + 16 * g + lq] = x[r];
    }
#pragma unroll
    for (int d = 1; d < 4; ++d)
#pragma unroll
        for (int i = d; i < 4; ++i) { const int j = i - d;
            f32x4 X = (f32x4){0.f, 0.f, 0.f, 0.f};
#pragma unroll
            for (int m = j; m < i; ++m)
#pragma unroll
                for (int kq = 0; kq < 4; ++kq) X = __builtin_amdgcn_mfma_f32_16x16x4f32(L[(16 * i + lq) * FS + 16 * m + 4 * kq + g], Tm[(16 * m + 4 * kq + g) * FS + 16 * j + lq], X, 0, 0, 0);
            f32x4 R = (f32x4){0.f, 0.f, 0.f, 0.f};
#pragma unroll
            for (int kk = 0; kk < 4; ++kk) R = __builtin_amdgcn_mfma_f32_16x16x4f32(Tm[(16 * i + lq) * FS + 16 * i + 4 * g + kk], X[kk], R, 0, 0, 0);
#pragma unroll
            for (int q = 0; q < 4; ++q) Tm[(16 * i + 4 * g + q) * FS + 16 * j + lq] = R[q];
        }
}

__device__ __forceinline__ void tri_inverse_simple(const LAS float* L, LAS float* Tm, int lane) {
#pragma unroll 1
    for (int t = 0; t < 64; ++t) { float a = (t == lane) ? 1.f : 0.f;
#pragma unroll 1
        for (int s = 0; s < t; ++s) a += L[t * FS + s] * Tm[s * FS + lane];
        Tm[t * FS + lane] = a; }
}
__device__ __forceinline__ float mixf(unsigned short cur, unsigned short prev, float mu) { const float c = bf2f(cur), p = bf2f(prev); return c + (p - c) * mu; }

__device__ __forceinline__ void phase_a(Frame& F, int b, int c) {
    LAS unsigned char* lds = F.lds;
    const int tid = F.tid, lane = F.lane, w = F.wave, g = lane >> 4, lq = lane & 15;
    const bf16* PROJ = (const bf16*)(F.ws + WS_PROJ);
    const int n0 = b * T + c * CH;
    const bool first = (c == 0);
    const float* mu = F.in[I_MU]; bf16* GATEp = (bf16*)(F.ws + WS_GATE);
    {
        const int t = tid >> 3, c0 = (tid & 7) * 32; const unsigned oc = (unsigned)(n0 + t) * PCOLS + C_WD + c0; const bool hasp = !(first && t == 0); const unsigned op = hasp ? oc - PCOLS : oc; const float* mup = mu + C_WD + c0;
#pragma unroll
        for (int q = 0; q < 4; ++q) {
            const u32x4 cu = *(const GAS u32x4*)(PROJ + (oc + q * 8)); u32x4 pv = *(const GAS u32x4*)(PROJ + (op + q * 8)); if (!hasp) pv = (u32x4){0u, 0u, 0u, 0u};
            const f32x4 m0 = *(const GAS f32x4*)(mup + q * 8), m1 = *(const GAS f32x4*)(mup + q * 8 + 4);
            float o[8];
#pragma unroll
            for (int k = 0; k < 4; ++k) { const unsigned cw = cu[k], pw = pv[k];
                const float x0 = bflo(cw) + (bflo(pw) - bflo(cw)) * (k < 2 ? m0[2 * k] : m1[2 * k - 4]), x1 = bfhi(cw) + (bfhi(pw) - bfhi(cw)) * (k < 2 ? m0[2 * k + 1] : m1[2 * k - 3]);
                if (c0 < 64) { o[2 * k] = 1.f - 2.f * frcp(fexp(2.f * x0) + 1.f); o[2 * k + 1] = 1.f - 2.f * frcp(fexp(2.f * x1) + 1.f); }
                else if (c0 < 128) { o[2 * k] = x0; o[2 * k + 1] = x1; }
                else { o[2 * k] = sigmoidf_(x0); o[2 * k + 1] = sigmoidf_(x1); } }
            u32x4 wv; wv.x = cvt_pk_bf16(o[0], o[1]); wv.y = cvt_pk_bf16(o[2], o[3]); wv.z = cvt_pk_bf16(o[4], o[5]); wv.w = cvt_pk_bf16(o[6], o[7]);
            LAS unsigned char* dst = (c0 < 64) ? lds + O_LW + t * MS + (c0 + q * 8) * 2 : (c0 < 128) ? lds + O_LA + t * MS + (c0 - 64 + q * 8) * 2 : lds + O_LG + t * LGS + (c0 - 128 + q * 8) * 2;
            *(LAS u32x4*)dst = wv; }
    }
    __syncthreads();
    const int tr = w >> 1, tcb = 2 * (w & 1);
    LAS float* EF = (LAS float*)(lds + O_LF);
    LAS float* NRM = (LAS float*)(lds + O_NRM); LAS float* BSP = (LAS float*)(lds + O_BSP); LAS float* TT = (LAS float*)(lds + O_C63);
#pragma unroll 1
    for (int h = 0; h < RH; ++h) {
        const int item = (b * RH + h) * NCHUNK + c;
        float ev[2][4], av[2][4], rv[2][4], kv[2][4], vv[2][4], kkr[2][4];
        float nrm_p[4] = {0.f, 0.f, 0.f, 0.f};
#pragma unroll
        for (int x = 0; x < 2; ++x) { const int tc = tcb + x, hj = h * RN + 16 * tc + lq;
            f32x4 wl = (f32x4){0.f, 0.f, 0.f, 0.f}, al = wl, gl = wl;
            wl = mm_tile_gb<2>(lds + O_LW, MS, tr, (const bf16*)(F.ws + WS_W2LT) + (size_t)(h * RN + 16 * tc) * 64, 64, wl, lq, g);
            al = mm_tile_gb<2>(lds + O_LA, MS, tr, (const bf16*)(F.ws + WS_A2LT) + (size_t)(h * RN + 16 * tc) * 64, 64, al, lq, g);
            gl = mm_tile_gb<4>(lds + O_LG, LGS, tr, (const bf16*)(F.ws + WS_G2LT) + (size_t)(h * RN + 16 * tc) * 128, 128, gl, lq, g);
            const float w0 = F.in[I_W0][hj], a0 = F.in[I_A0][hj], kkw = F.in[I_KK][hj];
            const float mur = mu[C_R + hj], muk = mu[C_K + hj], muv = mu[C_V + hj];
#pragma unroll
            for (int i = 0; i < 4; ++i) { const int t = 16 * tr + 4 * g + i; const bool hasp = !(first && t == 0); const unsigned oc = (unsigned)(n0 + t) * PCOLS + hj, op = hasp ? oc - PCOLS : oc;
                const float xw = -(w0 + wl[i]); const float sp = xw > 20.f ? xw : __logf(1.f + fexp(xw)); ev[x][i] = fexp(-sp - 0.5f);
                av[x][i] = sigmoidf_(a0 + al[i]);
                GATEp[(unsigned)(n0 + t) * RW + hj] = (bf16)f2bf(gl[i]);
                const unsigned short rc = PROJ[oc + C_R], kc = PROJ[oc + C_K], vc = PROJ[oc + C_V]; unsigned short rp = PROJ[op + C_R], kp = PROJ[op + C_K], vp = PROJ[op + C_V];
                if (!hasp) { rp = 0; kp = 0; vp = 0; }
                rv[x][i] = mixf(rc, rp, mur); kv[x][i] = mixf(kc, kp, muk); vv[x][i] = mixf(vc, vp, muv);
                kkr[x][i] = kv[x][i] * kkw; nrm_p[i] += kkr[x][i] * kkr[x][i]; }
        }
#pragma unroll
        for (int i = 0; i < 4; ++i) { float q = nrm_p[i]; q += __shfl_xor(q, 1); q += __shfl_xor(q, 2); q += __shfl_xor(q, 4); q += __shfl_xor(q, 8); if (lq == 0) NRM[(16 * tr + 4 * g + i) * 2 + (w & 1)] = q; }
        float cs[2][4];
#pragma unroll
        for (int x = 0; x < 2; ++x) { cs[x][0] = ev[x][0]; cs[x][1] = cs[x][0] + ev[x][1]; cs[x][2] = cs[x][1] + ev[x][2]; cs[x][3] = cs[x][2] + ev[x][3];
            float a = cs[x][3]; const float b1 = __shfl(a, lane - 16); a += (g >= 1) ? b1 : 0.f; const float b2 = __shfl(a, lane - 32); a += (g >= 2) ? b2 : 0.f;
            const float ex = a - cs[x][3];
#pragma unroll
            for (int i = 0; i < 4; ++i) cs[x][i] += ex;
            if (g == 3) TT[tr * 64 + 16 * (tcb + x) + lq] = a; }
        __syncthreads();
        float bs_p[4] = {0.f, 0.f, 0.f, 0.f};
#pragma unroll
        for (int x = 0; x < 2; ++x) { const int tc = tcb + x, j = 16 * tc + lq, hj = h * RN + j; const float ka = F.in[I_KA][hj], rk = F.in[I_RK][hj];
            const float t0v = TT[j], t1v = TT[64 + j], t2v = TT[128 + j], t3v = TT[192 + j]; const float c63 = (t0v + t1v) + (t2v + t3v);
            const float cbase = (tr > 0 ? t0v : 0.f) + (tr > 1 ? t1v : 0.f) + (tr > 2 ? t2v : 0.f);
            if (tr == 3 && g == 3) ((float*)(F.ws + WS_GC))[(size_t)item * 64 + j] = fexp(-c63);
            f32x4 ab, bb, kb, rb, bt, kt, vx;
#pragma unroll
            for (int i = 0; i < 4; ++i) { const int t = 16 * tr + 4 * g + i; const float cin = cs[x][i] + cbase, cex = cin - ev[x][i];
                const float nr = NRM[t * 2] + NRM[t * 2 + 1]; const float kk = kkr[x][i] / fmaxf(sqrtf(nr), 1e-12f);
                DBGCNT(F, 2, !(nr > 1e-6f && nr < 1e6f)); DBGCNT(F, 3, !(fabsf(kk) <= 1.001f)); DBGCNT(F, 6, !(ev[x][i] > 0.f && ev[x][i] < 0.62f && av[x][i] > 0.f && av[x][i] < 1.f)); DBGCNT(F, 8, !(fabsf(rv[x][i]) < 100.f && fabsf(kv[x][i]) < 100.f && fabsf(vv[x][i]) < 100.f)); DBGCNT(F, 9, !(cin >= 0.f && cin < 40.f && c63 >= cin));
                const float a = av[x][i], k2 = kv[x][i] * (1.f + (a - 1.f) * ka);
                const float gin = fexp(-cin), ginv = fexp(cin), gex = fexp(-cex), grel = fexp(cin - c63);
                ab[i] = -kk * gex; bb[i] = kk * a * ginv; kb[i] = k2 * ginv; rb[i] = rv[x][i] * gin; bt[i] = kk * a * grel; kt[i] = k2 * grel; vx[i] = vv[x][i];
                bs_p[i] += rv[x][i] * k2 * rk; }
            const int t0 = 16 * tr + 4 * g;
            st_nat(lds + O_AB, t0, j, ab); st_nat(lds + O_BB, t0, j, bb); st_nat(lds + O_KB, t0, j, kb); st_nat(lds + O_RB, t0, j, rb);
            st_tr(lds + O_ABT, t0, j, ab); st_tr(lds + O_VTT, t0, j, vx); st_tr(lds + O_BTT, t0, j, bt); st_tr(lds + O_KTT, t0, j, kt);
        }
#pragma unroll
        for (int i = 0; i < 4; ++i) { float q = bs_p[i]; q += __shfl_xor(q, 1); q += __shfl_xor(q, 2); q += __shfl_xor(q, 4); q += __shfl_xor(q, 8); if (lq == 0) BSP[(16 * tr + 4 * g + i) * 2 + (w & 1)] = q; }
        __syncthreads();
        if (tid < 64) ((float*)(F.ws + WS_BS))[(size_t)(n0 + tid) * RH + h] = BSP[tid * 2] + BSP[tid * 2 + 1];
#pragma unroll
        for (int x = 0; x < 2; ++x) { const int tc = tcb + x; f32x4 l = (f32x4){0.f, 0.f, 0.f, 0.f}, ak = l, rbm = l, rkm = l;
            if (tc <= tr) {
                l = mm_tile<2>(lds + O_AB, MS, tr, lds + O_BB, MS, tc, l, lq, g); ak = mm_tile<2>(lds + O_AB, MS, tr, lds + O_KB, MS, tc, ak, lq, g);
                rbm = mm_tile<2>(lds + O_RB, MS, tr, lds + O_BB, MS, tc, rbm, lq, g); rkm = mm_tile<2>(lds + O_RB, MS, tr, lds + O_KB, MS, tc, rkm, lq, g);
                const int s = 16 * tc + lq;
#pragma unroll
                for (int i = 0; i < 4; ++i) { const int t = 16 * tr + 4 * g + i; if (s >= t) { l[i] = 0.f; ak[i] = 0.f; } if (s > t) { rbm[i] = 0.f; rkm[i] = 0.f; } }
            }
            const int t0 = 16 * tr + 4 * g, s = 16 * tc + lq;
#pragma unroll
            for (int i = 0; i < 4; ++i) { EF[(t0 + i) * FS + s] = l[i]; DBGCNT(F, 7, !(fabsf(l[i]) <= 1.01f)); DBGCNT(F, 10, !(fabsf(ak[i]) < 300.f && fabsf(rbm[i]) < 300.f && fabsf(rkm[i]) < 300.f)); }
            st_nat(lds + O_AAK, t0, s, ak); st_nat(lds + O_ARB, t0, s, rbm); st_nat(lds + O_ARK, t0, s, rkm);
        }
        __syncthreads();
#ifdef DBG_SIMPLE_TRI
        if (w == 0) tri_inverse_simple(EF, (LAS float*)(lds + O_TF), lane);
#else
        if (w == 0) tri_inverse(EF, (LAS float*)(lds + O_TF), lane);
#endif
        __syncthreads();
        { const int t = tid >> 3, s0 = (tid & 7) * 8; const LAS float* tp = (const LAS float*)(lds + O_TF) + t * FS + s0; float o[8];
#pragma unroll
          for (int k = 0; k < 8; ++k) { o[k] = ((s0 >> 4) > (t >> 4)) ? 0.f : tp[k]; DBGCNT(F, 4, !(fabsf(o[k]) < 50.f)); }
          u32x4 wv; wv.x = cvt_pk_bf16(o[0], o[1]); wv.y = cvt_pk_bf16(o[2], o[3]); wv.z = cvt_pk_bf16(o[4], o[5]); wv.w = cvt_pk_bf16(o[6], o[7]);
          __syncthreads();
          *(LAS u32x4*)(lds + O_TM + t * MS + s0 * 2) = wv; }
        __syncthreads();
#pragma unroll
        for (int x = 0; x < 2; ++x) { const int tc = tcb + x; f32x4 gg = (f32x4){0.f, 0.f, 0.f, 0.f}, wt = gg;
            gg = mm_tile<2>(lds + O_AAK, MS, tr, lds + O_VTT, MS, tc, gg, lq, g); wt = mm_tile<2>(lds + O_TM, MS, tr, lds + O_ABT, MS, tc, wt, lq, g);
#pragma unroll
            for (int i = 0; i < 4; ++i) { DBGCNT(F, 12, !(fabsf(gg[i]) < 1e3f)); DBGCNT(F, 13, !(fabsf(wt[i]) < 1e2f)); }
            st_tr(lds + O_GT, 16 * tr + 4 * g, 16 * tc + lq, gg); st_tr(lds + O_WTT, 16 * tr + 4 * g, 16 * tc + lq, wt); }
        __syncthreads();
#pragma unroll
        for (int x = 0; x < 2; ++x) { const int tc = tcb + x; f32x4 ut = (f32x4){0.f, 0.f, 0.f, 0.f};
            ut = mm_tile<2>(lds + O_TM, MS, tr, lds + O_GT, MS, tc, ut, lq, g);
#pragma unroll
            for (int i = 0; i < 4; ++i) DBGCNT(F, 14, !(fabsf(ut[i]) < 1e3f));
            st_tr(lds + O_UTT, 16 * tr + 4 * g, 16 * tc + lq, ut); }
        __syncthreads();
#pragma unroll
        for (int x = 0; x < 2; ++x) { const int tc = tcb + x, t0 = 16 * tr + 4 * g, cj = 16 * tc + lq;
            f32x4 qt = (f32x4){0.f, 0.f, 0.f, 0.f}, yl = qt, pp = qt, nn = qt;
            qt = mm_tile<2>(lds + O_ARB, MS, tr, lds + O_WTT, MS, tc, qt, lq, g);
            yl = mm_tile<2>(lds + O_ARB, MS, tr, lds + O_UTT, MS, tc, yl, lq, g);
#ifdef DBG_SEL
            { f32x4 y2 = (f32x4){0.f, 0.f, 0.f, 0.f}; y2 = mm_tile<2>(lds + O_ARK, MS, tr, lds + O_VTT, MS, tc, y2, lq, g);
#pragma unroll
              for (int i = 0; i < 4; ++i) { DBGCNT(F, 15, !(fabsf(yl[i]) < 1e4f)); DBGCNT(F, 16, !(fabsf(y2[i]) < 1e4f)); }
#pragma unroll
              for (int ks = 0; ks < 2; ++ks) { const bf16x8 a1 = *(const LAS bf16x8*)(lds + O_ARB + (16 * tr + lq) * MS + (32 * ks + 8 * g) * 2), a2 = *(const LAS bf16x8*)(lds + O_ARK + (16 * tr + lq) * MS + (32 * ks + 8 * g) * 2);
                  const bf16x8 b1 = *(const LAS bf16x8*)(lds + O_UTT + (16 * tc + lq) * MS + (32 * ks + 8 * g) * 2), b2 = *(const LAS bf16x8*)(lds + O_VTT + (16 * tc + lq) * MS + (32 * ks + 8 * g) * 2);
#pragma unroll
                  for (int j = 0; j < 8; ++j) { DBGCNT(F, 17, !(fabsf(bf2f((bf16)a1[j])) < 300.f)); DBGCNT(F, 18, !(fabsf(bf2f((bf16)a2[j])) < 300.f)); DBGCNT(F, 19, !(fabsf(bf2f((bf16)b1[j])) < 1e3f)); DBGCNT(F, 20, !(fabsf(bf2f((bf16)b2[j])) < 100.f)); } } }
#endif
            yl = mm_tile<2>(lds + O_ARK, MS, tr, lds + O_VTT, MS, tc, yl, lq, g);
            pp = mm_tile<2>(lds + O_WTT, MS, tr, lds + O_BTT, MS, tc, pp, lq, g);
            nn = mm_tile<2>(lds + O_UTT, MS, tr, lds + O_BTT, MS, tc, nn, lq, g); nn = mm_tile<2>(lds + O_VTT, MS, tr, lds + O_KTT, MS, tc, nn, lq, g);
            bf16* QT = (bf16*)(F.ws + WS_QT) + (size_t)item * 4096; float* YL = (float*)(F.ws + WS_YLOC) + (size_t)item * 4096;
            bf16* PT = (bf16*)(F.ws + WS_PT) + (size_t)item * 4096; float* NNp = (float*)(F.ws + WS_NN) + (size_t)item * 4096;
#pragma unroll
            for (int i = 0; i < 4; ++i) { const float rbv = bf2f(*(const LAS bf16*)(lds + O_RB + (t0 + i) * MS + cj * 2));
                DBGCNT(F, 5, !(fabsf(yl[i]) < 1e4f)); DBGCNT(F, 11, !(fabsf(nn[i]) < 1e4f && fabsf(pp[i]) < 1e2f && fabsf(qt[i]) < 1e4f));
                QT[(unsigned)((t0 + i) * 64 + cj)] = (bf16)f2bf(qt[i] + rbv); YL[(unsigned)((t0 + i) * 64 + cj)] = yl[i]; NNp[(unsigned)((t0 + i) * 64 + cj)] = nn[i]; }
            u32x2 pw; pw.x = cvt_pk_bf16(pp[0], pp[1]); pw.y = cvt_pk_bf16(pp[2], pp[3]); *(GAS u32x2*)(PT + (unsigned)(cj * 64 + t0)) = pw;
        }
        __syncthreads();
    }
}

constexpr int SC_PT = 0, SC_NN = 8192, SC_GC = 12288, SC_DUM = 12544, SC_SLOT = 12800, SC_DEPTH = 8;
static_assert(SC_DEPTH * SC_SLOT <= RING_BYTES, "scan ring");
__device__ __forceinline__ void scan_issue(LAS unsigned char* ring, const unsigned char* ws, int bh, int vg, int c, int w, int lane) {
    const size_t item = (size_t)bh * NCHUNK + c; LAS unsigned char* slot = ring + (c & (SC_DEPTH - 1)) * SC_SLOT;
#pragma unroll
    for (int k = 0; k < 2; ++k) { const int id = 2 * (w - 1) + k;
        if (id < 8) { const int p = 64 * id + lane, r = p >> 3, sl = p & 7, ch = sl ^ (r & 7);
            __builtin_amdgcn_global_load_lds((const unsigned*)((const bf16*)(ws + WS_PT) + item * 4096 + r * 64 + ch * 8), (LAS unsigned*)(slot + SC_PT + 1024 * id), 16, 0, 0); }
        else if (id < 12) { const int q = id - 8, p = 64 * q + lane, r = p >> 4, sl = p & 15, ch = sl ^ (r & 15);
            __builtin_amdgcn_global_load_lds((const unsigned*)((const float*)(ws + WS_NN) + item * 4096 + (16 * vg + r) * 64 + ch * 4), (LAS unsigned*)(slot + SC_NN + 1024 * q), 16, 0, 0); }
        else { __builtin_amdgcn_global_load_lds((const unsigned*)((const float*)(ws + WS_GC) + item * 64 + lane), (LAS unsigned*)(slot + (id == 12 ? SC_GC : SC_DUM)), 4, 0, 0); }
    }
}
__device__ __forceinline__ void phase_scan(Frame& F, int bh, int vg) {
    const int lane = F.lane, w = F.wave, g = lane >> 4, lq = lane & 15;
    LAS unsigned char* ring = F.lds;
    f32x4 S[4];
#pragma unroll
    for (int kt = 0; kt < 4; ++kt) S[kt] = (f32x4){0.f, 0.f, 0.f, 0.f};
    const int v = 16 * vg + lq;
    if (w >= 1) {
#pragma unroll 1
        for (int c = 0; c < SC_DEPTH - 1; ++c) scan_issue(ring, F.ws, bh, vg, c, w, lane);
    }
#pragma unroll 1
    for (int c = 0; c < NCHUNK; ++c) {
        if (c <= NCHUNK - SC_DEPTH + 1) asm volatile("s_waitcnt vmcnt(12)" ::: "memory"); else asm volatile("s_waitcnt vmcnt(0)" ::: "memory");
        __builtin_amdgcn_s_barrier(); asm volatile("" ::: "memory");
        if (w >= 1 && c + SC_DEPTH - 1 < NCHUNK) scan_issue(ring, F.ws, bh, vg, c + SC_DEPTH - 1, w, lane);
        if (w == 0) {
            const LAS unsigned char* slot = ring + (c & (SC_DEPTH - 1)) * SC_SLOT; const size_t item = (size_t)bh * NCHUNK + c;
            bf16* S0 = (bf16*)(F.ws + WS_S0) + item * 4096;
            bf16x8 sf[2];
#pragma unroll
            for (int kt = 0; kt < 4; ++kt) { u32x2 wv; wv.x = cvt_pk_bf16(S[kt][0], S[kt][1]); wv.y = cvt_pk_bf16(S[kt][2], S[kt][3]); *(GAS u32x2*)(S0 + (size_t)v * 64 + 16 * kt + 4 * g) = wv; }
#pragma unroll
            for (int mb = 0; mb < 2; ++mb) { u32x4 wv; wv.x = cvt_pk_bf16(S[2 * mb][0], S[2 * mb][1]); wv.y = cvt_pk_bf16(S[2 * mb][2], S[2 * mb][3]);
                wv.z = cvt_pk_bf16(S[2 * mb + 1][0], S[2 * mb + 1][1]); wv.w = cvt_pk_bf16(S[2 * mb + 1][2], S[2 * mb + 1][3]); sf[mb] = __builtin_bit_cast(bf16x8, wv); }
#pragma unroll
            for (int kt = 0; kt < 4; ++kt) { const int k2 = 16 * kt + lq;
                const f32x4 nv = *(const LAS f32x4*)(slot + SC_NN + lq * 256 + (((4 * kt + g) ^ lq) << 4));
                const f32x4 gc = *(const LAS f32x4*)(slot + SC_GC + (16 * kt + 4 * g) * 4);
                f32x4 a = S[kt] * gc + nv;
#pragma unroll
                for (int mb = 0; mb < 2; ++mb) {
                    const u32x2 lo = *(const LAS u32x2*)(slot + SC_PT + k2 * 128 + (((4 * mb + (g >> 1)) ^ (k2 & 7)) << 4) + 8 * (g & 1));
                    const u32x2 hi = *(const LAS u32x2*)(slot + SC_PT + k2 * 128 + (((4 * mb + 2 + (g >> 1)) ^ (k2 & 7)) << 4) + 8 * (g & 1));
                    const bf16x8 pf = __builtin_bit_cast(bf16x8, (u32x4){lo.x, lo.y, hi.x, hi.y});
                    a = __builtin_amdgcn_mfma_f32_16x16x32_bf16(pf, sf[mb], a, 0, 0, 0); }
                S[kt] = a; }
        }
    }
    asm volatile("s_waitcnt vmcnt(0) lgkmcnt(0)" ::: "memory"); __builtin_amdgcn_s_barrier(); asm volatile("" ::: "memory");
}

__device__ __forceinline__ void phase_c(Frame& F, int b, int c, int h) {
    const int lane = F.lane, g = lane >> 4, lq = lane & 15;
    const size_t item = (size_t)(b * RH + h) * NCHUNK + c; const int n0 = b * T + c * CH;
    const bf16* QT = (const bf16*)(F.ws + WS_QT) + item * 4096; const bf16* S0 = (const bf16*)(F.ws + WS_S0) + item * 4096; const float* YL = (const float*)(F.ws + WS_YLOC) + item * 4096;
    const bf16* PROJ = (const bf16*)(F.ws + WS_PROJ); const float* mu = F.in[I_MU];
    bf16x8 sb[4][2];
#pragma unroll
    for (int tc = 0; tc < 4; ++tc)
#pragma unroll
        for (int ks = 0; ks < 2; ++ks) sb[tc][ks] = *(const GAS bf16x8*)(S0 + (size_t)(16 * tc + lq) * 64 + 32 * ks + 8 * g);
#pragma unroll 1
    for (int tr = 0; tr < 4; ++tr) {
        bf16x8 qa[2];
#pragma unroll
        for (int ks = 0; ks < 2; ++ks) qa[ks] = *(const GAS bf16x8*)(QT + (size_t)(16 * tr + lq) * 64 + 32 * ks + 8 * g);
        f32x4 y[4];
#pragma unroll
        for (int tc = 0; tc < 4; ++tc) {
#pragma unroll
            for (int i = 0; i < 4; ++i) { y[tc][i] = YL[(size_t)(16 * tr + 4 * g + i) * 64 + 16 * tc + lq]; DBGCNT(F, 0, !(fabsf(y[tc][i]) < 1e4f)); }
#ifndef DBG_NO_STATE
#pragma unroll
            for (int ks = 0; ks < 2; ++ks) y[tc] = __builtin_amdgcn_mfma_f32_16x16x32_bf16(qa[ks], sb[tc][ks], y[tc], 0, 0, 0);
#endif
            }
#pragma unroll
        for (int i = 0; i < 4; ++i) { const int t = 16 * tr + 4 * g + i, n = n0 + t;
            float s = (y[0][i] + y[1][i]) + (y[2][i] + y[3][i]); s += __shfl_xor(s, 1); s += __shfl_xor(s, 2); s += __shfl_xor(s, 4); s += __shfl_xor(s, 8);
            const float mean = s * (1.f / 64.f); float q = 0.f;
#pragma unroll
            for (int tc = 0; tc < 4; ++tc) { const float dlt = y[tc][i] - mean; q += dlt * dlt; }
            q += __shfl_xor(q, 1); q += __shfl_xor(q, 2); q += __shfl_xor(q, 4); q += __shfl_xor(q, 8);
            const float rstd = __builtin_amdgcn_rsqf(q * (1.f / 64.f) + GN_EPS);
            const float bsv = ((const float*)(F.ws + WS_BS))[(size_t)n * RH + h];
            const bool hasp = !(c == 0 && t == 0); const bf16* rowc = PROJ + (size_t)n * PCOLS; const bf16* rowp = hasp ? rowc - PCOLS : rowc;
#pragma unroll
            for (int tc = 0; tc < 4; ++tc) { const int hv = h * RN + 16 * tc + lq;
                const unsigned short vc = rowc[C_V + hv]; unsigned short vp = rowp[C_V + hv]; if (!hasp) vp = 0;
                const float vm = mixf(vc, vp, mu[C_V + hv]);
                const float yn = (y[tc][i] - mean) * rstd * F.in[I_LNG][hv] + F.in[I_LNB][hv];
                const float gt = bf2f(((const bf16*)(F.ws + WS_GATE))[(size_t)n * RW + hv]);
                float ov = (yn + bsv * vm) * gt;
#ifdef DBG_ZERO_RWKV
                ov = 0.f;
#endif
#ifdef DBG_PROBE
                ov = (DBG_PROBE == 1) ? gt : (DBG_PROBE == 2) ? bsv : (DBG_PROBE == 3) ? yn : (DBG_PROBE == 4) ? y[tc][i] : (DBG_PROBE == 5) ? 0.02f * (y[tc][i] - mean) : (DBG_PROBE == 6) ? 0.02f * y[tc][i] : vm;
#endif
#ifdef DBG_SCRUB_RWKV
                if (!(fabsf(ov) < 1e30f)) ov = 0.f;
#endif
                ((bf16*)(F.ws + WS_CAT))[(size_t)n * D + hv] = (bf16)f2bf(ov); }
        }
    }
}
}
__device__ __forceinline__ void diff_attn_phase(Frame& F) {
    const int lane = F.lane, w = F.wave, r = lane & 31, h = lane >> 5, rg = w >> 1, c = w & 1;
    float lam;
    { const float a = F.in[I_LQ1][lane] * F.in[I_LK1][lane], b2 = F.in[I_LQ2][lane] * F.in[I_LK2][lane]; lam = fexp(wave_sum(a)) - fexp(wave_sum(b2)) + LAMBDA_INIT; }
    const bf16* PROJ = (const bf16*)(F.ws + WS_PROJ); const bf16* VT = (const bf16*)(F.ws + WS_VT); bf16* CAT = (bf16*)(F.ws + WS_CAT);
    LAS float* xch = (LAS float*)F.lds;
    const bool tab = (F.G == 256);
    for (int p = F.bid; p < 256; p += F.G) {
#pragma unroll 1
        for (int s = 0; s < 2; ++s) { int bh, qb;
            if (tab) { const int u = attn_tab[F.bid][s]; if (u == 0xFFFF) break; bh = u >> 6; qb = u & 63; }
            else { bh = p >> 5; const int j = p & 31; qb = s ? 63 - j : j; }
            const int b = bh >> 2, hd = bh & 3; const int row0 = b * T + 128 * qb + 32 * rg;
            DiffBody32 body; f32x16 o[4]; float ls;
            const int nkt = 2 * qb + 2, nkt_w = (rg < 2) ? nkt - 1 : nkt;
            body.run(F.lds, PROJ + (size_t)row0 * PCOLS + C_QD + hd * 128 + c * 64, PCOLS, 0.125f * LOG2E, PROJ + (size_t)(b * T) * PCOLS + C_KD + hd * 128, PCOLS,
                     VT + (size_t)(hd * DV) * M + b * T, M, nkt, nkt_w, c, o, ls, F.tid, lane);
            if (c == 1) { const float sc = lam / ls;
#pragma unroll
                for (int db = 0; db < 4; ++db)
#pragma unroll
                    for (int i = 0; i < 16; ++i) xch[(rg * 64 + db * 16 + i) * 64 + lane] = o[db][i] * sc; }
            asm volatile("s_waitcnt lgkmcnt(0)" ::: "memory"); __builtin_amdgcn_s_barrier(); asm volatile("" ::: "memory");
            if (c == 0) { const float i0 = 1.f / ls; float q = 0.f;
#pragma unroll
                for (int db = 0; db < 4; ++db)
#pragma unroll
                    for (int i = 0; i < 16; ++i) { const float v = o[db][i] * i0 - xch[(rg * 64 + db * 16 + i) * 64 + lane]; o[db][i] = v; q += v * v; }
                { const auto r2 = __builtin_amdgcn_permlane32_swap(__float_as_uint(q), __float_as_uint(q), false, false); q = __uint_as_float(r2[0]) + __uint_as_float(r2[1]); }
                const float rstd = __builtin_amdgcn_rsqf(q * (1.f / DV) + NORM_EPS) * (1.f - LAMBDA_INIT);
                bf16* orow = CAT + (size_t)(row0 + r) * D + RW + hd * DV;
#pragma unroll
                for (int db = 0; db < 4; ++db)
#pragma unroll
                    for (int t = 0; t < 4; ++t) { const int dv = 32 * db + 8 * t + 4 * h; const f32x4 sg = *(const GAS f32x4*)(F.in[I_SUBG] + dv);
                        u32x2 wv; wv.x = cvt_pk_bf16(o[db][4 * t] * rstd * sg[0], o[db][4 * t + 1] * rstd * sg[1]); wv.y = cvt_pk_bf16(o[db][4 * t + 2] * rstd * sg[2], o[db][4 * t + 3] * rstd * sg[3]);
#ifdef DBG_ZERO_DIFF
                        wv.x = 0u; wv.y = 0u;
#endif
                        *(GAS u32x2*)(orow + dv) = wv; } }
            asm volatile("s_waitcnt lgkmcnt(0)" ::: "memory"); __builtin_amdgcn_s_barrier(); asm volatile("" ::: "memory");
        }
    }
}
__device__ __forceinline__ void cross_attn_phase(Frame& F, const int* ubase, int nunit) {
    typedef AttnBody<1, XD, XD, 2, 8> Body;
    const int lane = F.lane, w = F.wave, g = lane >> 4, lq = lane & 15;
    const bf16* QX = (const bf16*)(F.ws + WS_QX); const bf16* KM = (const bf16*)(F.ws + WS_KMEM); const bf16* VTM = (const bf16*)(F.ws + WS_VTMEM); bf16* XO = (bf16*)(F.ws + WS_XO);
#pragma unroll 1
    for (int uu = 0; uu < 2 * nunit; ++uu) { const int u = ubase[uu >> 1] + (uu & 1); const int bh = u >> 6, rb = u & 63, b = bh >> 2, h = bh & 3; const int row0 = b * T + 128 * rb + 16 * w;
        Body body; f32x4 o[1][16]; float ls[1];
        body.run(F.lds, QX + (size_t)row0 * D + h * XD, D, 1.0f, KM + (size_t)(b * MEM) * D + h * XD, D, VTM + (size_t)(h * XD) * (BATCH * MEM) + b * MEM, BATCH * MEM, 4, 4, false, o, ls, F.tid, lane);
        const float inv = pg8::F8_SXO / ls[0]; unsigned char* orow = (unsigned char*)XO + (size_t)(row0 + lq) * D + h * XD;
#pragma unroll
        for (int dt = 0; dt < 16; ++dt) { const f32x4 y = o[0][dt] * inv; *(GAS unsigned*)(orow + 16 * dt + 4 * g) = pk4_fp8(y[0], y[1], y[2], y[3]); }
    }
}

constexpr int RT_LCNT = X_OFF + 4096, RT_GBASE = RT_LCNT + 128, RT_ENTE = RT_GBASE + 128, RT_ENTP = RT_ENTE + 1024, RT_LGT = RT_ENTP + 1024;
__device__ __forceinline__ void router_phase(Frame& F, int cw_cnt, size_t ws_lists, size_t ws_gates) {
    const int lane = F.lane, w = F.wave, tid = F.tid;
    LAS int* lcnt = (LAS int*)(F.lds + RT_LCNT); LAS int* gbase = (LAS int*)(F.lds + RT_GBASE); LAS int* ente = (LAS int*)(F.lds + RT_ENTE); LAS int* entp = (LAS int*)(F.lds + RT_ENTP); LAS float* lgt = (LAS float*)(F.lds + RT_LGT);
    const float* H2 = (const float*)(F.ws + WS_H2); const float* RWT = (const float*)(F.ws + WS_RWT); const float* SS3 = (const float*)(F.ws + WS_SS3);
    int* lists = (int*)(F.ws + ws_lists); float* lgate = (float*)(F.ws + ws_gates); float* lrinv = lgate + (size_t)NE * CAP;
    LAS float* entg = (LAS float*)(F.lds + RT_LGT + 8448); LAS float* entr = entg + 256;
#pragma unroll 1
    for (int blk = F.bid; blk < M / 64; blk += F.G) {
        if (tid < NE) lcnt[tid] = 0;
        __syncthreads();
        const int nb = blk * 64 + w * 8;
        { const int lq = lane & 15, g = lane >> 4; LAS float* part = (LAS float*)F.lds;
          const f32x4* ap = (const f32x4*)(H2 + (size_t)(blk * 64 + lq) * D + 128 * w + 4 * g); const f32x4* bp = (const f32x4*)(RWT + (size_t)lq * D + 128 * w + 4 * g);
          f32x4 a[3][8], b[2][8], acc[4][2];
#define RT_LDA(slot, tt) do { _Pragma("unroll") for (int j = 0; j < 8; ++j) a[slot][j] = ap[(size_t)(tt) * 16 * (D / 4) + 4 * j]; } while (0)
#define RT_MMA(slot, tt) do { acc[tt][0] = (f32x4){0.f, 0.f, 0.f, 0.f}; acc[tt][1] = acc[tt][0]; _Pragma("unroll") for (int j = 0; j < 8; ++j) _Pragma("unroll") for (int m = 0; m < 4; ++m) { \
              acc[tt][0] = __builtin_amdgcn_mfma_f32_16x16x4f32(a[slot][j][m], b[0][j][m], acc[tt][0], 0, 0, 0); acc[tt][1] = __builtin_amdgcn_mfma_f32_16x16x4f32(a[slot][j][m], b[1][j][m], acc[tt][1], 0, 0, 0); } } while (0)
#pragma unroll
          for (int et = 0; et < 2; ++et)
#pragma unroll
              for (int j = 0; j < 8; ++j) b[et][j] = bp[(size_t)et * 16 * (D / 4) + 4 * j];
          RT_LDA(0, 0); RT_LDA(1, 1); RT_LDA(2, 2); __builtin_amdgcn_sched_barrier(0);
          RT_MMA(0, 0); __builtin_amdgcn_sched_barrier(0);
          RT_LDA(0, 3); __builtin_amdgcn_sched_barrier(0);
          RT_MMA(1, 1); RT_MMA(2, 2); __builtin_amdgcn_sched_barrier(0);
          RT_MMA(0, 3);
#undef RT_LDA
#undef RT_MMA
#pragma unroll
          for (int tt = 0; tt < 4; ++tt)
#pragma unroll
              for (int et = 0; et < 2; ++et)
#pragma unroll
                  for (int i = 0; i < 4; ++i) part[(w * 64 + tt * 16 + 4 * g + i) * 33 + et * 16 + lq] = acc[tt][et][i];
          __syncthreads();
#pragma unroll
          for (int q = 0; q < 4; ++q) { const int o = tid + 512 * q, tok = o >> 5, e = o & 31; float sum = 0.f;
#pragma unroll
              for (int ww = 0; ww < 8; ++ww) sum += part[(ww * 64 + tok) * 33 + e];
              lgt[tok * 33 + e] = sum; } }
        __syncthreads();
        if (lane < 8) { const int tl = w * 8 + lane, n = blk * 64 + tl;
            const float rinv = __builtin_amdgcn_rsqf(row_ss(SS3, n) * (1.f / D) + NORM_EPS);
            float v0 = -INFINITY, v1 = -INFINITY, v2 = -INFINITY, v3 = -INFINITY; int e0 = 0, e1 = 0, e2 = 0, e3 = 0;
#pragma unroll
            for (int e = 0; e < NE; ++e) { float x = lgt[tl * 33 + e] * rinv + F.in[I_RB][e]; if (!(x == x)) x = -3.0e38f;
                const bool c0 = x > v0, c1 = x > v1, c2 = x > v2, c3 = x > v3;
                v3 = c3 ? (c2 ? v2 : x) : v3; e3 = c3 ? (c2 ? e2 : e) : e3;
                v2 = c2 ? (c1 ? v1 : x) : v2; e2 = c2 ? (c1 ? e1 : e) : e2;
                v1 = c1 ? (c0 ? v0 : x) : v1; e1 = c1 ? (c0 ? e0 : e) : e1;
                v0 = c0 ? x : v0; e0 = c0 ? e : e0; }
            const float x1 = fexp(v1 - v0), x2 = fexp(v2 - v0), x3 = fexp(v3 - v0); const float inv = 1.f / (1.f + x1 + x2 + x3);
            const int es[4] = {e0, e1, e2, e3}; const float gs[4] = {inv, x1 * inv, x2 * inv, x3 * inv};
#pragma unroll
            for (int k = 0; k < 4; ++k) { const int li = tl * 4 + k; const int lp = __hip_atomic_fetch_add(&lcnt[es[k]], 1, __ATOMIC_RELAXED, __HIP_MEMORY_SCOPE_WORKGROUP); ente[li] = es[k]; entp[li] = lp; entg[li] = gs[k]; entr[li] = rinv; }
        }
        __syncthreads();
        if (tid < NE) gbase[tid] = (int)__hip_atomic_fetch_add((unsigned*)(F.ctl + cw_cnt + 64 * tid), (unsigned)lcnt[tid], RLX_AGENT);
#ifdef DUP_ATOM
        if (tid < NE) lgt[tid] = (float)__hip_atomic_fetch_add((unsigned*)(F.ctl + cw_cnt + 8192 + 64 * tid), (unsigned)lcnt[tid], RLX_AGENT);
#endif
        __syncthreads();
        if (tid < 256) { const int ee = ente[tid]; const size_t pos = (size_t)ee * CAP + gbase[ee] + entp[tid]; lists[pos] = blk * 256 + tid; lgate[pos] = entg[tid]; lrinv[pos] = entr[tid]; }
        __syncthreads();
    }
}
__device__ __forceinline__ void final_phase(Frame& F) {
    const int gw = F.bid * NWAVES + F.wave, NGW = F.G * NWAVES, lane = F.lane;
    const float* H2 = (const float*)(F.ws + WS_H2); const bf16* Y = (const bf16*)(F.ws + WS_YBUF);
    for (int n = gw; n < M; n += NGW) {
        f32x4 v[4]; float s = 0.f;
#pragma unroll
        for (int j = 0; j < 4; ++j) { v[j] = *((const GAS f32x4*)(H2 + (size_t)n * D) + lane + 64 * j);
#pragma unroll
            for (int k = 0; k < 4; ++k) { u32x2 y = *((const GAS u32x2*)(Y + (size_t)(n * 4 + k) * D) + lane + 64 * j);
#ifdef DBG_ZERO_MOE
                y.x = 0u; y.y = 0u;
#endif
                v[j].x += bflo(y.x); v[j].y += bfhi(y.x); v[j].z += bflo(y.y); v[j].w += bfhi(y.y); }
            s += (v[j].x * v[j].x + v[j].y * v[j].y) + (v[j].z * v[j].z + v[j].w * v[j].w); }
        float rstd = 1.f / sqrtf(wave_sum(s) * (1.f / D) + NORM_EPS);
#ifdef DBG_SEL
        { const unsigned cnt = __hip_atomic_load(F.ctl + 12288 + DBG_SEL, RLX_AGENT); rstd *= 0.9f * __log2f(1.f + (float)cnt) * (1.f / 30.f); }
#endif
#pragma unroll
        for (int j = 0; j < 4; ++j) { const f32x4 gg = *((const GAS f32x4*)F.in[I_FG] + lane + 64 * j); *((GAS f32x4*)(F.out + (size_t)n * D) + lane + 64 * j) = v[j] * rstd * gg; }
    }
}

constexpr int NPHASE = 13;
#ifndef P1_GEMM_WGS
#define P1_GEMM_WGS 144
#endif
struct Args { const float* in[34]; float* out; unsigned char* ws; int ph_lo, ph_hi; };
__global__ void __launch_bounds__(NTHR, 2) fwd_kernel(Args args) {
    extern __shared__ __attribute__((aligned(16))) unsigned char lds[];
    Frame F;
    F.lds = (LAS unsigned char*)lds; F.MISC = (volatile LAS unsigned*)(F.lds + MISC_OFF);
    F.tid = threadIdx.x; F.lane = F.tid & 63; F.wave = __builtin_amdgcn_readfirstlane(F.tid >> 6);
    F.G = gridDim.x; F.bid = blockIdx.x; F.ws = args.ws; F.ctl = (gu32*)(args.ws + WS_CTL); F.out = args.out;
#pragma unroll
    for (int i = 0; i < 34; ++i) F.in[i] = args.in[i];
    for (int u = F.tid; u < (LDS_BYTES - MISC_OFF) / 4; u += NTHR) ((LAS unsigned*)(F.lds + MISC_OFF))[u] = 0u;
    __syncthreads();
    XcdBarrier bar = xcd_barrier_post((unsigned*)(F.ctl + CW_BAR), F.MISC + 8);
    const int lo = args.ph_lo, hi = args.ph_hi;
#ifndef PHM
#define PHM 0xffff
#endif
#define IN(k) (((PHM >> (k)) & 1) && lo <= (k) && (k) < hi)
#ifdef DUP_BARRIER
#define SEAM(k) do { if (IN(k) && IN((k) + 1)) { xcd_barrier(bar); if ((k) == DUP_BARRIER || DUP_BARRIER == 99) { xcd_barrier(bar); } } } while (0)
#else
#define SEAM(k) do { if (IN(k) && IN((k) + 1)) xcd_barrier(bar); } while (0)
#endif
    LAS int* lstage = (LAS int*)(F.lds + X_OFF);
    LAS int* moe_tb = (LAS int*)(F.lds + X_OFF + 2048); LAS int* moe_cn = (LAS int*)(F.lds + X_OFF + 2048 + 256); LAS int* moe_rte = (LAS int*)(F.lds + X_OFF + 2048 + 512);

#define RETID() do { int t_ = threadIdx.x; asm volatile("" : "+v"(t_)); F.tid = t_; F.lane = t_ & 63; } while (0)
    if (IN(0)) { RETID(); p0_prologue(F);
#if defined(DUP_PHASE) && DUP_PHASE == 0
        { RETID(); p0_prologue(F);  }
#endif
    } SEAM(0);
    if (IN(1)) { RETID();
        const int NG1 = (F.G == 256) ? P1_GEMM_WGS : F.G;
        if (F.bid < NG1) {
        const bf16* XN = (const bf16*)(F.ws + WS_XN); const bf16* WinT = (const bf16*)(F.ws + WS_WINT); const bf16* MEMN = (const bf16*)(F.ws + WS_MEMN); const bf16* WkvT = (const bf16*)(F.ws + WS_WKVT);
        { pg8::Gemm g{XN, WinT, D, 0, nullptr}; pg8::StaticOrder S; S.init(M, PCOLS, NG1, F.bid, 0); pg8::EpiBf16 E{(bf16*)(F.ws + WS_PROJ), PCOLS};
          pg8::gemm_phase<pg8::EpiBf16, pg8::StaticOrder, true, false>(F.lds, lstage, g, S, E); }
        { pg8::Gemm g{WinT + (size_t)C_VD * D, XN, D, 0, nullptr}; pg8::StaticOrder S; S.init(512, M, NG1, F.bid, 0); pg8::EpiBf16 E{(bf16*)(F.ws + WS_VT), M};
          pg8::gemm_phase<pg8::EpiBf16, pg8::StaticOrder, true, false>(F.lds, lstage, g, S, E); }
        { pg8::Gemm g{MEMN, WkvT, D, 0, nullptr}; pg8::StaticOrder S; S.init(BATCH * MEM, D, NG1, F.bid, 16); pg8::EpiBf16 E{(bf16*)(F.ws + WS_KMEM), D};
          pg8::gemm_phase<pg8::EpiBf16, pg8::StaticOrder, true, false>(F.lds, lstage, g, S, E); }
        { pg8::Gemm g{WkvT + (size_t)D * D, MEMN, D, 0, nullptr}; pg8::StaticOrder S; S.init(D, BATCH * MEM, NG1, F.bid, 8); pg8::EpiBf16 E{(bf16*)(F.ws + WS_VTMEM), BATCH * MEM};
          pg8::gemm_phase<pg8::EpiBf16, pg8::StaticOrder, true, false>(F.lds, lstage, g, S, E); }

        }
        if (NG1 == F.G || F.bid >= NG1) p0_experts(F, NG1 == F.G ? 0 : NG1);
    } SEAM(1);
    if (IN(2)) { RETID(); for (int it = F.bid; it < BATCH * NCHUNK; it += F.G) rk::phase_a(F, it / NCHUNK, it % NCHUNK);
#if defined(DUP_PHASE) && DUP_PHASE == 2
        { RETID(); for (int it = F.bid; it < BATCH * NCHUNK; it += F.G) rk::phase_a(F, it / NCHUNK, it % NCHUNK);  }
#endif
    } SEAM(2);
    if (IN(3)) { RETID();
        for (int it = F.bid; it < BATCH * RH * 4; it += F.G) rk::phase_scan(F, it >> 2, it & 3);
#ifdef DUP_SCAN
        for (int it = F.bid; it < BATCH * RH * 4; it += F.G) rk::phase_scan(F, it >> 2, it & 3);
#endif
        diff_attn_phase(F);
#ifdef DUP_ATTN
        diff_attn_phase(F);
#endif

#if defined(DUP_PHASE) && DUP_PHASE == 3
        { RETID();
        for (int it = F.bid; it < BATCH * RH * 4; it += F.G) rk::phase_scan(F, it >> 2, it & 3);
        diff_attn_phase(F);
     }
#endif
    } SEAM(3);
    if (IN(4)) { RETID(); for (int it = F.bid; it < BATCH * NCHUNK; it += F.G) rk::phase_c(F, it / NCHUNK, it % NCHUNK, F.wave);
#if defined(DUP_PHASE) && DUP_PHASE == 4
        { RETID(); for (int it = F.bid; it < BATCH * NCHUNK; it += F.G) rk::phase_c(F, it / NCHUNK, it % NCHUNK, F.wave);  }
#endif
    } SEAM(4);
    if (IN(5)) { RETID(); pg8::Gemm g{(const bf16*)(F.ws + WS_CAT), (const bf16*)(F.ws + WS_WOUTT), D, 0, nullptr}; pg8::StaticOrder S; S.init(M, D, F.G, F.bid, 0);
        pg8::EpiResid2T<2> E{F.in[I_X], nullptr, nullptr, (bf16*)(F.ws + WS_H1B), (float*)(F.ws + WS_SS1), nullptr, F.ws + WS_H1, 1.0f};
        pg8::gemm_phase<pg8::EpiResid2T<2>, pg8::StaticOrder, true, false>(F.lds, lstage, g, S, E);
#if defined(DUP_PHASE) && DUP_PHASE == 5
        { RETID(); pg8::Gemm g{(const bf16*)(F.ws + WS_CAT), (const bf16*)(F.ws + WS_WOUTT), D, 0, nullptr}; pg8::StaticOrder S; S.init(M, D, F.G, F.bid, 0);
        pg8::EpiResid2T<2> E{F.in[I_X], nullptr, nullptr, (bf16*)(F.ws + WS_H1B), (float*)(F.ws + WS_SS1), nullptr, F.ws + WS_H1, 1.0f};
        pg8::gemm_phase<pg8::EpiResid2T<2>, pg8::StaticOrder, true, false>(F.lds, lstage, g, S, E);  }
#endif
    } SEAM(5);
    if (IN(6)) { RETID(); pg8::Gemm g{(const bf16*)(F.ws + WS_H1), (const bf16*)(F.ws + WS_WQT), D / 2, 0, nullptr}; pg8::StaticOrder S; S.init(M, D, F.G, F.bid, 0);
        pg8::EpiRowScaleBf16 E{(bf16*)(F.ws + WS_QX), D, (const float*)(F.ws + WS_SS1), 0.0625f * LOG2E / (F8_SA * F8_SW)};
        pg8::gemm_phase<pg8::EpiRowScaleBf16, pg8::StaticOrder, true, false, true>(F.lds, lstage, g, S, E);
        __builtin_amdgcn_fence(__ATOMIC_RELEASE, "workgroup"); __syncthreads(); __builtin_amdgcn_fence(__ATOMIC_ACQUIRE, "workgroup");
        RETID();
        int ub[4]; int nu = 0; pg8::Unit u;
#pragma unroll
        for (int i = 0; i < 4; ++i) if (S.next(i, u)) { ub[i] = ((u.pm >> 5) * 4 + u.pn) * 64 + 2 * (u.pm & 31); nu = i + 1; } else ub[i] = 0;
        cross_attn_phase(F, ub, nu);
    } SEAM(7);
    if (IN(8)) { RETID(); pg8::Gemm g{(const bf16*)(F.ws + WS_XO), (const bf16*)(F.ws + WS_WOT), D / 2, 0, nullptr}; pg8::StaticOrder S; S.init(M, D, F.G, F.bid, 0);
        pg8::EpiResid2T<1> E{nullptr, (const bf16*)(F.ws + WS_H1B), (float*)(F.ws + WS_H2), nullptr, (float*)(F.ws + WS_SS3), F.in[I_N3G], F.ws + WS_H2B, 1.0f / (pg8::F8_SXO * F8_SW)};
        pg8::gemm_phase<pg8::EpiResid2T<1>, pg8::StaticOrder, true, false, true>(F.lds, lstage, g, S, E);
#if defined(DUP_PHASE) && DUP_PHASE == 8
        { RETID(); pg8::Gemm g{(const bf16*)(F.ws + WS_XO), (const bf16*)(F.ws + WS_WOT), D / 2, 0, nullptr}; pg8::StaticOrder S; S.init(M, D, F.G, F.bid, 0);
        pg8::EpiResid2T<1> E{nullptr, (const bf16*)(F.ws + WS_H1B), (float*)(F.ws + WS_H2), nullptr, (float*)(F.ws + WS_SS3), F.in[I_N3G], F.ws + WS_H2B, 1.0f / (pg8::F8_SXO * F8_SW)};
        pg8::gemm_phase<pg8::EpiResid2T<1>, pg8::StaticOrder, true, false, true>(F.lds, lstage, g, S, E);  }
#endif
    } SEAM(8);
    if (IN(9)) { RETID(); router_phase(F, CW_CNT, WS_LISTS, WS_LGATE);
#if defined(DUP_PHASE) && DUP_PHASE == 9
        { RETID(); router_phase(F, CW_CNT + 4096, WS_YBUF, WS_YBUF + 4 * MiB); }
#endif
    } SEAM(9);
    if (IN(10) || IN(11)) { RETID();
        if (F.tid < NE) moe_cn[F.tid] = (int)__hip_atomic_load(F.ctl + CW_CNT + 64 * F.tid, RLX_AGENT);
        __syncthreads();
        if (F.tid == 0) { int a = 0; for (int e = 0; e < NE; ++e) { moe_tb[e] = a; a += (moe_cn[e] + 255) >> 8; } moe_tb[NE] = a; }
        __syncthreads();
        if (F.tid < MAXRT) { int e = 0; for (int k = 1; k < NE; ++k) e = (F.tid >= moe_tb[k]) ? k : e; moe_rte[F.tid] = e; }
        __syncthreads();
    }
    if (IN(10)) { RETID(); pg8::Gemm g{(const bf16*)(F.ws + WS_H2B), (const bf16*)(F.ws + WS_W1T), D / 2, (size_t)FF * D, (const int*)(F.ws + WS_LISTS)};
        pg8::MoeOrder S{moe_tb, moe_cn, moe_rte, 8, F.G, F.bid, __builtin_amdgcn_readfirstlane(moe_tb[NE])};
        pg8::EpiSwiglu E{F.ws + WS_ACT, F.in[I_B1], (const float*)(F.ws + WS_LRINV), (const int*)(F.ws + WS_LISTS)};
        pg8::gemm_phase<pg8::EpiSwiglu, pg8::MoeOrder, true, true, true>(F.lds, lstage, g, S, E);
#if defined(DUP_PHASE) && DUP_PHASE == 10
        { RETID(); pg8::Gemm g{(const bf16*)(F.ws + WS_H2B), (const bf16*)(F.ws + WS_W1T), D / 2, (size_t)FF * D, (const int*)(F.ws + WS_LISTS)};
        pg8::MoeOrder S{moe_tb, moe_cn, moe_rte, 8, F.G, F.bid, __builtin_amdgcn_readfirstlane(moe_tb[NE])};
        pg8::EpiSwiglu E{F.ws + WS_ACT, F.in[I_B1], (const float*)(F.ws + WS_LRINV), (const int*)(F.ws + WS_LISTS)};
        pg8::gemm_phase<pg8::EpiSwiglu, pg8::MoeOrder, true, true, true>(F.lds, lstage, g, S, E);  }
#endif
    } SEAM(10);
    if (IN(11)) { RETID(); pg8::Gemm g{(const bf16*)(F.ws + WS_ACT), (const bf16*)(F.ws + WS_W2T), FF / 2, (size_t)D * FF / 2, nullptr};
        pg8::MoeOrder S{moe_tb, moe_cn, moe_rte, 4, F.G, F.bid, __builtin_amdgcn_readfirstlane(moe_tb[NE])};
        pg8::EpiMoe2 E{(bf16*)(F.ws + WS_YBUF), F.in[I_B2], (const float*)(F.ws + WS_LGATE), (const int*)(F.ws + WS_LISTS)};
        pg8::gemm_phase<pg8::EpiMoe2, pg8::MoeOrder, true, false, true>(F.lds, lstage, g, S, E);
#if defined(DUP_PHASE) && DUP_PHASE == 112
        { RETID(); pg8::Gemm g{(const bf16*)(F.ws + WS_H2B), (const bf16*)(F.ws + WS_W2T), FF, (size_t)D * FF, (const int*)(F.ws + WS_LISTS)};
        pg8::MoeOrder S{moe_tb, moe_cn, moe_rte, 4, F.G, F.bid, __builtin_amdgcn_readfirstlane(moe_tb[NE])};
        pg8::EpiBf16 E{(bf16*)(F.ws + 532 * MiB), D};
        pg8::gemm_phase<pg8::EpiBf16, pg8::MoeOrder, true, true>(F.lds, lstage, g, S, E);  }
#endif
#if defined(DUP_PHASE) && DUP_PHASE == 11
        { RETID(); pg8::Gemm g{(const bf16*)(F.ws + WS_ACT), (const bf16*)(F.ws + WS_W2T), FF / 2, (size_t)D * FF / 2, nullptr};
        pg8::MoeOrder S{moe_tb, moe_cn, moe_rte, 4, F.G, F.bid, __builtin_amdgcn_readfirstlane(moe_tb[NE])};
        pg8::EpiMoe2 E{(bf16*)(F.ws + WS_YBUF), F.in[I_B2], (const float*)(F.ws + WS_LGATE), (const int*)(F.ws + WS_LISTS)};
        pg8::gemm_phase<pg8::EpiMoe2, pg8::MoeOrder, true, false, true>(F.lds, lstage, g, S, E);  }
#endif
    } SEAM(11);
    if (IN(12)) { RETID(); final_phase(F);
#if defined(DUP_PHASE) && DUP_PHASE == 12
        { RETID(); final_phase(F);  }
#endif
    }
#undef IN
#undef SEAM
}

#ifndef MK_SPLIT
#define MK_SPLIT 0
#endif
extern "C" void kernel_launch(void* const* d_in, const int* in_sizes, int n_in, void* d_out, int out_size, void* d_ws, size_t ws_size, hipStream_t stream) {
    static int grid = 0;
    if (grid == 0) {
        if (n_in != 34 || out_size != M * D || ws_size < WS_END) { fprintf(stderr, "kernel_launch: unexpected shapes (n_in %d out %d ws %zu)\n", n_in, out_size, ws_size); grid = -1; return; }
        int dev = 0, cus = 0, per_cu = 0;
        if (hipGetDevice(&dev) != hipSuccess || hipDeviceGetAttribute(&cus, hipDeviceAttributeMultiprocessorCount, dev) != hipSuccess) { grid = -1; return; }
        if (hipFuncSetAttribute((const void*)fwd_kernel, hipFuncAttributeMaxDynamicSharedMemorySize, LDS_BYTES) != hipSuccess) { fprintf(stderr, "kernel_launch: hipFuncSetAttribute failed\n"); grid = -1; return; }
        if (hipOccupancyMaxActiveBlocksPerMultiprocessor(&per_cu, (const void*)fwd_kernel, NTHR, LDS_BYTES) != hipSuccess || per_cu < 1) fprintf(stderr, "kernel_launch: occupancy query reports %d\n", per_cu);
        (void)hipGetLastError();
        grid = cus;
    }
    if (grid < 0) return;
    (void)hipMemsetAsync((char*)d_ws + WS_CTL, 0, CTL_ZERO_BYTES, stream);
    Args a{};
    for (int i = 0; i < 34; ++i) a.in[i] = (const float*)d_in[i];
    a.out = (float*)d_out; a.ws = (unsigned char*)d_ws;
#if MK_SPLIT
    for (int p = 0; p < NPHASE; ++p) { a.ph_lo = p; a.ph_hi = p + 1; hipLaunchKernelGGL(fwd_kernel, dim3(grid), dim3(NTHR), LDS_BYTES, stream, a); }
#else
    a.ph_lo = 0; a.ph_hi = NPHASE; hipLaunchKernelGGL(fwd_kernel, dim3(grid), dim3(NTHR), LDS_BYTES, stream, a);
#endif
}
```

```cpp
#include <hip/hip_runtime.h>
#include <cstdio>
#include <cstdint>

#define GAS __attribute__((address_space(1)))
#define LAS __attribute__((address_space(3)))
typedef unsigned short bf16;
typedef short bf16x8 __attribute__((ext_vector_type(8)));
typedef short bf16x4 __attribute__((ext_vector_type(4)));
typedef float f32x4 __attribute__((ext_vector_type(4)));
typedef float f32x2 __attribute__((ext_vector_type(2)));
typedef unsigned u32x4 __attribute__((ext_vector_type(4)));
typedef unsigned u32x2 __attribute__((ext_vector_type(2)));
typedef GAS unsigned gu32;
typedef int i32x4 __attribute__((ext_vector_type(4)));
typedef int i32x8 __attribute__((ext_vector_type(8)));
#define RLX_AGENT __ATOMIC_RELAXED, __HIP_MEMORY_SCOPE_AGENT
#define LDS_WAIT() asm volatile("s_waitcnt lgkmcnt(0)" ::: "memory")
#define VM_WAIT() asm volatile("s_waitcnt vmcnt(0)" ::: "memory")

typedef __bf16 bf16x2_t __attribute__((ext_vector_type(2)));
__device__ __forceinline__ unsigned cvt_pk_bf16(float lo, float hi) { const f32x2 v = {lo, hi}; const bf16x2_t b = __builtin_convertvector(v, bf16x2_t); return __builtin_bit_cast(unsigned, b); }
__device__ __forceinline__ unsigned f2bf(float f) { unsigned u = __builtin_bit_cast(unsigned, f); return (u + 0x7fffu + ((u >> 16) & 1u)) >> 16; }
__device__ __forceinline__ unsigned pk2(float lo, float hi) { return f2bf(lo) | (f2bf(hi) << 16); }
__device__ __forceinline__ float bf2f(bf16 b) { return __builtin_bit_cast(float, (unsigned)b << 16); }
__device__ __forceinline__ float bflo(unsigned u) { return __builtin_bit_cast(float, u << 16); }
__device__ __forceinline__ float bfhi(unsigned u) { return __builtin_bit_cast(float, u & 0xffff0000u); }
__device__ __forceinline__ float fexp2(float x) { return __builtin_amdgcn_exp2f(x); }
__device__ __forceinline__ float fexp(float x) { return __builtin_amdgcn_exp2f(x * 1.4426950408889634f); }
__device__ __forceinline__ float frcp(float x) { return __builtin_amdgcn_rcpf(x); }
__device__ __forceinline__ float sigmoidf_(float x) { return frcp(1.0f + fexp(-x)); }
__device__ __forceinline__ unsigned pk4_fp8(float a, float b, float c, float d) {
    a = __builtin_amdgcn_fmed3f(a, -448.f, 448.f); b = __builtin_amdgcn_fmed3f(b, -448.f, 448.f); c = __builtin_amdgcn_fmed3f(c, -448.f, 448.f); d = __builtin_amdgcn_fmed3f(d, -448.f, 448.f);
    int w = 0; w = __builtin_amdgcn_cvt_pk_fp8_f32(a, b, w, false); w = __builtin_amdgcn_cvt_pk_fp8_f32(c, d, w, true); return (unsigned)w; }
__device__ __forceinline__ i32x8 cat8(bf16x8 lo, bf16x8 hi) { const i32x4 a = __builtin_bit_cast(i32x4, lo), b = __builtin_bit_cast(i32x4, hi); return __builtin_shufflevector(a, b, 0, 1, 2, 3, 4, 5, 6, 7); }
constexpr float F8_SA = 16.f, F8_SW = 256.f, F8_SACT = 8.f;
#ifndef F8_SCALE
#define F8_SCALE 0
#endif

namespace pg8 {
constexpr int BM = 256, BK = 64, HALF = 128, HTB = HALF * BK * 2  , STAGE_BYTES = 8 * HTB, NXCD = 8, WGM = 8;
__host__ __device__ __forceinline__ int lds_byte(int r, int c) { const int st = (r >> 4) * 2 + (c >> 5), rr = r & 15, cc = c & 31, ob = rr * 64 + cc * 2; return st * 1024 + (ob ^ (((ob >> 9) & 1) << 5)); }
__host__ __device__ __forceinline__ void stage_rc(int b, int& R, int& C) { const int st = b / 1024, sb = b % 1024, swz = sb ^ (((sb >> 9) & 1) << 5); R = (st >> 1) * 16 + swz / 64; C = (st & 1) * 32 + (swz % 64) / 2; }
__host__ __device__ __forceinline__ int perm32(int rho) { const int n = rho >> 4, i = rho & 15; return 8 * (i >> 2) + 4 * n + (i & 3); }

struct Unit { int pm, pn, e, nvalid, lbase, orow; int kind; unsigned abase, boffs; };
struct Gemm { const bf16* A; const bf16* Bt; int K; size_t bstride; const int* rowlist; };

struct StaticOrder {
    static constexpr bool MERGED = false;
    int nM, nN, nwg, G, c;
    __device__ __forceinline__ void init(int M, int N, int G_, int c_, int rot) { nM = M / BM; nN = N / BM; nwg = nM * nN; G = G_; c = (c_ + rot) % G_; }
    __device__ __forceinline__ bool next(int i, Unit& u) const {
        const long L = (long)i * G + c; if (L >= nwg) return false;
        int wgid = (int)L; { const int q = nwg / NXCD, r = nwg % NXCD, xcd = wgid % NXCD, off = wgid / NXCD; wgid = (xcd < r ? xcd * (q + 1) : r * (q + 1) + (xcd - r) * q) + off; }
        const int nig = WGM * nN, gid = wgid / nig, fm = gid * WGM, gsz = (nM - fm) < WGM ? (nM - fm) : WGM;
        u.pm = fm + ((wgid % nig) % gsz); u.pn = (wgid % nig) / gsz; u.e = 0; u.nvalid = 256; u.lbase = 0; u.orow = u.pm * BM; u.kind = 0; u.abase = 0; u.boffs = 0; return true;
    }
};

template <class Epi, class Sched, bool ALIGN_EPI, bool GATHER, bool F8 = false>
__device__ __forceinline__ void gemm_phase(LAS unsigned char* lds, LAS int* lstage  , const Gemm g, const Sched& S, const Epi& E) {
    int tid = threadIdx.x; asm volatile("" : "+v"(tid));
    const int wid = __builtin_amdgcn_readfirstlane(tid >> 6), lane = tid & 63, wr = wid >> 2, wc = wid & 3, fr = lane & 15, fq = lane >> 4;
    const int K = g.K, nt = K / BK;
    unsigned voffB[2], vA[2][2];
#pragma unroll
    for (int i = 0; i < 2; ++i) { int R, C; stage_rc(tid * 16 + i * 8192, R, C); const int Rb = Epi::PERM ? ((R & ~31) + perm32(R & 31)) : R;
        voffB[i] = (unsigned)(Rb * K + C) * 2u;
#pragma unroll
        for (int h = 0; h < 2; ++h) vA[h][i] = (unsigned)((h * HALF + R) * K + C) * 2u; }
    const size_t kstep = (size_t)(BK * 2);
    const size_t hstep = (size_t)HALF * K * 2;
    const size_t tstep = 2 * hstep;
    constexpr int AH1 = GATHER ? 1 : 0; const size_t AH = GATHER ? (size_t)0 : hstep;
    const unsigned ldsw = (unsigned)wid * 1024u;
    const int aoff = lds_byte(wr * 64 + fr, fq * 8), boff = lds_byte(wc * 32 + fr, fq * 8);
#define PG8_SA(b, h) (((b) * 2 + (h)) * HTB)
#define PG8_SB(b, h) ((4 + (b) * 2 + (h)) * HTB)
#define PG8_STAGE_(rs, base, bufoff, off, voff) do { _Pragma("unroll") for (int _i = 0; _i < 2; ++_i) { \
        if constexpr (F8) { asm volatile("s_mov_b32 m0, %0\n\ts_nop 0\n\tbuffer_load_dwordx4 %1, %2, %3 offen lds" \
            :: "s"(lds32 + (unsigned)(bufoff) + ldsw + (unsigned)_i * 8192u), "v"((voff)[_i]), "s"(rs), "s"((unsigned)(off)) : "m0", "memory"); } \
        else __builtin_amdgcn_global_load_lds((const unsigned*)((const char*)(base) + (off) + (voff)[_i]), (LAS unsigned*)(lds + (bufoff) + ldsw + _i * 8192), 16, 0, 0); } } while (0)
#define PG8_STA(bufoff, off, voff) PG8_STAGE_(rsA, g.A, bufoff, off, voff)
#define PG8_STB(bufoff, off, voff) PG8_STAGE_(rsB, g.Bt, bufoff, off, voff)
#define PG8_LDA(dst, b, h) do { _Pragma("unroll") for (int m = 0; m < 4; ++m) _Pragma("unroll") for (int k = 0; k < 2; ++k) dst[m][k] = *(const LAS bf16x8*)(lds + PG8_SA(b, h) + aoff + m * 2048 + k * 1024); } while (0)
#define PG8_LDB(dst, b, h) do { _Pragma("unroll") for (int n = 0; n < 2; ++n) _Pragma("unroll") for (int k = 0; k < 2; ++k) dst[n][k] = *(const LAS bf16x8*)(lds + PG8_SB(b, h) + boff + n * 2048 + k * 1024); } while (0)
#define PG8_MMA(ai, bj, At, Bt) do { __builtin_amdgcn_s_setprio(1); _Pragma("unroll") for (int m = 0; m < 4; ++m) _Pragma("unroll") for (int n = 0; n < 2; ++n) { \
        if constexpr (F8) acc[ai][bj][m][n] = __builtin_amdgcn_mfma_scale_f32_16x16x128_f8f6f4(cat8(Bt[n][0], Bt[n][1]), cat8(At[m][0], At[m][1]), acc[ai][bj][m][n], 0, 0, 0, F8_SCALE, 0, F8_SCALE); \
        else { _Pragma("unroll") for (int k = 0; k < 2; ++k) acc[ai][bj][m][n] = __builtin_amdgcn_mfma_f32_16x16x32_bf16(Bt[n][k], At[m][k], acc[ai][bj][m][n], 0, 0, 0); } } __builtin_amdgcn_s_setprio(0); } while (0)
#define PG8_WAIT_V(n) asm volatile("s_waitcnt vmcnt(" #n ")" ::: "memory")
#define PG8_WAIT_L(n) asm volatile("s_waitcnt lgkmcnt(" #n ")" ::: "memory")
#define PG8_BAR __builtin_amdgcn_s_barrier()
#define PG8_SCHED __builtin_amdgcn_sched_barrier(0)
    Unit cur, nxt; int ui = 0;
    if (!S.next(0, cur)) return;
    f32x4 acc[2][2][4][2];
#pragma unroll
    for (int a = 0; a < 2; ++a)
#pragma unroll
        for (int b = 0; b < 2; ++b)
#pragma unroll
            for (int m = 0; m < 4; ++m)
#pragma unroll
                for (int n = 0; n < 2; ++n) acc[a][b][m][n] = (f32x4){0.f, 0.f, 0.f, 0.f};
    bf16x8 At[4][2], B0[2][2], B1[2][2];
    size_t cA = GATHER ? (size_t)0 : (size_t)cur.pm * tstep;
    size_t cB = ((size_t)cur.e * g.bstride) * 2 + (size_t)cur.pn * tstep;
    const unsigned lds32 = (unsigned)(uintptr_t)lds;
    const __amdgpu_buffer_rsrc_t rsA = __builtin_amdgcn_make_buffer_rsrc((void*)g.A, 0, 0x7fffffff, 0x00020000), rsB = __builtin_amdgcn_make_buffer_rsrc((void*)g.Bt, 0, 0x7fffffff, 0x00020000);
    if constexpr (GATHER) {
        if (wid == 0) { unsigned lo16 = threadIdx.x; asm volatile("" : "+v"(lo16)); lo16 = (lo16 & 63u) * 16u; __builtin_amdgcn_global_load_lds((const unsigned*)((const char*)(g.rowlist + cur.lbase) + lo16), (LAS unsigned*)lstage, 16, 0, 0); }
        PG8_WAIT_V(0); __builtin_amdgcn_s_barrier();
#pragma unroll
        for (int h = 0; h < 2; ++h)
#pragma unroll
            for (int i = 0; i < 2; ++i) { int R, C; stage_rc(tid * 16 + i * 8192, R, C); const int rr = h * HALF + R; const int ent = lstage[rr]; int src = rr < cur.nvalid ? ((ent >> 2) & 16383) : 0;
                if constexpr (Sched::MERGED) { if (cur.kind) src = cur.orow + rr; }
                vA[h][i] = (unsigned)(src * K + C) * 2u; }
        PG8_WAIT_L(0); __builtin_amdgcn_s_barrier();
    }
    int pend = -1;
    if constexpr (Sched::MERGED) { cA = cur.abase; cB = cur.boffs; if (cur.kind) S.wait_slow(cur); }
    PG8_STB(PG8_SB(0, 0), cB, voffB); PG8_STB(PG8_SB(0, 1), cB + hstep, voffB); PG8_STA(PG8_SA(0, 0), cA, vA[0]); PG8_STA(PG8_SA(0, 1), cA + AH, vA[AH1]);
    if (wr == 1) PG8_BAR;
    PG8_WAIT_V(2); PG8_BAR;
    PG8_STB(PG8_SB(1, 0), cB + kstep, voffB); PG8_STA(PG8_SA(1, 0), cA + kstep, vA[0]); PG8_STB(PG8_SB(1, 1), cB + hstep + kstep, voffB);
    PG8_WAIT_V(6); PG8_BAR;
    for (;;) {
        const bool has_next = S.next(ui + 1, nxt);
        size_t nA = has_next ? (GATHER ? (size_t)0 : (size_t)nxt.pm * tstep) : cA;
        size_t nB = has_next ? ((size_t)nxt.e * g.bstride) * 2 + (size_t)nxt.pn * tstep : cB;
        if constexpr (Sched::MERGED) { if (has_next) { nA = nxt.abase; nB = nxt.boffs; } }
#pragma unroll 1
        for (int t = 0; t < nt; t += 2) {
            const bool last = (t == nt - 2);
            if constexpr (GATHER) {
                if (t == 0 && has_next && wid == 0) { unsigned lo16 = threadIdx.x; asm volatile("" : "+v"(lo16)); lo16 = (lo16 & 63u) * 16u;
                    __builtin_amdgcn_global_load_lds((const unsigned*)((const char*)(g.rowlist + nxt.lbase) + lo16), (LAS unsigned*)(lstage + 256 * ((ui + 1) & 1)), 16, 0, 0); }
            }
            if constexpr (Sched::MERGED) {
                if (t == 0 && has_next && nxt.kind && tid == 0) __builtin_amdgcn_global_load_lds((const unsigned*)(S.ready + 64 * nxt.pm), (LAS unsigned*)(S.pollw + ((ui + 1) & 1)), 4, 0, 16);
                if (last) {
                    if (pend >= 0) { if (lane == 0) __hip_atomic_fetch_add(S.ready + 64 * pend, 1u, RLX_AGENT); pend = -1; }
                    if (has_next && nxt.kind) { if ((unsigned)__builtin_amdgcn_readfirstlane((int)S.pollw[(ui + 1) & 1]) < S.need) S.wait_slow(nxt); }
                }
            }
            const size_t a1 = cA + (size_t)(t + 1) * kstep;
            const size_t a2 = last ? nA : cA + (size_t)(t + 2) * kstep; const size_t b2 = last ? nB : cB + (size_t)(t + 2) * kstep;
            const size_t a3 = a2 + kstep; const size_t b3 = b2 + kstep;
            PG8_LDB(B0, 0, 0); PG8_LDB(B1, 0, 1); PG8_SCHED; PG8_LDA(At, 0, 0); PG8_STA(PG8_SA(1, 1), a1 + AH, vA[AH1]);
            if constexpr (GATHER) { if (last && has_next) {
                int tl = tid; asm volatile("" : "+v"(tl));
#pragma unroll
                for (int h = 0; h < 2; ++h)
#pragma unroll
                    for (int i = 0; i < 2; ++i) { int R, C; stage_rc(tl * 16 + i * 8192, R, C); const int rr = h * HALF + R; const int ent = lstage[256 * ((ui + 1) & 1) + rr]; int src = rr < nxt.nvalid ? ((ent >> 2) & 16383) : 0;
                        if constexpr (Sched::MERGED) { if (nxt.kind) src = nxt.orow + rr; }
                        vA[h][i] = (unsigned)(src * K + C) * 2u; } } }
            PG8_WAIT_V(8); PG8_WAIT_L(0); PG8_BAR; PG8_MMA(0, 0, At, B0); PG8_MMA(0, 1, At, B1); PG8_BAR; PG8_SCHED;
            PG8_LDA(At, 0, 1); PG8_STB(PG8_SB(0, 0), b2, voffB); PG8_STB(PG8_SB(0, 1), b2 + hstep, voffB); PG8_STA(PG8_SA(0, 0), a2, vA[0]);
            PG8_WAIT_V(8); PG8_WAIT_L(0); PG8_BAR; PG8_MMA(1, 0, At, B0); PG8_MMA(1, 1, At, B1); PG8_BAR; PG8_SCHED;
            PG8_LDB(B0, 1, 0); PG8_LDB(B1, 1, 1); PG8_SCHED; PG8_LDA(At, 1, 0); PG8_STA(PG8_SA(0, 1), a2 + AH, vA[AH1]);
            PG8_WAIT_V(8); PG8_WAIT_L(0); PG8_BAR; PG8_MMA(0, 0, At, B0); PG8_MMA(0, 1, At, B1); PG8_BAR; PG8_SCHED;
            PG8_LDA(At, 1, 1); PG8_STB(PG8_SB(1, 0), b3, voffB); PG8_STB(PG8_SB(1, 1), b3 + hstep, voffB); PG8_STA(PG8_SA(1, 0), a3, vA[0]);
            PG8_WAIT_V(8); PG8_WAIT_L(0); PG8_BAR; PG8_MMA(1, 0, At, B0); PG8_MMA(1, 1, At, B1); PG8_BAR; PG8_SCHED;
        }
        if constexpr (ALIGN_EPI) { if (wr == 0) PG8_BAR; }
        E(acc, cur, wr, wc, fr, fq);
        if constexpr (Sched::MERGED) { if (cur.kind == 0) pend = cur.pm; }
        if (!has_next) break;
#pragma unroll
        for (int a = 0; a < 2; ++a)
#pragma unroll
            for (int b = 0; b < 2; ++b)
#pragma unroll
                for (int m = 0; m < 4; ++m)
#pragma unroll
                    for (int n = 0; n < 2; ++n) acc[a][b][m][n] = (f32x4){0.f, 0.f, 0.f, 0.f};
        cur = nxt; cA = nA; cB = nB; ++ui;
        if constexpr (ALIGN_EPI) { if (wr == 1) PG8_BAR; }
    }
    PG8_WAIT_V(0);
    if constexpr (Sched::MERGED) { if (pend >= 0 && lane == 0) __hip_atomic_fetch_add(S.ready + 64 * pend, 1u, RLX_AGENT); }
    if constexpr (!ALIGN_EPI) { if (wr == 0) PG8_BAR; }
    PG8_BAR;
#undef PG8_SA
#undef PG8_SB
#undef PG8_STAGE_
#undef PG8_STA
#undef PG8_STB
#undef PG8_LDA
#undef PG8_LDB
#undef PG8_MMA
#undef PG8_WAIT_V
#undef PG8_WAIT_L
#undef PG8_BAR
#undef PG8_SCHED
}
}
constexpr int NWAVES = 8, NTHR = 512;
constexpr int BATCH = 2, T = 8192, D = 1024, M = BATCH * T;
constexpr int CH = 64, NCHUNK = T / CH;
constexpr int RW = 512, RH = 8, RN = 64;
constexpr int DH = 4, DD = 64, DV = 128;
constexpr int SHIFT_COLS = 1792, PCOLS = 2816, IN_COLS = 3328;
constexpr int C_R = 0, C_K = 512, C_V = 1024, C_WD = 1536, C_AD = 1600, C_GD = 1664, C_QD = 1792, C_KD = 2304, C_VD = 2816;
constexpr int MEM = 256, XH = 4, XD = 256;
constexpr int NE = 32, TOPK = 4, FF = 1024, CAP = M;
constexpr int MAXRT = (M * TOPK) / 256 + NE;
constexpr float NORM_EPS = 1e-5f, GN_EPS = 64e-5f, LOG2E = 1.4426950408889634f;
constexpr float LAMBDA_INIT = 0.8f - 0.6f;

constexpr size_t MiB = 1u << 20;
constexpr size_t WS_CTL = 0, CTL_ZERO_BYTES = 1 * MiB;
constexpr size_t WS_SS1 = 250 * MiB + 512 * 1024, WS_SS3 = 251 * MiB;
constexpr size_t WS_WINT = 1 * MiB, WS_WOUTT = 8 * MiB, WS_WQT = 10 * MiB, WS_WKVT = 12 * MiB, WS_WOT = 16 * MiB;
constexpr size_t WS_W2LT = 18 * MiB, WS_A2LT = WS_W2LT + 64 * 1024, WS_G2LT = WS_W2LT + 128 * 1024, WS_RWT = WS_W2LT + 256 * 1024;
constexpr size_t WS_W1T = 20 * MiB, WS_W2T = 148 * MiB;
constexpr size_t WS_LGATE = 212 * MiB, WS_LRINV = 214 * MiB;
constexpr size_t WS_XN = 212 * MiB, WS_MEMN = 244 * MiB, WS_KMEM = 245 * MiB, WS_VTMEM = 246 * MiB;
constexpr size_t WS_LISTS = 247 * MiB, WS_GATES = 249 * MiB, WS_GC = 249 * MiB + 512 * 1024, WS_BS = 250 * MiB;
constexpr size_t WS_PROJ = 252 * MiB, WS_VT = 340 * MiB, WS_QT = 356 * MiB, WS_PT = 372 * MiB, WS_S0 = 388 * MiB, WS_GATE = 404 * MiB, WS_YLOC = 420 * MiB, WS_NN = 452 * MiB;
constexpr size_t WS_CAT = 484 * MiB, WS_H1 = 516 * MiB, WS_H1B = 580 * MiB, WS_QX = 612 * MiB, WS_XO = 644 * MiB, WS_H2 = 676 * MiB, WS_H2B = 740 * MiB;
constexpr size_t WS_ACT = 252 * MiB;
constexpr size_t WS_YBUF = 404 * MiB, WS_END = 772 * MiB;
static_assert(WS_ACT + (size_t)MAXRT * 256 * FF * 2 <= WS_GATE, "ACT overlay");
static_assert(WS_PROJ + (size_t)M * PCOLS * 2 <= WS_VT, "PROJ");
constexpr int CW_TMO = 0, CW_BAR = 4096, CW_CNT = 8192;
constexpr int CW_SCAN = 40960;
constexpr int CW_RDY = 20480;
static_assert((CW_BAR + 3456) <= CW_CNT && (CW_CNT + 64 * NE) * 4 <= (int)CTL_ZERO_BYTES, "CTL map");

constexpr int RING_BYTES = 131072;
constexpr int X_OFF = RING_BYTES;
constexpr int MISC_OFF = 163840 - 1024;
constexpr int LDS_BYTES = 163840;

__device__ __forceinline__ float row_ss(const float* ssp, int row) {
    const f32x4 a = *(const f32x4*)(ssp + (size_t)row * 16), b = *(const f32x4*)(ssp + (size_t)row * 16 + 4), c = *(const f32x4*)(ssp + (size_t)row * 16 + 8), d = *(const f32x4*)(ssp + (size_t)row * 16 + 12);
    return (((a[0] + a[1]) + (a[2] + a[3])) + ((b[0] + b[1]) + (b[2] + b[3]))) + (((c[0] + c[1]) + (c[2] + c[3])) + ((d[0] + d[1]) + (d[2] + d[3])));
}
namespace pg8 {
struct EpiBf16 {
    static constexpr bool PERM = true;
    bf16* O; int ldc;
    __device__ __forceinline__ void operator()(const f32x4 (&acc)[2][2][4][2], const Unit& u, int wr, int wc, int fr, int fq) const {
        { unsigned tl = threadIdx.x; asm volatile("" : "+v"(tl)); fr = (int)(tl & 15u); fq = (int)((tl >> 4) & 3u); }
        const int col0 = u.pn * BM + wc * 32 + 8 * fq;
#pragma unroll
        for (int ai = 0; ai < 2; ++ai)
#pragma unroll
            for (int m = 0; m < 4; ++m) { bf16* rowp = O + (size_t)(u.orow + ai * HALF + wr * 64 + m * 16 + fr) * ldc + col0;
#pragma unroll
                for (int bj = 0; bj < 2; ++bj) { const f32x4 v0 = acc[ai][bj][m][0], v1 = acc[ai][bj][m][1];
                    u32x4 w; w.x = cvt_pk_bf16(v0[0], v0[1]); w.y = cvt_pk_bf16(v0[2], v0[3]); w.z = cvt_pk_bf16(v1[0], v1[1]); w.w = cvt_pk_bf16(v1[2], v1[3]);
                    *(u32x4*)(rowp + bj * HALF) = w; } }
    }
};
struct EpiRowScaleBf16 {
    static constexpr bool PERM = true;
    bf16* O; int ldc; const float* ss; float scale;
    __device__ __forceinline__ void operator()(const f32x4 (&acc)[2][2][4][2], const Unit& u, int wr, int wc, int fr, int fq) const {
        { unsigned tl = threadIdx.x; asm volatile("" : "+v"(tl)); fr = (int)(tl & 15u); fq = (int)((tl >> 4) & 3u); }
        const int col0 = u.pn * BM + wc * 32 + 8 * fq;
#pragma unroll
        for (int ai = 0; ai < 2; ++ai)
#pragma unroll
            for (int m = 0; m < 4; ++m) { const int row = u.orow + ai * HALF + wr * 64 + m * 16 + fr; bf16* rowp = O + (size_t)row * ldc + col0;
                const float s = scale * __builtin_amdgcn_rsqf(row_ss(ss, row) * (1.0f / D) + NORM_EPS);
#pragma unroll
                for (int bj = 0; bj < 2; ++bj) { const f32x4 v0 = acc[ai][bj][m][0] * s, v1 = acc[ai][bj][m][1] * s;
                    u32x4 w; w.x = cvt_pk_bf16(v0[0], v0[1]); w.y = cvt_pk_bf16(v0[2], v0[3]); w.z = cvt_pk_bf16(v1[0], v1[1]); w.w = cvt_pk_bf16(v1[2], v1[3]);
                    *(u32x4*)(rowp + bj * HALF) = w; } }
    }
};
struct EpiResid {
    static constexpr bool PERM = true;
    const float* base; float* H; bf16* Hb; float* ss;
    __device__ __forceinline__ void operator()(const f32x4 (&acc)[2][2][4][2], const Unit& u, int wr, int wc, int fr, int fq) const {
        { unsigned tl = threadIdx.x; asm volatile("" : "+v"(tl)); fr = (int)(tl & 15u); fq = (int)((tl >> 4) & 3u); }
        const int col0 = u.pn * BM + wc * 32 + 8 * fq;
#pragma unroll
        for (int ai = 0; ai < 2; ++ai)
#pragma unroll
            for (int m = 0; m < 4; ++m) { const int row = u.orow + ai * HALF + wr * 64 + m * 16 + fr; const size_t off = (size_t)row * D + col0; float q = 0.f;
#pragma unroll
                for (int bj = 0; bj < 2; ++bj) {
                    const f32x4 b0 = *(const f32x4*)(base + off + bj * HALF), b1 = *(const f32x4*)(base + off + bj * HALF + 4);
                    const f32x4 v0 = acc[ai][bj][m][0] + b0, v1 = acc[ai][bj][m][1] + b1;
                    *(f32x4*)(H + off + bj * HALF) = v0; *(f32x4*)(H + off + bj * HALF + 4) = v1;
                    u32x4 w; w.x = cvt_pk_bf16(v0[0], v0[1]); w.y = cvt_pk_bf16(v0[2], v0[3]); w.z = cvt_pk_bf16(v1[0], v1[1]); w.w = cvt_pk_bf16(v1[2], v1[3]);
                    *(u32x4*)(Hb + off + bj * HALF) = w;
                    q += (v0[0] * v0[0] + v0[1] * v0[1]) + (v0[2] * v0[2] + v0[3] * v0[3]) + (v1[0] * v1[0] + v1[1] * v1[1]) + (v1[2] * v1[2] + v1[3] * v1[3]); }
                q += __shfl_xor(q, 16); q += __shfl_xor(q, 32);
                if (fq == 0) ss[(size_t)row * 16 + u.pn * 4 + wc] = q; }
    }
};
template <int M8>
struct EpiResid2T {
    static constexpr bool PERM = true; static constexpr bool HB8 = (M8 == 1 || M8 == 3);
    const float* basef; const bf16* baseb; float* H; bf16* Hb; float* ss; const float* g8; unsigned char* H8; float ascale;
    __device__ __forceinline__ void operator()(const f32x4 (&acc)[2][2][4][2], const Unit& u, int wr, int wc, int fr, int fq) const {
        { unsigned tl = threadIdx.x; asm volatile("" : "+v"(tl)); fr = (int)(tl & 15u); fq = (int)((tl >> 4) & 3u); }
        const int col0 = u.pn * BM + wc * 32 + 8 * fq;
        f32x4 gs[2][2];
        if constexpr (HB8) {
#pragma unroll
            for (int bj = 0; bj < 2; ++bj) { gs[bj][0] = *(const f32x4*)(g8 + col0 + bj * HALF) * F8_SA; gs[bj][1] = *(const f32x4*)(g8 + col0 + bj * HALF + 4) * F8_SA; } }
#pragma unroll
        for (int ai = 0; ai < 2; ++ai)
#pragma unroll
            for (int m = 0; m < 4; ++m) { const int row = u.orow + ai * HALF + wr * 64 + m * 16 + fr; const size_t off = (size_t)row * D + col0; float q = 0.f;
#pragma unroll
                for (int bj = 0; bj < 2; ++bj) {
                    f32x4 b0, b1;
                    if (basef) { b0 = __builtin_nontemporal_load((const f32x4*)(basef + off + bj * HALF)); b1 = __builtin_nontemporal_load((const f32x4*)(basef + off + bj * HALF + 4)); }
                    else { const u32x4 bb = *(const u32x4*)(baseb + off + bj * HALF); b0 = (f32x4){bflo(bb.x), bfhi(bb.x), bflo(bb.y), bfhi(bb.y)}; b1 = (f32x4){bflo(bb.z), bfhi(bb.z), bflo(bb.w), bfhi(bb.w)}; }
                    const f32x4 v0 = acc[ai][bj][m][0] * ascale + b0, v1 = acc[ai][bj][m][1] * ascale + b1;
                    if (H) { *(f32x4*)(H + off + bj * HALF) = v0; *(f32x4*)(H + off + bj * HALF + 4) = v1; }
                    if constexpr (HB8) { const f32x4 s0 = v0 * gs[bj][0], s1 = v1 * gs[bj][1]; u32x2 w8; w8.x = pk4_fp8(s0[0], s0[1], s0[2], s0[3]); w8.y = pk4_fp8(s1[0], s1[1], s1[2], s1[3]);
                        *(u32x2*)(H8 + off + bj * HALF) = w8; }
                    if constexpr (M8 == 2) { const f32x4 s0 = v0 * F8_SA, s1 = v1 * F8_SA; u32x2 w8; w8.x = pk4_fp8(s0[0], s0[1], s0[2], s0[3]); w8.y = pk4_fp8(s1[0], s1[1], s1[2], s1[3]);
                        *(u32x2*)(H8 + off + bj * HALF) = w8; }
                    if constexpr (M8 != 1) { u32x4 w; w.x = cvt_pk_bf16(v0[0], v0[1]); w.y = cvt_pk_bf16(v0[2], v0[3]); w.z = cvt_pk_bf16(v1[0], v1[1]); w.w = cvt_pk_bf16(v1[2], v1[3]);
                        *(u32x4*)(Hb + off + bj * HALF) = w; }
                    q += (v0[0] * v0[0] + v0[1] * v0[1]) + (v0[2] * v0[2] + v0[3] * v0[3]) + (v1[0] * v1[0] + v1[1] * v1[1]) + (v1[2] * v1[2] + v1[3] * v1[3]); }
                q += __shfl_xor(q, 16); q += __shfl_xor(q, 32);
                if (fq == 0) ss[(size_t)row * 16 + u.pn * 4 + wc] = q; }
    }
};
using EpiResid2 = EpiResid2T<0>;
constexpr float F8_SY = 128.f;
constexpr float F8_SXO = 128.f;
struct EpiSwiglu {
    static constexpr bool PERM = true; static constexpr float LOG2E_ = 1.4426950408889634f;
    unsigned char* ACT; const float* b1; const float* lrinv; const int* list; bool wt;
    __device__ __forceinline__ void operator()(const f32x4 (&acc)[2][2][4][2], const Unit& u, int wr, int wc, int fr, int fq) const {
        { unsigned tl = threadIdx.x; asm volatile("" : "+v"(tl)); fr = (int)(tl & 15u); fq = (int)((tl >> 4) & 3u); }
        const int j0 = u.pn * HALF + wc * 32 + 8 * fq; const float* bg = b1 + (size_t)u.e * (2 * FF) + j0; const float* bl = bg + FF;
        const f32x4 g0 = *(const f32x4*)bg, g1 = *(const f32x4*)(bg + 4), l0 = *(const f32x4*)bl, l1 = *(const f32x4*)(bl + 4);
        float sr[2][4];
#pragma unroll
        for (int ai = 0; ai < 2; ++ai)
#pragma unroll
            for (int m = 0; m < 4; ++m) sr[ai][m] = lrinv[u.lbase + ai * HALF + wr * 64 + m * 16 + fr];
        asm volatile("" :: "v"(sr[0][0]), "v"(sr[0][1]), "v"(sr[0][2]), "v"(sr[0][3]), "v"(sr[1][0]), "v"(sr[1][1]), "v"(sr[1][2]), "v"(sr[1][3]));
        asm volatile("" :: "v"(g0), "v"(g1), "v"(l0), "v"(l1));
#pragma unroll
        for (int ai = 0; ai < 2; ++ai)
#pragma unroll
            for (int m = 0; m < 4; ++m) { const int rr = ai * HALF + wr * 64 + m * 16 + fr;
                if (rr < u.nvalid) {
                    const float s = sr[ai][m] * (1.0f / (F8_SA * F8_SW));
                    u32x2 w;
#pragma unroll
                    for (int n = 0; n < 2; ++n) {
                        f32x4 gt = acc[ai][0][m][n] * s + (n ? g1 : g0), ln = acc[ai][1][m][n] * s + (n ? l1 : l0);
#pragma unroll
                        for (int j = 0; j < 4; ++j) { gt[j] = fminf(gt[j], 7.0f); ln[j] = __builtin_amdgcn_fmed3f(ln[j], -7.0f, 7.0f); }
                        f32x4 ex = gt * (-1.702f * LOG2E_);
#pragma unroll
                        for (int j = 0; j < 4; ++j) ex[j] = fexp2(ex[j]);
                        ex = ex + 1.0f;
#pragma unroll
                        for (int j = 0; j < 4; ++j) ex[j] = frcp(ex[j]);
                        const f32x4 o = (gt * ex) * (ln * F8_SACT + F8_SACT);
                        int pk = 0; pk = __builtin_amdgcn_cvt_pk_fp8_f32(o[0], o[1], pk, false); pk = __builtin_amdgcn_cvt_pk_fp8_f32(o[2], o[3], pk, true);
                        if (n == 0) w.x = (unsigned)pk; else w.y = (unsigned)pk; }
                    if (wt) __hip_atomic_store((unsigned long long*)(ACT + (size_t)(u.orow + rr) * FF + j0), (unsigned long long)w.x | ((unsigned long long)w.y << 32), RLX_AGENT);
                    else *(u32x2*)(ACT + (size_t)(u.orow + rr) * FF + j0) = w; } }
    }
};
struct EpiMoe2 {
    static constexpr bool PERM = true;
    unsigned char* Y; const float* b2; const float* gates; const int* list;
    __device__ __forceinline__ void operator()(const f32x4 (&acc)[2][2][4][2], const Unit& u, int wr, int wc, int fr, int fq) const {
        { unsigned tl = threadIdx.x; asm volatile("" : "+v"(tl)); fr = (int)(tl & 15u); fq = (int)((tl >> 4) & 3u); }
        const int col0 = u.pn * BM + wc * 32 + 8 * fq; const float* bb = b2 + (size_t)u.e * D + col0;
        f32x4 bv[2][2];
#pragma unroll
        for (int bj = 0; bj < 2; ++bj) { bv[bj][0] = *(const f32x4*)(bb + bj * HALF); bv[bj][1] = *(const f32x4*)(bb + bj * HALF + 4); }
        int en[2][4]; float gt[2][4];
#pragma unroll
        for (int ai = 0; ai < 2; ++ai)
#pragma unroll
            for (int m = 0; m < 4; ++m) { const int ix = u.lbase + ai * HALF + wr * 64 + m * 16 + fr; en[ai][m] = list[ix]; gt[ai][m] = gates[ix]; }
        asm volatile("" :: "v"(en[0][0]), "v"(en[0][1]), "v"(en[0][2]), "v"(en[0][3]), "v"(en[1][0]), "v"(en[1][1]), "v"(en[1][2]), "v"(en[1][3]));
        asm volatile("" :: "v"(gt[0][0]), "v"(gt[0][1]), "v"(gt[0][2]), "v"(gt[0][3]), "v"(gt[1][0]), "v"(gt[1][1]), "v"(gt[1][2]), "v"(gt[1][3]));
        asm volatile("" :: "v"(bv[0][0]), "v"(bv[0][1]), "v"(bv[1][0]), "v"(bv[1][1]));
#pragma unroll
        for (int ai = 0; ai < 2; ++ai)
#pragma unroll
            for (int m = 0; m < 4; ++m) { const int rr = ai * HALF + wr * 64 + m * 16 + fr;
                if (rr < u.nvalid) {
                    const int ent = en[ai][m] & 65535; const float gw = gt[ai][m] * F8_SY; unsigned char* rowp = Y + (size_t)ent * D + col0;
#pragma unroll
                    for (int bj = 0; bj < 2; ++bj) { const f32x4 v0 = (acc[ai][bj][m][0] * (1.0f / (F8_SACT * F8_SW)) + bv[bj][0]) * gw, v1 = (acc[ai][bj][m][1] * (1.0f / (F8_SACT * F8_SW)) + bv[bj][1]) * gw;
                        u32x2 w; w.x = pk4_fp8(v0[0], v0[1], v0[2], v0[3]); w.y = pk4_fp8(v1[0], v1[1], v1[2], v1[3]);
                        *(u32x2*)(rowp + bj * HALF) = w; } } }
    }
};
struct EpiMoeBoth {
    static constexpr bool PERM = true;
    EpiSwiglu up; EpiMoe2 down;
    __device__ __forceinline__ void operator()(const f32x4 (&acc)[2][2][4][2], const Unit& u, int wr, int wc, int fr, int fq) const { if (u.kind == 0) up(acc, u, wr, wc, fr, fq); else down(acc, u, wr, wc, fr, fq); }
};
struct MoeOrder {
    static constexpr bool MERGED = false;
    const LAS int* tb; const LAS int* cn; const LAS int* rte; int ncol, G, c, ntile;
    __device__ __forceinline__ bool next(int i, Unit& u) const {
        const int L = i * G + c, rt = L / ncol, pn = L % ncol; if (rt >= ntile) return false;
        const int e = __builtin_amdgcn_readfirstlane(rte[rt]);
        const int tile = rt - __builtin_amdgcn_readfirstlane(tb[e]), left = __builtin_amdgcn_readfirstlane(cn[e]) - tile * 256;
        u.pm = rt; u.pn = pn; u.e = e; u.nvalid = left < 256 ? left : 256; u.lbase = e * CAP + tile * 256; u.orow = rt * 256; u.kind = 0; u.abase = 0; u.boffs = 0; return true;
    }
};
struct MoeOrder2 {
    static constexpr bool MERGED = true;
    const LAS int* tb; const LAS int* cn; const LAS int* rte; int G, c, ntile; gu32* ready; volatile LAS unsigned* pollw; unsigned need; gu32* tmo;
    __device__ __forceinline__ bool next(int i, Unit& u) const {
        const int L = i * G + c, n10 = ntile * 8; const int kind = L >= n10 ? 1 : 0; const int L2 = kind ? L - n10 : L; const int rt = kind ? (L2 >> 2) : (L2 >> 3), pn = kind ? (L2 & 3) : (L2 & 7);
        if (rt >= ntile) return false;
        const int e = __builtin_amdgcn_readfirstlane(rte[rt]);
        const int tile = rt - __builtin_amdgcn_readfirstlane(tb[e]), left = __builtin_amdgcn_readfirstlane(cn[e]) - tile * 256;
        u.pm = rt; u.pn = pn; u.e = e; u.nvalid = left < 256 ? left : 256; u.lbase = e * CAP + tile * 256; u.orow = rt * 256; u.kind = kind;
        u.abase = kind ? (unsigned)WS_ACT : (unsigned)WS_H2B;
        u.boffs = (kind ? (unsigned)WS_W2T + (unsigned)e * (unsigned)(D * FF) : (unsigned)WS_W1T + (unsigned)e * (unsigned)(2 * FF * D)) + (unsigned)pn * (256u * 1024u);
        return true;
    }
    __device__ __forceinline__ void wait_slow(const Unit& u) const {
        unsigned spins = 0;
        while ((unsigned)__builtin_amdgcn_readfirstlane((int)__hip_atomic_load(ready + 64 * u.pm, RLX_AGENT)) < need) {
            if (++spins > 4000000u) { if ((threadIdx.x & 63) == 0) __hip_atomic_store(tmo, 0x700u | (unsigned)(u.pm & 0xff), RLX_AGENT); break; }
            __builtin_amdgcn_s_sleep(2); }
        __builtin_amdgcn_fence(__ATOMIC_ACQUIRE, "agent");
    }
};
}
#define XB_TMO      128
#define XB_XCNT(j)  (256  + 64 * (j))
#define XB_XSUB(j)  (1280 + 64 * (j))
#define XB_XGEN(j)  (2304 + 64 * (j))
#define XB_TOP      3328
#define XB_TOPGEN   3392
#define XCD_BAR_WORDS 3456
#define XB_SPIN_CAP (1u << 18)

__device__ __forceinline__ unsigned xb_ld(unsigned* p)              { return __hip_atomic_load(p, __ATOMIC_RELAXED, __HIP_MEMORY_SCOPE_AGENT); }
__device__ __forceinline__ unsigned xb_add(unsigned* p, unsigned v) { return __hip_atomic_fetch_add(p, v, __ATOMIC_RELAXED, __HIP_MEMORY_SCOPE_AGENT); }
__device__ __forceinline__ unsigned xb_xcc_id() { return (unsigned)__builtin_amdgcn_s_getreg((3 << 11) | 20) & 0xFu; }
#define XB_SPIN(cond, bar) do { unsigned _sp = 0; while (cond) { __builtin_amdgcn_s_sleep(1); \
    if ((++_sp & 255u) == 0u) { if (xb_ld(&(bar)[XB_TMO])) break; if (_sp > XB_SPIN_CAP) { atomicAdd(&(bar)[XB_TMO], 1u); break; } } } } while (0)

struct XcdBarrier {
    unsigned* bar; unsigned x;
    volatile LAS unsigned* st;
};

__device__ __forceinline__ XcdBarrier xcd_barrier_post(unsigned* bar, volatile LAS unsigned* st) {
    XcdBarrier b; b.bar = bar; b.x = xb_xcc_id(); b.st = st;
    if (threadIdx.x == 0) (void)xb_add(&bar[XB_XCNT(b.x)], 1u);
    return b;
}
__device__ __forceinline__ void xcd_barrier_complete(unsigned* bar, unsigned x, unsigned& nloc, unsigned& nx) {
    const unsigned G = gridDim.x * gridDim.y * gridDim.z;
    unsigned sum, cnt, mine, sp = 0u;
    for (;;) {
        sum = 0u; cnt = 0u; mine = 0u;
#pragma unroll
        for (unsigned j = 0; j < 16; ++j) { const unsigned c = xb_ld(&bar[XB_XCNT(j)]); sum += c; cnt += (c > 0u) ? 1u : 0u; mine = (j == x) ? c : mine; }
        if (sum == G) break;
        __builtin_amdgcn_s_sleep(1);
        if ((++sp & 255u) == 0u) { if (xb_ld(&bar[XB_TMO])) break; if (sp > XB_SPIN_CAP) { atomicAdd(&bar[XB_TMO], 1u); break; } }
    }
    nloc = mine > 0u ? mine : 1u; nx = cnt > 0u ? cnt : 1u;
}

__device__ __forceinline__ void xcd_barrier(const XcdBarrier& b) {
    asm volatile("s_waitcnt vmcnt(0)" ::: "memory");
    __syncthreads();
    if (threadIdx.x == 0) {
        unsigned* bar = b.bar;
        __builtin_amdgcn_s_waitcnt(0);
        unsigned nloc = b.st[0], nx = b.st[1];
        if (nloc == 0u) { xcd_barrier_complete(bar, b.x, nloc, nx); b.st[0] = nloc; b.st[1] = nx; }
        const unsigned old = xb_add(&bar[XB_XSUB(b.x)], 1u);
        const unsigned gen = old / nloc;
        if (old + 1u == (gen + 1u) * nloc) {
            __builtin_amdgcn_fence(__ATOMIC_RELEASE, "agent");
            asm volatile("s_waitcnt vmcnt(0)" ::: "memory");
            const unsigned og = xb_add(&bar[XB_TOP], 1u);
            const unsigned tg = og / nx;
            if (og + 1u == (tg + 1u) * nx) xb_add(&bar[XB_TOPGEN], 1u);
            else XB_SPIN(xb_ld(&bar[XB_TOPGEN]) == tg, bar);
            __builtin_amdgcn_fence(__ATOMIC_ACQUIRE, "agent");
            xb_add(&bar[XB_XGEN(b.x)], 1u);
            asm volatile("s_waitcnt vmcnt(0)" ::: "memory");
        } else {
            XB_SPIN(xb_ld(&bar[XB_XGEN(b.x)]) == gen, bar);
            __builtin_amdgcn_fence(__ATOMIC_ACQUIRE, "agent");
            asm volatile("s_waitcnt vmcnt(0)" ::: "memory");
        }
    }
    __syncthreads();
}
#ifdef DBG_SEL
#define DBGCNT(F, k, cond) do { if (cond) atomicAdd((unsigned*)((F).ctl + 12288 + (k)), 1u); } while (0)
#else
#define DBGCNT(F, k, cond) do { } while (0)
#endif
struct Frame {
    LAS unsigned char* lds;
    volatile LAS unsigned* MISC;
    gu32* ctl;
    unsigned char* ws;
    int tid, lane, wave, G, bid;
    const float* in[34];
    float* out;
};
__device__ __forceinline__ float wave_sum(float v) {
#pragma unroll
    for (int o = 1; o < 64; o <<= 1) v += __shfl_xor(v, o);
    return v;
}
__device__ __forceinline__ float wave_max(float v) {
#pragma unroll
    for (int o = 1; o < 64; o <<= 1) v = fmaxf(v, __shfl_xor(v, o));
    return v;
}
__device__ __forceinline__ void p0_transpose_item(const float* W, int N, const float* gk, bf16* WT, int Kd, int k0, int n0, int drow, LAS float* scr, int lane) {
    float v[32];
#pragma unroll
    for (int i = 0; i < 32; ++i) { const int kk = 2 * i + (lane >> 5); v[i] = W[(size_t)(k0 + kk) * N + n0 + (lane & 31)]; }
    if (gk) {
#pragma unroll
        for (int i = 0; i < 32; ++i) { const int kk = 2 * i + (lane >> 5); v[i] *= gk[k0 + kk]; }
    }
#pragma unroll
    for (int i = 0; i < 32; ++i) { const int kk = 2 * i + (lane >> 5); scr[kk * 33 + (lane & 31)] = v[i]; }
    LDS_WAIT(); asm volatile("" ::: "memory");
    const int c = lane & 7;
#pragma unroll
    for (int j = 0; j < 4; ++j) { const int n = (lane >> 3) + 8 * j; const LAS float* s = scr + (8 * c) * 33 + n;
        u32x4 o; o.x = pk2(s[0 * 33], s[1 * 33]); o.y = pk2(s[2 * 33], s[3 * 33]); o.z = pk2(s[4 * 33], s[5 * 33]); o.w = pk2(s[6 * 33], s[7 * 33]);
        *(GAS u32x4*)(WT + (size_t)(drow + n) * Kd + k0 + 8 * c) = o; }
    LDS_WAIT(); asm volatile("" ::: "memory");
}
__device__ __forceinline__ void p0_transpose_item8(const float* W, int N, float scale, unsigned char* WT, int Kd, int k0, int n0, int drow, int lane) {
    const int g = lane >> 3, q = lane & 7;
    const GAS f32x4* src = (const GAS f32x4*)(W + (size_t)(k0 + 16 * g) * N + n0 + 4 * q);
    f32x4 v[16];
#pragma unroll
    for (int i = 0; i < 16; ++i) v[i] = __builtin_nontemporal_load(src + (size_t)i * (N / 4)) * scale;
#pragma unroll
    for (int j = 0; j < 4; ++j) {
        u32x4 o; o.x = pk4_fp8(v[0][j], v[1][j], v[2][j], v[3][j]); o.y = pk4_fp8(v[4][j], v[5][j], v[6][j], v[7][j]);
        o.z = pk4_fp8(v[8][j], v[9][j], v[10][j], v[11][j]); o.w = pk4_fp8(v[12][j], v[13][j], v[14][j], v[15][j]);
        __builtin_nontemporal_store(o, (GAS u32x4*)(WT + (size_t)(drow + 4 * q + j) * Kd + k0 + 16 * g)); }
}
__device__ __forceinline__ void p0_transpose_item8(const float* W, int N, const float* gk, float scale, unsigned char* WT, int Kd, int k0, int n0, int lane) {
    const int g = lane >> 3, q = lane & 7;
    const GAS f32x4* src = (const GAS f32x4*)(W + (size_t)(k0 + 16 * g) * N + n0 + 4 * q);
    f32x4 v[16];
#pragma unroll
    for (int i = 0; i < 16; ++i) v[i] = src[(size_t)i * (N / 4)] * scale;
    if (gk) {
#pragma unroll
        for (int i4 = 0; i4 < 4; ++i4) { const f32x4 gg = *(const GAS f32x4*)(gk + k0 + 16 * g + 4 * i4);
#pragma unroll
            for (int i = 0; i < 4; ++i) v[4 * i4 + i] = v[4 * i4 + i] * gg[i]; } }
#pragma unroll
    for (int j = 0; j < 4; ++j) {
        u32x4 o; o.x = pk4_fp8(v[0][j], v[1][j], v[2][j], v[3][j]); o.y = pk4_fp8(v[4][j], v[5][j], v[6][j], v[7][j]);
        o.z = pk4_fp8(v[8][j], v[9][j], v[10][j], v[11][j]); o.w = pk4_fp8(v[12][j], v[13][j], v[14][j], v[15][j]);
        *(GAS u32x4*)(WT + (size_t)(n0 + 4 * q + j) * Kd + k0 + 16 * g) = o; }
}
__device__ __forceinline__ void rms_row_to_bf16(const float* xrow, const float* g, bf16* orow, int lane) {
    const GAS f32x4* xr = (const GAS f32x4*)xrow + lane; const GAS f32x4* gr = (const GAS f32x4*)g + lane;
    f32x4 v[4]; float s = 0.f;
#pragma unroll
    for (int j = 0; j < 4; ++j) { v[j] = __builtin_nontemporal_load(xr + 64 * j); s += (v[j].x * v[j].x + v[j].y * v[j].y) + (v[j].z * v[j].z + v[j].w * v[j].w); }
    const float rstd = 1.f / sqrtf(wave_sum(s) * (1.f / D) + NORM_EPS);
    GAS unsigned long long* o8 = (GAS unsigned long long*)orow + lane;
#pragma unroll
    for (int j = 0; j < 4; ++j) { const f32x4 gg = gr[64 * j];
        o8[64 * j] = (unsigned long long)pk2(v[j].x * rstd * gg.x, v[j].y * rstd * gg.y) | ((unsigned long long)pk2(v[j].z * rstd * gg.z, v[j].w * rstd * gg.w) << 32); }
}
enum { I_X = 0, I_MEM, I_N1G, I_WIN, I_MU, I_W0, I_W2, I_A0, I_A2, I_G2, I_KK, I_KA, I_RK, I_LNG, I_LNB, I_LQ1, I_LK1, I_LQ2, I_LK2, I_SUBG, I_WOUT, I_N2G, I_MNG, I_WQ, I_WKV, I_WO, I_N3G,
       I_RW, I_RB, I_W1, I_B1, I_W2E, I_B2, I_FG };

__device__ __forceinline__ void p0_prologue(Frame& F) {
    LAS float* scr = (LAS float*)(F.lds + F.wave * 16384);
    const int gw = F.bid * NWAVES + F.wave, NGW = F.G * NWAVES;
    constexpr int I_IN = 16 * (IN_COLS / 32), I_SQ = 16 * 32, I_KV = 16 * 64, I_L64 = 1 * 16, I_L128 = 2 * 16, I_E1 = 16 * 64, I_E2 = 16 * 32;
    constexpr int I_S8 = 8 * 32;
    constexpr int NITEMS = I_IN + I_SQ + 2 * I_S8 + I_KV + 2 * I_L64 + I_L128;
    for (int it = gw; it < NITEMS; it += NGW) {
        int r = it;
        if (r < I_IN) { const int nb = IN_COLS / 32; p0_transpose_item(F.in[I_WIN], IN_COLS, nullptr, (bf16*)(F.ws + WS_WINT), D, 64 * (r / nb), 32 * (r % nb), 32 * (r % nb), scr, F.lane); continue; } r -= I_IN;
        if (r < I_SQ) { p0_transpose_item(F.in[I_WOUT], D, nullptr, (bf16*)(F.ws + WS_WOUTT), D, 64 * (r / 32), 32 * (r % 32), 32 * (r % 32), scr, F.lane); continue; } r -= I_SQ;
        if (r < I_S8) { p0_transpose_item8(F.in[I_WQ], D, F.in[I_N2G], F8_SW, F.ws + WS_WQT, D, 128 * (r / 32), 32 * (r % 32), F.lane); continue; } r -= I_S8;
        if (r < I_S8) { p0_transpose_item8(F.in[I_WO], D, nullptr, F8_SW, F.ws + WS_WOT, D, 128 * (r / 32), 32 * (r % 32), F.lane); continue; } r -= I_S8;
        if (r < I_KV) { p0_transpose_item(F.in[I_WKV], 2 * D, nullptr, (bf16*)(F.ws + WS_WKVT), D, 64 * (r / 64), 32 * (r % 64), 32 * (r % 64), scr, F.lane); continue; } r -= I_KV;
        if (r < I_L64) { p0_transpose_item(F.in[I_W2], RW, nullptr, (bf16*)(F.ws + WS_W2LT), 64, 0, 32 * r, 32 * r, scr, F.lane); continue; } r -= I_L64;
        if (r < I_L64) { p0_transpose_item(F.in[I_A2], RW, nullptr, (bf16*)(F.ws + WS_A2LT), 64, 0, 32 * r, 32 * r, scr, F.lane); continue; } r -= I_L64;
        p0_transpose_item(F.in[I_G2], RW, nullptr, (bf16*)(F.ws + WS_G2LT), 128, 64 * (r / 16), 32 * (r % 16), 32 * (r % 16), scr, F.lane);
    }
    for (int m = gw; m < M; m += NGW) rms_row_to_bf16(F.in[I_X] + (size_t)m * D, F.in[I_N1G], (bf16*)(F.ws + WS_XN) + (size_t)m * D, F.lane);
    for (int m = gw; m < BATCH * MEM; m += NGW) rms_row_to_bf16(F.in[I_MEM] + (size_t)m * D, F.in[I_MNG], (bf16*)(F.ws + WS_MEMN) + (size_t)m * D, F.lane);
    { float* rwt = (float*)(F.ws + WS_RWT); const int gt = F.bid * NTHR + F.tid;
      for (int i = gt; i < NE * D; i += F.G * NTHR) { const int e = i / D, k = i % D; rwt[i] = F.in[I_RW][k * NE + e] * F.in[I_N3G][k]; } }
}

#ifndef CV_P2_HALVES
#define CV_P2_HALVES 1
#endif
constexpr int CV_E1 = 8 * 64, CV_E2 = 8 * 32, CV_NIT = NE * (CV_E1 + CV_E2);
constexpr int CV_P2_ITEMS = (BATCH * NCHUNK * NWAVES * RH * CV_P2_HALVES) / 2, CV_X = CV_NIT - CV_P2_ITEMS;
static_assert(CV_X >= 0 && D == FF, "conversion split");
__device__ __forceinline__ void p0_experts(Frame& F, int wg0) {
    const int gw = (F.bid - wg0) * NWAVES + F.wave, NGW = (F.G - wg0) * NWAVES;
    for (int it = gw; it < CV_X; it += NGW) {
        const int e = it / (CV_E1 + CV_E2); int r = it - e * (CV_E1 + CV_E2);
        if (r < CV_E1) {
            const int n0 = 32 * (r % 64), k0 = 128 * (r / 64); const int nn = n0 < FF ? n0 : n0 - FF; const int drow = 256 * (nn / 128) + (n0 < FF ? 0 : 128) + (nn % 128);
            p0_transpose_item8(F.in[I_W1] + (size_t)e * D * 2 * FF, 2 * FF, F8_SW, F.ws + WS_W1T + (size_t)e * 2 * FF * D, D, k0, n0, drow, F.lane);
        } else { r -= CV_E1;
            p0_transpose_item8(F.in[I_W2E] + (size_t)e * FF * D, D, F8_SW, F.ws + WS_W2T + (size_t)e * D * FF, FF, 128 * (r / 32), 32 * (r % 32), 32 * (r % 32), F.lane);
        }
    }
}
struct ConvHalf { const float* src; unsigned char* dst; int N; };
__device__ __forceinline__ ConvHalf conv_half_decode(const Frame& F, int q, int lane) {
    const int it = CV_X + (q >> 1), half = q & 1, e = it / (CV_E1 + CV_E2); int r = it - e * (CV_E1 + CV_E2);
    const int g = lane >> 3, q4 = lane & 7; ConvHalf c;
    if (r < CV_E1) { const int n0 = 32 * (r % 64), k0 = 128 * (r / 64) + 64 * half; const int nn = n0 < FF ? n0 : n0 - FF; const int drow = 256 * (nn / 128) + (n0 < FF ? 0 : 128) + (nn % 128);
        c.N = 2 * FF; c.src = F.in[I_W1] + (size_t)e * D * 2 * FF + (size_t)(k0 + 8 * g) * (2 * FF) + n0 + 4 * q4; c.dst = F.ws + WS_W1T + (size_t)e * 2 * FF * D + (size_t)(drow + 4 * q4) * D + k0 + 8 * g;
    } else { r -= CV_E1; const int n0 = 32 * (r % 32), k0 = 128 * (r / 32) + 64 * half;
        c.N = D; c.src = F.in[I_W2E] + (size_t)e * FF * D + (size_t)(k0 + 8 * g) * D + n0 + 4 * q4; c.dst = F.ws + WS_W2T + (size_t)e * D * FF + (size_t)(n0 + 4 * q4) * FF + k0 + 8 * g; }
    return c;
}
__device__ __forceinline__ void conv_half_load(const Frame& F, int q, int lane, f32x4 (&v)[8]) {
    const ConvHalf c = conv_half_decode(F, q, lane); const GAS f32x4* src = (const GAS f32x4*)c.src;
#pragma unroll
    for (int i = 0; i < 8; ++i) v[i] = __builtin_nontemporal_load(src + (size_t)i * (c.N / 4));
}
__device__ __forceinline__ void conv_half_store(const Frame& F, int q, int lane, const f32x4 (&v)[8]) {
    const ConvHalf c = conv_half_decode(F, q, lane);
#pragma unroll
    for (int j = 0; j < 4; ++j) { u32x2 o; o.x = pk4_fp8(v[0][j] * F8_SW, v[1][j] * F8_SW, v[2][j] * F8_SW, v[3][j] * F8_SW); o.y = pk4_fp8(v[4][j] * F8_SW, v[5][j] * F8_SW, v[6][j] * F8_SW, v[7][j] * F8_SW);
        __builtin_nontemporal_store(o, (GAS u32x2*)(c.dst + (size_t)j * D)); }
}
template <int NMAP, int DQK, int DVV, int NBUF, int PF>
struct AttnBody {
    static constexpr int KROW = DQK * 2, VROW = 128, KCH = DQK / 8;
    static constexpr int KT_BYTES = NMAP * 64 * KROW, VT_BYTES = DVV * VROW, BUF_BYTES = KT_BYTES + VT_BYTES;
    static constexpr int NPK = KT_BYTES / (16 * NTHR), NPV = VT_BYTES / (16 * NTHR), NDMA = NPK + NPV;
    static constexpr int NKS = DQK / 32, NDT = DVV / 16, KB = NKS < 4 ? NKS : 4;
    static_assert(NBUF * BUF_BYTES <= RING_BYTES + 24576, "attention ring exceeds LDS");
    static_assert(NDMA * (NBUF - 1) <= 48 && NBUF >= 2, "vmcnt range; a ring needs two slots");

    __device__ __forceinline__ void dma_tile(LAS unsigned char* slot, const bf16* Kp, int ldk, const bf16* VTp, int ldvt, int key0, int tid, int wave) const {
        asm volatile("" : "+v"(tid));
#pragma unroll
        for (int i = 0; i < NPK; ++i) { const int p = tid + NTHR * i, row = p / KCH, sl = p % KCH, ch = sl ^ ksw(row), mp = row >> 6, key = row & 63;
            __builtin_amdgcn_global_load_lds((const unsigned*)(Kp + (unsigned)((key0 + key) * ldk + mp * DQK + ch * 8)), (LAS unsigned*)(slot + (i * NTHR + wave * 64) * 16), 16, 0, 0); }
#pragma unroll
        for (int i = 0; i < NPV; ++i) { const int p = tid + NTHR * i, dv = p >> 3, sl = p & 7, ch = sl ^ vsw(dv);
            __builtin_amdgcn_global_load_lds((const unsigned*)(VTp + (unsigned)(dv * ldvt + key0 + ch * 8)), (LAS unsigned*)(slot + KT_BYTES + (i * NTHR + wave * 64) * 16), 16, 0, 0); }
    }
    __device__ __forceinline__ static int ksw(int row) { return KCH == 8 ? ((row & 3) | (((row >> 3) & 1) << 2)) : (((row & 1) * 3) | (((row >> 1) & 1) << 2) | (((row >> 3) & 1) << 3)); }
    __device__ __forceinline__ static int vsw(int dv) { return dv & 7; }
    __device__ __forceinline__ static int vt_off(int dv, int ch) { return KT_BYTES + dv * VROW + ((ch ^ vsw(dv)) << 4); }
    __device__ __forceinline__ static int k_off(int row, int ch) { return row * KROW + ((ch ^ ksw(row)) << 4); }
    __device__ __forceinline__ static int sigma(int t4, int m) { return 32 * (t4 >> 1) + 8 * (m >> 2) + 4 * (t4 & 1) + (m & 3); }
    static constexpr int NKB = NKS < 4 ? NKS : 4;
    struct Offs { int kb[NKB]; int vb[2]; };
    __device__ __forceinline__ static Offs make_offs(int lq, int g) { Offs o; const int r0 = 8 * (lq >> 2) + (lq & 3);
#pragma unroll
        for (int j = 0; j < NKB; ++j) o.kb[j] = k_off(r0, 4 * j + g);
        o.vb[0] = vt_off(lq, g); o.vb[1] = vt_off(lq, 4 + g); return o; }

    __device__ __forceinline__ void pv_tile(const LAS unsigned char* buf, bf16x8 (&vf)[PF], const bf16x8 (&pf)[NMAP][2], f32x4 (&o)[NMAP][NDT], const Offs& of) {
#pragma unroll
        for (int f0 = 0; f0 < 2 * NDT; f0 += PF) {
            bf16x8 vn[PF];
            if (f0 + PF < 2 * NDT) {
#pragma unroll
                for (int f = 0; f < PF; ++f) { const int dt = (f0 + PF + f) >> 1, mb = (f0 + PF + f) & 1; vn[f] = *(const LAS bf16x8*)(buf + of.vb[mb] + dt * 16 * VROW); }
            }
#pragma unroll
            for (int f = 0; f < PF; ++f) { const int dt = (f0 + f) >> 1, mb = (f0 + f) & 1;
#pragma unroll
                for (int c = 0; c < NMAP; ++c) o[c][dt] = __builtin_amdgcn_mfma_f32_16x16x32_bf16(vf[f], pf[c][mb], o[c][dt], 0, 0, 0); }
            if (f0 + PF < 2 * NDT) {
#pragma unroll
                for (int f = 0; f < PF; ++f) vf[f] = vn[f];
            }
        }
    }
    __device__ __forceinline__ void vf_first(const LAS unsigned char* buf, bf16x8 (&vf)[PF], const Offs& of) {
#pragma unroll
        for (int f = 0; f < PF; ++f) { const int dt = f >> 1, mb = f & 1; vf[f] = *(const LAS bf16x8*)(buf + of.vb[mb] + dt * 16 * VROW); }
    }
    __device__ __forceinline__ void s_tile(const LAS unsigned char* buf, const bf16x8 (&qf)[NMAP][NKS], float (&mrun)[NMAP], f32x4 (&ol)[NMAP], f32x4 (&o)[NMAP][NDT], bf16x8 (&pf)[NMAP][2], const Offs& of, bool first) {
        constexpr float THR = 8.0f;
        f32x4 s[NMAP][4];
#pragma unroll
        for (int c = 0; c < NMAP; ++c) { const float mi = first ? 0.f : -mrun[c];
#pragma unroll
            for (int t4 = 0; t4 < 4; ++t4) { s[c][t4] = (f32x4){mi, mi, mi, mi};
#pragma unroll
                for (int k0 = 0; k0 < NKS; k0 += KB) { bf16x8 kf[KB];
#pragma unroll
                    for (int ks = 0; ks < KB; ++ks) kf[ks] = *(const LAS bf16x8*)(buf + of.kb[(k0 + ks) & (NKB - 1)] + ((c * 64 + 32 * (t4 >> 1) + 4 * (t4 & 1)) * KROW + ((k0 + ks) / NKB) * NKB * 64));
#pragma unroll
                    for (int ks = 0; ks < KB; ++ks) s[c][t4] = __builtin_amdgcn_mfma_f32_16x16x32_bf16(kf[ks], qf[c][k0 + ks], s[c][t4], 0, 0, 0); } } }
#pragma unroll
        for (int c = 0; c < NMAP; ++c) {
            float mx = __builtin_fmaxf(__builtin_fmaxf(s[c][0][0], s[c][0][1]), s[c][0][2]);
#pragma unroll
            for (int t4 = 0; t4 < 4; ++t4) { if (t4 > 0) mx = __builtin_fmaxf(__builtin_fmaxf(mx, s[c][t4][0]), s[c][t4][1]); mx = __builtin_fmaxf(__builtin_fmaxf(mx, s[c][t4][2]), s[c][t4][3]); }
            { const auto r1 = __builtin_amdgcn_permlane16_swap(__float_as_uint(mx), __float_as_uint(mx), false, false); mx = fmaxf(__uint_as_float(r1[0]), __uint_as_float(r1[1]));
              const auto r2 = __builtin_amdgcn_permlane32_swap(__float_as_uint(mx), __float_as_uint(mx), false, false); mx = fmaxf(__uint_as_float(r2[0]), __uint_as_float(r2[1])); }
            if (first) {
                mrun[c] = mx;
#pragma unroll
                for (int t4 = 0; t4 < 4; ++t4) s[c][t4] = s[c][t4] - mx;
            } else if (__any(mx > THR)) {
                const float d = mx > THR ? mx : 0.f, alpha = fexp2(-d); mrun[c] += d; ol[c] = ol[c] * alpha;
#pragma unroll
                for (int dt = 0; dt < NDT; ++dt) o[c][dt] = o[c][dt] * alpha;
#pragma unroll
                for (int t4 = 0; t4 < 4; ++t4) s[c][t4] = s[c][t4] - d;
            }
#pragma unroll
            for (int t4 = 0; t4 < 4; ++t4)
#pragma unroll
                for (int i = 0; i < 4; ++i) s[c][t4][i] = fexp2(s[c][t4][i]);
#pragma unroll
            for (int mb = 0; mb < 2; ++mb) { u32x4 w; w.x = cvt_pk_bf16(s[c][2 * mb][0], s[c][2 * mb][1]); w.y = cvt_pk_bf16(s[c][2 * mb][2], s[c][2 * mb][3]);
                w.z = cvt_pk_bf16(s[c][2 * mb + 1][0], s[c][2 * mb + 1][1]); w.w = cvt_pk_bf16(s[c][2 * mb + 1][2], s[c][2 * mb + 1][3]); pf[c][mb] = __builtin_bit_cast(bf16x8, w); }
            const bf16x8 ones = (bf16x8){0x3F80, 0x3F80, 0x3F80, 0x3F80, 0x3F80, 0x3F80, 0x3F80, 0x3F80};
            ol[c] = __builtin_amdgcn_mfma_f32_16x16x32_bf16(ones, pf[c][0], ol[c], 0, 0, 0); ol[c] = __builtin_amdgcn_mfma_f32_16x16x32_bf16(ones, pf[c][1], ol[c], 0, 0, 0);
        }
    }

    __device__ __forceinline__ void run(LAS unsigned char* lds, const bf16* Qp, int ldq, float qscale, const bf16* Kp, int ldk, const bf16* VTp, int ldvt, int nkt, int nkt_w, bool late,
                                        f32x4 (&o)[NMAP][NDT], float (&lsum)[NMAP], int tid, int lane) {
        const int g = lane >> 4, lq = lane & 15;
        bf16x8 qf[NMAP][NKS];
#pragma unroll
        for (int c = 0; c < NMAP; ++c)
#pragma unroll
            for (int ks = 0; ks < NKS; ++ks) { const u32x4 raw = *(const GAS u32x4*)(Qp + (size_t)lq * ldq + c * DQK + ks * 32 + g * 8);
                u32x4 w = raw;
                if (qscale != 1.0f) { w.x = cvt_pk_bf16(bflo(raw.x) * qscale, bfhi(raw.x) * qscale); w.y = cvt_pk_bf16(bflo(raw.y) * qscale, bfhi(raw.y) * qscale);
                                      w.z = cvt_pk_bf16(bflo(raw.z) * qscale, bfhi(raw.z) * qscale); w.w = cvt_pk_bf16(bflo(raw.w) * qscale, bfhi(raw.w) * qscale); }
                qf[c][ks] = __builtin_bit_cast(bf16x8, w); }
        float mrun[NMAP]; f32x4 ol[NMAP];
#pragma unroll
        for (int c = 0; c < NMAP; ++c) { mrun[c] = -INFINITY; ol[c] = (f32x4){0.f, 0.f, 0.f, 0.f};
#pragma unroll
            for (int dt = 0; dt < NDT; ++dt) o[c][dt] = (f32x4){0.f, 0.f, 0.f, 0.f}; }
        bf16x8 pfp[NMAP][2];
#pragma unroll
        for (int c = 0; c < NMAP; ++c) { pfp[c][0] = (bf16x8){0, 0, 0, 0, 0, 0, 0, 0}; pfp[c][1] = pfp[c][0]; }

        const int wave = __builtin_amdgcn_readfirstlane(tid >> 6);
        const Offs of = make_offs(lq, g);
#pragma unroll
        for (int j = 0; j < NBUF - 1; ++j) if (j < nkt) dma_tile(lds + j * BUF_BYTES, Kp, ldk, VTp, ldvt, j * 64, tid, wave);
        int bi = 0;
        for (int kt = 0; kt < nkt; ++kt) {
            LAS unsigned char* buf = lds + bi * BUF_BYTES;
            { const int ahead = (nkt - 1 - kt) < (NBUF - 2) ? (nkt - 1 - kt) : (NBUF - 2);
              if (ahead >= 1 && NBUF > 2) asm volatile("s_waitcnt vmcnt(%0)" :: "n"(NDMA) : "memory"); else asm volatile("s_waitcnt vmcnt(0)" ::: "memory"); }
            __builtin_amdgcn_s_barrier(); asm volatile("" ::: "memory");
            if (kt < nkt_w) { bf16x8 vf[PF]; s_tile(buf, qf, mrun, ol, o, pfp, of, kt == 0); vf_first(buf, vf, of);
                { const int kn = kt + NBUF - 1; if (kn < nkt) { const int bn = (bi == 0) ? NBUF - 1 : bi - 1; dma_tile(lds + bn * BUF_BYTES, Kp, ldk, VTp, ldvt, kn * 64, tid, wave); } }
                pv_tile(buf, vf, pfp, o, of); }
            else { const int kn = kt + NBUF - 1; if (kn < nkt) { const int bn = (bi == 0) ? NBUF - 1 : bi - 1; dma_tile(lds + bn * BUF_BYTES, Kp, ldk, VTp, ldvt, kn * 64, tid, wave); } }
            bi = (bi + 1 == NBUF) ? 0 : bi + 1;
        }
        asm volatile("s_waitcnt lgkmcnt(0)" ::: "memory"); __builtin_amdgcn_s_barrier(); asm volatile("" ::: "memory");
#pragma unroll
        for (int c = 0; c < NMAP; ++c) lsum[c] = ol[c][0];
    }
};
typedef float f32x16 __attribute__((ext_vector_type(16)));
struct DiffBody32 {
    static constexpr int KT_BYTES = 2 * 64 * 128, VT_BYTES = 128 * 128, BUF_BYTES = KT_BYTES + VT_BYTES, NBUF = 3, NDMA = 4;
    __device__ __forceinline__ static int swz(int row) { return (row >> 1) & 7; }
    __device__ __forceinline__ static int sigma(int rho) { return 16 * (rho >> 4) + 8 * ((rho >> 2) & 1) + 4 * ((rho >> 3) & 1) + (rho & 3); }
    __device__ __forceinline__ static void dma_offs(int tid, int ldk, int ldvt, unsigned (&ko)[2], unsigned (&vo)[2]) {
#pragma unroll
        for (int i = 0; i < 2; ++i) { const int p = tid + NTHR * i, row = p >> 3, sl = p & 7, ch = sl ^ swz(row), mp = row >> 6, key = row & 63; ko[i] = (unsigned)(key * ldk + mp * 64 + ch * 8); }
#pragma unroll
        for (int i = 0; i < 2; ++i) { const int p = tid + NTHR * i, dv = p >> 3, sl = p & 7, ch = sl ^ swz(dv); vo[i] = (unsigned)(dv * ldvt + ch * 8); }
    }
    __device__ __forceinline__ void dma_tile(LAS unsigned char* slot, const bf16* Kp, int ldk, const bf16* VTp, int key0, const unsigned (&ko)[2], const unsigned (&vo)[2], int wave) const {
        const bf16* kb = Kp + (size_t)key0 * ldk; const bf16* vb = VTp + key0;
#pragma unroll
        for (int i = 0; i < 2; ++i) __builtin_amdgcn_global_load_lds((const unsigned*)(kb + ko[i]), (LAS unsigned*)(slot + (i * NTHR + wave * 64) * 16), 16, 0, 0);
#pragma unroll
        for (int i = 0; i < 2; ++i) __builtin_amdgcn_global_load_lds((const unsigned*)(vb + vo[i]), (LAS unsigned*)(slot + KT_BYTES + (i * NTHR + wave * 64) * 16), 16, 0, 0);
    }
    __device__ __forceinline__ void run(LAS unsigned char* lds, const bf16* Qp  , int ldq, float qscale, const bf16* Kp, int ldk, const bf16* VTp, int ldvt,
                                        int nkt, int nkt_w, int c, f32x16 (&o)[4], float& lsum, int tid, int lane) {
        const int r = lane & 31, h = lane >> 5, wave = __builtin_amdgcn_readfirstlane(tid >> 6);
        bf16x8 qf[4];
#pragma unroll
        for (int ks = 0; ks < 4; ++ks) { const u32x4 raw = *(const GAS u32x4*)(Qp + (size_t)r * ldq + ks * 16 + h * 8); u32x4 w;
            w.x = cvt_pk_bf16(bflo(raw.x) * qscale, bfhi(raw.x) * qscale); w.y = cvt_pk_bf16(bflo(raw.y) * qscale, bfhi(raw.y) * qscale);
            w.z = cvt_pk_bf16(bflo(raw.z) * qscale, bfhi(raw.z) * qscale); w.w = cvt_pk_bf16(bflo(raw.w) * qscale, bfhi(raw.w) * qscale); qf[ks] = __builtin_bit_cast(bf16x8, w); }
        int kof[4], vof[4];
        { const int kr = sigma(r);
#pragma unroll
          for (int ks = 0; ks < 4; ++ks) kof[ks] = kr * 128 + (((2 * ks + h) ^ swz(kr)) << 4);
#pragma unroll
          for (int f = 0; f < 4; ++f) vof[f] = KT_BYTES + r * 128 + (((2 * f + h) ^ swz(r)) << 4); }
        float mrun = -INFINITY, ls = 0.f;
        unsigned ko[2], vo[2]; dma_offs(tid, ldk, ldvt, ko, vo);
#pragma unroll
        for (int db = 0; db < 4; ++db)
#pragma unroll
            for (int i = 0; i < 16; ++i) o[db][i] = 0.f;
#pragma unroll
        for (int j = 0; j < NBUF - 1; ++j) if (j < nkt) dma_tile(lds + j * BUF_BYTES, Kp, ldk, VTp, j * 64, ko, vo, wave);
        int bi = 0;
        for (int kt = 0; kt < nkt; ++kt) {
            const LAS unsigned char* buf = lds + bi * BUF_BYTES;
            { const int ahead = (nkt - 1 - kt) < 1 ? (nkt - 1 - kt) : 1;
              if (ahead >= 1) asm volatile("s_waitcnt vmcnt(%0)" :: "n"(NDMA) : "memory"); else asm volatile("s_waitcnt vmcnt(0)" ::: "memory"); }
            __builtin_amdgcn_s_barrier(); asm volatile("" ::: "memory");
            const int kn = kt + NBUF - 1; const int bn = (bi == 0) ? NBUF - 1 : bi - 1;
            if (kt < nkt_w) {
                constexpr float THR = 8.0f; const bool first = (kt == 0);
                f32x16 s[2];
                { const float mi = first ? 0.f : -mrun;
#pragma unroll
                  for (int kb = 0; kb < 2; ++kb) {
#pragma unroll
                      for (int i = 0; i < 16; ++i) s[kb][i] = mi;
                      bf16x8 kf[4];
#pragma unroll
                      for (int ks = 0; ks < 4; ++ks) kf[ks] = *(const LAS bf16x8*)(buf + kof[ks] + (c * 64 + 32 * kb) * 128);
#pragma unroll
                      for (int ks = 0; ks < 4; ++ks) s[kb] = __builtin_amdgcn_mfma_f32_32x32x16_bf16(kf[ks], qf[ks], s[kb], 0, 0, 0); } }
                float mx = __builtin_fmaxf(__builtin_fmaxf(s[0][0], s[0][1]), s[0][2]);
#pragma unroll
                for (int kb = 0; kb < 2; ++kb)
#pragma unroll
                    for (int i = (kb == 0 ? 3 : 0); i + 1 < 16; i += 2) mx = __builtin_fmaxf(__builtin_fmaxf(mx, s[kb][i]), s[kb][i + 1]);
                mx = fmaxf(mx, s[0][15]); mx = fmaxf(mx, s[1][15] > s[1][14] ? s[1][15] : s[1][14]);
                { const auto r2 = __builtin_amdgcn_permlane32_swap(__float_as_uint(mx), __float_as_uint(mx), false, false); mx = fmaxf(__uint_as_float(r2[0]), __uint_as_float(r2[1])); }
                if (first) { mrun = mx; s[0] = s[0] - mx; s[1] = s[1] - mx; }
                else if (__any(mx > THR)) { const float d = mx > THR ? mx : 0.f, alpha = fexp2(-d); mrun += d; ls *= alpha;
#pragma unroll
                    for (int db = 0; db < 4; ++db) o[db] = o[db] * alpha;
                    s[0] = s[0] - d; s[1] = s[1] - d; }
                if (kn < nkt) dma_tile(lds + bn * BUF_BYTES, Kp, ldk, VTp, kn * 64, ko, vo, wave);
                f32x2 ps2 = (f32x2){0.f, 0.f};
#pragma unroll
                for (int kb = 0; kb < 2; ++kb)
#pragma unroll
                    for (int i = 0; i < 16; i += 2) { const float e0 = fexp2(s[kb][i]), e1 = fexp2(s[kb][i + 1]); s[kb][i] = e0; s[kb][i + 1] = e1; ps2 = ps2 + (f32x2){e0, e1}; }
                ls += ps2[0] + ps2[1];
                bf16x8 pf[4];
#pragma unroll
                for (int f = 0; f < 4; ++f) { const int kb = f >> 1, s8 = 8 * (f & 1); u32x4 w;
                    w.x = cvt_pk_bf16(s[kb][s8 + 0], s[kb][s8 + 1]); w.y = cvt_pk_bf16(s[kb][s8 + 2], s[kb][s8 + 3]); w.z = cvt_pk_bf16(s[kb][s8 + 4], s[kb][s8 + 5]); w.w = cvt_pk_bf16(s[kb][s8 + 6], s[kb][s8 + 7]);
                    pf[f] = __builtin_bit_cast(bf16x8, w); }
                bf16x8 vf[4][4];
#pragma unroll
                for (int f = 0; f < 4; ++f) vf[0][f] = *(const LAS bf16x8*)(buf + vof[f]);
#pragma unroll
                for (int db = 0; db < 4; ++db) {
                    if (db + 1 < 4) {
#pragma unroll
                        for (int f = 0; f < 4; ++f) vf[db + 1][f] = *(const LAS bf16x8*)(buf + vof[f] + (db + 1) * 32 * 128);
                    }
#pragma unroll
                    for (int f = 0; f < 4; ++f) o[db] = __builtin_amdgcn_mfma_f32_32x32x16_bf16(vf[db][f], pf[f], o[db], 0, 0, 0); }
            } else if (kn < nkt) dma_tile(lds + bn * BUF_BYTES, Kp, ldk, VTp, kn * 64, ko, vo, wave);
            bi = (bi + 1 == NBUF) ? 0 : bi + 1;
        }
        asm volatile("s_waitcnt lgkmcnt(0)" ::: "memory"); __builtin_amdgcn_s_barrier(); asm volatile("" ::: "memory");
        { const auto r2 = __builtin_amdgcn_permlane32_swap(__float_as_uint(ls), __float_as_uint(ls), false, false); lsum = __uint_as_float(r2[0]) + __uint_as_float(r2[1]); }
    }
};
constexpr int ATTN_MAXU = 2;
__constant__ unsigned short attn_tab[256][ATTN_MAXU] = {
{34,17},
{98,81},
{162,145},
{226,209},
{290,273},
{354,337},
{418,401},
{482,465},
{33,19},
{97,83},
{161,147},
{225,211},
{289,275},
{353,339},
{417,403},
{481,467},
{31,20},
{95,84},
{159,148},
{223,212},
{287,276},
{351,340},
{415,404},
{479,468},
{50,1},
{114,65},
{178,129},
{242,193},
{306,257},
{370,321},
{434,385},
{498,449},
{52,0},
{116,64},
{180,128},
{244,192},
{308,256},
{372,320},
{436,384},
{500,448},
{36,15},
{100,79},
{164,143},
{228,207},
{292,271},
{356,335},
{420,399},
{484,463},
{49,2},
{113,66},
{177,130},
{241,194},
{305,258},
{369,322},
{433,386},
{497,450},
{47,5},
{111,69},
{175,133},
{239,197},
{303,261},
{367,325},
{431,389},
{495,453},
{39,28},
{103,92},
{167,156},
{231,220},
{295,284},
{359,348},
{423,412},
{487,476},
{57,10},
{121,74},
{185,138},
{249,202},
{313,266},
{377,330},
{441,394},
{505,458},
{45,22},
{109,86},
{173,150},
{237,214},
{301,278},
{365,342},
{429,406},
{493,470},
{40,27},
{104,91},
{168,155},
{232,219},
{296,283},
{360,347},
{424,411},
{488,475},
{54,13},
{118,77},
{182,141},
{246,205},
{310,269},
{374,333},
{438,397},
{502,461},
{44,23},
{108,87},
{172,151},
{236,215},
{300,279},
{364,343},
{428,407},
{492,471},
{35,32},
{99,96},
{163,160},
{227,224},
{291,288},
{355,352},
{419,416},
{483,480},
{58,9},
{122,73},
{186,137},
{250,201},
{314,265},
{378,329},
{442,393},
{506,457},
{37,30},
{101,94},
{165,158},
{229,222},
{293,286},
{357,350},
{421,414},
{485,478},
{59,8},
{123,72},
{187,136},
{251,200},
{315,264},
{379,328},
{443,392},
{507,456},
{55,12},
{119,76},
{183,140},
{247,204},
{311,268},
{375,332},
{439,396},
{503,460},
{53,14},
{117,78},
{181,142},
{245,206},
{309,270},
{373,334},
{437,398},
{501,462},
{43,24},
{107,88},
{171,152},
{235,216},
{299,280},
{363,344},
{427,408},
{491,472},
{61,6},
{125,70},
{189,134},
{253,198},
{317,262},
{381,326},
{445,390},
{509,454},
{38,29},
{102,93},
{166,157},
{230,221},
{294,285},
{358,349},
{422,413},
{486,477},
{60,7},
{124,71},
{188,135},
{252,199},
{316,263},
{380,327},
{444,391},
{508,455},
{62,4},
{126,68},
{190,132},
{254,196},
{318,260},
{382,324},
{446,388},
{510,452},
{56,11},
{120,75},
{184,139},
{248,203},
{312,267},
{376,331},
{440,395},
{504,459},
{48,18},
{112,82},
{176,146},
{240,210},
{304,274},
{368,338},
{432,402},
{496,466},
{41,26},
{105,90},
{169,154},
{233,218},
{297,282},
{361,346},
{425,410},
{489,474},
{42,25},
{106,89},
{170,153},
{234,217},
{298,281},
{362,345},
{426,409},
{490,473},
{51,16},
{115,80},
{179,144},
{243,208},
{307,272},
{371,336},
{435,400},
{499,464},
{63,3},
{127,67},
{191,131},
{255,195},
{319,259},
{383,323},
{447,387},
{511,451},
{46,21},
{110,85},
{174,149},
{238,213},
{302,277},
{366,341},
{430,405},
{494,469}};
namespace rk {
constexpr int MS = 144;
constexpr int MB = 64 * MS;
constexpr int O_AB = 0 * MB, O_BB = 1 * MB, O_KB = 2 * MB, O_RB = 3 * MB, O_ABT = 4 * MB, O_VTT = 5 * MB, O_BTT = 6 * MB, O_KTT = 7 * MB, O_AAK = 8 * MB, O_ARB = 9 * MB, O_ARK = 10 * MB;
constexpr int O_TM = O_KB, O_GT = O_AB, O_WTT = O_BB, O_UTT = O_AAK;
constexpr int FS = 66;
constexpr int O_LF = 11 * MB, O_TF = 0;
constexpr int O_LA = O_LF + 64 * FS * 4;
static_assert(O_LA + MB <= RING_BYTES && 64 * FS * 4 <= 2 * MB, "rwkv LDS map");
constexpr int O_LW = X_OFF, O_LG = X_OFF + MB, LGS = 272, O_NRM = O_LG + 64 * LGS, O_BSP = O_NRM + 512, O_C63 = O_BSP + 512;
static_assert(O_C63 + 1024 <= MISC_OFF, "rwkv LDS extras");

template <int NKS>
__device__ __forceinline__ f32x4 mm_tile(const LAS unsigned char* A, int astr, int tr, const LAS unsigned char* B, int bstr, int tc, f32x4 acc, int lq, int g) {
#pragma unroll
    for (int ks = 0; ks < NKS; ++ks) {
        const bf16x8 a = *(const LAS bf16x8*)(A + (16 * tr + lq) * astr + (32 * ks + 8 * g) * 2);
        const bf16x8 b = *(const LAS bf16x8*)(B + (16 * tc + lq) * bstr + (32 * ks + 8 * g) * 2);
        acc = __builtin_amdgcn_mfma_f32_16x16x32_bf16(a, b, acc, 0, 0, 0); }
    return acc;
}
template <int NKS>
__device__ __forceinline__ f32x4 mm_tile_gb(const LAS unsigned char* A, int astr, int tr, const bf16* Bg, int ldb, f32x4 acc, int lq, int g) {
#pragma unroll
    for (int ks = 0; ks < NKS; ++ks) {
        const bf16x8 a = *(const LAS bf16x8*)(A + (16 * tr + lq) * astr + (32 * ks + 8 * g) * 2);
        const bf16x8 b = *(const GAS bf16x8*)(Bg + (size_t)lq * ldb + 32 * ks + 8 * g);
        acc = __builtin_amdgcn_mfma_f32_16x16x32_bf16(a, b, acc, 0, 0, 0); }
    return acc;
}
__device__ __forceinline__ void st_nat(LAS unsigned char* Mx, int t0, int col, const f32x4& v) {
#pragma unroll
    for (int i = 0; i < 4; ++i) *(LAS bf16*)(Mx + (t0 + i) * MS + col * 2) = (bf16)f2bf(v[i]);
}
__device__ __forceinline__ void st_tr(LAS unsigned char* Mx, int t0, int col, const f32x4& v) {
    u32x2 w; w.x = cvt_pk_bf16(v[0], v[1]); w.y = cvt_pk_bf16(v[2], v[3]); *(LAS u32x2*)(Mx + col * MS + t0 * 2) = w;
}

__device__ __forceinline__ void tri_inverse(const LAS float* L, LAS float* Tm, int lane) {
    const int g = lane >> 4, lq = lane & 15;
    {
        float x[16];
#pragma unroll
        for (int r = 0; r < 16; ++r) { float a = (r == lq) ? 1.f : 0.f;
#pragma unroll
            for (int s = 0; s < r; ++s) a += L[(16 * g + r) * FS + 16 * g + s] * x[s];
            x[r] = a; }
#pragma unroll
        for (int r = 0; r < 16; ++r) Tm[(16 * g + r) * FS + 16 * g + lq] = x[r];
    }
#pragma unroll
    for (int d = 1; d < 4; ++d)
#pragma unroll
        for (int i = d; i < 4; ++i) { const int j = i - d;
            f32x4 X = (f32x4){0.f, 0.f, 0.f, 0.f}, X1 = X;
#pragma unroll
            for (int m = j; m < i; ++m)
#pragma unroll
                for (int kq = 0; kq < 4; kq += 2) {
                    X = __builtin_amdgcn_mfma_f32_16x16x4f32(L[(16 * i + lq) * FS + 16 * m + 4 * kq + g], Tm[(16 * m + 4 * kq + g) * FS + 16 * j + lq], X, 0, 0, 0);
                    X1 = __builtin_amdgcn_mfma_f32_16x16x4f32(L[(16 * i + lq) * FS + 16 * m + 4 * (kq + 1) + g], Tm[(16 * m + 4 * (kq + 1) + g) * FS + 16 * j + lq], X1, 0, 0, 0); }
            X = X + X1;
            f32x4 R = (f32x4){0.f, 0.f, 0.f, 0.f}, R1 = R;
#pragma unroll
            for (int kk = 0; kk < 4; kk += 2) { R = __builtin_amdgcn_mfma_f32_16x16x4f32(Tm[(16 * i + lq) * FS + 16 * i + 4 * g + kk], X[kk], R, 0, 0, 0);
                R1 = __builtin_amdgcn_mfma_f32_16x16x4f32(Tm[(16 * i + lq) * FS + 16 * i + 4 * g + kk + 1], X[kk + 1], R1, 0, 0, 0); }
            R = R + R1;
#pragma unroll
            for (int q = 0; q < 4; ++q) Tm[(16 * i + 4 * g + q) * FS + 16 * j + lq] = R[q];
        }
}

__device__ __forceinline__ void tri_inverse_simple(const LAS float* L, LAS float* Tm, int lane) {
#pragma unroll 1
    for (int t = 0; t < 64; ++t) { float a = (t == lane) ? 1.f : 0.f;
#pragma unroll 1
        for (int s = 0; s < t; ++s) a += L[t * FS + s] * Tm[s * FS + lane];
        Tm[t * FS + lane] = a; }
}
__device__ __forceinline__ float mixf(unsigned short cur, unsigned short prev, float mu) { const float c = bf2f(cur), p = bf2f(prev); return c + (p - c) * mu; }

__device__ __forceinline__ void phase_a(Frame& F, int b, int c) {
    LAS unsigned char* lds = F.lds;
    const int tid = F.tid, lane = F.lane, w = F.wave, g = lane >> 4, lq = lane & 15;
    const bf16* PROJ = (const bf16*)(F.ws + WS_PROJ);
    const int n0 = b * T + c * CH;
    const bool first = (c == 0);
    const float* mu = F.in[I_MU]; bf16* GATEp = (bf16*)(F.ws + WS_GATE);
    {
        const int t = tid >> 3, c0 = (tid & 7) * 32; const unsigned oc = (unsigned)(n0 + t) * PCOLS + C_WD + c0; const bool hasp = !(first && t == 0); const unsigned op = hasp ? oc - PCOLS : oc; const float* mup = mu + C_WD + c0;
        u32x4 cuq[4], pvq[4]; f32x4 m0q[4], m1q[4];
#pragma unroll
        for (int q = 0; q < 4; ++q) { cuq[q] = *(const GAS u32x4*)(PROJ + (oc + q * 8)); pvq[q] = *(const GAS u32x4*)(PROJ + (op + q * 8)); m0q[q] = *(const GAS f32x4*)(mup + q * 8); m1q[q] = *(const GAS f32x4*)(mup + q * 8 + 4); }
        __builtin_amdgcn_sched_barrier(0);
#pragma unroll
        for (int q = 0; q < 4; ++q) {
            const u32x4 cu = cuq[q]; u32x4 pv = pvq[q]; if (!hasp) pv = (u32x4){0u, 0u, 0u, 0u};
            const f32x4 m0 = m0q[q], m1 = m1q[q];
            float o[8];
#pragma unroll
            for (int k = 0; k < 4; ++k) { const unsigned cw = cu[k], pw = pv[k];
                const float x0 = bflo(cw) + (bflo(pw) - bflo(cw)) * (k < 2 ? m0[2 * k] : m1[2 * k - 4]), x1 = bfhi(cw) + (bfhi(pw) - bfhi(cw)) * (k < 2 ? m0[2 * k + 1] : m1[2 * k - 3]);
                if (c0 < 64) { o[2 * k] = 1.f - 2.f * frcp(fexp(2.f * x0) + 1.f); o[2 * k + 1] = 1.f - 2.f * frcp(fexp(2.f * x1) + 1.f); }
                else if (c0 < 128) { o[2 * k] = x0; o[2 * k + 1] = x1; }
                else { o[2 * k] = sigmoidf_(x0); o[2 * k + 1] = sigmoidf_(x1); } }
            u32x4 wv; wv.x = cvt_pk_bf16(o[0], o[1]); wv.y = cvt_pk_bf16(o[2], o[3]); wv.z = cvt_pk_bf16(o[4], o[5]); wv.w = cvt_pk_bf16(o[6], o[7]);
            LAS unsigned char* dst = (c0 < 64) ? lds + O_LW + t * MS + (c0 + q * 8) * 2 : (c0 < 128) ? lds + O_LA + t * MS + (c0 - 64 + q * 8) * 2 : lds + O_LG + t * LGS + (c0 - 128 + q * 8) * 2;
            *(LAS u32x4*)dst = wv; }
    }
    __syncthreads();
    const int tr = w >> 1, tcb = 2 * (w & 1);
    LAS float* EF = (LAS float*)(lds + O_LF);
    LAS float* NRM = (LAS float*)(lds + O_NRM); LAS float* BSP = (LAS float*)(lds + O_BSP); LAS float* TT = (LAS float*)(lds + O_C63);
    float pc[2][8]; unsigned short pr[2][5], pk[2][5], pv[2][5];
#define RK_LOADP(hh) do { _Pragma("unroll") for (int x = 0; x < 2; ++x) { const int hj = (hh) * RN + 16 * (tcb + x) + lq; \
        pc[x][0] = F.in[I_W0][hj]; pc[x][1] = F.in[I_A0][hj]; pc[x][2] = F.in[I_KK][hj]; pc[x][3] = mu[C_R + hj]; pc[x][4] = mu[C_K + hj]; pc[x][5] = mu[C_V + hj]; pc[x][6] = F.in[I_KA][hj]; pc[x][7] = F.in[I_RK][hj]; \
        _Pragma("unroll") for (int ii = 0; ii < 5; ++ii) { const int t = 16 * tr + 4 * g + ii - 1; const unsigned o = (unsigned)(n0 + ((first && t < 0) ? 0 : t)) * PCOLS + hj; \
            pr[x][ii] = PROJ[o + C_R]; pk[x][ii] = PROJ[o + C_K]; pv[x][ii] = PROJ[o + C_V]; } } } while (0)
    RK_LOADP(0);
#pragma unroll 1
    for (int h = 0; h < RH; ++h) {
        const int item = (b * RH + h) * NCHUNK + c;
        float ev[2][4], av[2][4], rv[2][4], kv[2][4], vv[2][4], kkr[2][4];
        float nrm_p[4] = {0.f, 0.f, 0.f, 0.f};
        bf16x8 fw[2][2], fa[2][2], fg[2][4];
        int lq = lane & 15, g = lane >> 4; asm volatile("" : "+v"(lq), "+v"(g));
#pragma unroll
        for (int x = 0; x < 2; ++x) { const int tc = tcb + x, hj = h * RN + 16 * tc + lq;
            const bf16* bw = (const bf16*)(F.ws + WS_W2LT) + (size_t)(h * RN + 16 * tc) * 64; const bf16* ba = (const bf16*)(F.ws + WS_A2LT) + (size_t)(h * RN + 16 * tc) * 64; const bf16* bg = (const bf16*)(F.ws + WS_G2LT) + (size_t)(h * RN + 16 * tc) * 128;
#pragma unroll
            for (int ks = 0; ks < 2; ++ks) { fw[x][ks] = *(const GAS bf16x8*)(bw + (size_t)lq * 64 + 32 * ks + 8 * g); fa[x][ks] = *(const GAS bf16x8*)(ba + (size_t)lq * 64 + 32 * ks + 8 * g); }
#pragma unroll
            for (int ks = 0; ks < 4; ++ks) fg[x][ks] = *(const GAS bf16x8*)(bg + (size_t)lq * 128 + 32 * ks + 8 * g);
            __builtin_amdgcn_sched_barrier(0);
            f32x4 wl = (f32x4){0.f, 0.f, 0.f, 0.f}, al = wl, gl = wl;
#pragma unroll
            for (int ks = 0; ks < 2; ++ks) { wl = __builtin_amdgcn_mfma_f32_16x16x32_bf16(*(const LAS bf16x8*)(lds + O_LW + (16 * tr + lq) * MS + (32 * ks + 8 * g) * 2), fw[x][ks], wl, 0, 0, 0);
                al = __builtin_amdgcn_mfma_f32_16x16x32_bf16(*(const LAS bf16x8*)(lds + O_LA + (16 * tr + lq) * MS + (32 * ks + 8 * g) * 2), fa[x][ks], al, 0, 0, 0); }
#pragma unroll
            for (int ks = 0; ks < 4; ++ks) gl = __builtin_amdgcn_mfma_f32_16x16x32_bf16(*(const LAS bf16x8*)(lds + O_LG + (16 * tr + lq) * LGS + (32 * ks + 8 * g) * 2), fg[x][ks], gl, 0, 0, 0);
            const float w0 = pc[x][0], a0 = pc[x][1], kkw = pc[x][2];
            const float mur = pc[x][3], muk = pc[x][4], muv = pc[x][5];
#pragma unroll
            for (int i = 0; i < 4; ++i) { const int t = 16 * tr + 4 * g + i; const bool hasp = !(first && t == 0);
                const float xw = -(w0 + wl[i]); const float sp = xw > 20.f ? xw : __logf(1.f + fexp(xw)); ev[x][i] = fexp(-sp - 0.5f);
                av[x][i] = sigmoidf_(a0 + al[i]);
                GATEp[(unsigned)(n0 + t) * RW + hj] = (bf16)f2bf(gl[i]);
                const unsigned short rc = pr[x][i + 1], kc = pk[x][i + 1], vc = pv[x][i + 1]; unsigned short rp = pr[x][i], kp = pk[x][i], vp = pv[x][i];
                if (!hasp) { rp = 0; kp = 0; vp = 0; }
                rv[x][i] = mixf(rc, rp, mur); kv[x][i] = mixf(kc, kp, muk); vv[x][i] = mixf(vc, vp, muv);
                kkr[x][i] = kv[x][i] * kkw; nrm_p[i] += kkr[x][i] * kkr[x][i]; }
        }
        f32x4 cvv[CV_P2_HALVES][8]; const int cvq = ((h * (BATCH * NCHUNK) + b * NCHUNK + c) * NWAVES + w) * CV_P2_HALVES;
#pragma unroll
        for (int j = 0; j < CV_P2_HALVES; ++j) conv_half_load(F, cvq + j, lane, cvv[j]);
        __builtin_amdgcn_sched_barrier(0);
#pragma unroll
        for (int i = 0; i < 4; ++i) { float q = nrm_p[i]; q += __shfl_xor(q, 1); q += __shfl_xor(q, 2); q += __shfl_xor(q, 4); q += __shfl_xor(q, 8); if (lq == 0) NRM[(16 * tr + 4 * g + i) * 2 + (w & 1)] = q; }
        float cs[2][4];
#pragma unroll
        for (int x = 0; x < 2; ++x) { cs[x][0] = ev[x][0]; cs[x][1] = cs[x][0] + ev[x][1]; cs[x][2] = cs[x][1] + ev[x][2]; cs[x][3] = cs[x][2] + ev[x][3];
            float a = cs[x][3]; const float b1 = __shfl(a, lane - 16); a += (g >= 1) ? b1 : 0.f; const float b2 = __shfl(a, lane - 32); a += (g >= 2) ? b2 : 0.f;
            const float ex = a - cs[x][3];
#pragma unroll
            for (int i = 0; i < 4; ++i) cs[x][i] += ex;
            if (g == 3) TT[tr * 64 + 16 * (tcb + x) + lq] = a; }
        __syncthreads();
        float bs_p[4] = {0.f, 0.f, 0.f, 0.f};
#pragma unroll
        for (int x = 0; x < 2; ++x) { const int tc = tcb + x, j = 16 * tc + lq; const float ka = pc[x][6], rk = pc[x][7];
            const float t0v = TT[j], t1v = TT[64 + j], t2v = TT[128 + j], t3v = TT[192 + j]; const float c63 = (t0v + t1v) + (t2v + t3v);
            const float cbase = (tr > 0 ? t0v : 0.f) + (tr > 1 ? t1v : 0.f) + (tr > 2 ? t2v : 0.f);
            if (tr == 3 && g == 3) ((float*)(F.ws + WS_GC))[(size_t)item * 64 + j] = fexp(-c63);
            f32x4 ab, bb, kb, rb, bt, kt, vx;
#pragma unroll
            for (int i = 0; i < 4; ++i) { const int t = 16 * tr + 4 * g + i; const float cin = cs[x][i] + cbase, cex = cin - ev[x][i];
                const float nr = NRM[t * 2] + NRM[t * 2 + 1]; const float kk = kkr[x][i] / fmaxf(sqrtf(nr), 1e-12f);
                DBGCNT(F, 2, !(nr > 1e-6f && nr < 1e6f)); DBGCNT(F, 3, !(fabsf(kk) <= 1.001f)); DBGCNT(F, 6, !(ev[x][i] > 0.f && ev[x][i] < 0.62f && av[x][i] > 0.f && av[x][i] < 1.f)); DBGCNT(F, 8, !(fabsf(rv[x][i]) < 100.f && fabsf(kv[x][i]) < 100.f && fabsf(vv[x][i]) < 100.f)); DBGCNT(F, 9, !(cin >= 0.f && cin < 40.f && c63 >= cin));
                const float a = av[x][i], k2 = kv[x][i] * (1.f + (a - 1.f) * ka);
                const float gin = fexp(-cin), ginv = fexp(cin), gex = fexp(-cex), grel = fexp(cin - c63);
                ab[i] = -kk * gex; bb[i] = kk * a * ginv; kb[i] = k2 * ginv; rb[i] = rv[x][i] * gin; bt[i] = kk * a * grel; kt[i] = k2 * grel; vx[i] = vv[x][i];
                bs_p[i] += rv[x][i] * k2 * rk; }
            const int t0 = 16 * tr + 4 * g;
            st_nat(lds + O_AB, t0, j, ab); st_nat(lds + O_BB, t0, j, bb); st_nat(lds + O_KB, t0, j, kb); st_nat(lds + O_RB, t0, j, rb);
            st_tr(lds + O_ABT, t0, j, ab); st_tr(lds + O_VTT, t0, j, vx); st_tr(lds + O_BTT, t0, j, bt); st_tr(lds + O_KTT, t0, j, kt);
        }
#pragma unroll
        for (int i = 0; i < 4; ++i) { float q = bs_p[i]; q += __shfl_xor(q, 1); q += __shfl_xor(q, 2); q += __shfl_xor(q, 4); q += __shfl_xor(q, 8); if (lq == 0) BSP[(16 * tr + 4 * g + i) * 2 + (w & 1)] = q; }
        { const int hn = h + 1 < RH ? h + 1 : h; RK_LOADP(hn); __builtin_amdgcn_sched_barrier(0); }
        __syncthreads();
        if (tid < 64) ((float*)(F.ws + WS_BS))[(size_t)(n0 + tid) * RH + h] = BSP[tid * 2] + BSP[tid * 2 + 1];
#pragma unroll
        for (int x = 0; x < 2; ++x) { const int tc = tcb + x; f32x4 l = (f32x4){0.f, 0.f, 0.f, 0.f}, ak = l, rbm = l, rkm = l;
            if (tc <= tr) {
                l = mm_tile<2>(lds + O_AB, MS, tr, lds + O_BB, MS, tc, l, lq, g); ak = mm_tile<2>(lds + O_AB, MS, tr, lds + O_KB, MS, tc, ak, lq, g);
                rbm = mm_tile<2>(lds + O_RB, MS, tr, lds + O_BB, MS, tc, rbm, lq, g); rkm = mm_tile<2>(lds + O_RB, MS, tr, lds + O_KB, MS, tc, rkm, lq, g);
                const int s = 16 * tc + lq;
#pragma unroll
                for (int i = 0; i < 4; ++i) { const int t = 16 * tr + 4 * g + i; if (s >= t) { l[i] = 0.f; ak[i] = 0.f; } if (s > t) { rbm[i] = 0.f; rkm[i] = 0.f; } }
            }
            const int t0 = 16 * tr + 4 * g, s = 16 * tc + lq;
#pragma unroll
            for (int i = 0; i < 4; ++i) { EF[(t0 + i) * FS + s] = l[i]; DBGCNT(F, 7, !(fabsf(l[i]) <= 1.01f)); DBGCNT(F, 10, !(fabsf(ak[i]) < 300.f && fabsf(rbm[i]) < 300.f && fabsf(rkm[i]) < 300.f)); }
            st_nat(lds + O_AAK, t0, s, ak); st_nat(lds + O_ARB, t0, s, rbm); st_nat(lds + O_ARK, t0, s, rkm);
        }
        __syncthreads();
#ifdef DBG_SIMPLE_TRI
        if (w == 0) tri_inverse_simple(EF, (LAS float*)(lds + O_TF), lane);
#else
        if (w == 0) tri_inverse(EF, (LAS float*)(lds + O_TF), lane);
#endif
        __syncthreads();
        { const int t = tid >> 3, s0 = (tid & 7) * 8; const LAS float* tp = (const LAS float*)(lds + O_TF) + t * FS + s0; float o[8];
#pragma unroll
          for (int k = 0; k < 8; ++k) { o[k] = ((s0 >> 4) > (t >> 4)) ? 0.f : tp[k]; DBGCNT(F, 4, !(fabsf(o[k]) < 50.f)); }
          u32x4 wv; wv.x = cvt_pk_bf16(o[0], o[1]); wv.y = cvt_pk_bf16(o[2], o[3]); wv.z = cvt_pk_bf16(o[4], o[5]); wv.w = cvt_pk_bf16(o[6], o[7]);
          __syncthreads();
          *(LAS u32x4*)(lds + O_TM + t * MS + s0 * 2) = wv; }
        __syncthreads();
#pragma unroll
        for (int j = 0; j < CV_P2_HALVES; ++j) conv_half_store(F, cvq + j, lane, cvv[j]);
#pragma unroll
        for (int x = 0; x < 2; ++x) { const int tc = tcb + x; f32x4 gg = (f32x4){0.f, 0.f, 0.f, 0.f}, wt = gg;
            gg = mm_tile<2>(lds + O_AAK, MS, tr, lds + O_VTT, MS, tc, gg, lq, g); wt = mm_tile<2>(lds + O_TM, MS, tr, lds + O_ABT, MS, tc, wt, lq, g);
#pragma unroll
            for (int i = 0; i < 4; ++i) { DBGCNT(F, 12, !(fabsf(gg[i]) < 1e3f)); DBGCNT(F, 13, !(fabsf(wt[i]) < 1e2f)); }
            st_tr(lds + O_GT, 16 * tr + 4 * g, 16 * tc + lq, gg); st_tr(lds + O_WTT, 16 * tr + 4 * g, 16 * tc + lq, wt); }
        __syncthreads();
#pragma unroll
        for (int x = 0; x < 2; ++x) { const int tc = tcb + x; f32x4 ut = (f32x4){0.f, 0.f, 0.f, 0.f};
            ut = mm_tile<2>(lds + O_TM, MS, tr, lds + O_GT, MS, tc, ut, lq, g);
#pragma unroll
            for (int i = 0; i < 4; ++i) DBGCNT(F, 14, !(fabsf(ut[i]) < 1e3f));
            st_tr(lds + O_UTT, 16 * tr + 4 * g, 16 * tc + lq, ut); }
        __syncthreads();
#pragma unroll
        for (int x = 0; x < 2; ++x) { const int tc = tcb + x, t0 = 16 * tr + 4 * g, cj = 16 * tc + lq;
            f32x4 qt = (f32x4){0.f, 0.f, 0.f, 0.f}, yl = qt, pp = qt, nn = qt;
            qt = mm_tile<2>(lds + O_ARB, MS, tr, lds + O_WTT, MS, tc, qt, lq, g);
            yl = mm_tile<2>(lds + O_ARB, MS, tr, lds + O_UTT, MS, tc, yl, lq, g);
#ifdef DBG_SEL
            { f32x4 y2 = (f32x4){0.f, 0.f, 0.f, 0.f}; y2 = mm_tile<2>(lds + O_ARK, MS, tr, lds + O_VTT, MS, tc, y2, lq, g);
#pragma unroll
              for (int i = 0; i < 4; ++i) { DBGCNT(F, 15, !(fabsf(yl[i]) < 1e4f)); DBGCNT(F, 16, !(fabsf(y2[i]) < 1e4f)); }
#pragma unroll
              for (int ks = 0; ks < 2; ++ks) { const bf16x8 a1 = *(const LAS bf16x8*)(lds + O_ARB + (16 * tr + lq) * MS + (32 * ks + 8 * g) * 2), a2 = *(const LAS bf16x8*)(lds + O_ARK + (16 * tr + lq) * MS + (32 * ks + 8 * g) * 2);
                  const bf16x8 b1 = *(const LAS bf16x8*)(lds + O_UTT + (16 * tc + lq) * MS + (32 * ks + 8 * g) * 2), b2 = *(const LAS bf16x8*)(lds + O_VTT + (16 * tc + lq) * MS + (32 * ks + 8 * g) * 2);
#pragma unroll
                  for (int j = 0; j < 8; ++j) { DBGCNT(F, 17, !(fabsf(bf2f((bf16)a1[j])) < 300.f)); DBGCNT(F, 18, !(fabsf(bf2f((bf16)a2[j])) < 300.f)); DBGCNT(F, 19, !(fabsf(bf2f((bf16)b1[j])) < 1e3f)); DBGCNT(F, 20, !(fabsf(bf2f((bf16)b2[j])) < 100.f)); } } }
#endif
            yl = mm_tile<2>(lds + O_ARK, MS, tr, lds + O_VTT, MS, tc, yl, lq, g);
            pp = mm_tile<2>(lds + O_WTT, MS, tr, lds + O_BTT, MS, tc, pp, lq, g);
            nn = mm_tile<2>(lds + O_UTT, MS, tr, lds + O_BTT, MS, tc, nn, lq, g); nn = mm_tile<2>(lds + O_VTT, MS, tr, lds + O_KTT, MS, tc, nn, lq, g);
            bf16* QT = (bf16*)(F.ws + WS_QT) + (size_t)item * 4096; float* YL = (float*)(F.ws + WS_YLOC) + (size_t)item * 4096;
            bf16* PT = (bf16*)(F.ws + WS_PT) + (size_t)item * 4096; float* NNp = (float*)(F.ws + WS_NN) + (size_t)item * 4096;
#pragma unroll
            for (int i = 0; i < 4; ++i) { const float rbv = bf2f(*(const LAS bf16*)(lds + O_RB + (t0 + i) * MS + cj * 2));
                DBGCNT(F, 5, !(fabsf(yl[i]) < 1e4f)); DBGCNT(F, 11, !(fabsf(nn[i]) < 1e4f && fabsf(pp[i]) < 1e2f && fabsf(qt[i]) < 1e4f));
                QT[(unsigned)((t0 + i) * 64 + cj)] = (bf16)f2bf(qt[i] + rbv); YL[(unsigned)((t0 + i) * 64 + cj)] = yl[i]; NNp[(unsigned)((t0 + i) * 64 + cj)] = nn[i]; }
            u32x2 pw; pw.x = cvt_pk_bf16(pp[0], pp[1]); pw.y = cvt_pk_bf16(pp[2], pp[3]); *(GAS u32x2*)(PT + (unsigned)(cj * 64 + t0)) = pw;
        }
        __syncthreads();
    }
}

constexpr int SC_PT = 0, SC_NN = 8192, SC_GC = 12288, SC_DUM = 12544, SC_SLOT = 12800, SC_DEPTH = 8;
static_assert(SC_DEPTH * SC_SLOT <= RING_BYTES, "scan ring");
#undef RK_LOADP
__device__ __forceinline__ void scan_issue(LAS unsigned char* ring, const unsigned char* ws, int bh, int vg, int c, int w, int lane) {
    const size_t item = (size_t)bh * NCHUNK + c; LAS unsigned char* slot = ring + (c & (SC_DEPTH - 1)) * SC_SLOT;
#pragma unroll
    for (int k = 0; k < 2; ++k) { const int id = 2 * (w - 1) + k;
        if (id < 8) { const int p = 64 * id + lane, r = p >> 3, sl = p & 7, ch = sl ^ (r & 7);
            __builtin_amdgcn_global_load_lds((const unsigned*)((const bf16*)(ws + WS_PT) + item * 4096 + r * 64 + ch * 8), (LAS unsigned*)(slot + SC_PT + 1024 * id), 16, 0, 0); }
        else if (id < 12) { const int q = id - 8, p = 64 * q + lane, r = p >> 4, sl = p & 15, ch = sl ^ (r & 15);
            __builtin_amdgcn_global_load_lds((const unsigned*)((const float*)(ws + WS_NN) + item * 4096 + (16 * vg + r) * 64 + ch * 4), (LAS unsigned*)(slot + SC_NN + 1024 * q), 16, 0, 0); }
        else { __builtin_amdgcn_global_load_lds((const unsigned*)((const float*)(ws + WS_GC) + item * 64 + lane), (LAS unsigned*)(slot + (id == 12 ? SC_GC : SC_DUM)), 4, 0, 0); }
    }
}
__device__ __forceinline__ void phase_scan(Frame& F, int bh, int vg) {
    const int lane = F.lane, w = F.wave, g = lane >> 4, lq = lane & 15;
    LAS unsigned char* ring = F.lds;
    f32x4 S[4];
#pragma unroll
    for (int kt = 0; kt < 4; ++kt) S[kt] = (f32x4){0.f, 0.f, 0.f, 0.f};
    const int v = 16 * vg + lq;
    if (w >= 1) {
#pragma unroll 1
        for (int c = 0; c < SC_DEPTH - 1; ++c) scan_issue(ring, F.ws, bh, vg, c, w, lane);
    }
#pragma unroll 1
    for (int c = 0; c < NCHUNK; ++c) {
        if (c <= NCHUNK - SC_DEPTH + 1) asm volatile("s_waitcnt vmcnt(12)" ::: "memory"); else asm volatile("s_waitcnt vmcnt(0)" ::: "memory");
        __builtin_amdgcn_s_barrier(); asm volatile("" ::: "memory");
        if (w >= 1 && c + SC_DEPTH - 1 < NCHUNK) scan_issue(ring, F.ws, bh, vg, c + SC_DEPTH - 1, w, lane);
        if (w == 0) {
            const LAS unsigned char* slot = ring + (c & (SC_DEPTH - 1)) * SC_SLOT; const size_t item = (size_t)bh * NCHUNK + c;
            bf16* S0 = (bf16*)(F.ws + WS_S0) + item * 4096;
            bf16x8 sf[2];
#pragma unroll
            for (int kt = 0; kt < 4; ++kt) { u32x2 wv; wv.x = cvt_pk_bf16(S[kt][0], S[kt][1]); wv.y = cvt_pk_bf16(S[kt][2], S[kt][3]); *(GAS u32x2*)(S0 + (size_t)v * 64 + 16 * kt + 4 * g) = wv; }
#pragma unroll
            for (int mb = 0; mb < 2; ++mb) { u32x4 wv; wv.x = cvt_pk_bf16(S[2 * mb][0], S[2 * mb][1]); wv.y = cvt_pk_bf16(S[2 * mb][2], S[2 * mb][3]);
                wv.z = cvt_pk_bf16(S[2 * mb + 1][0], S[2 * mb + 1][1]); wv.w = cvt_pk_bf16(S[2 * mb + 1][2], S[2 * mb + 1][3]); sf[mb] = __builtin_bit_cast(bf16x8, wv); }
#pragma unroll
            for (int kt = 0; kt < 4; ++kt) { const int k2 = 16 * kt + lq;
                const f32x4 nv = *(const LAS f32x4*)(slot + SC_NN + lq * 256 + (((4 * kt + g) ^ lq) << 4));
                const f32x4 gc = *(const LAS f32x4*)(slot + SC_GC + (16 * kt + 4 * g) * 4);
                f32x4 a = S[kt] * gc + nv;
#pragma unroll
                for (int mb = 0; mb < 2; ++mb) {
                    const u32x2 lo = *(const LAS u32x2*)(slot + SC_PT + k2 * 128 + (((4 * mb + (g >> 1)) ^ (k2 & 7)) << 4) + 8 * (g & 1));
                    const u32x2 hi = *(const LAS u32x2*)(slot + SC_PT + k2 * 128 + (((4 * mb + 2 + (g >> 1)) ^ (k2 & 7)) << 4) + 8 * (g & 1));
                    const bf16x8 pf = __builtin_bit_cast(bf16x8, (u32x4){lo.x, lo.y, hi.x, hi.y});
                    a = __builtin_amdgcn_mfma_f32_16x16x32_bf16(pf, sf[mb], a, 0, 0, 0); }
                S[kt] = a; }
        }
    }
    asm volatile("s_waitcnt vmcnt(0) lgkmcnt(0)" ::: "memory"); __builtin_amdgcn_s_barrier(); asm volatile("" ::: "memory");
    if (w == 0) { __builtin_amdgcn_fence(__ATOMIC_RELEASE, "agent"); if (lane == 0) __hip_atomic_fetch_add(F.ctl + CW_SCAN + 64 * bh, 1u, RLX_AGENT); }
}
__device__ __forceinline__ void scan_wait(Frame& F, int bh) {
    unsigned spins = 0;
    while ((unsigned)__builtin_amdgcn_readfirstlane((int)__hip_atomic_load(F.ctl + CW_SCAN + 64 * bh, RLX_AGENT)) < 4u) {
        if (++spins > 4000000u) { if (F.lane == 0) __hip_atomic_store(F.ctl + CW_TMO, 0x300u | (unsigned)bh, RLX_AGENT); break; }
        __builtin_amdgcn_s_sleep(2); }
    __builtin_amdgcn_fence(__ATOMIC_ACQUIRE, "agent");
}

__device__ __forceinline__ void phase_c(Frame& F, int b, int c, int h) {
    const int lane = F.lane, g = lane >> 4, lq = lane & 15;
    const size_t item = (size_t)(b * RH + h) * NCHUNK + c; const int n0 = b * T + c * CH;
    const bf16* QT = (const bf16*)(F.ws + WS_QT) + item * 4096; const bf16* S0 = (const bf16*)(F.ws + WS_S0) + item * 4096; const float* YL = (const float*)(F.ws + WS_YLOC) + item * 4096;
    const bf16* PROJ = (const bf16*)(F.ws + WS_PROJ); const float* mu = F.in[I_MU];
    bf16x8 sb[4][2];
#pragma unroll
    for (int tc = 0; tc < 4; ++tc)
#pragma unroll
        for (int ks = 0; ks < 2; ++ks) sb[tc][ks] = *(const GAS bf16x8*)(S0 + (size_t)(16 * tc + lq) * 64 + 32 * ks + 8 * g);
    float pmu[4], plg[4], plb[4];
#pragma unroll
    for (int tc = 0; tc < 4; ++tc) { const int hv = h * RN + 16 * tc + lq; pmu[tc] = mu[C_V + hv]; plg[tc] = F.in[I_LNG][hv]; plb[tc] = F.in[I_LNB][hv]; }
#pragma unroll 1
    for (int tr = 0; tr < 4; ++tr) {
        bf16x8 qa[2]; f32x4 y[4]; float bsv[4]; unsigned short pv[4][5], pg[4][4];
#pragma unroll
        for (int ks = 0; ks < 2; ++ks) qa[ks] = *(const GAS bf16x8*)(QT + (size_t)(16 * tr + lq) * 64 + 32 * ks + 8 * g);
#pragma unroll
        for (int tc = 0; tc < 4; ++tc)
#pragma unroll
            for (int i = 0; i < 4; ++i) y[tc][i] = YL[(size_t)(16 * tr + 4 * g + i) * 64 + 16 * tc + lq];
#pragma unroll
        for (int i = 0; i < 4; ++i) bsv[i] = ((const float*)(F.ws + WS_BS))[(size_t)(n0 + 16 * tr + 4 * g + i) * RH + h];
#pragma unroll
        for (int ii = 0; ii < 5; ++ii) { const int t = 16 * tr + 4 * g + ii - 1; const bf16* row = PROJ + (size_t)(n0 + ((c == 0 && t < 0) ? 0 : t)) * PCOLS + C_V + h * RN + lq;
#pragma unroll
            for (int tc = 0; tc < 4; ++tc) pv[tc][ii] = row[16 * tc]; }
#pragma unroll
        for (int i = 0; i < 4; ++i) { const bf16* grow = (const bf16*)(F.ws + WS_GATE) + (size_t)(n0 + 16 * tr + 4 * g + i) * RW + h * RN + lq;
#pragma unroll
            for (int tc = 0; tc < 4; ++tc) pg[tc][i] = grow[16 * tc]; }
        __builtin_amdgcn_sched_barrier(0);
#pragma unroll
        for (int tc = 0; tc < 4; ++tc) {
#pragma unroll
            for (int i = 0; i < 4; ++i) DBGCNT(F, 0, !(fabsf(y[tc][i]) < 1e4f));
#ifndef DBG_NO_STATE
#pragma unroll
            for (int ks = 0; ks < 2; ++ks) y[tc] = __builtin_amdgcn_mfma_f32_16x16x32_bf16(qa[ks], sb[tc][ks], y[tc], 0, 0, 0);
#endif
            }
#pragma unroll
        for (int i = 0; i < 4; ++i) { const int t = 16 * tr + 4 * g + i, n = n0 + t;
            float s = (y[0][i] + y[1][i]) + (y[2][i] + y[3][i]); s += __shfl_xor(s, 1); s += __shfl_xor(s, 2); s += __shfl_xor(s, 4); s += __shfl_xor(s, 8);
            const float mean = s * (1.f / 64.f); float q = 0.f;
#pragma unroll
            for (int tc = 0; tc < 4; ++tc) { const float dlt = y[tc][i] - mean; q += dlt * dlt; }
            q += __shfl_xor(q, 1); q += __shfl_xor(q, 2); q += __shfl_xor(q, 4); q += __shfl_xor(q, 8);
            const float rstd = __builtin_amdgcn_rsqf(q * (1.f / 64.f) + GN_EPS);
            const bool hasp = !(c == 0 && t == 0);
#pragma unroll
            for (int tc = 0; tc < 4; ++tc) { const int hv = h * RN + 16 * tc + lq;
                const unsigned short vc = pv[tc][i + 1]; unsigned short vp = pv[tc][i]; if (!hasp) vp = 0;
                const float vm = mixf(vc, vp, pmu[tc]);
                const float yn = (y[tc][i] - mean) * rstd * plg[tc] + plb[tc];
                const float gt = bf2f(pg[tc][i]);
                float ov = (yn + bsv[i] * vm) * gt;
#ifdef DBG_ZERO_RWKV
                ov = 0.f;
#endif
#ifdef DBG_SCRUB_RWKV
                if (!(fabsf(ov) < 1e30f)) ov = 0.f;
#endif
                ((bf16*)(F.ws + WS_CAT))[(size_t)n * D + hv] = (bf16)f2bf(ov); }
        }
    }
}
}
__device__ __forceinline__ void diff_attn_phase(Frame& F) {
    const int lane = F.lane, w = F.wave, r = lane & 31, h = lane >> 5, rg = w >> 1, c = w & 1;
    float lam;
    { const float a = F.in[I_LQ1][lane] * F.in[I_LK1][lane], b2 = F.in[I_LQ2][lane] * F.in[I_LK2][lane]; lam = fexp(wave_sum(a)) - fexp(wave_sum(b2)) + LAMBDA_INIT; }
    const bf16* PROJ = (const bf16*)(F.ws + WS_PROJ); const bf16* VT = (const bf16*)(F.ws + WS_VT); bf16* CAT = (bf16*)(F.ws + WS_CAT);
    LAS float* xch = (LAS float*)F.lds;
    const bool tab = (F.G == 256);
    for (int p = F.bid; p < 256; p += F.G) {
#pragma unroll 1
        for (int s = 0; s < 2; ++s) { int bh, qb;
            if (tab) { const int u = attn_tab[F.bid][s]; if (u == 0xFFFF) break; bh = u >> 6; qb = u & 63; }
            else { bh = p >> 5; const int j = p & 31; qb = s ? 63 - j : j; }
            const int b = bh >> 2, hd = bh & 3; const int row0 = b * T + 128 * qb + 32 * rg;
            DiffBody32 body; f32x16 o[4]; float ls;
            const int nkt = 2 * qb + 2, nkt_w = (rg < 2) ? nkt - 1 : nkt;
            body.run(F.lds, PROJ + (size_t)row0 * PCOLS + C_QD + hd * 128 + c * 64, PCOLS, 0.125f * LOG2E, PROJ + (size_t)(b * T) * PCOLS + C_KD + hd * 128, PCOLS,
                     VT + (size_t)(hd * DV) * M + b * T, M, nkt, nkt_w, c, o, ls, F.tid, lane);
            if (c == 1) { const float sc = lam / ls;
#pragma unroll
                for (int db = 0; db < 4; ++db)
#pragma unroll
                    for (int i = 0; i < 16; ++i) xch[(rg * 64 + db * 16 + i) * 64 + lane] = o[db][i] * sc; }
            asm volatile("s_waitcnt lgkmcnt(0)" ::: "memory"); __builtin_amdgcn_s_barrier(); asm volatile("" ::: "memory");
            if (c == 0) { const float i0 = 1.f / ls; float q = 0.f;
#pragma unroll
                for (int db = 0; db < 4; ++db)
#pragma unroll
                    for (int i = 0; i < 16; ++i) { const float v = o[db][i] * i0 - xch[(rg * 64 + db * 16 + i) * 64 + lane]; o[db][i] = v; q += v * v; }
                { const auto r2 = __builtin_amdgcn_permlane32_swap(__float_as_uint(q), __float_as_uint(q), false, false); q = __uint_as_float(r2[0]) + __uint_as_float(r2[1]); }
                const float rstd = __builtin_amdgcn_rsqf(q * (1.f / DV) + NORM_EPS) * (1.f - LAMBDA_INIT);
                bf16* orow = CAT + (size_t)(row0 + r) * D + RW + hd * DV;
#pragma unroll
                for (int db = 0; db < 4; ++db)
#pragma unroll
                    for (int t = 0; t < 4; ++t) { const int dv = 32 * db + 8 * t + 4 * h; const f32x4 sg = *(const GAS f32x4*)(F.in[I_SUBG] + dv);
                        u32x2 wv; wv.x = cvt_pk_bf16(o[db][4 * t] * rstd * sg[0], o[db][4 * t + 1] * rstd * sg[1]); wv.y = cvt_pk_bf16(o[db][4 * t + 2] * rstd * sg[2], o[db][4 * t + 3] * rstd * sg[3]);
#ifdef DBG_ZERO_DIFF
                        wv.x = 0u; wv.y = 0u;
#endif
                        *(GAS u32x2*)(orow + dv) = wv; } }
            asm volatile("s_waitcnt lgkmcnt(0)" ::: "memory"); __builtin_amdgcn_s_barrier(); asm volatile("" ::: "memory");
        }
    }
}
__device__ __forceinline__ void cross_attn_phase(Frame& F, const int* ubase, int nunit) {
    typedef AttnBody<1, XD, XD, 2, 8> Body;
    const int lane = F.lane, w = F.wave, g = lane >> 4, lq = lane & 15;
    const bf16* QX = (const bf16*)(F.ws + WS_QX); const bf16* KM = (const bf16*)(F.ws + WS_KMEM); const bf16* VTM = (const bf16*)(F.ws + WS_VTMEM); bf16* XO = (bf16*)(F.ws + WS_XO);
#pragma unroll 1
    for (int uu = 0; uu < 2 * nunit; ++uu) { const int u = ubase[uu >> 1] + (uu & 1); const int bh = u >> 6, rb = u & 63, b = bh >> 2, h = bh & 3; const int row0 = b * T + 128 * rb + 16 * w;
        Body body; f32x4 o[1][16]; float ls[1];
        body.run(F.lds, QX + (size_t)row0 * D + h * XD, D, 1.0f, KM + (size_t)(b * MEM) * D + h * XD, D, VTM + (size_t)(h * XD) * (BATCH * MEM) + b * MEM, BATCH * MEM, 4, 4, false, o, ls, F.tid, lane);
        const float inv = pg8::F8_SXO / ls[0]; unsigned char* orow = (unsigned char*)XO + (size_t)(row0 + lq) * D + h * XD;
#pragma unroll
        for (int dt = 0; dt < 16; ++dt) { const f32x4 y = o[0][dt] * inv; *(GAS unsigned*)(orow + 16 * dt + 4 * g) = pk4_fp8(y[0], y[1], y[2], y[3]); }
    }
}

constexpr int RT_LCNT = X_OFF + 4096, RT_GBASE = RT_LCNT + 128, RT_ENTE = RT_GBASE + 128, RT_ENTP = RT_ENTE + 1024, RT_LGT = RT_ENTP + 1024;
__device__ __forceinline__ void router_phase(Frame& F, int cw_cnt, size_t ws_lists, size_t ws_gates) {
    const int lane = F.lane, w = F.wave, tid = F.tid;
    LAS int* lcnt = (LAS int*)(F.lds + RT_LCNT); LAS int* gbase = (LAS int*)(F.lds + RT_GBASE); LAS int* ente = (LAS int*)(F.lds + RT_ENTE); LAS int* entp = (LAS int*)(F.lds + RT_ENTP); LAS float* lgt = (LAS float*)(F.lds + RT_LGT);
    const float* H2 = (const float*)(F.ws + WS_H2); const float* RWT = (const float*)(F.ws + WS_RWT); const float* SS3 = (const float*)(F.ws + WS_SS3);
    int* lists = (int*)(F.ws + ws_lists); float* lgate = (float*)(F.ws + ws_gates); float* lrinv = lgate + (size_t)NE * CAP;
    LAS float* entg = (LAS float*)(F.lds + RT_LGT + 8448); LAS float* entr = entg + 256;
#pragma unroll 1
    for (int blk = F.bid; blk < M / 64; blk += F.G) {
        if (tid < NE) lcnt[tid] = 0;
        __syncthreads();
        const int nb = blk * 64 + w * 8;
        { const int lq = lane & 15, g = lane >> 4; LAS float* part = (LAS float*)F.lds;
          const u32x2* ap = (const u32x2*)((const bf16*)H2 + (size_t)(blk * 64 + lq) * D + 128 * w + 4 * g); const f32x4* bp = (const f32x4*)(RWT + (size_t)lq * D + 128 * w + 4 * g);
          u32x2 a[3][8]; f32x4 b[2][8], acc[4][2];
#define RT_LDA(slot, tt) do { _Pragma("unroll") for (int j = 0; j < 8; ++j) a[slot][j] = ap[(size_t)(tt) * 16 * (D / 4) + 4 * j]; } while (0)
#define RT_MMA(slot, tt) do { acc[tt][0] = (f32x4){0.f, 0.f, 0.f, 0.f}; acc[tt][1] = acc[tt][0]; _Pragma("unroll") for (int j = 0; j < 8; ++j) { \
              const f32x4 af = (f32x4){bflo(a[slot][j].x), bfhi(a[slot][j].x), bflo(a[slot][j].y), bfhi(a[slot][j].y)}; _Pragma("unroll") for (int m = 0; m < 4; ++m) { \
              acc[tt][0] = __builtin_amdgcn_mfma_f32_16x16x4f32(af[m], b[0][j][m], acc[tt][0], 0, 0, 0); acc[tt][1] = __builtin_amdgcn_mfma_f32_16x16x4f32(af[m], b[1][j][m], acc[tt][1], 0, 0, 0); } } } while (0)
#pragma unroll
          for (int et = 0; et < 2; ++et)
#pragma unroll
              for (int j = 0; j < 8; ++j) b[et][j] = bp[(size_t)et * 16 * (D / 4) + 4 * j];
          RT_LDA(0, 0); RT_LDA(1, 1); RT_LDA(2, 2); __builtin_amdgcn_sched_barrier(0);
          RT_MMA(0, 0); __builtin_amdgcn_sched_barrier(0);
          RT_LDA(0, 3); __builtin_amdgcn_sched_barrier(0);
          RT_MMA(1, 1); RT_MMA(2, 2); __builtin_amdgcn_sched_barrier(0);
          RT_MMA(0, 3);
#undef RT_LDA
#undef RT_MMA
#pragma unroll
          for (int tt = 0; tt < 4; ++tt)
#pragma unroll
              for (int et = 0; et < 2; ++et)
#pragma unroll
                  for (int i = 0; i < 4; ++i) part[(w * 64 + tt * 16 + 4 * g + i) * 33 + et * 16 + lq] = acc[tt][et][i];
          __syncthreads();
#pragma unroll
          for (int q = 0; q < 4; ++q) { const int o = tid + 512 * q, tok = o >> 5, e = o & 31; float sum = 0.f;
#pragma unroll
              for (int ww = 0; ww < 8; ++ww) sum += part[(ww * 64 + tok) * 33 + e];
              lgt[tok * 33 + e] = sum; } }
        __syncthreads();
        if (lane < 8) { const int tl = w * 8 + lane, n = blk * 64 + tl;
            const float rinv = __builtin_amdgcn_rsqf(row_ss(SS3, n) * (1.f / D) + NORM_EPS);
            float v0 = -INFINITY, v1 = -INFINITY, v2 = -INFINITY, v3 = -INFINITY; int e0 = 0, e1 = 0, e2 = 0, e3 = 0;
#pragma unroll
            for (int e = 0; e < NE; ++e) { float x = lgt[tl * 33 + e] * rinv + F.in[I_RB][e]; if (!(x == x)) x = -3.0e38f;
                const bool c0 = x > v0, c1 = x > v1, c2 = x > v2, c3 = x > v3;
                v3 = c3 ? (c2 ? v2 : x) : v3; e3 = c3 ? (c2 ? e2 : e) : e3;
                v2 = c2 ? (c1 ? v1 : x) : v2; e2 = c2 ? (c1 ? e1 : e) : e2;
                v1 = c1 ? (c0 ? v0 : x) : v1; e1 = c1 ? (c0 ? e0 : e) : e1;
                v0 = c0 ? x : v0; e0 = c0 ? e : e0; }
            const float x1 = fexp(v1 - v0), x2 = fexp(v2 - v0), x3 = fexp(v3 - v0); const float inv = 1.f / (1.f + x1 + x2 + x3);
            const int es[4] = {e0, e1, e2, e3}; const float gs[4] = {inv, x1 * inv, x2 * inv, x3 * inv};
#pragma unroll
            for (int k = 0; k < 4; ++k) { const int li = tl * 4 + k; const int lp = __hip_atomic_fetch_add(&lcnt[es[k]], 1, __ATOMIC_RELAXED, __HIP_MEMORY_SCOPE_WORKGROUP); ente[li] = es[k]; entp[li] = lp; entg[li] = gs[k]; entr[li] = rinv; }
        }
        __syncthreads();
        if (tid < NE) gbase[tid] = (int)__hip_atomic_fetch_add((unsigned*)(F.ctl + cw_cnt + 64 * tid), (unsigned)lcnt[tid], RLX_AGENT);
#ifdef DUP_ATOM
        if (tid < NE) lgt[tid] = (float)__hip_atomic_fetch_add((unsigned*)(F.ctl + cw_cnt + 8192 + 64 * tid), (unsigned)lcnt[tid], RLX_AGENT);
#endif
        __syncthreads();
        if (tid < 256) { const int ee = ente[tid]; const size_t pos = (size_t)ee * CAP + gbase[ee] + entp[tid]; lists[pos] = blk * 256 + tid; lgate[pos] = entg[tid]; lrinv[pos] = entr[tid]; }
        __syncthreads();
    }
}
__device__ __forceinline__ void final_phase(Frame& F) {
    const int gw = F.bid * NWAVES + F.wave, NGW = F.G * NWAVES, lane = F.lane;
    const float* H2 = (const float*)(F.ws + WS_H2); const unsigned char* Y = F.ws + WS_YBUF;
    f32x4 gg[4];
#pragma unroll
    for (int j = 0; j < 4; ++j) gg[j] = *((const GAS f32x4*)F.in[I_FG] + 4 * lane + j);
    for (int n = gw; n < M; n += NGW) {
        f32x4 v[4]; u32x4 y[4];
        { const u32x4 h0 = __builtin_nontemporal_load((const GAS u32x4*)((const bf16*)H2 + (size_t)n * D) + 2 * lane), h1 = __builtin_nontemporal_load((const GAS u32x4*)((const bf16*)H2 + (size_t)n * D) + 2 * lane + 1);
          v[0] = (f32x4){bflo(h0.x), bfhi(h0.x), bflo(h0.y), bfhi(h0.y)}; v[1] = (f32x4){bflo(h0.z), bfhi(h0.z), bflo(h0.w), bfhi(h0.w)};
          v[2] = (f32x4){bflo(h1.x), bfhi(h1.x), bflo(h1.y), bfhi(h1.y)}; v[3] = (f32x4){bflo(h1.z), bfhi(h1.z), bflo(h1.w), bfhi(h1.w)}; }
#pragma unroll
        for (int k = 0; k < 4; ++k) y[k] = __builtin_nontemporal_load((const GAS u32x4*)(Y + (size_t)(n * 4 + k) * D) + lane);
        float s = 0.f;
#pragma unroll
        for (int j = 0; j < 4; ++j) {
            f32x4 a = (f32x4){0.f, 0.f, 0.f, 0.f};
#pragma unroll
            for (int k = 0; k < 4; ++k) { const f32x2 lo = __builtin_amdgcn_cvt_pk_f32_fp8((int)y[k][j], false), hi = __builtin_amdgcn_cvt_pk_f32_fp8((int)y[k][j], true);
                a[0] += lo[0]; a[1] += lo[1]; a[2] += hi[0]; a[3] += hi[1]; }
            v[j] = v[j] + a * (1.0f / pg8::F8_SY);
            s += (v[j].x * v[j].x + v[j].y * v[j].y) + (v[j].z * v[j].z + v[j].w * v[j].w); }
        float rstd = 1.f / sqrtf(wave_sum(s) * (1.f / D) + NORM_EPS);
#pragma unroll
        for (int j = 0; j < 4; ++j) __builtin_nontemporal_store(v[j] * rstd * gg[j], (GAS f32x4*)(F.out + (size_t)n * D) + 4 * lane + j);
    }
}

constexpr int NPHASE = 13;
#ifndef P1_GEMM_WGS
#define P1_GEMM_WGS 172
#endif
#if P1_GEMM_WGS >= 170
#define P1_ROT_VT (P1_GEMM_WGS - 16)
#define P1_ROT_K (P1_GEMM_WGS - 144)
#define P1_ROT_V (P1_GEMM_WGS - 152)
#else
#define P1_ROT_VT 0
#define P1_ROT_K 16
#define P1_ROT_V 8
#endif
struct Args { const float* in[34]; float* out; unsigned char* ws; int ph_lo, ph_hi; };
__global__ void __launch_bounds__(NTHR, 2) fwd_kernel(Args args) {
    extern __shared__ __attribute__((aligned(16))) unsigned char lds[];
    Frame F;
    F.lds = (LAS unsigned char*)lds; F.MISC = (volatile LAS unsigned*)(F.lds + MISC_OFF);
    F.tid = threadIdx.x; F.lane = F.tid & 63; F.wave = __builtin_amdgcn_readfirstlane(F.tid >> 6);
    F.G = gridDim.x; F.bid = blockIdx.x; F.ws = args.ws; F.ctl = (gu32*)(args.ws + WS_CTL); F.out = args.out;
#pragma unroll
    for (int i = 0; i < 34; ++i) F.in[i] = args.in[i];
    for (int u = F.tid; u < (LDS_BYTES - MISC_OFF) / 4; u += NTHR) ((LAS unsigned*)(F.lds + MISC_OFF))[u] = 0u;
    __syncthreads();
    XcdBarrier bar = xcd_barrier_post((unsigned*)(F.ctl + CW_BAR), F.MISC + 8);
    const int lo = args.ph_lo, hi = args.ph_hi;
#ifndef PHM
#define PHM 0xffff
#endif
#define IN(k) (((PHM >> (k)) & 1) && lo <= (k) && (k) < hi)
#ifdef DUP_BARRIER
#define SEAM(k) do { if (IN(k) && IN((k) + 1)) { xcd_barrier(bar); if ((k) == DUP_BARRIER || DUP_BARRIER == 99) { xcd_barrier(bar); } } } while (0)
#else
#define SEAM(k) do { if (IN(k) && IN((k) + 1)) xcd_barrier(bar); } while (0)
#endif
    LAS int* lstage = (LAS int*)(F.lds + X_OFF);
    LAS int* moe_tb = (LAS int*)(F.lds + X_OFF + 2048); LAS int* moe_cn = (LAS int*)(F.lds + X_OFF + 2048 + 256); LAS int* moe_rte = (LAS int*)(F.lds + X_OFF + 2048 + 512);

#define RETID() do { int t_ = threadIdx.x; asm volatile("" : "+v"(t_)); F.tid = t_; F.lane = t_ & 63; } while (0)
    if (IN(0)) { RETID(); p0_prologue(F);
#if defined(DUP_PHASE) && DUP_PHASE == 0
        { RETID(); p0_prologue(F);  }
#endif
    } SEAM(0);
    if (IN(1)) { RETID();
        const int NG1 = (F.G == 256) ? P1_GEMM_WGS : F.G;
        if (F.bid < NG1) {
        const bf16* XN = (const bf16*)(F.ws + WS_XN); const bf16* WinT = (const bf16*)(F.ws + WS_WINT); const bf16* MEMN = (const bf16*)(F.ws + WS_MEMN); const bf16* WkvT = (const bf16*)(F.ws + WS_WKVT);
        { pg8::Gemm g{XN, WinT, D, 0, nullptr}; pg8::StaticOrder S; S.init(M, PCOLS, NG1, F.bid, 0); pg8::EpiBf16 E{(bf16*)(F.ws + WS_PROJ), PCOLS};
          pg8::gemm_phase<pg8::EpiBf16, pg8::StaticOrder, true, false>(F.lds, lstage, g, S, E); }
        { pg8::Gemm g{WinT + (size_t)C_VD * D, XN, D, 0, nullptr}; pg8::StaticOrder S; S.init(512, M, NG1, F.bid, P1_ROT_VT); pg8::EpiBf16 E{(bf16*)(F.ws + WS_VT), M};
          pg8::gemm_phase<pg8::EpiBf16, pg8::StaticOrder, true, false>(F.lds, lstage, g, S, E); }
        { pg8::Gemm g{MEMN, WkvT, D, 0, nullptr}; pg8::StaticOrder S; S.init(BATCH * MEM, D, NG1, F.bid, P1_ROT_K); pg8::EpiBf16 E{(bf16*)(F.ws + WS_KMEM), D};
          pg8::gemm_phase<pg8::EpiBf16, pg8::StaticOrder, true, false>(F.lds, lstage, g, S, E); }
        { pg8::Gemm g{WkvT + (size_t)D * D, MEMN, D, 0, nullptr}; pg8::StaticOrder S; S.init(D, BATCH * MEM, NG1, F.bid, P1_ROT_V); pg8::EpiBf16 E{(bf16*)(F.ws + WS_VTMEM), BATCH * MEM};
          pg8::gemm_phase<pg8::EpiBf16, pg8::StaticOrder, true, false>(F.lds, lstage, g, S, E); }

        }
        if (NG1 == F.G || F.bid >= NG1) p0_experts(F, NG1 == F.G ? 0 : NG1);
    } SEAM(1);
    if (IN(2)) { RETID(); for (int it = F.bid; it < BATCH * NCHUNK; it += F.G) rk::phase_a(F, it / NCHUNK, it % NCHUNK);
#if defined(DUP_PHASE) && DUP_PHASE == 2
        { RETID(); for (int it = F.bid; it < BATCH * NCHUNK; it += F.G) rk::phase_a(F, it / NCHUNK, it % NCHUNK);  }
#endif
    } SEAM(2);
    if (IN(3)) { RETID();
        for (int it = F.bid; it < BATCH * RH * 4; it += F.G) rk::phase_scan(F, it >> 2, it & 3);
#ifdef DUP_SCAN
        for (int it = F.bid; it < BATCH * RH * 4; it += F.G) rk::phase_scan(F, it >> 2, it & 3);
#endif
        diff_attn_phase(F);
#ifdef DUP_ATTN
        diff_attn_phase(F);
#endif

#if defined(DUP_PHASE) && DUP_PHASE == 3
        { RETID();
        for (int it = F.bid; it < BATCH * RH * 4; it += F.G) rk::phase_scan(F, it >> 2, it & 3);
        diff_attn_phase(F);
     }
#endif
    }
    if (IN(4)) { RETID(); for (int it = F.bid; it < BATCH * NCHUNK; it += F.G) { rk::scan_wait(F, (it / NCHUNK) * RH + F.wave); rk::phase_c(F, it / NCHUNK, it % NCHUNK, F.wave); }
    } SEAM(4);
    if (IN(5)) { RETID(); pg8::Gemm g{(const bf16*)(F.ws + WS_CAT), (const bf16*)(F.ws + WS_WOUTT), D, 0, nullptr}; pg8::StaticOrder S; S.init(M, D, F.G, F.bid, 0);
        pg8::EpiResid2T<2> E{F.in[I_X], nullptr, nullptr, (bf16*)(F.ws + WS_H1B), (float*)(F.ws + WS_SS1), nullptr, F.ws + WS_H1, 1.0f};
        pg8::gemm_phase<pg8::EpiResid2T<2>, pg8::StaticOrder, true, false>(F.lds, lstage, g, S, E);
#if defined(DUP_PHASE) && DUP_PHASE == 5
        { RETID(); pg8::Gemm g{(const bf16*)(F.ws + WS_CAT), (const bf16*)(F.ws + WS_WOUTT), D, 0, nullptr}; pg8::StaticOrder S; S.init(M, D, F.G, F.bid, 0);
        pg8::EpiResid2T<2> E{F.in[I_X], nullptr, nullptr, (bf16*)(F.ws + WS_H1B), (float*)(F.ws + WS_SS1), nullptr, F.ws + WS_H1, 1.0f};
        pg8::gemm_phase<pg8::EpiResid2T<2>, pg8::StaticOrder, true, false>(F.lds, lstage, g, S, E);  }
#endif
    } SEAM(5);
    if (IN(6)) { RETID(); pg8::Gemm g{(const bf16*)(F.ws + WS_H1), (const bf16*)(F.ws + WS_WQT), D / 2, 0, nullptr}; pg8::StaticOrder S; S.init(M, D, F.G, F.bid, 0);
        pg8::EpiRowScaleBf16 E{(bf16*)(F.ws + WS_QX), D, (const float*)(F.ws + WS_SS1), 0.0625f * LOG2E / (F8_SA * F8_SW)};
        pg8::gemm_phase<pg8::EpiRowScaleBf16, pg8::StaticOrder, true, false, true>(F.lds, lstage, g, S, E);
        __builtin_amdgcn_fence(__ATOMIC_RELEASE, "workgroup"); __syncthreads(); __builtin_amdgcn_fence(__ATOMIC_ACQUIRE, "workgroup");
        RETID();
        int ub[4]; int nu = 0; pg8::Unit u;
#pragma unroll
        for (int i = 0; i < 4; ++i) if (S.next(i, u)) { ub[i] = ((u.pm >> 5) * 4 + u.pn) * 64 + 2 * (u.pm & 31); nu = i + 1; } else ub[i] = 0;
        cross_attn_phase(F, ub, nu);
    } SEAM(7);
    if (IN(8)) { RETID(); pg8::Gemm g{(const bf16*)(F.ws + WS_XO), (const bf16*)(F.ws + WS_WOT), D / 2, 0, nullptr}; pg8::StaticOrder S; S.init(M, D, F.G, F.bid, 0);
        pg8::EpiResid2T<3> E{nullptr, (const bf16*)(F.ws + WS_H1B), nullptr, (bf16*)(F.ws + WS_H2), (float*)(F.ws + WS_SS3), F.in[I_N3G], F.ws + WS_H2B, 1.0f / (pg8::F8_SXO * F8_SW)};
        pg8::gemm_phase<pg8::EpiResid2T<3>, pg8::StaticOrder, true, false, true>(F.lds, lstage, g, S, E);
#if defined(DUP_PHASE) && DUP_PHASE == 8
        { RETID(); pg8::Gemm g{(const bf16*)(F.ws + WS_XO), (const bf16*)(F.ws + WS_WOT), D / 2, 0, nullptr}; pg8::StaticOrder S; S.init(M, D, F.G, F.bid, 0);
        pg8::EpiResid2T<3> E{nullptr, (const bf16*)(F.ws + WS_H1B), nullptr, (bf16*)(F.ws + WS_H2), (float*)(F.ws + WS_SS3), F.in[I_N3G], F.ws + WS_H2B, 1.0f / (pg8::F8_SXO * F8_SW)};
        pg8::gemm_phase<pg8::EpiResid2T<3>, pg8::StaticOrder, true, false, true>(F.lds, lstage, g, S, E);  }
#endif
    } SEAM(8);
    if (IN(9)) { RETID(); router_phase(F, CW_CNT, WS_LISTS, WS_LGATE);
#if defined(DUP_PHASE) && DUP_PHASE == 9
        { RETID(); router_phase(F, CW_CNT + 4096, WS_YBUF, WS_YBUF + 4 * MiB); }
#endif
    } SEAM(9);
    if (IN(10) || IN(11)) { RETID();
        if (F.tid < NE) moe_cn[F.tid] = (int)__hip_atomic_load(F.ctl + CW_CNT + 64 * F.tid, RLX_AGENT);
        __syncthreads();
        if (F.tid == 0) { int a = 0; for (int e = 0; e < NE; ++e) { moe_tb[e] = a; a += (moe_cn[e] + 255) >> 8; } moe_tb[NE] = a; }
        __syncthreads();
        if (F.tid < MAXRT) { int e = 0; for (int k = 1; k < NE; ++k) e = (F.tid >= moe_tb[k]) ? k : e; moe_rte[F.tid] = e; }
        __syncthreads();
    }
    if (IN(10)) { RETID(); pg8::Gemm g{(const bf16*)F.ws, (const bf16*)F.ws, D / 2, 0, (const int*)(F.ws + WS_LISTS)};
        pg8::MoeOrder2 S{moe_tb, moe_cn, moe_rte, F.G, F.bid, __builtin_amdgcn_readfirstlane(moe_tb[NE]), F.ctl + CW_RDY, (volatile LAS unsigned*)(F.lds + X_OFF + 3840), 64u, F.ctl + CW_TMO};
        pg8::EpiMoeBoth E{pg8::EpiSwiglu{F.ws + WS_ACT, F.in[I_B1], (const float*)(F.ws + WS_LRINV), (const int*)(F.ws + WS_LISTS), true},
                          pg8::EpiMoe2{F.ws + WS_YBUF, F.in[I_B2], (const float*)(F.ws + WS_LGATE), (const int*)(F.ws + WS_LISTS)}};
        pg8::gemm_phase<pg8::EpiMoeBoth, pg8::MoeOrder2, true, true, true>(F.lds, lstage, g, S, E);
    } SEAM(11);
    if (IN(12)) { RETID(); final_phase(F);
#if defined(DUP_PHASE) && DUP_PHASE == 12
        { RETID(); final_phase(F);  }
#endif
    }
#undef IN
#undef SEAM
}

#ifndef MK_SPLIT
#define MK_SPLIT 0
#endif
extern "C" void kernel_launch(void* const* d_in, const int* in_sizes, int n_in, void* d_out, int out_size, void* d_ws, size_t ws_size, hipStream_t stream) {
    static int grid = 0;
    if (grid == 0) {
        if (n_in != 34 || out_size != M * D || ws_size < WS_END) { fprintf(stderr, "kernel_launch: unexpected shapes (n_in %d out %d ws %zu)\n", n_in, out_size, ws_size); grid = -1; return; }
        int dev = 0, cus = 0, per_cu = 0;
        if (hipGetDevice(&dev) != hipSuccess || hipDeviceGetAttribute(&cus, hipDeviceAttributeMultiprocessorCount, dev) != hipSuccess) { grid = -1; return; }
        if (hipFuncSetAttribute((const void*)fwd_kernel, hipFuncAttributeMaxDynamicSharedMemorySize, LDS_BYTES) != hipSuccess) { fprintf(stderr, "kernel_launch: hipFuncSetAttribute failed\n"); grid = -1; return; }
        if (hipOccupancyMaxActiveBlocksPerMultiprocessor(&per_cu, (const void*)fwd_kernel, NTHR, LDS_BYTES) != hipSuccess || per_cu < 1) fprintf(stderr, "kernel_launch: occupancy query reports %d\n", per_cu);
        (void)hipGetLastError();
        grid = cus;
    }
    if (grid < 0) return;
    (void)hipMemsetAsync((char*)d_ws + WS_CTL, 0, CTL_ZERO_BYTES, stream);
    Args a{};
    for (int i = 0; i < 34; ++i) a.in[i] = (const float*)d_in[i];
    a.out = (float*)d_out; a.ws = (unsigned char*)d_ws;
#if MK_SPLIT
    for (int p = 0; p < NPHASE; ++p) { a.ph_lo = p; a.ph_hi = p + 1; hipLaunchKernelGGL(fwd_kernel, dim3(grid), dim3(NTHR), LDS_BYTES, stream, a); }
#else
    a.ph_lo = 0; a.ph_hi = NPHASE; hipLaunchKernelGGL(fwd_kernel, dim3(grid), dim3(NTHR), LDS_BYTES, stream, a);
#endif
}
```
